# Optimizing an MI355X kernel written in HIP

```python
import math
import jax
import jax.numpy as jnp
from jax import lax
import numpy as np

D_MODEL = 1024
BATCH = 8
SEQ = 2048
DEPTH = 4

GRID_W = 64
CTX_LEN = 256
N_BRANCH = 4
BRANCH_W = D_MODEL // 4
S5_GROUP = 16
S5_GROUPS = BRANCH_W // S5_GROUP
S5_STATE = 64
NA_HEAD_DIM = 64
NA_HEADS = BRANCH_W // NA_HEAD_DIM
NA_WIN_ROWS = 8
NA_WIN_COLS = 16
NA_SCALE = NA_HEAD_DIM ** -0.5
CONV_W = 3
CHUNK = 128
SGU_GROUPS = 4
SGU_GROUP_W = BRANCH_W // SGU_GROUPS
D_FF = 4 * D_MODEL
N_MOD = 6
EPS = 1e-6
NEG_INF = -1e30
N_SLOTS = 9
IN_W = N_SLOTS * BRANCH_W + N_BRANCH * D_MODEL
SPLIT_IDX = tuple(BRANCH_W * k for k in range(1, N_SLOTS + 1))

kernel_name = 'hybrid_diffusion_parallel_mixer'


def rms_norm(x, g):
    xf = x.astype(jnp.float32)
    y = xf * lax.rsqrt(jnp.mean(xf * xf, axis=-1, keepdims=True) + EPS)
    return (y * g.astype(jnp.float32)).astype(x.dtype)


def layer_norm(x, g, b):
    xf = x.astype(jnp.float32)
    mu = jnp.mean(xf, axis=-1, keepdims=True)
    var = jnp.mean(jnp.square(xf - mu), axis=-1, keepdims=True)
    y = (xf - mu) * lax.rsqrt(var + EPS)
    return (y * g.astype(jnp.float32) + b.astype(jnp.float32)).astype(x.dtype)


def modulate(h, shift, scale):
    return h * (1 + scale) + shift


def s5_discretize(lam_re, lam_im, log_dt, b_re, b_im):
    dt = jnp.exp(log_dt)[:, None]
    zr, zi = lam_re * dt, lam_im * dt
    mag = jnp.exp(zr)
    ar, ai = mag * jnp.cos(zi), mag * jnp.sin(zi)
    nr, ni = ar - 1.0, ai
    den = lam_re * lam_re + lam_im * lam_im
    cr = (nr * lam_re + ni * lam_im) / den
    ci = (ni * lam_re - nr * lam_im) / den
    bbr = cr[..., None] * b_re - ci[..., None] * b_im
    bbi = cr[..., None] * b_im + ci[..., None] * b_re
    return ar, ai, bbr, bbi


def _cplx_combine(e1, e2):
    a1r, a1i, b1r, b1i = e1
    a2r, a2i, b2r, b2i = e2
    return (a2r * a1r - a2i * a1i, a2r * a1i + a2i * a1r,
            a2r * b1r - a2i * b1i + b2r, a2r * b1i + a2i * b1r + b2i)


def s5_scan(u, ar, ai, bbr, bbi, s0, reverse):
    bur = jnp.einsum('blgh,gph->blgp', u, bbr)
    bui = jnp.einsum('blgh,gph->blgp', u, bbi)
    acr = jnp.broadcast_to(ar, bur.shape)
    aci = jnp.broadcast_to(ai, bur.shape)
    pr, pi_, hr, hi = lax.associative_scan(_cplx_combine, (acr, aci, bur, bui), axis=1, reverse=reverse)
    if s0 is not None:
        s0r, s0i = s0[0][:, None], s0[1][:, None]
        hr = hr + pr * s0r - pi_ * s0i
        hi = hi + pr * s0i + pi_ * s0r
    return hr, hi


def s5_readout(hr, hi, cr, ci):
    y = jnp.einsum('blgp,ghp->blgh', hr, cr) - jnp.einsum('blgp,ghp->blgh', hi, ci)
    return y.reshape(y.shape[0], y.shape[1], BRANCH_W)


def s5_glu(y, w, b):
    g = jax.nn.gelu(y)
    return g * jax.nn.sigmoid(g @ w.astype(jnp.float32) + b.astype(jnp.float32))


def s5_branch(u_lat, u_ctx, lam_re, lam_im, log_dt, b_re, b_im, c_re, c_im, d_skip, glu_w, glu_b, ctx_out):
    f32 = jnp.float32
    bn, seq_len, _ = u_lat.shape
    ctx_len = u_ctx.shape[1]
    ul = u_lat.astype(f32).reshape(bn, seq_len, S5_GROUPS, S5_GROUP)
    uc = u_ctx.astype(f32).reshape(bn, ctx_len, S5_GROUPS, S5_GROUP)
    d32 = d_skip.astype(f32)
    yl = u_lat.astype(f32) * d32
    yc = u_ctx.astype(f32) * d32 if ctx_out else None
    for direction in range(2):
        reverse = direction == 1
        ar, ai, bbr, bbi = s5_discretize(lam_re[direction].astype(f32), lam_im[direction].astype(f32),
                                         log_dt[direction].astype(f32), b_re[direction].astype(f32),
                                         b_im[direction].astype(f32))
        cr, ci = c_re[direction].astype(f32), c_im[direction].astype(f32)
        hcr, hci = s5_scan(uc, ar, ai, bbr, bbi, None, reverse)
        end = 0 if reverse else ctx_len - 1
        hlr, hli = s5_scan(ul, ar, ai, bbr, bbi, (hcr[:, end], hci[:, end]), reverse)
        yl = yl + s5_readout(hlr, hli, cr, ci)
        if ctx_out:
            yc = yc + s5_readout(hcr, hci, cr, ci)
    out_l = s5_glu(yl, glu_w, glu_b).astype(u_lat.dtype)
    out_c = s5_glu(yc, glu_w, glu_b).astype(u_ctx.dtype) if ctx_out else None
    return out_l, out_c


def neighborhood_attention(q, k, v, kc, vc, rpb):
    bn, seq_len, _ = q.shape
    rows = seq_len // GRID_W
    wr = min(NA_WIN_ROWS, rows)
    qg = q.reshape(bn, rows, GRID_W, NA_HEADS, NA_HEAD_DIM) * NA_SCALE
    kg = k.reshape(bn, rows, GRID_W, NA_HEADS, NA_HEAD_DIM)
    vg = v.reshape(bn, rows, GRID_W, NA_HEADS, NA_HEAD_DIM)
    kc = kc.reshape(bn, -1, NA_HEADS, NA_HEAD_DIM)
    vc = vc.reshape(bn, -1, NA_HEADS, NA_HEAD_DIM)
    r = jnp.arange(rows)
    row_start = jnp.clip(r - wr // 2, 0, rows - wr)
    row_idx = row_start[:, None] + jnp.arange(wr)[None, :]
    k_band = kg[:, row_idx]
    v_band = vg[:, row_idx]
    j = jnp.arange(GRID_W)
    col_start = jnp.clip(j - NA_WIN_COLS // 2, 0, GRID_W - NA_WIN_COLS)
    col_ok = (j[None, :] >= col_start[:, None]) & (j[None, :] < col_start[:, None] + NA_WIN_COLS)
    dr = row_idx - r[:, None] + NA_WIN_ROWS - 1
    dc = jnp.clip(j[None, :] - j[:, None] + NA_WIN_COLS - 1, 0, 2 * NA_WIN_COLS - 2)
    bias = rpb[:, dr[:, None, :, None], dc[None, :, None, :]]
    s_win = jnp.einsum('brqhd,brskhd->bhrqsk', qg, k_band).astype(jnp.float32) + bias.astype(jnp.float32)[None]
    s_win = jnp.where(col_ok[:, None, :], s_win, NEG_INF)
    n_win = wr * GRID_W
    s_win = s_win.reshape(bn, NA_HEADS, rows, GRID_W, n_win)
    s_ctx = jnp.einsum('brqhd,bchd->bhrqc', qg, kc).astype(jnp.float32)
    p = jax.nn.softmax(jnp.concatenate([s_win, s_ctx], axis=-1), axis=-1).astype(v.dtype)
    p_win = p[..., :n_win].reshape(bn, NA_HEADS, rows, GRID_W, wr, GRID_W)
    p_ctx = p[..., n_win:]
    o = jnp.einsum('bhrqsk,brskhd->brqhd', p_win, v_band) + jnp.einsum('bhrqc,bchd->brqhd', p_ctx, vc)
    return o.reshape(bn, seq_len, BRANCH_W)


def context_attention(qc, kc, vc):
    bn, ctx_len, _ = qc.shape
    q = qc.reshape(bn, ctx_len, NA_HEADS, NA_HEAD_DIM) * NA_SCALE
    k = kc.reshape(bn, ctx_len, NA_HEADS, NA_HEAD_DIM)
    v = vc.reshape(bn, ctx_len, NA_HEADS, NA_HEAD_DIM)
    s = jnp.einsum('bqhd,bkhd->bhqk', q, k).astype(jnp.float32)
    p = jax.nn.softmax(s, axis=-1).astype(v.dtype)
    return jnp.einsum('bhqk,bkhd->bqhd', p, v).reshape(bn, ctx_len, BRANCH_W)


def short_conv(b_gate, c_gate, xin, w):
    z = c_gate * xin
    y = lax.conv_general_dilated(z, w[:, None, :], window_strides=(1,),
                                 padding=((CONV_W // 2, CONV_W // 2),),
                                 dimension_numbers=('NWC', 'WIO', 'NWC'),
                                 feature_group_count=BRANCH_W)
    return b_gate * y


def spatial_gating(u, v, ln_g, ln_b, w_s, b_s):
    bn, seq_len, _ = v.shape
    vn = layer_norm(v, ln_g, ln_b)
    vg = vn.reshape(bn, seq_len // CHUNK, CHUNK, SGU_GROUPS, SGU_GROUP_W)
    z = jnp.einsum('gts,bnsgc->bntgc', w_s, vg) + b_s.T[None, None, :, :, None]
    return u * z.reshape(bn, seq_len, BRANCH_W)


def merge_branches(ys, gate_logits, w_branch, w_out):
    y = jnp.stack(ys, axis=-2)
    yp = jnp.einsum('blkw,kwd->blkd', y, w_branch)
    g = jax.nn.sigmoid(gate_logits.reshape(gate_logits.shape[0], gate_logits.shape[1], N_BRANCH, D_MODEL))
    return jnp.sum(g * yp, axis=-2) @ w_out


def token_mixers(al, ac, w_in, w_branch, w_out, s5_lam_re, s5_lam_im, s5_log_dt, s5_b_re, s5_b_im,
                 s5_c_re, s5_c_im, s5_d, s5_glu_w, s5_glu_b, na_rpb, conv_w, sgu_ln_g, sgu_ln_b,
                 sgu_w, sgu_b, ctx_out):
    pl = jnp.split(al @ w_in, SPLIT_IDX, axis=-1)
    if ctx_out:
        pc = jnp.split(ac @ w_in, SPLIT_IDX, axis=-1)
    else:
        pc = jnp.split(ac @ w_in[:, :4 * BRANCH_W], SPLIT_IDX[:3], axis=-1)
    ya_l, ya_c = s5_branch(pl[0], pc[0], s5_lam_re, s5_lam_im, s5_log_dt, s5_b_re, s5_b_im,
                           s5_c_re, s5_c_im, s5_d, s5_glu_w, s5_glu_b, ctx_out)
    yb_l = neighborhood_attention(pl[1], pl[2], pl[3], pc[2], pc[3], na_rpb)
    yc_l = short_conv(pl[4], pl[5], pl[6], conv_w)
    yd_l = spatial_gating(pl[7], pl[8], sgu_ln_g, sgu_ln_b, sgu_w, sgu_b)
    out_l = merge_branches((ya_l, yb_l, yc_l, yd_l), pl[9], w_branch, w_out)
    if not ctx_out:
        return out_l, None
    yb_c = context_attention(pc[1], pc[2], pc[3])
    yc_c = short_conv(pc[4], pc[5], pc[6], conv_w)
    yd_c = spatial_gating(pc[7], pc[8], sgu_ln_g, sgu_ln_b, sgu_w, sgu_b)
    out_c = merge_branches((ya_c, yb_c, yc_c, yd_c), pc[9], w_branch, w_out)
    return out_l, out_c


def sq_relu_mlp(h, w1, w2):
    return jnp.square(jax.nn.relu(h @ w1)) @ w2


def setup_inputs(seed: int = 0) -> dict:
    key = jax.random.key(seed)
    ks = jax.random.split(key, 32)
    f32 = jnp.float32

    def nrm(k, shape, scale):
        return jax.random.normal(k, shape, f32) * scale

    n_idx = jnp.arange(S5_STATE, dtype=f32)
    s5_shape = (DEPTH, 2, S5_GROUPS, S5_STATE)
    return {
        'x': nrm(ks[0], (BATCH, SEQ, D_MODEL), 1.0),
        'c': nrm(ks[1], (BATCH, D_MODEL), 1.0),
        'ctx': nrm(ks[2], (BATCH, CTX_LEN, D_MODEL), 1.0),
        'c_ctx': nrm(ks[3], (D_MODEL,), 1.0),
        'ada_w': nrm(ks[4], (DEPTH, D_MODEL, N_MOD * D_MODEL), 0.5 * D_MODEL ** -0.5),
        'ada_b': nrm(ks[5], (DEPTH, N_MOD * D_MODEL), 0.02),
        'norm_g': 1.0 + nrm(ks[6], (DEPTH, 2, D_MODEL), 0.02),
        'final_g': 1.0 + nrm(ks[7], (D_MODEL,), 0.02),
        'w_in': nrm(ks[8], (DEPTH, D_MODEL, IN_W), D_MODEL ** -0.5),
        'w_branch': nrm(ks[9], (DEPTH, N_BRANCH, BRANCH_W, D_MODEL), BRANCH_W ** -0.5),
        'w_out': nrm(ks[10], (DEPTH, D_MODEL, D_MODEL), D_MODEL ** -0.5),
        's5_lam_re': -0.5 * jnp.exp(nrm(ks[11], s5_shape, 0.05)),
        's5_lam_im': math.pi * n_idx + nrm(ks[12], s5_shape, 0.01),
        's5_log_dt': jax.random.uniform(ks[13], (DEPTH, 2, S5_GROUPS), f32, math.log(1e-3), math.log(1e-1)),
        's5_b_re': nrm(ks[14], (DEPTH, 2, S5_GROUPS, S5_STATE, S5_GROUP), (2 * S5_GROUP) ** -0.5),
        's5_b_im': nrm(ks[15], (DEPTH, 2, S5_GROUPS, S5_STATE, S5_GROUP), (2 * S5_GROUP) ** -0.5),
        's5_c_re': nrm(ks[16], (DEPTH, 2, S5_GROUPS, S5_GROUP, S5_STATE), (2 * S5_STATE) ** -0.5),
        's5_c_im': nrm(ks[17], (DEPTH, 2, S5_GROUPS, S5_GROUP, S5_STATE), (2 * S5_STATE) ** -0.5),
        's5_d': nrm(ks[18], (DEPTH, BRANCH_W), 1.0),
        's5_glu_w': nrm(ks[19], (DEPTH, BRANCH_W, BRANCH_W), BRANCH_W ** -0.5),
        's5_glu_b': nrm(ks[20], (DEPTH, BRANCH_W), 0.02),
        'na_rpb': nrm(ks[21], (DEPTH, NA_HEADS, 2 * NA_WIN_ROWS - 1, 2 * NA_WIN_COLS - 1), 0.1),
        'conv_w': nrm(ks[22], (DEPTH, CONV_W, BRANCH_W), CONV_W ** -0.5),
        'sgu_ln_g': 1.0 + nrm(ks[23], (DEPTH, BRANCH_W), 0.02),
        'sgu_ln_b': nrm(ks[24], (DEPTH, BRANCH_W), 0.02),
        'sgu_w': nrm(ks[25], (DEPTH, SGU_GROUPS, CHUNK, CHUNK), CHUNK ** -0.5),
        'sgu_b': 1.0 + nrm(ks[26], (DEPTH, SGU_GROUPS, CHUNK), 0.02),
        'w_ff1': nrm(ks[27], (DEPTH, D_MODEL, D_FF), D_MODEL ** -0.5),
        'w_ff2': nrm(ks[28], (DEPTH, D_FF, D_MODEL), D_FF ** -0.5),
    }


def reference(x, c, ctx, c_ctx, ada_w, ada_b, norm_g, final_g, w_in, w_branch, w_out,
              s5_lam_re, s5_lam_im, s5_log_dt, s5_b_re, s5_b_im, s5_c_re, s5_c_im, s5_d,
              s5_glu_w, s5_glu_b, na_rpb, conv_w, sgu_ln_g, sgu_ln_b, sgu_w, sgu_b, w_ff1, w_ff2):
    silu_c = jax.nn.silu(c)
    silu_cc = jax.nn.silu(c_ctx)
    hl, hc = x, ctx
    for i in range(DEPTH):
        ctx_out = i < DEPTH - 1
        ml = jnp.split((silu_c @ ada_w[i] + ada_b[i])[:, None, :], N_MOD, axis=-1)
        mc = jnp.split(silu_cc @ ada_w[i] + ada_b[i], N_MOD, axis=-1)
        al = modulate(rms_norm(hl, norm_g[i, 0]), ml[0], ml[1])
        ac = modulate(rms_norm(hc, norm_g[i, 0]), mc[0], mc[1])
        yl, yc = token_mixers(al, ac, w_in[i], w_branch[i], w_out[i], s5_lam_re[i], s5_lam_im[i],
                              s5_log_dt[i], s5_b_re[i], s5_b_im[i], s5_c_re[i], s5_c_im[i], s5_d[i],
                              s5_glu_w[i], s5_glu_b[i], na_rpb[i], conv_w[i], sgu_ln_g[i], sgu_ln_b[i],
                              sgu_w[i], sgu_b[i], ctx_out)
        hl = hl + ml[2] * yl
        bl = modulate(rms_norm(hl, norm_g[i, 1]), ml[3], ml[4])
        hl = hl + ml[5] * sq_relu_mlp(bl, w_ff1[i], w_ff2[i])
        if ctx_out:
            hc = hc + mc[2] * yc
            bc = modulate(rms_norm(hc, norm_g[i, 1]), mc[3], mc[4])
            hc = hc + mc[5] * sq_relu_mlp(bc, w_ff1[i], w_ff2[i])
    return rms_norm(hl, final_g)
```

```cpp
#include <hip/hip_runtime.h>
#include <hip/hip_cooperative_groups.h>
namespace cg = cooperative_groups;

#define LAS __attribute__((address_space(3)))
typedef unsigned short bf16_t;
typedef short bf16x8 __attribute__((ext_vector_type(8)));
typedef float f32x4 __attribute__((ext_vector_type(4)));
typedef unsigned u32x4 __attribute__((ext_vector_type(4)));
typedef unsigned u32x2 __attribute__((ext_vector_type(2)));

#ifndef PHMASK
#define PHMASK 0x7ff
#endif
#ifndef MULTI_LAUNCH
#define MULTI_LAUNCH 0
#endif

constexpr int DM = 1024, NB = 8, SEQL = 2048, NDEPTH = 4, CTXL = 256, DFF = 4096, INW = 6400;
constexpr int ML = NB * SEQL;
constexpr int MC = NB * CTXL;
constexpr int MT = ML + MC;
constexpr int TCH = 32;
constexpr int NCHUNK = MT / TCH;
constexpr int XUR = 768;
constexpr int XUK = 768;

constexpr size_t OFF_H = 0;
constexpr size_t OFF_A = OFF_H + (size_t)MT * DM * 4;
constexpr size_t OFF_MIX = OFF_A + (size_t)MT * DM * 2;
constexpr size_t OFF_R1 = OFF_MIX + (size_t)MT * DM * 2;
constexpr size_t OFF_PS = OFF_R1;
constexpr size_t OFF_Y4 = OFF_PS + (size_t)MT * 2304 * 2;
constexpr size_t OFF_VT = OFF_Y4 + (size_t)MT * DM * 2;
constexpr size_t OFF_XU = OFF_VT + (size_t)NB * 4 * 64 * 2304 * 2;
constexpr size_t OFF_S = OFF_XU + (size_t)16 * XUR * XUK * 2;
constexpr size_t OFF_YG = OFF_S + (size_t)16 * NCHUNK * 256 * 4;
constexpr size_t OFF_R1END = OFF_YG + (size_t)MT * 256 * 2;
constexpr size_t OFF_FFH = OFF_R1;
constexpr size_t OFF_MIXTMP = OFF_PS;
constexpr size_t OFF_GS = OFF_VT;
constexpr size_t OFF_WIN = OFF_R1END;
constexpr size_t OFF_WFF1 = OFF_WIN + (size_t)INW * DM * 2;
constexpr size_t OFF_WFF2 = OFF_WFF1 + (size_t)DFF * DM * 2;
constexpr size_t OFF_WOUT = OFF_WFF2 + (size_t)DFF * DM * 2;
constexpr size_t OFF_WBR = OFF_WOUT + (size_t)DM * DM * 2;
constexpr size_t OFF_WGLU = OFF_WBR + (size_t)DM * DM * 2;
constexpr size_t OFF_W1 = OFF_WGLU + (size_t)256 * 256 * 2;
constexpr size_t OFF_W2 = OFF_W1 + (size_t)16 * 256 * 512 * 2;
constexpr size_t OFF_SGUWT = OFF_W2 + (size_t)16 * 512 * 768 * 2;
constexpr size_t OFF_MOD = OFF_SGUWT + (size_t)4 * 128 * 128 * 4;
constexpr size_t OFF_END = OFF_MOD + (size_t)NDEPTH * 9 * 6144 * 4;
static_assert((size_t)MT * DFF * 2 <= OFF_R1END - OFF_R1, "FFH alias");
static_assert((size_t)256 * 262144 <= (size_t)MT * 2304 * 2, "MIXTMP alias");
static_assert((size_t)256 * 131072 <= OFF_R1END - OFF_VT, "GS alias");
static_assert(OFF_END < 440000000ull, "workspace");

struct P {
  const float *x, *c, *ctx, *c_ctx, *ada_w, *ada_b, *norm_g, *final_g, *w_in, *w_branch, *w_out,
      *lam_re, *lam_im, *log_dt, *b_re, *b_im, *c_re, *c_im, *s5_d, *glu_w, *glu_b, *rpb, *conv_w,
      *ln_g, *ln_b, *sgu_w, *sgu_b, *w_ff1, *w_ff2;
  float* out;
  unsigned char* ws;
  int ph_lo, ph_hi;
};

__device__ __forceinline__ int otid() { int t = threadIdx.x; asm volatile("" : "+v"(t)); return t; }
__device__ __forceinline__ float bf2f(bf16_t b) { return __uint_as_float(((unsigned)b) << 16); }
__device__ __forceinline__ float bflo(unsigned w) { return __uint_as_float(w << 16); }
__device__ __forceinline__ float bfhi(unsigned w) { return __uint_as_float(w & 0xffff0000u); }
__device__ __forceinline__ unsigned cvt_pk_bf16(float lo, float hi) { unsigned r; asm volatile("v_cvt_pk_bf16_f32 %0, %1, %2" : "=v"(r) : "v"(lo), "v"(hi)); return r; }
__device__ __forceinline__ float sigm(float x) { return 1.f / (1.f + __expf(-x)); }
__device__ __forceinline__ float gelu_tanh(float x) { return x * sigm(1.5957691216057308f * (x + 0.044715f * x * x * x)); }
__device__ __forceinline__ u32x4 pack8(f32x4 a, f32x4 b) { u32x4 r; r[0] = cvt_pk_bf16(a[0], a[1]); r[1] = cvt_pk_bf16(a[2], a[3]); r[2] = cvt_pk_bf16(b[0], b[1]); r[3] = cvt_pk_bf16(b[2], b[3]); return r; }
__device__ __forceinline__ float wave_sum(float v) {
#pragma unroll
  for (int o = 32; o >= 1; o >>= 1) v += __shfl_xor(v, o);
  return v;
}

constexpr int BM = 256, BK = 64, HALF = 128, HTB = HALF * BK * 2, NXCD = 8, WGM = 8;
__device__ __forceinline__ int lds_byte(int r, int c) { const int st = (r >> 4) * 2 + (c >> 5), rr = r & 15, cc = c & 31, ob = rr * 64 + cc * 2; return st * 1024 + (ob ^ (((ob >> 9) & 1) << 5)); }
__device__ __forceinline__ void stage_rc(int b, int& R, int& C) { const int st = b / 1024, sb = b % 1024, swz = sb ^ (((sb >> 9) & 1) << 5); R = (st >> 1) * 16 + swz / 64; C = (st & 1) * 32 + (swz % 64) / 2; }
__device__ __forceinline__ int perm32(int rho) { const int n = rho >> 4, i = rho & 15; return 8 * (i >> 2) + 4 * n + (i & 3); }

struct Unit { const char* A; const char* B; int nt, pm, pn, kind; };

__device__ __forceinline__ void rect_map(int L, int nM, int nN, int& pm, int& pn) {
  const int nwg = nM * nN; int wgid = L;
  { const int q = nwg / NXCD, r = nwg % NXCD, xcd = wgid % NXCD, off = wgid / NXCD; wgid = (xcd < r ? xcd * (q + 1) : r * (q + 1) + (xcd - r) * q) + off; }
  const int nig = WGM * nN, gid = wgid / nig, fm = gid * WGM, gsz = (nM - fm) < WGM ? (nM - fm) : WGM;
  pm = fm + ((wgid % nig) % gsz); pn = (wgid % nig) / gsz;
}

template <class Sched, class Epi>
__device__ __forceinline__ void gemm_phase(LAS unsigned char* lds, const int lda, const int ldb, const Sched& S, const Epi& E) {
  int tid_ = threadIdx.x; asm volatile("" : "+v"(tid_));
  const int tid = tid_, wid = __builtin_amdgcn_readfirstlane(tid >> 6), lane = tid & 63, wr = wid >> 2, wc = wid & 3, fr = lane & 15, fq = lane >> 4;
  unsigned voffA[2], voffB[2];
#pragma unroll
  for (int i = 0; i < 2; ++i) { int R, C; stage_rc(tid * 16 + i * 8192, R, C); const int Rb = (R & ~31) + perm32(R & 31);
    voffA[i] = (unsigned)(R * lda + C) * 2u; voffB[i] = (unsigned)(Rb * ldb + C) * 2u; }
  const size_t kstep = (size_t)(BK * 2);
  const size_t hstepA = (size_t)HALF * lda * 2, hstepB = (size_t)HALF * ldb * 2;
  const unsigned ldsw = (unsigned)wid * 1024u;
  const int aoff = lds_byte(wr * 64 + fr, fq * 8), boff = lds_byte(wc * 32 + fr, fq * 8);
#define PG8_SA(b, h) (((b) * 2 + (h)) * HTB)
#define PG8_SB(b, h) ((4 + (b) * 2 + (h)) * HTB)
#define PG8_STAGE(bufoff, gbase, voff) do { _Pragma("unroll") for (int _i = 0; _i < 2; ++_i) \
    __builtin_amdgcn_global_load_lds((const unsigned*)((const char*)(gbase) + (voff)[_i]), (LAS unsigned*)(lds + (bufoff) + ldsw + _i * 8192), 16, 0, 0); } while (0)
#define PG8_LDA(dst, b, h) do { _Pragma("unroll") for (int m = 0; m < 4; ++m) _Pragma("unroll") for (int k = 0; k < 2; ++k) dst[m][k] = *(const LAS bf16x8*)(lds + PG8_SA(b, h) + aoff + m * 2048 + k * 1024); } while (0)
#define PG8_LDB(dst, b, h) do { _Pragma("unroll") for (int n = 0; n < 2; ++n) _Pragma("unroll") for (int k = 0; k < 2; ++k) dst[n][k] = *(const LAS bf16x8*)(lds + PG8_SB(b, h) + boff + n * 2048 + k * 1024); } while (0)
#define PG8_MMA(ai, bj, At, Bt) do { __builtin_amdgcn_s_setprio(1); _Pragma("unroll") for (int m = 0; m < 4; ++m) _Pragma("unroll") for (int n = 0; n < 2; ++n) _Pragma("unroll") for (int k = 0; k < 2; ++k) \
    acc[ai][bj][m][n] = __builtin_amdgcn_mfma_f32_16x16x32_bf16(Bt[n][k], At[m][k], acc[ai][bj][m][n], 0, 0, 0); __builtin_amdgcn_s_setprio(0); } while (0)
#define PG8_WAIT_V(n) asm volatile("s_waitcnt vmcnt(" #n ")" ::: "memory")
#define PG8_WAIT_L(n) asm volatile("s_waitcnt lgkmcnt(" #n ")" ::: "memory")
#define PG8_BAR __builtin_amdgcn_s_barrier()
#define PG8_SCHED __builtin_amdgcn_sched_barrier(0)
  Unit cur, nxt; int ui = 0;
  if (!S.next(0, cur)) return;
  f32x4 acc[2][2][4][2];
#pragma unroll
  for (int a = 0; a < 2; ++a)
#pragma unroll
    for (int b = 0; b < 2; ++b)
#pragma unroll
      for (int m = 0; m < 4; ++m)
#pragma unroll
        for (int n = 0; n < 2; ++n) acc[a][b][m][n] = (f32x4){0.f, 0.f, 0.f, 0.f};
  bf16x8 At[4][2], B0[2][2], B1[2][2];
  const char* cA = cur.A; const char* cB = cur.B;
  PG8_STAGE(PG8_SB(0, 0), cB, voffB); PG8_STAGE(PG8_SA(0, 0), cA, voffA); PG8_STAGE(PG8_SB(0, 1), cB + hstepB, voffB); PG8_STAGE(PG8_SA(0, 1), cA + hstepA, voffA);
  if (wr == 1) PG8_BAR;
  PG8_WAIT_V(4); PG8_BAR;
  PG8_STAGE(PG8_SB(1, 0), cB + kstep, voffB); PG8_STAGE(PG8_SA(1, 0), cA + kstep, voffA); PG8_STAGE(PG8_SB(1, 1), cB + hstepB + kstep, voffB);
  PG8_WAIT_V(6); PG8_BAR;
  for (;;) {
    const bool has_next = S.next(ui + 1, nxt);
    const char* nA = has_next ? nxt.A : cA; const char* nB = has_next ? nxt.B : cB;
    const int nt = cur.nt;
    for (int t = 0; t < nt; t += 2) {
      const bool last = (t == nt - 2);
      const char* a1 = cA + (size_t)(t + 1) * kstep;
      const char* a2 = last ? nA : cA + (size_t)(t + 2) * kstep; const char* b2 = last ? nB : cB + (size_t)(t + 2) * kstep;
      const char* a3 = a2 + kstep; const char* b3 = b2 + kstep;
      PG8_LDB(B0, 0, 0); PG8_SCHED; PG8_LDA(At, 0, 0); PG8_STAGE(PG8_SA(1, 1), a1 + hstepA, voffA);
      PG8_WAIT_L(8); PG8_BAR; PG8_WAIT_L(0); PG8_MMA(0, 0, At, B0); PG8_BAR; PG8_SCHED;
      PG8_LDB(B1, 0, 1); PG8_STAGE(PG8_SB(0, 0), b2, voffB);
      PG8_BAR; PG8_WAIT_L(0); PG8_MMA(0, 1, At, B1); PG8_BAR;
      PG8_LDA(At, 0, 1); PG8_STAGE(PG8_SA(0, 0), a2, voffA);
      PG8_BAR; PG8_WAIT_L(0); PG8_MMA(1, 0, At, B0); PG8_BAR; PG8_SCHED;
      PG8_STAGE(PG8_SB(0, 1), b2 + hstepB, voffB);
      PG8_WAIT_V(6); PG8_BAR; PG8_MMA(1, 1, At, B1); PG8_BAR;
      PG8_LDB(B0, 1, 0); PG8_SCHED; PG8_LDA(At, 1, 0); PG8_STAGE(PG8_SA(0, 1), a2 + hstepA, voffA);
      PG8_WAIT_L(8); PG8_BAR; PG8_WAIT_L(0); PG8_MMA(0, 0, At, B0); PG8_BAR; PG8_SCHED;
      PG8_LDB(B1, 1, 1); PG8_STAGE(PG8_SB(1, 0), b3, voffB);
      PG8_BAR; PG8_WAIT_L(0); PG8_MMA(0, 1, At, B1); PG8_BAR;
      PG8_LDA(At, 1, 1); PG8_STAGE(PG8_SA(1, 0), a3, voffA);
      PG8_BAR; PG8_WAIT_L(0); PG8_MMA(1, 0, At, B0); PG8_BAR; PG8_SCHED;
      PG8_STAGE(PG8_SB(1, 1), b3 + hstepB, voffB);
      PG8_WAIT_V(6); PG8_BAR; PG8_MMA(1, 1, At, B1); PG8_BAR;
    }
    E(acc, cur, wr, wc, fr, fq);
    if (!has_next) break;
#pragma unroll
    for (int a = 0; a < 2; ++a)
#pragma unroll
      for (int b = 0; b < 2; ++b)
#pragma unroll
        for (int m = 0; m < 4; ++m)
#pragma unroll
          for (int n = 0; n < 2; ++n) acc[a][b][m][n] = (f32x4){0.f, 0.f, 0.f, 0.f};
    cur = nxt; cA = nA; cB = nB; ++ui;
  }
  PG8_WAIT_V(0);
  if (wr == 0) PG8_BAR;
  PG8_BAR;
#undef PG8_SA
#undef PG8_SB
#undef PG8_STAGE
#undef PG8_LDA
#undef PG8_LDB
#undef PG8_MMA
#undef PG8_WAIT_V
#undef PG8_WAIT_L
#undef PG8_BAR
#undef PG8_SCHED
}

typedef f32x4 Acc[2][2][4][2];
#define EPI_ROWS(u, wr, fr) \
  _Pragma("unroll") for (int ai = 0; ai < 2; ++ai) _Pragma("unroll") for (int m = 0; m < 4; ++m)
#define EPI_ROW(u, wr, fr) ((u).pm * 256 + ai * 128 + (wr) * 64 + m * 16 + (fr))
#define EPI_COL(wc, fq) (bj * 128 + (wc) * 32 + (fq) * 8)

__device__ __forceinline__ int bsel_of_tile(int pm) { return pm < 64 ? (pm >> 3) : 8; }

struct RectSched {
  const char* A; const char* B; size_t a_tile, b_tile; int nM, nN, nt, G, c;
  __device__ __forceinline__ bool next(int i, Unit& u) const {
    const int L = i * G + c; if (L >= nM * nN) return false;
    int pm, pn; rect_map(L, nM, nN, pm, pn);
    u.pm = pm; u.pn = pn; u.kind = 0; u.nt = nt; u.A = A + (size_t)pm * a_tile; u.B = B + (size_t)pn * b_tile; return true;
  }
};
struct G1Sched {
  const char* A; const char* B; int G, c, last;
  __device__ __forceinline__ bool next(int i, Unit& u) const {
    const int L = i * G + c; const int nl = 64 * 9, ncx = last ? 24 : 72;
    if (L >= nl + ncx) return false;
    int pm, pn;
    if (L < nl) rect_map(L, 64, 9, pm, pn);
    else { const int q = L - nl; if (last) { pm = 64 + q / 3; const int s = q % 3; pn = s == 0 ? 0 : (s + 1); } else { pm = 64 + q / 9; pn = q % 9; } }
    u.pm = pm; u.pn = pn; u.kind = 0; u.nt = 16; u.A = A + (size_t)pm * (256 * 1024 * 2); u.B = B + (size_t)pn * (256 * 1024 * 2); return true;
  }
};
struct S5Sched {
  const char* A; const char* B; size_t b_group, b_tile; int nMs, nN, nt, G, c;
  __device__ __forceinline__ bool next(int i, Unit& u) const {
    const int L = i * G + c; if (L >= 16 * nMs * nN) return false;
    const int g = L / (nMs * nN), r = L % (nMs * nN), pm = r / nN, pn = r % nN;
    u.pm = pm; u.pn = pn; u.kind = g; u.nt = nt;
    u.A = A + ((size_t)g * XUR + (size_t)pm * 256) * XUK * 2; u.B = B + (size_t)g * b_group + (size_t)pn * b_tile; return true;
  }
};
struct MergeSched {
  const char* Abuf; const char* Y4; const char* Win; const char* Wbr; int nM, G, c;
  __device__ __forceinline__ bool next(int i, Unit& u) const {
    const int su = (i >> 3) * G + c; if (su >= nM * 4) return false;
    const int j = i & 7, k = j >> 1, pm = su >> 2, pd = su & 3;
    u.pm = pm; u.pn = pd; u.kind = j;
    if (!(j & 1)) { u.nt = 16; u.A = Abuf + (size_t)pm * (256 * 1024 * 2); u.B = Win + (size_t)(2304 + k * 1024 + pd * 256) * (1024 * 2); }
    else { u.nt = 4; u.A = Y4 + (size_t)pm * (256 * 1024 * 2) + (size_t)k * 512; u.B = Wbr + (size_t)(pd * 256) * (1024 * 2) + (size_t)k * 512; }
    return true;
  }
};

struct EpiG1 {
  bf16_t* PS; bf16_t* XU; bf16_t* VT;
  __device__ __forceinline__ void operator()(const Acc& acc, const Unit& u, int wr, int wc, int fr, int fq) const {
    EPI_ROWS(u, wr, fr) {
      const int row = EPI_ROW(u, wr, fr);
#pragma unroll
      for (int bj = 0; bj < 2; ++bj) {
        const int c = EPI_COL(wc, fq);
        const u32x4 pk = pack8(acc[ai][bj][m][0], acc[ai][bj][m][1]);
        if (u.pn == 0) {
          const int g = c >> 4, h0 = c & 15;
          *(u32x4*)(XU + ((size_t)(g * XUR + (row >> 5)) * XUK + (row & 31) * 16 + h0)) = pk;
        } else if (u.pn == 3) {
          int b, tok; if (row < ML) { b = row >> 11; tok = row & 2047; } else { const int r2 = row - ML; b = r2 >> 8; tok = 2048 + (r2 & 255); }
          const int head = c >> 6, d0 = c & 63;
          bf16_t* base = VT + ((size_t)((b * 4 + head) * 64 + d0)) * 2304 + tok;
#pragma unroll
          for (int i = 0; i < 4; ++i) { base[(size_t)(2 * i) * 2304] = (bf16_t)(pk[i] & 0xffffu); base[(size_t)(2 * i + 1) * 2304] = (bf16_t)(pk[i] >> 16); }
        } else {
          *(u32x4*)(PS + (size_t)row * 2304 + u.pn * 256 + c) = pk;
        }
      }
    }
  }
};
struct EpiS1 {
  float* S;
  __device__ __forceinline__ void operator()(const Acc& acc, const Unit& u, int wr, int wc, int fr, int fq) const {
    EPI_ROWS(u, wr, fr) {
      const int row = EPI_ROW(u, wr, fr);
      if (row < NCHUNK) {
#pragma unroll
        for (int bj = 0; bj < 2; ++bj) {
          const int c = EPI_COL(wc, fq);
          float* dst = S + ((size_t)u.kind * NCHUNK + row) * 256 + c;
          *(f32x4*)dst = acc[ai][bj][m][0]; *(f32x4*)(dst + 4) = acc[ai][bj][m][1];
        }
      }
    }
  }
};
struct EpiS2 {
  bf16_t* YG; int rowlim;
  __device__ __forceinline__ void operator()(const Acc& acc, const Unit& u, int wr, int wc, int fr, int fq) const {
    EPI_ROWS(u, wr, fr) {
      const int row = EPI_ROW(u, wr, fr);
      if (row < rowlim) {
#pragma unroll
        for (int bj = 0; bj < 2; ++bj) {
          const int col = u.pn * 256 + EPI_COL(wc, fq);
          const int t = col >> 4, h0 = col & 15;
          f32x4 a = acc[ai][bj][m][0], b = acc[ai][bj][m][1];
#pragma unroll
          for (int i = 0; i < 4; ++i) { a[i] = gelu_tanh(a[i]); b[i] = gelu_tanh(b[i]); }
          *(u32x4*)(YG + ((size_t)(row * TCH + t)) * 256 + u.kind * 16 + h0) = pack8(a, b);
        }
      }
    }
  }
};
struct EpiGLU {
  const bf16_t* YG; const float* bias; bf16_t* Y4;
  __device__ __forceinline__ void operator()(const Acc& acc, const Unit& u, int wr, int wc, int fr, int fq) const {
    EPI_ROWS(u, wr, fr) {
      const int row = EPI_ROW(u, wr, fr);
#pragma unroll
      for (int bj = 0; bj < 2; ++bj) {
        const int c = EPI_COL(wc, fq);
        const u32x4 gv = *(const u32x4*)(YG + (size_t)row * 256 + c);
        const f32x4 b0 = *(const f32x4*)(bias + c), b1 = *(const f32x4*)(bias + c + 4);
        f32x4 a = acc[ai][bj][m][0] + b0, b = acc[ai][bj][m][1] + b1;
        a[0] = bflo(gv[0]) * sigm(a[0]); a[1] = bfhi(gv[0]) * sigm(a[1]); a[2] = bflo(gv[1]) * sigm(a[2]); a[3] = bfhi(gv[1]) * sigm(a[3]);
        b[0] = bflo(gv[2]) * sigm(b[0]); b[1] = bfhi(gv[2]) * sigm(b[1]); b[2] = bflo(gv[3]) * sigm(b[2]); b[3] = bfhi(gv[3]) * sigm(b[3]);
        *(u32x4*)(Y4 + (size_t)row * 1024 + c) = pack8(a, b);
      }
    }
  }
};
struct EpiMerge {
  bf16_t* GS; float* TMP; bf16_t* MIX;
  __device__ __forceinline__ void operator()(const Acc& acc, const Unit& u, int wr, int wc, int fr, int fq) const {
    const int tid = otid(); const int j = u.kind, k = j >> 1;
    EPI_ROWS(u, wr, fr) {
#pragma unroll
      for (int bj = 0; bj < 2; ++bj) {
        const int e = (ai * 4 + m) * 2 + bj;
        bf16_t* gs = GS + ((size_t)e * 512 + tid) * 8;
        float* tp = TMP + ((size_t)e * 512 + tid) * 8;
        if (!(j & 1)) {
          f32x4 a = acc[ai][bj][m][0], b = acc[ai][bj][m][1];
#pragma unroll
          for (int i = 0; i < 4; ++i) { a[i] = sigm(a[i]); b[i] = sigm(b[i]); }
          *(u32x4*)gs = pack8(a, b);
        } else {
          const u32x4 gv = *(const u32x4*)gs;
          f32x4 a = acc[ai][bj][m][0], b = acc[ai][bj][m][1];
          a[0] *= bflo(gv[0]); a[1] *= bfhi(gv[0]); a[2] *= bflo(gv[1]); a[3] *= bfhi(gv[1]);
          b[0] *= bflo(gv[2]); b[1] *= bfhi(gv[2]); b[2] *= bflo(gv[3]); b[3] *= bfhi(gv[3]);
          if (k > 0) { a += *(const f32x4*)tp; b += *(const f32x4*)(tp + 4); }
          if (k < 3) { *(f32x4*)tp = a; *(f32x4*)(tp + 4) = b; }
          else { const int row = EPI_ROW(u, wr, fr); const int c = u.pn * 256 + EPI_COL(wc, fq); *(u32x4*)(MIX + (size_t)row * 1024 + c) = pack8(a, b); }
        }
      }
    }
  }
};
struct EpiRes {
  const float* hL; const float* hC; float* H; const float* modbase; int modidx;
  __device__ __forceinline__ void operator()(const Acc& acc, const Unit& u, int wr, int wc, int fr, int fq) const {
    const float* mv = modbase + (size_t)bsel_of_tile(u.pm) * 6144 + modidx * 1024;
    EPI_ROWS(u, wr, fr) {
      const int row = EPI_ROW(u, wr, fr);
      const float* hs = row < ML ? hL + (size_t)row * 1024 : hC + (size_t)(row - ML) * 1024;
#pragma unroll
      for (int bj = 0; bj < 2; ++bj) {
        const int c = u.pn * 256 + EPI_COL(wc, fq);
        const f32x4 h0 = *(const f32x4*)(hs + c), h1 = *(const f32x4*)(hs + c + 4);
        const f32x4 m0 = *(const f32x4*)(mv + c), m1 = *(const f32x4*)(mv + c + 4);
        float* hd = H + (size_t)row * 1024 + c;
        *(f32x4*)hd = h0 + m0 * acc[ai][bj][m][0]; *(f32x4*)(hd + 4) = h1 + m1 * acc[ai][bj][m][1];
      }
    }
  }
};
struct EpiFF1 {
  bf16_t* FFH;
  __device__ __forceinline__ void operator()(const Acc& acc, const Unit& u, int wr, int wc, int fr, int fq) const {
    EPI_ROWS(u, wr, fr) {
      const int row = EPI_ROW(u, wr, fr);
#pragma unroll
      for (int bj = 0; bj < 2; ++bj) {
        const int c = u.pn * 256 + EPI_COL(wc, fq);
        f32x4 a = acc[ai][bj][m][0], b = acc[ai][bj][m][1];
#pragma unroll
        for (int i = 0; i < 4; ++i) { a[i] = fmaxf(a[i], 0.f); a[i] *= a[i]; b[i] = fmaxf(b[i], 0.f); b[i] *= b[i]; }
        *(u32x4*)(FFH + (size_t)row * 4096 + c) = pack8(a, b);
      }
    }
  }
};

__device__ void mod_task(const P& p, int task, float* lds) {
  const int tid = otid();
  float* sc = lds;
  float* red = lds + 9 * 1024;
  for (int i = tid; i < 9 * 1024; i += 512) { const float v = i < 8192 ? p.c[i] : p.c_ctx[i - 8192]; sc[i] = v * sigm(v); }
  __syncthreads();
  const int l = task / 48, jb = task % 48, jl = tid & 127, ks = tid >> 7, j = jb * 128 + jl;
  float a[9];
#pragma unroll
  for (int s = 0; s < 9; ++s) a[s] = 0.f;
  const float* w = p.ada_w + (size_t)l * 1024 * 6144 + j;
  for (int k = ks * 256; k < ks * 256 + 256; ++k) {
    const float wv = w[(size_t)k * 6144];
#pragma unroll
    for (int s = 0; s < 9; ++s) a[s] += sc[s * 1024 + k] * wv;
  }
#pragma unroll
  for (int s = 0; s < 9; ++s) red[(ks * 9 + s) * 128 + jl] = a[s];
  __syncthreads();
  float* MOD = (float*)(p.ws + OFF_MOD);
  for (int i = tid; i < 9 * 128; i += 512) {
    const int s = i >> 7, jj = i & 127;
    const float v = red[(0 * 9 + s) * 128 + jj] + red[(1 * 9 + s) * 128 + jj] + red[(2 * 9 + s) * 128 + jj] + red[(3 * 9 + s) * 128 + jj];
    MOD[((size_t)l * 9 + s) * 6144 + jb * 128 + jj] = v + p.ada_b[l * 6144 + jb * 128 + jj];
  }
  __syncthreads();
}

__device__ void tr_tile(const float* src, int lds_, bf16_t* dst, int ldd, float* tile  ) {
  const int tid = otid();
#pragma unroll
  for (int ps = 0; ps < 2; ++ps) {
    const int k = (tid >> 4) + ps * 32, n4 = (tid & 15) * 4;
    const f32x4 v = *(const f32x4*)(src + (size_t)k * lds_ + n4);
    tile[k * 65 + n4] = v[0]; tile[k * 65 + n4 + 1] = v[1]; tile[k * 65 + n4 + 2] = v[2]; tile[k * 65 + n4 + 3] = v[3];
  }
  __syncthreads();
  {
    const int n = tid >> 3, k8 = (tid & 7) * 8;
    u32x4 o;
#pragma unroll
    for (int i = 0; i < 4; ++i) o[i] = cvt_pk_bf16(tile[(k8 + 2 * i) * 65 + n], tile[(k8 + 2 * i + 1) * 65 + n]);
    *(u32x4*)(dst + (size_t)n * ldd + k8) = o;
  }
  __syncthreads();
}

struct cpx { float re, im; };
__device__ __forceinline__ cpx cmul(cpx a, cpx b) { return {a.re * b.re - a.im * b.im, a.re * b.im + a.im * b.re}; }
__device__ __forceinline__ cpx s5_apow(float lre, float lim, float dt, float e) {
  const float zr = lre * dt * e, zi = lim * dt * e; const float mg = expf(zr); float sn, cs; sincosf(zi, &sn, &cs); return {mg * cs, mg * sn};
}
__device__ __forceinline__ cpx s5_coef(float lre, float lim, float dt) {
  const cpx a = s5_apow(lre, lim, dt, 1.f); const float nr = a.re - 1.f, ni = a.im, den = lre * lre + lim * lim;
  return {(nr * lre + ni * lim) / den, (ni * lre - nr * lim) / den};
}

constexpr int NT_WIN = 1600, NT_FF1 = 1024, NT_FF2 = 1024, NT_OUT = 256, NT_BR = 256, NT_GLU = 16;
constexpr int NT_TR = NT_WIN + NT_FF1 + NT_FF2 + NT_OUT + NT_BR + NT_GLU;
constexpr int NT_TOEP = 512, NT_W2S = 256, NT_W1 = 128, NT_SGUW = 16;
constexpr int NT_PREP = NT_TR + NT_TOEP + NT_W2S + NT_W1 + NT_SGUW;

__device__ void prep_task(const P& p, int l, int task, float* lds) {
  const int tid = otid();
  unsigned char* ws = p.ws;
  if (task < NT_TR) {
    const float* src; bf16_t* dst; int N, ldd, tk, tn;
    int t = task;
    if (t < NT_WIN) { src = p.w_in + (size_t)l * 1024 * 6400; N = 6400; dst = (bf16_t*)(ws + OFF_WIN); ldd = 1024; tk = t / 100; tn = t % 100; }
    else if ((t -= NT_WIN) < NT_FF1) { src = p.w_ff1 + (size_t)l * 1024 * 4096; N = 4096; dst = (bf16_t*)(ws + OFF_WFF1); ldd = 1024; tk = t / 64; tn = t % 64; }
    else if ((t -= NT_FF1) < NT_FF2) { src = p.w_ff2 + (size_t)l * 4096 * 1024; N = 1024; dst = (bf16_t*)(ws + OFF_WFF2); ldd = 4096; tk = t / 16; tn = t % 16; }
    else if ((t -= NT_FF2) < NT_OUT) { src = p.w_out + (size_t)l * 1024 * 1024; N = 1024; dst = (bf16_t*)(ws + OFF_WOUT); ldd = 1024; tk = t / 16; tn = t % 16; }
    else if ((t -= NT_OUT) < NT_BR) { const int k = t >> 6; t &= 63; src = p.w_branch + ((size_t)l * 4 + k) * 256 * 1024; N = 1024; dst = (bf16_t*)(ws + OFF_WBR) + k * 256; ldd = 1024; tk = t / 16; tn = t % 16; }
    else { t -= NT_BR; src = p.glu_w + (size_t)l * 256 * 256; N = 256; dst = (bf16_t*)(ws + OFF_WGLU); ldd = 256; tk = t / 4; tn = t % 4; }
    tr_tile(src + (size_t)tk * 64 * N + tn * 64, N, dst + (size_t)tn * 64 * ldd + tk * 64, ldd, lds);
    return;
  }
  task -= NT_TR;
  bf16_t* W2 = (bf16_t*)(ws + OFF_W2);
  bf16_t* W1 = (bf16_t*)(ws + OFF_W1);
  if (task < NT_TOEP) {
    const int g = task >> 5, lag = task & 31;
    cpx* E = (cpx*)lds;
    if (tid < 128) {
      const int d = tid >> 6, pp = tid & 63; const int li = ((l * 2 + d) * 16 + g);
      const float dt = expf(p.log_dt[li]); const float lre = p.lam_re[li * 64 + pp], lim = p.lam_im[li * 64 + pp];
      E[tid] = cmul(s5_apow(lre, lim, dt, (float)lag), s5_coef(lre, lim, dt));
    }
    __syncthreads();
    if (tid < 256) {
      const int hp = tid >> 4, h = tid & 15;
      float kv[2];
#pragma unroll
      for (int d = 0; d < 2; ++d) {
        const int li = ((l * 2 + d) * 16 + g);
        const float* cre = p.c_re + ((size_t)li * 16 + hp) * 64; const float* cim = p.c_im + ((size_t)li * 16 + hp) * 64;
        const float* bre = p.b_re + (size_t)li * 64 * 16 + h; const float* bim = p.b_im + (size_t)li * 64 * 16 + h;
        float s = 0.f;
        for (int pp = 0; pp < 64; ++pp) {
          const cpx bb = cmul(E[d * 64 + pp], (cpx){bre[pp * 16], bim[pp * 16]});
          s += cre[pp] * bb.re - cim[pp] * bb.im;
        }
        kv[d] = s;
      }
      bf16_t* Wg = W2 + (size_t)g * 512 * 768;
      if (lag == 0) {
        const float v = kv[0] + kv[1] + (hp == h ? p.s5_d[l * 256 + g * 16 + h] : 0.f);
        const bf16_t bv = (bf16_t)(cvt_pk_bf16(v, 0.f) & 0xffffu);
        for (int t = 0; t < TCH; ++t) Wg[(size_t)(t * 16 + hp) * 768 + t * 16 + h] = bv;
      } else {
        const unsigned pk = cvt_pk_bf16(kv[0], kv[1]);
        const bf16_t v0 = (bf16_t)(pk & 0xffffu), v1 = (bf16_t)(pk >> 16);
        for (int jj = 0; jj + lag < TCH; ++jj) {
          const int t = jj + lag;
          Wg[(size_t)(t * 16 + hp) * 768 + jj * 16 + h] = v0;
          Wg[(size_t)(jj * 16 + hp) * 768 + t * 16 + h] = v1;
        }
      }
    }
    __syncthreads();
    return;
  }
  task -= NT_TOEP;
  if (task < NT_W2S) {
    for (int it = 0; it < 8; ++it) {
      const int idx = (task * 8 + it) * 512 + tid;
      const int pp = idx & 63, d = (idx >> 6) & 1, hp = (idx >> 7) & 15, t = (idx >> 11) & 31, g = idx >> 16;
      const int li = ((l * 2 + d) * 16 + g);
      const float dt = expf(p.log_dt[li]); const float lre = p.lam_re[li * 64 + pp], lim = p.lam_im[li * 64 + pp];
      const cpx ap = s5_apow(lre, lim, dt, d == 0 ? (float)(t + 1) : (float)(TCH - t));
      const cpx cc = {p.c_re[((size_t)li * 16 + hp) * 64 + pp], p.c_im[((size_t)li * 16 + hp) * 64 + pp]};
      const cpx v = cmul(cc, ap);
      *(unsigned*)(W2 + ((size_t)g * 512 + t * 16 + hp) * 768 + 512 + d * 128 + 2 * pp) = cvt_pk_bf16(v.re, -v.im);
    }
    return;
  }
  task -= NT_W2S;
  if (task < NT_W1) {
    const int idx = task * 512 + tid;
    const int j = idx & 31, pp = (idx >> 5) & 63, d = (idx >> 11) & 1, g = idx >> 12;
    const int li = ((l * 2 + d) * 16 + g);
    const float dt = expf(p.log_dt[li]); const float lre = p.lam_re[li * 64 + pp], lim = p.lam_im[li * 64 + pp];
    const cpx e = cmul(s5_apow(lre, lim, dt, d == 0 ? (float)(TCH - 1 - j) : (float)j), s5_coef(lre, lim, dt));
    const float* bre = p.b_re + ((size_t)li * 64 + pp) * 16; const float* bim = p.b_im + ((size_t)li * 64 + pp) * 16;
    bf16_t* r0 = W1 + ((size_t)g * 256 + d * 128 + 2 * pp) * 512 + j * 16;
    bf16_t* r1 = r0 + 512;
#pragma unroll
    for (int h = 0; h < 16; h += 2) {
      const cpx v0 = cmul(e, (cpx){bre[h], bim[h]}), v1 = cmul(e, (cpx){bre[h + 1], bim[h + 1]});
      *(unsigned*)(r0 + h) = cvt_pk_bf16(v0.re, v1.re); *(unsigned*)(r1 + h) = cvt_pk_bf16(v0.im, v1.im);
    }
    return;
  }
  task -= NT_W1;
  {
    float* WT = (float*)(ws + OFF_SGUWT);
    for (int it = 0; it < 8; ++it) {
      const int idx = (task * 8 + it) * 512 + tid;
      const int t = idx & 127, s = (idx >> 7) & 127, g = idx >> 14;
      WT[idx] = p.sgu_w[(((size_t)l * 4 + g) * 128 + t) * 128 + s];
    }
  }
}

__device__ void norm_rows(const P& p, const float* hL, const float* hC, const float* gvec, const float* modbase, int shift_idx, int nrows) {
  const int tid = otid(); const int lane = tid & 63, wid = tid >> 6;
  bf16_t* A = (bf16_t*)(p.ws + OFF_A);
  for (int row = blockIdx.x * 8 + wid; row < nrows; row += gridDim.x * 8) {
    const float* h = row < ML ? hL + (size_t)row * 1024 : hC + (size_t)(row - ML) * 1024;
    const int bsel = row < ML ? (row >> 11) : 8;
    const float* sh = modbase + (size_t)bsel * 6144 + shift_idx * 1024; const float* sc = sh + 1024;
    f32x4 v[4]; float ss = 0.f;
#pragma unroll
    for (int i = 0; i < 4; ++i) { v[i] = *(const f32x4*)(h + i * 256 + lane * 4); ss += v[i][0] * v[i][0] + v[i][1] * v[i][1] + v[i][2] * v[i][2] + v[i][3] * v[i][3]; }
    ss = wave_sum(ss);
    const float rstd = rsqrtf(ss * (1.f / 1024.f) + 1e-6f);
#pragma unroll
    for (int i = 0; i < 4; ++i) {
      const int c = i * 256 + lane * 4;
      const f32x4 g = *(const f32x4*)(gvec + c), s1 = *(const f32x4*)(sc + c), s0 = *(const f32x4*)(sh + c);
      f32x4 y;
#pragma unroll
      for (int q = 0; q < 4; ++q) y[q] = (v[i][q] * rstd * g[q]) * (1.f + s1[q]) + s0[q];
      u32x2 o; o[0] = cvt_pk_bf16(y[0], y[1]); o[1] = cvt_pk_bf16(y[2], y[3]);
      *(u32x2*)(A + (size_t)row * 1024 + c) = o;
    }
  }
}

__device__ void final_rows(const P& p) {
  const int tid = otid(); const int lane = tid & 63, wid = tid >> 6;
  const float* H = (const float*)(p.ws + OFF_H);
  for (int row = blockIdx.x * 8 + wid; row < ML; row += gridDim.x * 8) {
    const float* h = H + (size_t)row * 1024;
    f32x4 v[4]; float ss = 0.f;
#pragma unroll
    for (int i = 0; i < 4; ++i) { v[i] = *(const f32x4*)(h + i * 256 + lane * 4); ss += v[i][0] * v[i][0] + v[i][1] * v[i][1] + v[i][2] * v[i][2] + v[i][3] * v[i][3]; }
    ss = wave_sum(ss);
    const float rstd = rsqrtf(ss * (1.f / 1024.f) + 1e-6f);
#pragma unroll
    for (int i = 0; i < 4; ++i) {
      const int c = i * 256 + lane * 4;
      const f32x4 g = *(const f32x4*)(p.final_g + c);
      f32x4 y;
#pragma unroll
      for (int q = 0; q < 4; ++q) y[q] = v[i][q] * rstd * g[q];
      *(f32x4*)(p.out + (size_t)row * 1024 + c) = y;
    }
  }
}

template <bool LAT>
__device__ __forceinline__ void attn_task(const P& p, int task, int l, const float* rpb_lds, int lane) {
  constexpr int NG = LAT ? 16 : 8;
  const bf16_t* PS = (const bf16_t*)(p.ws + OFF_PS);
  const bf16_t* VT = (const bf16_t*)(p.ws + OFF_VT);
  bf16_t* Y4 = (bf16_t*)(p.ws + OFF_Y4);
  int b, head, r = 0, jb = 0, qrow0;
  if (LAT) { jb = task & 3; r = (task >> 2) & 31; head = (task >> 7) & 3; b = task >> 9; qrow0 = b * 2048 + r * 64 + jb * 16; }
  else { const int qb = task & 15; head = (task >> 4) & 3; b = task >> 6; qrow0 = ML + b * 256 + qb * 16; }
  const int n = lane & 15, kg = lane >> 4;
  const bf16_t* qp = PS + (size_t)(qrow0 + n) * 2304 + 256 + head * 64 + kg * 8;
  const bf16x8 q0 = *(const bf16x8*)qp, q1 = *(const bf16x8*)(qp + 32);
  const int rs = LAT ? min(max(r - 4, 0), 24) : 0;
  const int clo = LAT ? (jb == 0 ? 0 : jb == 1 ? 8 : jb == 2 ? 24 : 32) : 0;
  const int keyX = 8 * (n >> 2) + (n & 3);
  f32x4 s[NG][2];
#pragma unroll
  for (int gi = 0; gi < NG; ++gi) {
    int tokrow0;
    if (LAT && gi < 8) tokrow0 = b * 2048 + (rs + gi) * 64 + clo; else tokrow0 = ML + b * 256 + (gi - (LAT ? 8 : 0)) * 32;
    const bf16_t* kp = PS + (size_t)(tokrow0 + keyX) * 2304 + 512 + head * 64 + kg * 8;
    const bf16x8 kx0 = *(const bf16x8*)kp, kx1 = *(const bf16x8*)(kp + 32);
    const bf16x8 ky0 = *(const bf16x8*)(kp + 4 * 2304), ky1 = *(const bf16x8*)(kp + 4 * 2304 + 32);
    f32x4 z = {0.f, 0.f, 0.f, 0.f};
    s[gi][0] = __builtin_amdgcn_mfma_f32_16x16x32_bf16(kx0, q0, z, 0, 0, 0);
    s[gi][0] = __builtin_amdgcn_mfma_f32_16x16x32_bf16(kx1, q1, s[gi][0], 0, 0, 0);
    s[gi][1] = __builtin_amdgcn_mfma_f32_16x16x32_bf16(ky0, q0, z, 0, 0, 0);
    s[gi][1] = __builtin_amdgcn_mfma_f32_16x16x32_bf16(ky1, q1, s[gi][1], 0, 0, 0);
  }
  float mx = -3.0e38f;
  const int jq = jb * 16 + n; const int cs = min(max(jq - 8, 0), 48);
#pragma unroll
  for (int gi = 0; gi < NG; ++gi)
#pragma unroll
    for (int blk = 0; blk < 2; ++blk)
#pragma unroll
      for (int i = 0; i < 4; ++i) {
        float v = s[gi][blk][i] * 0.125f;
        if (LAT && gi < 8) {
          const int kc = clo + 8 * kg + blk * 4 + i;
          const bool ok = (kc >= cs) && (kc < cs + 16);
          const int dr = rs + gi - r + 7; const int dc = min(max(kc - jq + 15, 0), 30);
          const float bias = rpb_lds[(head * 15 + dr) * 31 + dc];
          v = ok ? v + bias : -1.0e30f;
        }
        s[gi][blk][i] = v; mx = fmaxf(mx, v);
      }
  mx = fmaxf(mx, __shfl_xor(mx, 16)); mx = fmaxf(mx, __shfl_xor(mx, 32));
  float sum = 0.f;
#pragma unroll
  for (int gi = 0; gi < NG; ++gi)
#pragma unroll
    for (int blk = 0; blk < 2; ++blk)
#pragma unroll
      for (int i = 0; i < 4; ++i) { const float e = __expf(s[gi][blk][i] - mx); s[gi][blk][i] = e; sum += e; }
  sum += __shfl_xor(sum, 16); sum += __shfl_xor(sum, 32);
  f32x4 o[4];
#pragma unroll
  for (int db = 0; db < 4; ++db) o[db] = (f32x4){0.f, 0.f, 0.f, 0.f};
  const bf16_t* vbase = VT + ((size_t)((b * 4 + head) * 64 + n)) * 2304 + kg * 8;
#pragma unroll
  for (int gi = 0; gi < NG; ++gi) {
    int tok0;
    if (LAT && gi < 8) tok0 = (rs + gi) * 64 + clo; else tok0 = 2048 + (gi - (LAT ? 8 : 0)) * 32;
    const u32x4 pk = pack8(s[gi][0], s[gi][1]);
    bf16x8 pf; __builtin_memcpy(&pf, &pk, 16);
#pragma unroll
    for (int db = 0; db < 4; ++db) {
      const bf16x8 vf = *(const bf16x8*)(vbase + (size_t)(db * 16) * 2304 + tok0);
      o[db] = __builtin_amdgcn_mfma_f32_16x16x32_bf16(vf, pf, o[db], 0, 0, 0);
    }
  }
  const float inv = 1.f / sum;
  bf16_t* op = Y4 + (size_t)(qrow0 + n) * 1024 + 256 + head * 64 + kg * 4;
#pragma unroll
  for (int db = 0; db < 4; ++db) {
    u32x2 w; w[0] = cvt_pk_bf16(o[db][0] * inv, o[db][1] * inv); w[1] = cvt_pk_bf16(o[db][2] * inv, o[db][3] * inv);
    *(u32x2*)(op + db * 16) = w;
  }
}

__device__ __forceinline__ void conv_task(const P& p, int l, int task) {
  const bf16_t* PS = (const bf16_t*)(p.ws + OFF_PS);
  bf16_t* Y4 = (bf16_t*)(p.ws + OFF_Y4);
  const int idx = task * 512 + otid();
  const int row = idx >> 5, c0 = (idx & 31) * 8;
  int pos, len; if (row < ML) { pos = row & 2047; len = 2048; } else { pos = (row - ML) & 255; len = 256; }
  const bf16_t* base = PS + (size_t)row * 2304;
  float z[3][8];
#pragma unroll
  for (int d = 0; d < 3; ++d) {
    const int pp = pos + d - 1;
    if (pp >= 0 && pp < len) {
      const u32x4 cv = *(const u32x4*)(base + (d - 1) * 2304 + 5 * 256 + c0), xv = *(const u32x4*)(base + (d - 1) * 2304 + 6 * 256 + c0);
#pragma unroll
      for (int i = 0; i < 4; ++i) { z[d][2 * i] = bflo(cv[i]) * bflo(xv[i]); z[d][2 * i + 1] = bfhi(cv[i]) * bfhi(xv[i]); }
    } else {
#pragma unroll
      for (int i = 0; i < 8; ++i) z[d][i] = 0.f;
    }
  }
  const u32x4 bv = *(const u32x4*)(base + 4 * 256 + c0);
  const float* w = p.conv_w + (size_t)l * 3 * 256 + c0;
  float y[8];
#pragma unroll
  for (int i = 0; i < 8; ++i) y[i] = w[i] * z[0][i] + w[256 + i] * z[1][i] + w[512 + i] * z[2][i];
  u32x4 o;
#pragma unroll
  for (int i = 0; i < 4; ++i) o[i] = cvt_pk_bf16(bflo(bv[i]) * y[2 * i], bfhi(bv[i]) * y[2 * i + 1]);
  *(u32x4*)(Y4 + (size_t)row * 1024 + 512 + c0) = o;
}

__device__ void sgu_task(const P& p, int l, int task, float* lds) {
  const int tid = otid();
  const bf16_t* PS = (const bf16_t*)(p.ws + OFF_PS);
  bf16_t* Y4 = (bf16_t*)(p.ws + OFF_Y4);
  const float* WT = (const float*)(p.ws + OFF_SGUWT);
  const int chunk = task >> 2, g = task & 3;
  float* wT = lds;
  float* vn = lds + 128 * 128;
  for (int i = tid; i < 128 * 128 / 4; i += 512) *(f32x4*)(wT + i * 4) = *(const f32x4*)(WT + (size_t)g * 16384 + i * 4);
  {
    const int s = tid >> 2, q = tid & 3;
    const bf16_t* vr = PS + (size_t)(chunk * 128 + s) * 2304 + 8 * 256;
    float sm = 0.f, sq = 0.f;
#pragma unroll
    for (int i = 0; i < 8; ++i) {
      const u32x4 v = *(const u32x4*)(vr + q * 64 + i * 8);
#pragma unroll
      for (int k = 0; k < 4; ++k) { const float a = bflo(v[k]), b = bfhi(v[k]); sm += a + b; sq += a * a + b * b; }
    }
    sm += __shfl_xor(sm, 1); sm += __shfl_xor(sm, 2); sq += __shfl_xor(sq, 1); sq += __shfl_xor(sq, 2);
    const float mu = sm * (1.f / 256.f); const float var = fmaxf(sq * (1.f / 256.f) - mu * mu, 0.f); const float rstd = rsqrtf(var + 1e-6f);
    const int cb = g * 64 + q * 16;
    const float* lg = p.ln_g + l * 256 + cb; const float* lb = p.ln_b + l * 256 + cb;
#pragma unroll
    for (int i = 0; i < 2; ++i) {
      const u32x4 v = *(const u32x4*)(vr + cb + i * 8);
#pragma unroll
      for (int k = 0; k < 4; ++k) {
        const int cc = i * 8 + 2 * k;
        vn[s * 64 + q * 16 + cc] = (bflo(v[k]) - mu) * rstd * lg[cc] + lb[cc];
        vn[s * 64 + q * 16 + cc + 1] = (bfhi(v[k]) - mu) * rstd * lg[cc + 1] + lb[cc + 1];
      }
    }
  }
  __syncthreads();
  const int tt = tid >> 4, cc = tid & 15;
  f32x4 acc[4];
#pragma unroll
  for (int i = 0; i < 4; ++i) acc[i] = (f32x4){0.f, 0.f, 0.f, 0.f};
#pragma unroll 4
  for (int s = 0; s < 128; ++s) {
    const f32x4 wv = *(const f32x4*)(wT + s * 128 + tt * 4);
    const f32x4 vv = *(const f32x4*)(vn + s * 64 + cc * 4);
#pragma unroll
    for (int i = 0; i < 4; ++i) acc[i] += wv[i] * vv;
  }
#pragma unroll
  for (int i = 0; i < 4; ++i) {
    const int t = tt * 4 + i; const int row = chunk * 128 + t;
    const float bs = p.sgu_b[((size_t)l * 4 + g) * 128 + t];
    const u32x2 uv = *(const u32x2*)(PS + (size_t)row * 2304 + 7 * 256 + g * 64 + cc * 4);
    u32x2 o; o[0] = cvt_pk_bf16(bflo(uv[0]) * (acc[i][0] + bs), bfhi(uv[0]) * (acc[i][1] + bs)); o[1] = cvt_pk_bf16(bflo(uv[1]) * (acc[i][2] + bs), bfhi(uv[1]) * (acc[i][3] + bs));
    *(u32x2*)(Y4 + (size_t)row * 1024 + 768 + g * 64 + cc * 4) = o;
  }
  __syncthreads();
}

__device__ void carry_phase(const P& p, int l) {
  const int gt = blockIdx.x * 512 + otid();
  if (gt >= 16 * 8 * 2 * 64) return;
  const int pp = gt & 63, d = (gt >> 6) & 1, b = (gt >> 7) & 7, g = gt >> 10;
  const float* S = (const float*)(p.ws + OFF_S) + (size_t)g * NCHUNK * 256 + d * 128 + 2 * pp;
  bf16_t* XU = (bf16_t*)(p.ws + OFF_XU) + (size_t)g * XUR * XUK + 512 + d * 128 + 2 * pp;
  const int li = ((l * 2 + d) * 16 + g);
  const float dt = expf(p.log_dt[li]);
  const cpx aT = s5_apow(p.lam_re[li * 64 + pp], p.lam_im[li * 64 + pp], dt, (float)TCH);
  cpx st = {0.f, 0.f};
  for (int i0 = 0; i0 < 72; i0 += 8) {
    float sre[8], sim[8]; int rows[8];
#pragma unroll
    for (int k = 0; k < 8; ++k) {
      const int i = i0 + k; int row;
      if (i < 8) row = 512 + b * 8 + (d == 0 ? i : 7 - i); else row = b * 64 + (d == 0 ? (i - 8) : 63 - (i - 8));
      rows[k] = row; const float2 v = *(const float2*)(S + (size_t)row * 256); sre[k] = v.x; sim[k] = v.y;
    }
#pragma unroll
    for (int k = 0; k < 8; ++k) {
      *(unsigned*)(XU + (size_t)rows[k] * XUK) = cvt_pk_bf16(st.re, st.im);
      const cpx ns = cmul(aT, st); st.re = ns.re + sre[k]; st.im = ns.im + sim[k];
    }
  }
}

constexpr int PH_PER_LAYER = 11;
constexpr int N_PHASES = 1 + NDEPTH * PH_PER_LAYER + 1;

__global__ void __launch_bounds__(512, 2) mk_forward(P p) {
  extern __shared__ __attribute__((aligned(16))) unsigned char shm[];
  LAS unsigned char* lds = (LAS unsigned char*)shm;
  float* ldsf = (float*)shm;
  const int G = gridDim.x, wg = blockIdx.x;
  unsigned char* ws = p.ws;
  float* H = (float*)(ws + OFF_H);
  const float* MOD = (const float*)(ws + OFF_MOD);

  for (int ph = p.ph_lo; ph < p.ph_hi; ++ph) {
    int tid_ = threadIdx.x; asm volatile("" : "+v"(tid_));
    const int tid = tid_, lane = tid & 63, wid = tid >> 6;
    if (ph == 0) {
      for (int t = wg; t < 192; t += G) mod_task(p, t, ldsf);
      for (int t = (wg + G - (192 % G)) % G; t < NT_PREP; t += G) prep_task(p, 0, t, ldsf);
    } else if (ph == N_PHASES - 1) {
      final_rows(p);
    } else {
      const int l = (ph - 1) / PH_PER_LAYER, sp = (ph - 1) % PH_PER_LAYER;
      const bool last = (l == NDEPTH - 1);
      const float* hL = l == 0 ? p.x : H; const float* hC = l == 0 ? p.ctx : H + (size_t)ML * 1024;
      const float* modl = MOD + (size_t)l * 9 * 6144;
      const int nMrows = last ? 64 : 72;
      switch (sp) {
#if PHMASK & 1
        case 0: {
          if (l > 0) for (int t = wg; t < NT_PREP; t += G) prep_task(p, l, t, ldsf);
          norm_rows(p, hL, hC, p.norm_g + (size_t)(l * 2 + 0) * 1024, modl, 0, MT);
        } break;
#endif
#if PHMASK & 2
        case 1: {
          G1Sched S{(const char*)(ws + OFF_A), (const char*)(ws + OFF_WIN), G, wg, last ? 1 : 0};
          EpiG1 E{(bf16_t*)(ws + OFF_PS), (bf16_t*)(ws + OFF_XU), (bf16_t*)(ws + OFF_VT)};
          gemm_phase(lds, 1024, 1024, S, E);
        } break;
#endif
#if PHMASK & 4
        case 2: {
          {
            S5Sched S{(const char*)(ws + OFF_XU), (const char*)(ws + OFF_W1), (size_t)256 * 512 * 2, 0, 3, 1, 8, G, wg};
            EpiS1 E{(float*)(ws + OFF_S)};
            gemm_phase(lds, XUK, 512, S, E);
          }
          __syncthreads();
          for (int i = tid; i < 4 * 15 * 31; i += 512) ldsf[i] = p.rpb[(size_t)l * 4 * 15 * 31 + i];
          __syncthreads();
          const int nwaves = G * 8, gw = wg * 8 + wid;
          for (int t = gw; t < 4096; t += nwaves) attn_task<true>(p, t, l, ldsf, lane);
          if (!last) for (int t = gw; t < 512; t += nwaves) attn_task<false>(p, t, l, ldsf, lane);
          const int nconv = (last ? ML : MT) * 32 / 512;
          for (int t = wg; t < nconv; t += G) conv_task(p, l, t);
          __syncthreads();
          const int nsgu = (last ? 128 : 144) * 4;
          for (int t = wg; t < nsgu; t += G) sgu_task(p, l, t, ldsf);
        } break;
#endif
#if PHMASK & 8
        case 3: carry_phase(p, l); break;
#endif
#if PHMASK & 16
        case 4: {
          S5Sched S{(const char*)(ws + OFF_XU), (const char*)(ws + OFF_W2), (size_t)512 * 768 * 2, (size_t)256 * 768 * 2, last ? 2 : 3, 2, 12, G, wg};
          EpiS2 E{(bf16_t*)(ws + OFF_YG), last ? 512 : NCHUNK};
          gemm_phase(lds, XUK, 768, S, E);
        } break;
#endif
#if PHMASK & 32
        case 5: {
          RectSched S{(const char*)(ws + OFF_YG), (const char*)(ws + OFF_WGLU), (size_t)256 * 256 * 2, 0, nMrows, 1, 4, G, wg};
          EpiGLU E{(const bf16_t*)(ws + OFF_YG), p.glu_b + l * 256, (bf16_t*)(ws + OFF_Y4)};
          gemm_phase(lds, 256, 256, S, E);
        } break;
#endif
#if PHMASK & 64
        case 6: {
          MergeSched S{(const char*)(ws + OFF_A), (const char*)(ws + OFF_Y4), (const char*)(ws + OFF_WIN), (const char*)(ws + OFF_WBR), nMrows, G, wg};
          EpiMerge E{(bf16_t*)(ws + OFF_GS + (size_t)wg * 131072), (float*)(ws + OFF_MIXTMP + (size_t)wg * 262144), (bf16_t*)(ws + OFF_MIX)};
          gemm_phase(lds, 1024, 1024, S, E);
        } break;
#endif
#if PHMASK & 128
        case 7: {
          RectSched S{(const char*)(ws + OFF_MIX), (const char*)(ws + OFF_WOUT), (size_t)256 * 1024 * 2, (size_t)256 * 1024 * 2, nMrows, 4, 16, G, wg};
          EpiRes E{hL, hC, H, modl, 2};
          gemm_phase(lds, 1024, 1024, S, E);
        } break;
#endif
#if PHMASK & 256
        case 8: norm_rows(p, H, H + (size_t)ML * 1024, p.norm_g + (size_t)(l * 2 + 1) * 1024, modl, 3, last ? ML : MT); break;
#endif
#if PHMASK & 512
        case 9: {
          RectSched S{(const char*)(ws + OFF_A), (const char*)(ws + OFF_WFF1), (size_t)256 * 1024 * 2, (size_t)256 * 1024 * 2, nMrows, 16, 16, G, wg};
          EpiFF1 E{(bf16_t*)(ws + OFF_FFH)};
          gemm_phase(lds, 1024, 1024, S, E);
        } break;
#endif
#if PHMASK & 1024
        case 10: {
          RectSched S{(const char*)(ws + OFF_FFH), (const char*)(ws + OFF_WFF2), (size_t)256 * 4096 * 2, (size_t)256 * 4096 * 2, nMrows, 4, 64, G, wg};
          EpiRes E{H, H + (size_t)ML * 1024, H, modl, 5};
          gemm_phase(lds, 4096, 4096, S, E);
        } break;
#endif
      }
    }
    if (ph + 1 < p.ph_hi) { cg::this_grid().sync(); }
  }
}

extern "C" void kernel_launch(void* const* d_in, const int* in_sizes, int n_in, void* d_out, int out_size, void* d_ws, size_t ws_size, hipStream_t stream) {
  constexpr size_t kDynLds = 131072;
  static int grid_blocks = 0;
  if (!grid_blocks) {
    (void)hipFuncSetAttribute((const void*)mk_forward, hipFuncAttributeMaxDynamicSharedMemorySize, (int)kDynLds);
    int dev = 0, cus = 0, per_cu = 0;
    (void)hipGetDevice(&dev);
    (void)hipDeviceGetAttribute(&cus, hipDeviceAttributeMultiprocessorCount, dev);
    (void)hipOccupancyMaxActiveBlocksPerMultiprocessor(&per_cu, mk_forward, 512, kDynLds);
    if (per_cu < 1) per_cu = 1;
    grid_blocks = cus;
  }
  P p{};
  const float** pp = (const float**)&p;
  for (int i = 0; i < 29; ++i) pp[i] = (const float*)d_in[i];
  p.out = (float*)d_out; p.ws = (unsigned char*)d_ws;
#if MULTI_LAUNCH
  for (int ph = 0; ph < N_PHASES; ++ph) {
    p.ph_lo = ph; p.ph_hi = ph + 1;
    hipLaunchKernelGGL(mk_forward, dim3(grid_blocks), dim3(512), kDynLds, stream, p);
  }
#else
  p.ph_lo = 0; p.ph_hi = N_PHASES;
  void* args[] = {&p};
  (void)hipLaunchCooperativeKernel((void*)mk_forward, dim3(grid_blocks), dim3(512), args, kDynLds, stream);
#endif
}
```

```cpp
#include <hip/hip_runtime.h>
#include <hip/hip_cooperative_groups.h>
namespace cg = cooperative_groups;

#define LAS __attribute__((address_space(3)))
typedef unsigned short bf16_t;
typedef short bf16x8 __attribute__((ext_vector_type(8)));
typedef float f32x4 __attribute__((ext_vector_type(4)));
typedef unsigned u32x4 __attribute__((ext_vector_type(4)));
typedef unsigned u32x2 __attribute__((ext_vector_type(2)));

#ifndef PHMASK
#define PHMASK 0x7ff
#endif
#ifndef DBL_MASK
#define DBL_MASK 0
#endif
#ifndef MULTI_LAUNCH
#define MULTI_LAUNCH 0
#endif

constexpr int DM = 1024, NB = 8, SEQL = 2048, NDEPTH = 4, CTXL = 256, DFF = 4096, INW = 6400;
constexpr int ML = NB * SEQL;
constexpr int MC = NB * CTXL;
constexpr int MT = ML + MC;
constexpr int TCH = 32;
constexpr int NCHUNK = MT / TCH;
constexpr int XUR = 768;
constexpr int XUK = 768;

constexpr size_t OFF_H = 0;
constexpr size_t OFF_A = OFF_H + (size_t)MT * DM * 4;
constexpr size_t OFF_MIX = OFF_A + (size_t)MT * DM * 2;
constexpr size_t OFF_R1 = OFF_MIX + (size_t)MT * DM * 2;
constexpr size_t OFF_PS = OFF_R1;
constexpr size_t OFF_Y4 = OFF_PS + (size_t)MT * 2304 * 2;
constexpr size_t OFF_VT = OFF_Y4 + (size_t)MT * DM * 2;
constexpr size_t OFF_XU = OFF_VT + (size_t)NB * 4 * 64 * 2304 * 2;
constexpr size_t OFF_S = OFF_XU + (size_t)16 * XUR * XUK * 2;
constexpr size_t OFF_YG = OFF_S + (size_t)16 * NCHUNK * 256 * 4;
constexpr size_t OFF_R1END = OFF_YG + (size_t)MT * 256 * 2;
constexpr size_t OFF_FFH = OFF_R1;
constexpr size_t OFF_MIXTMP = OFF_PS;
constexpr size_t OFF_GS = OFF_VT;
constexpr size_t OFF_WIN = OFF_R1END;
constexpr size_t OFF_WFF1 = OFF_WIN + (size_t)INW * DM * 2;
constexpr size_t OFF_WFF2 = OFF_WFF1 + (size_t)DFF * DM * 2;
constexpr size_t OFF_WOUT = OFF_WFF2 + (size_t)DFF * DM * 2;
constexpr size_t OFF_WBR = OFF_WOUT + (size_t)DM * DM * 2;
constexpr size_t OFF_WGLU = OFF_WBR + (size_t)DM * DM * 2;
constexpr size_t OFF_W1 = OFF_WGLU + (size_t)256 * 256 * 2;
constexpr size_t OFF_W2 = OFF_W1 + (size_t)16 * 256 * 512 * 2;
constexpr size_t OFF_SGUWT = OFF_W2 + (size_t)16 * 512 * 768 * 2;
constexpr size_t OFF_MOD = OFF_SGUWT + (size_t)4 * 128 * 128 * 4;
constexpr size_t OFF_BAR = OFF_MOD + (size_t)NDEPTH * 9 * 6144 * 4;
constexpr size_t OFF_END = OFF_BAR + 16384;
static_assert((size_t)MT * DFF * 2 <= OFF_R1END - OFF_R1, "FFH alias");
static_assert((size_t)256 * 262144 <= (size_t)MT * 2304 * 2, "MIXTMP alias");
static_assert((size_t)256 * 131072 <= OFF_R1END - OFF_VT, "GS alias");
static_assert(OFF_END < 440000000ull, "workspace");

struct P {
  const float *x, *c, *ctx, *c_ctx, *ada_w, *ada_b, *norm_g, *final_g, *w_in, *w_branch, *w_out,
      *lam_re, *lam_im, *log_dt, *b_re, *b_im, *c_re, *c_im, *s5_d, *glu_w, *glu_b, *rpb, *conv_w,
      *ln_g, *ln_b, *sgu_w, *sgu_b, *w_ff1, *w_ff2;
  float* out;
  unsigned char* ws;
  int ph_lo, ph_hi;
};

__device__ __forceinline__ int otid() { int t = threadIdx.x; asm volatile("" : "+v"(t)); return t; }
__device__ __forceinline__ float bf2f(bf16_t b) { return __uint_as_float(((unsigned)b) << 16); }
__device__ __forceinline__ float bflo(unsigned w) { return __uint_as_float(w << 16); }
__device__ __forceinline__ float bfhi(unsigned w) { return __uint_as_float(w & 0xffff0000u); }
__device__ __forceinline__ unsigned cvt_pk_bf16(float lo, float hi) { unsigned r; asm volatile("v_cvt_pk_bf16_f32 %0, %1, %2" : "=v"(r) : "v"(lo), "v"(hi)); return r; }
__device__ __forceinline__ float sigm(float x) { return 1.f / (1.f + __expf(-x)); }
__device__ __forceinline__ float gelu_tanh(float x) { return x * sigm(1.5957691216057308f * (x + 0.044715f * x * x * x)); }
__device__ __forceinline__ u32x4 pack8(f32x4 a, f32x4 b) { u32x4 r; r[0] = cvt_pk_bf16(a[0], a[1]); r[1] = cvt_pk_bf16(a[2], a[3]); r[2] = cvt_pk_bf16(b[0], b[1]); r[3] = cvt_pk_bf16(b[2], b[3]); return r; }
__device__ __forceinline__ float wave_sum(float v) {
#pragma unroll
  for (int o = 32; o >= 1; o >>= 1) v += __shfl_xor(v, o);
  return v;
}


#define XB_TMO      128
#define XB_XCNT(j)  (256  + 64 * (j))
#define XB_XSUB(j)  (1280 + 64 * (j))
#define XB_XGEN(j)  (2304 + 64 * (j))
#define XB_TOP      3328
#define XB_TOPGEN   3392
#define XCD_BAR_WORDS 3456
#define XB_SPIN_CAP (1u << 22)
__device__ __forceinline__ unsigned xb_ld(unsigned* p)              { return __hip_atomic_load(p, __ATOMIC_RELAXED, __HIP_MEMORY_SCOPE_AGENT); }
__device__ __forceinline__ unsigned xb_add(unsigned* p, unsigned v) { return __hip_atomic_fetch_add(p, v, __ATOMIC_RELAXED, __HIP_MEMORY_SCOPE_AGENT); }
__device__ __forceinline__ unsigned xb_xcc_id() { return (unsigned)__builtin_amdgcn_s_getreg((3 << 11) | 20) & 0xFu; }
#define XB_SPIN(cond, bar) do { unsigned _sp = 0; while (cond) { __builtin_amdgcn_s_sleep(1); \
    if ((++_sp & 255u) == 0u) { if (xb_ld(&(bar)[XB_TMO])) break; if (_sp > XB_SPIN_CAP) { atomicAdd(&(bar)[XB_TMO], 1u); break; } } } } while (0)
struct XcdBarrier { unsigned* bar; unsigned x; volatile LAS unsigned* st; };
__device__ __forceinline__ XcdBarrier xcd_barrier_post(unsigned* bar, volatile LAS unsigned* st) {
  XcdBarrier b; b.bar = bar; b.x = xb_xcc_id(); b.st = st;
  if (threadIdx.x == 0) (void)xb_add(&bar[XB_XCNT(b.x)], 1u);
  return b;
}
__device__ __forceinline__ void xcd_barrier_complete(unsigned* bar, unsigned x, unsigned& nloc, unsigned& nx) {
  const unsigned G = gridDim.x * gridDim.y * gridDim.z;
  unsigned sum, cnt, mine, sp = 0u;
  for (;;) {
    sum = 0u; cnt = 0u; mine = 0u;
#pragma unroll
    for (unsigned j = 0; j < 16; ++j) { const unsigned c = xb_ld(&bar[XB_XCNT(j)]); sum += c; cnt += (c > 0u) ? 1u : 0u; mine = (j == x) ? c : mine; }
    if (sum == G) break;
    __builtin_amdgcn_s_sleep(1);
    if ((++sp & 255u) == 0u) { if (xb_ld(&bar[XB_TMO])) break; if (sp > XB_SPIN_CAP) { atomicAdd(&bar[XB_TMO], 1u); break; } }
  }
  nloc = mine > 0u ? mine : 1u; nx = cnt > 0u ? cnt : 1u;
}
__device__ __forceinline__ void xcd_barrier(const XcdBarrier& b) {
  asm volatile("s_waitcnt vmcnt(0)" ::: "memory");
  __syncthreads();
  if (threadIdx.x == 0) {
    unsigned* bar = b.bar;
    __builtin_amdgcn_s_waitcnt(0);
    unsigned nloc = b.st[0], nx = b.st[1];
    if (nloc == 0u) { xcd_barrier_complete(bar, b.x, nloc, nx); b.st[0] = nloc; b.st[1] = nx; }
    const unsigned old = xb_add(&bar[XB_XSUB(b.x)], 1u);
    const unsigned gen = old / nloc;
    if (old + 1u == (gen + 1u) * nloc) {
      __builtin_amdgcn_fence(__ATOMIC_RELEASE, "agent");
      asm volatile("s_waitcnt vmcnt(0)" ::: "memory");
      const unsigned og = xb_add(&bar[XB_TOP], 1u);
      const unsigned tg = og / nx;
      if (og + 1u == (tg + 1u) * nx) xb_add(&bar[XB_TOPGEN], 1u);
      else XB_SPIN(xb_ld(&bar[XB_TOPGEN]) == tg, bar);
      __builtin_amdgcn_fence(__ATOMIC_ACQUIRE, "agent");
      xb_add(&bar[XB_XGEN(b.x)], 1u);
      asm volatile("s_waitcnt vmcnt(0)" ::: "memory");
    } else {
      XB_SPIN(xb_ld(&bar[XB_XGEN(b.x)]) == gen, bar);
      __builtin_amdgcn_fence(__ATOMIC_ACQUIRE, "agent");
      asm volatile("s_waitcnt vmcnt(0)" ::: "memory");
    }
  }
  __syncthreads();
}

constexpr int BM = 256, BK = 64, HALF = 128, HTB = HALF * BK * 2, NXCD = 8, WGM = 8;
__device__ __forceinline__ int lds_byte(int r, int c) { const int st = (r >> 4) * 2 + (c >> 5), rr = r & 15, cc = c & 31, ob = rr * 64 + cc * 2; return st * 1024 + (ob ^ (((ob >> 9) & 1) << 5)); }
__device__ __forceinline__ void stage_rc(int b, int& R, int& C) { const int st = b / 1024, sb = b % 1024, swz = sb ^ (((sb >> 9) & 1) << 5); R = (st >> 1) * 16 + swz / 64; C = (st & 1) * 32 + (swz % 64) / 2; }
__device__ __forceinline__ int perm32(int rho) { const int n = rho >> 4, i = rho & 15; return 8 * (i >> 2) + 4 * n + (i & 3); }

struct Unit { const char* A; const char* B; int nt, pm, pn, kind; };

__device__ __forceinline__ void rect_map(int L, int nM, int nN, int& pm, int& pn) {
  const int nwg = nM * nN; int wgid = L;
  { const int q = nwg / NXCD, r = nwg % NXCD, xcd = wgid % NXCD, off = wgid / NXCD; wgid = (xcd < r ? xcd * (q + 1) : r * (q + 1) + (xcd - r) * q) + off; }
  const int nig = WGM * nN, gid = wgid / nig, fm = gid * WGM, gsz = (nM - fm) < WGM ? (nM - fm) : WGM;
  pm = fm + ((wgid % nig) % gsz); pn = (wgid % nig) / gsz;
}

template <class Sched, class Epi>
__device__ __forceinline__ void gemm_phase(LAS unsigned char* lds, const int lda, const int ldb, const Sched& S, const Epi& E) {
  int tid_ = threadIdx.x; asm volatile("" : "+v"(tid_));
  const int tid = tid_, wid = __builtin_amdgcn_readfirstlane(tid >> 6), lane = tid & 63, wr = wid >> 2, wc = wid & 3, fr = lane & 15, fq = lane >> 4;
  unsigned voffA[2], voffB[2];
#pragma unroll
  for (int i = 0; i < 2; ++i) { int R, C; stage_rc(tid * 16 + i * 8192, R, C); const int Rb = (R & ~31) + perm32(R & 31);
    voffA[i] = (unsigned)(R * lda + C) * 2u; voffB[i] = (unsigned)(Rb * ldb + C) * 2u; }
  const size_t kstep = (size_t)(BK * 2);
  const size_t hstepA = (size_t)HALF * lda * 2, hstepB = (size_t)HALF * ldb * 2;
  const unsigned ldsw = (unsigned)wid * 1024u;
  const int aoff = lds_byte(wr * 64 + fr, fq * 8), boff = lds_byte(wc * 32 + fr, fq * 8);
#define PG8_SA(b, h) (((b) * 2 + (h)) * HTB)
#define PG8_SB(b, h) ((4 + (b) * 2 + (h)) * HTB)
#define PG8_STAGE(bufoff, gbase, voff) do { _Pragma("unroll") for (int _i = 0; _i < 2; ++_i) \
    __builtin_amdgcn_global_load_lds((const unsigned*)((const char*)(gbase) + (voff)[_i]), (LAS unsigned*)(lds + (bufoff) + ldsw + _i * 8192), 16, 0, 0); } while (0)
#define PG8_LDA(dst, b, h) do { _Pragma("unroll") for (int m = 0; m < 4; ++m) _Pragma("unroll") for (int k = 0; k < 2; ++k) dst[m][k] = *(const LAS bf16x8*)(lds + PG8_SA(b, h) + aoff + m * 2048 + k * 1024); } while (0)
#define PG8_LDB(dst, b, h) do { _Pragma("unroll") for (int n = 0; n < 2; ++n) _Pragma("unroll") for (int k = 0; k < 2; ++k) dst[n][k] = *(const LAS bf16x8*)(lds + PG8_SB(b, h) + boff + n * 2048 + k * 1024); } while (0)
#define PG8_MMA(ai, bj, At, Bt) do { __builtin_amdgcn_s_setprio(1); _Pragma("unroll") for (int m = 0; m < 4; ++m) _Pragma("unroll") for (int n = 0; n < 2; ++n) _Pragma("unroll") for (int k = 0; k < 2; ++k) \
    acc[ai][bj][m][n] = __builtin_amdgcn_mfma_f32_16x16x32_bf16(Bt[n][k], At[m][k], acc[ai][bj][m][n], 0, 0, 0); __builtin_amdgcn_s_setprio(0); } while (0)
#define PG8_WAIT_V(n) asm volatile("s_waitcnt vmcnt(" #n ")" ::: "memory")
#define PG8_WAIT_L(n) asm volatile("s_waitcnt lgkmcnt(" #n ")" ::: "memory")
#define PG8_BAR __builtin_amdgcn_s_barrier()
#define PG8_SCHED __builtin_amdgcn_sched_barrier(0)
  Unit cur, nxt; int ui = 0;
  if (!S.next(0, cur)) return;
  f32x4 acc[2][2][4][2];
#pragma unroll
  for (int a = 0; a < 2; ++a)
#pragma unroll
    for (int b = 0; b < 2; ++b)
#pragma unroll
      for (int m = 0; m < 4; ++m)
#pragma unroll
        for (int n = 0; n < 2; ++n) acc[a][b][m][n] = (f32x4){0.f, 0.f, 0.f, 0.f};
  bf16x8 At[4][2], B0[2][2], B1[2][2];
  const char* cA = cur.A; const char* cB = cur.B;
  PG8_STAGE(PG8_SB(0, 0), cB, voffB); PG8_STAGE(PG8_SA(0, 0), cA, voffA); PG8_STAGE(PG8_SB(0, 1), cB + hstepB, voffB); PG8_STAGE(PG8_SA(0, 1), cA + hstepA, voffA);
  if (wr == 1) PG8_BAR;
  PG8_WAIT_V(4); PG8_BAR;
  PG8_STAGE(PG8_SB(1, 0), cB + kstep, voffB); PG8_STAGE(PG8_SA(1, 0), cA + kstep, voffA); PG8_STAGE(PG8_SB(1, 1), cB + hstepB + kstep, voffB);
  PG8_WAIT_V(6); PG8_BAR;
  for (;;) {
    const bool has_next = S.next(ui + 1, nxt);
    const char* nA = has_next ? nxt.A : cA; const char* nB = has_next ? nxt.B : cB;
    const int nt = cur.nt;
    for (int t = 0; t < nt; t += 2) {
      const bool last = (t == nt - 2);
      const char* a1 = cA + (size_t)(t + 1) * kstep;
      const char* a2 = last ? nA : cA + (size_t)(t + 2) * kstep; const char* b2 = last ? nB : cB + (size_t)(t + 2) * kstep;
      const char* a3 = a2 + kstep; const char* b3 = b2 + kstep;
      PG8_LDB(B0, 0, 0); PG8_SCHED; PG8_LDA(At, 0, 0); PG8_STAGE(PG8_SA(1, 1), a1 + hstepA, voffA);
      PG8_WAIT_L(8); PG8_BAR; PG8_WAIT_L(0); PG8_MMA(0, 0, At, B0); PG8_BAR; PG8_SCHED;
      PG8_LDB(B1, 0, 1); PG8_STAGE(PG8_SB(0, 0), b2, voffB);
      PG8_BAR; PG8_WAIT_L(0); PG8_MMA(0, 1, At, B1); PG8_BAR;
      PG8_LDA(At, 0, 1); PG8_STAGE(PG8_SA(0, 0), a2, voffA);
      PG8_BAR; PG8_WAIT_L(0); PG8_MMA(1, 0, At, B0); PG8_BAR; PG8_SCHED;
      PG8_STAGE(PG8_SB(0, 1), b2 + hstepB, voffB);
      PG8_WAIT_V(6); PG8_BAR; PG8_MMA(1, 1, At, B1); PG8_BAR;
      PG8_LDB(B0, 1, 0); PG8_SCHED; PG8_LDA(At, 1, 0); PG8_STAGE(PG8_SA(0, 1), a2 + hstepA, voffA);
      PG8_WAIT_L(8); PG8_BAR; PG8_WAIT_L(0); PG8_MMA(0, 0, At, B0); PG8_BAR; PG8_SCHED;
      PG8_LDB(B1, 1, 1); PG8_STAGE(PG8_SB(1, 0), b3, voffB);
      PG8_BAR; PG8_WAIT_L(0); PG8_MMA(0, 1, At, B1); PG8_BAR;
      PG8_LDA(At, 1, 1); PG8_STAGE(PG8_SA(1, 0), a3, voffA);
      PG8_BAR; PG8_WAIT_L(0); PG8_MMA(1, 0, At, B0); PG8_BAR; PG8_SCHED;
      PG8_STAGE(PG8_SB(1, 1), b3 + hstepB, voffB);
      PG8_WAIT_V(6); PG8_BAR; PG8_MMA(1, 1, At, B1); PG8_BAR;
    }
    E(acc, cur, wr, wc, fr, fq);
    if (!has_next) break;
#pragma unroll
    for (int a = 0; a < 2; ++a)
#pragma unroll
      for (int b = 0; b < 2; ++b)
#pragma unroll
        for (int m = 0; m < 4; ++m)
#pragma unroll
          for (int n = 0; n < 2; ++n) acc[a][b][m][n] = (f32x4){0.f, 0.f, 0.f, 0.f};
    cur = nxt; cA = nA; cB = nB; ++ui;
  }
  PG8_WAIT_V(0);
  if (wr == 0) PG8_BAR;
  PG8_BAR;
#undef PG8_SA
#undef PG8_SB
#undef PG8_STAGE
#undef PG8_LDA
#undef PG8_LDB
#undef PG8_MMA
#undef PG8_WAIT_V
#undef PG8_WAIT_L
#undef PG8_BAR
#undef PG8_SCHED
}

typedef f32x4 Acc[2][2][4][2];
#define EPI_ROWS(u, wr, fr) \
  _Pragma("unroll") for (int ai = 0; ai < 2; ++ai) _Pragma("unroll") for (int m = 0; m < 4; ++m)
#define EPI_ROW(u, wr, fr) ((u).pm * 256 + ai * 128 + (wr) * 64 + m * 16 + (fr))
#define EPI_COL(wc, fq) (bj * 128 + (wc) * 32 + (fq) * 8)

__device__ __forceinline__ int bsel_of_tile(int pm) { return pm < 64 ? (pm >> 3) : 8; }

struct RectSched {
  const char* A; const char* B; size_t a_tile, b_tile; int nM, nN, nt, G, c;
  __device__ __forceinline__ bool next(int i, Unit& u) const {
    const int L = i * G + c; if (L >= nM * nN) return false;
    int pm, pn; rect_map(L, nM, nN, pm, pn);
    u.pm = pm; u.pn = pn; u.kind = 0; u.nt = nt; u.A = A + (size_t)pm * a_tile; u.B = B + (size_t)pn * b_tile; return true;
  }
};
struct G1Sched {
  const char* A; const char* B; int G, c, last;
  __device__ __forceinline__ bool next(int i, Unit& u) const {
    const int L = i * G + c; const int nl = 64 * 9, ncx = last ? 24 : 72;
    if (L >= nl + ncx) return false;
    int pm, pn;
    if (L < nl) rect_map(L, 64, 9, pm, pn);
    else { const int q = L - nl; if (last) { pm = 64 + q / 3; const int s = q % 3; pn = s == 0 ? 0 : (s + 1); } else { pm = 64 + q / 9; pn = q % 9; } }
    u.pm = pm; u.pn = pn; u.kind = 0; u.nt = 16; u.A = A + (size_t)pm * (256 * 1024 * 2); u.B = B + (size_t)pn * (256 * 1024 * 2); return true;
  }
};
struct S5Sched {
  const char* A; const char* B; size_t b_group, b_tile; int nMs, nN, nt, G, c;
  __device__ __forceinline__ bool next(int i, Unit& u) const {
    const int L = i * G + c; if (L >= 16 * nMs * nN) return false;
    const int g = L / (nMs * nN), r = L % (nMs * nN), pm = r / nN, pn = r % nN;
    u.pm = pm; u.pn = pn; u.kind = g; u.nt = nt;
    u.A = A + ((size_t)g * XUR + (size_t)pm * 256) * XUK * 2; u.B = B + (size_t)g * b_group + (size_t)pn * b_tile; return true;
  }
};
struct MergeSched {
  const char* Abuf; const char* Y4; const char* Win; const char* Wbr; int nM, G, c;
  __device__ __forceinline__ bool next(int i, Unit& u) const {
    const int su = (i >> 3) * G + c; if (su >= nM * 4) return false;
    const int j = i & 7, k = j >> 1, pm = su >> 2, pd = su & 3;
    u.pm = pm; u.pn = pd; u.kind = j;
    if (!(j & 1)) { u.nt = 16; u.A = Abuf + (size_t)pm * (256 * 1024 * 2); u.B = Win + (size_t)(2304 + k * 1024 + pd * 256) * (1024 * 2); }
    else { u.nt = 4; u.A = Y4 + (size_t)pm * (256 * 1024 * 2) + (size_t)k * 512; u.B = Wbr + (size_t)(pd * 256) * (1024 * 2) + (size_t)k * 512; }
    return true;
  }
};

struct EpiG1 {
  bf16_t* PS; bf16_t* XU; bf16_t* VT;
  __device__ __forceinline__ void operator()(const Acc& acc, const Unit& u, int wr, int wc, int fr, int fq) const {
    EPI_ROWS(u, wr, fr) {
      const int row = EPI_ROW(u, wr, fr);
#pragma unroll
      for (int bj = 0; bj < 2; ++bj) {
        const int c = EPI_COL(wc, fq);
        const u32x4 pk = pack8(acc[ai][bj][m][0], acc[ai][bj][m][1]);
        if (u.pn == 0) {
          const int g = c >> 4, h0 = c & 15;
          *(u32x4*)(XU + ((size_t)(g * XUR + (row >> 5)) * XUK + (row & 31) * 16 + h0)) = pk;
        } else if (u.pn == 3) {
          int b, tok; if (row < ML) { b = row >> 11; tok = row & 2047; } else { const int r2 = row - ML; b = r2 >> 8; tok = 2048 + (r2 & 255); }
          const int head = c >> 6, d0 = c & 63;
          bf16_t* base = VT + ((size_t)((b * 4 + head) * 64 + d0)) * 2304 + tok;
#pragma unroll
          for (int i = 0; i < 4; ++i) { base[(size_t)(2 * i) * 2304] = (bf16_t)(pk[i] & 0xffffu); base[(size_t)(2 * i + 1) * 2304] = (bf16_t)(pk[i] >> 16); }
        } else {
          *(u32x4*)(PS + (size_t)row * 2304 + u.pn * 256 + c) = pk;
        }
      }
    }
  }
};
struct EpiS1 {
  float* S;
  __device__ __forceinline__ void operator()(const Acc& acc, const Unit& u, int wr, int wc, int fr, int fq) const {
    EPI_ROWS(u, wr, fr) {
      const int row = EPI_ROW(u, wr, fr);
      if (row < NCHUNK) {
#pragma unroll
        for (int bj = 0; bj < 2; ++bj) {
          const int c = EPI_COL(wc, fq);
          float* dst = S + ((size_t)u.kind * NCHUNK + row) * 256 + c;
          *(f32x4*)dst = acc[ai][bj][m][0]; *(f32x4*)(dst + 4) = acc[ai][bj][m][1];
        }
      }
    }
  }
};
struct EpiS2 {
  bf16_t* YG; int rowlim;
  __device__ __forceinline__ void operator()(const Acc& acc, const Unit& u, int wr, int wc, int fr, int fq) const {
    EPI_ROWS(u, wr, fr) {
      const int row = EPI_ROW(u, wr, fr);
      if (row < rowlim) {
#pragma unroll
        for (int bj = 0; bj < 2; ++bj) {
          const int col = u.pn * 256 + EPI_COL(wc, fq);
          const int t = col >> 4, h0 = col & 15;
          f32x4 a = acc[ai][bj][m][0], b = acc[ai][bj][m][1];
#pragma unroll
          for (int i = 0; i < 4; ++i) { a[i] = gelu_tanh(a[i]); b[i] = gelu_tanh(b[i]); }
          *(u32x4*)(YG + ((size_t)(row * TCH + t)) * 256 + u.kind * 16 + h0) = pack8(a, b);
        }
      }
    }
  }
};
struct EpiGLU {
  const bf16_t* YG; const float* bias; bf16_t* Y4;
  __device__ __forceinline__ void operator()(const Acc& acc, const Unit& u, int wr, int wc, int fr, int fq) const {
    EPI_ROWS(u, wr, fr) {
      const int row = EPI_ROW(u, wr, fr);
#pragma unroll
      for (int bj = 0; bj < 2; ++bj) {
        const int c = EPI_COL(wc, fq);
        const u32x4 gv = *(const u32x4*)(YG + (size_t)row * 256 + c);
        const f32x4 b0 = *(const f32x4*)(bias + c), b1 = *(const f32x4*)(bias + c + 4);
        f32x4 a = acc[ai][bj][m][0] + b0, b = acc[ai][bj][m][1] + b1;
        a[0] = bflo(gv[0]) * sigm(a[0]); a[1] = bfhi(gv[0]) * sigm(a[1]); a[2] = bflo(gv[1]) * sigm(a[2]); a[3] = bfhi(gv[1]) * sigm(a[3]);
        b[0] = bflo(gv[2]) * sigm(b[0]); b[1] = bfhi(gv[2]) * sigm(b[1]); b[2] = bflo(gv[3]) * sigm(b[2]); b[3] = bfhi(gv[3]) * sigm(b[3]);
        *(u32x4*)(Y4 + (size_t)row * 1024 + c) = pack8(a, b);
      }
    }
  }
};
struct EpiMerge {
  bf16_t* GS; float* TMP; bf16_t* MIX;
  __device__ __forceinline__ void operator()(const Acc& acc, const Unit& u, int wr, int wc, int fr, int fq) const {
    const int tid = otid(); const int j = u.kind, k = j >> 1;
    EPI_ROWS(u, wr, fr) {
#pragma unroll
      for (int bj = 0; bj < 2; ++bj) {
        const int e = (ai * 4 + m) * 2 + bj;
        bf16_t* gs = GS + ((size_t)e * 512 + tid) * 8;
        float* tp = TMP + ((size_t)e * 512 + tid) * 8;
        if (!(j & 1)) {
          f32x4 a = acc[ai][bj][m][0], b = acc[ai][bj][m][1];
#pragma unroll
          for (int i = 0; i < 4; ++i) { a[i] = sigm(a[i]); b[i] = sigm(b[i]); }
          *(u32x4*)gs = pack8(a, b);
        } else {
          const u32x4 gv = *(const u32x4*)gs;
          f32x4 a = acc[ai][bj][m][0], b = acc[ai][bj][m][1];
          a[0] *= bflo(gv[0]); a[1] *= bfhi(gv[0]); a[2] *= bflo(gv[1]); a[3] *= bfhi(gv[1]);
          b[0] *= bflo(gv[2]); b[1] *= bfhi(gv[2]); b[2] *= bflo(gv[3]); b[3] *= bfhi(gv[3]);
          if (k > 0) { a += *(const f32x4*)tp; b += *(const f32x4*)(tp + 4); }
          if (k < 3) { *(f32x4*)tp = a; *(f32x4*)(tp + 4) = b; }
          else { const int row = EPI_ROW(u, wr, fr); const int c = u.pn * 256 + EPI_COL(wc, fq); *(u32x4*)(MIX + (size_t)row * 1024 + c) = pack8(a, b); }
        }
      }
    }
  }
};
struct EpiRes {
  const float* hL; const float* hC; float* H; const float* modbase; int modidx;
  __device__ __forceinline__ void operator()(const Acc& acc, const Unit& u, int wr, int wc, int fr, int fq) const {
    const float* mv = modbase + (size_t)bsel_of_tile(u.pm) * 6144 + modidx * 1024;
    EPI_ROWS(u, wr, fr) {
      const int row = EPI_ROW(u, wr, fr);
      const float* hs = row < ML ? hL + (size_t)row * 1024 : hC + (size_t)(row - ML) * 1024;
#pragma unroll
      for (int bj = 0; bj < 2; ++bj) {
        const int c = u.pn * 256 + EPI_COL(wc, fq);
        const f32x4 h0 = *(const f32x4*)(hs + c), h1 = *(const f32x4*)(hs + c + 4);
        const f32x4 m0 = *(const f32x4*)(mv + c), m1 = *(const f32x4*)(mv + c + 4);
        float* hd = H + (size_t)row * 1024 + c;
        *(f32x4*)hd = h0 + m0 * acc[ai][bj][m][0]; *(f32x4*)(hd + 4) = h1 + m1 * acc[ai][bj][m][1];
      }
    }
  }
};
struct EpiFF1 {
  bf16_t* FFH;
  __device__ __forceinline__ void operator()(const Acc& acc, const Unit& u, int wr, int wc, int fr, int fq) const {
    EPI_ROWS(u, wr, fr) {
      const int row = EPI_ROW(u, wr, fr);
#pragma unroll
      for (int bj = 0; bj < 2; ++bj) {
        const int c = u.pn * 256 + EPI_COL(wc, fq);
        f32x4 a = acc[ai][bj][m][0], b = acc[ai][bj][m][1];
#pragma unroll
        for (int i = 0; i < 4; ++i) { a[i] = fmaxf(a[i], 0.f); a[i] *= a[i]; b[i] = fmaxf(b[i], 0.f); b[i] *= b[i]; }
        *(u32x4*)(FFH + (size_t)row * 4096 + c) = pack8(a, b);
      }
    }
  }
};

__device__ void mod_task(const P& p, int task, float* lds) {
  const int tid = otid();
  float* sc = lds;
  float* red = lds + 9 * 1024;
  for (int i = tid; i < 9 * 1024; i += 512) { const float v = i < 8192 ? p.c[i] : p.c_ctx[i - 8192]; sc[i] = v * sigm(v); }
  __syncthreads();
  const int l = task / 48, jb = task % 48, jl = tid & 127, ks = tid >> 7, j = jb * 128 + jl;
  float a[9];
#pragma unroll
  for (int s = 0; s < 9; ++s) a[s] = 0.f;
  const float* w = p.ada_w + (size_t)l * 1024 * 6144 + j;
  for (int k = ks * 256; k < ks * 256 + 256; ++k) {
    const float wv = w[(size_t)k * 6144];
#pragma unroll
    for (int s = 0; s < 9; ++s) a[s] += sc[s * 1024 + k] * wv;
  }
#pragma unroll
  for (int s = 0; s < 9; ++s) red[(ks * 9 + s) * 128 + jl] = a[s];
  __syncthreads();
  float* MOD = (float*)(p.ws + OFF_MOD);
  for (int i = tid; i < 9 * 128; i += 512) {
    const int s = i >> 7, jj = i & 127;
    const float v = red[(0 * 9 + s) * 128 + jj] + red[(1 * 9 + s) * 128 + jj] + red[(2 * 9 + s) * 128 + jj] + red[(3 * 9 + s) * 128 + jj];
    MOD[((size_t)l * 9 + s) * 6144 + jb * 128 + jj] = v + p.ada_b[l * 6144 + jb * 128 + jj];
  }
  __syncthreads();
}

__device__ void tr_tile(const float* src, int lds_, bf16_t* dst, int ldd, float* tile  ) {
  const int tid = otid();
#pragma unroll
  for (int ps = 0; ps < 2; ++ps) {
    const int k = (tid >> 4) + ps * 32, n4 = (tid & 15) * 4;
    const f32x4 v = *(const f32x4*)(src + (size_t)k * lds_ + n4);
    tile[k * 65 + n4] = v[0]; tile[k * 65 + n4 + 1] = v[1]; tile[k * 65 + n4 + 2] = v[2]; tile[k * 65 + n4 + 3] = v[3];
  }
  __syncthreads();
  {
    const int n = tid >> 3, k8 = (tid & 7) * 8;
    u32x4 o;
#pragma unroll
    for (int i = 0; i < 4; ++i) o[i] = cvt_pk_bf16(tile[(k8 + 2 * i) * 65 + n], tile[(k8 + 2 * i + 1) * 65 + n]);
    *(u32x4*)(dst + (size_t)n * ldd + k8) = o;
  }
  __syncthreads();
}

struct cpx { float re, im; };
__device__ __forceinline__ cpx cmul(cpx a, cpx b) { return {a.re * b.re - a.im * b.im, a.re * b.im + a.im * b.re}; }
__device__ __forceinline__ cpx s5_apow(float lre, float lim, float dt, float e) {
  const float zr = lre * dt * e, zi = lim * dt * e; const float mg = expf(zr); float sn, cs; sincosf(zi, &sn, &cs); return {mg * cs, mg * sn};
}
__device__ __forceinline__ cpx s5_coef(float lre, float lim, float dt) {
  const cpx a = s5_apow(lre, lim, dt, 1.f); const float nr = a.re - 1.f, ni = a.im, den = lre * lre + lim * lim;
  return {(nr * lre + ni * lim) / den, (ni * lre - nr * lim) / den};
}

constexpr int NT_WIN = 1600, NT_FF1 = 1024, NT_FF2 = 1024, NT_OUT = 256, NT_BR = 256, NT_GLU = 16;
constexpr int NT_TR = NT_WIN + NT_FF1 + NT_FF2 + NT_OUT + NT_BR + NT_GLU;
constexpr int NT_TOEP = 512, NT_W2S = 256, NT_W1 = 128, NT_SGUW = 16;
constexpr int NT_PREP = NT_TR + NT_TOEP + NT_W2S + NT_W1 + NT_SGUW;

__device__ void prep_task(const P& p, int l, int task, float* lds) {
  const int tid = otid();
  unsigned char* ws = p.ws;
  if (task < NT_TR) {
    const float* src; bf16_t* dst; int N, ldd, tk, tn;
    int t = task;
    if (t < NT_WIN) { src = p.w_in + (size_t)l * 1024 * 6400; N = 6400; dst = (bf16_t*)(ws + OFF_WIN); ldd = 1024; tk = t / 100; tn = t % 100; }
    else if ((t -= NT_WIN) < NT_FF1) { src = p.w_ff1 + (size_t)l * 1024 * 4096; N = 4096; dst = (bf16_t*)(ws + OFF_WFF1); ldd = 1024; tk = t / 64; tn = t % 64; }
    else if ((t -= NT_FF1) < NT_FF2) { src = p.w_ff2 + (size_t)l * 4096 * 1024; N = 1024; dst = (bf16_t*)(ws + OFF_WFF2); ldd = 4096; tk = t / 16; tn = t % 16; }
    else if ((t -= NT_FF2) < NT_OUT) { src = p.w_out + (size_t)l * 1024 * 1024; N = 1024; dst = (bf16_t*)(ws + OFF_WOUT); ldd = 1024; tk = t / 16; tn = t % 16; }
    else if ((t -= NT_OUT) < NT_BR) { const int k = t >> 6; t &= 63; src = p.w_branch + ((size_t)l * 4 + k) * 256 * 1024; N = 1024; dst = (bf16_t*)(ws + OFF_WBR) + k * 256; ldd = 1024; tk = t / 16; tn = t % 16; }
    else { t -= NT_BR; src = p.glu_w + (size_t)l * 256 * 256; N = 256; dst = (bf16_t*)(ws + OFF_WGLU); ldd = 256; tk = t / 4; tn = t % 4; }
    tr_tile(src + (size_t)tk * 64 * N + tn * 64, N, dst + (size_t)tn * 64 * ldd + tk * 64, ldd, lds);
    return;
  }
  task -= NT_TR;
  bf16_t* W2 = (bf16_t*)(ws + OFF_W2);
  bf16_t* W1 = (bf16_t*)(ws + OFF_W1);
  if (task < NT_TOEP) {
    const int g = task >> 5, lag = task & 31;
    cpx* E = (cpx*)lds;
    if (tid < 128) {
      const int d = tid >> 6, pp = tid & 63; const int li = ((l * 2 + d) * 16 + g);
      const float dt = expf(p.log_dt[li]); const float lre = p.lam_re[li * 64 + pp], lim = p.lam_im[li * 64 + pp];
      E[tid] = cmul(s5_apow(lre, lim, dt, (float)lag), s5_coef(lre, lim, dt));
    }
    __syncthreads();
    if (tid < 256) {
      const int hp = tid >> 4, h = tid & 15;
      float kv[2];
#pragma unroll
      for (int d = 0; d < 2; ++d) {
        const int li = ((l * 2 + d) * 16 + g);
        const float* cre = p.c_re + ((size_t)li * 16 + hp) * 64; const float* cim = p.c_im + ((size_t)li * 16 + hp) * 64;
        const float* bre = p.b_re + (size_t)li * 64 * 16 + h; const float* bim = p.b_im + (size_t)li * 64 * 16 + h;
        float s = 0.f;
        for (int pp = 0; pp < 64; ++pp) {
          const cpx bb = cmul(E[d * 64 + pp], (cpx){bre[pp * 16], bim[pp * 16]});
          s += cre[pp] * bb.re - cim[pp] * bb.im;
        }
        kv[d] = s;
      }
      bf16_t* Wg = W2 + (size_t)g * 512 * 768;
      if (lag == 0) {
        const float v = kv[0] + kv[1] + (hp == h ? p.s5_d[l * 256 + g * 16 + h] : 0.f);
        const bf16_t bv = (bf16_t)(cvt_pk_bf16(v, 0.f) & 0xffffu);
        for (int t = 0; t < TCH; ++t) Wg[(size_t)(t * 16 + hp) * 768 + t * 16 + h] = bv;
      } else {
        const unsigned pk = cvt_pk_bf16(kv[0], kv[1]);
        const bf16_t v0 = (bf16_t)(pk & 0xffffu), v1 = (bf16_t)(pk >> 16);
        for (int jj = 0; jj + lag < TCH; ++jj) {
          const int t = jj + lag;
          Wg[(size_t)(t * 16 + hp) * 768 + jj * 16 + h] = v0;
          Wg[(size_t)(jj * 16 + hp) * 768 + t * 16 + h] = v1;
        }
      }
    }
    __syncthreads();
    return;
  }
  task -= NT_TOEP;
  if (task < NT_W2S) {
    for (int it = 0; it < 8; ++it) {
      const int idx = (task * 8 + it) * 512 + tid;
      const int pp = idx & 63, d = (idx >> 6) & 1, hp = (idx >> 7) & 15, t = (idx >> 11) & 31, g = idx >> 16;
      const int li = ((l * 2 + d) * 16 + g);
      const float dt = expf(p.log_dt[li]); const float lre = p.lam_re[li * 64 + pp], lim = p.lam_im[li * 64 + pp];
      const cpx ap = s5_apow(lre, lim, dt, d == 0 ? (float)(t + 1) : (float)(TCH - t));
      const cpx cc = {p.c_re[((size_t)li * 16 + hp) * 64 + pp], p.c_im[((size_t)li * 16 + hp) * 64 + pp]};
      const cpx v = cmul(cc, ap);
      *(unsigned*)(W2 + ((size_t)g * 512 + t * 16 + hp) * 768 + 512 + d * 128 + 2 * pp) = cvt_pk_bf16(v.re, -v.im);
    }
    return;
  }
  task -= NT_W2S;
  if (task < NT_W1) {
    const int idx = task * 512 + tid;
    const int j = idx & 31, pp = (idx >> 5) & 63, d = (idx >> 11) & 1, g = idx >> 12;
    const int li = ((l * 2 + d) * 16 + g);
    const float dt = expf(p.log_dt[li]); const float lre = p.lam_re[li * 64 + pp], lim = p.lam_im[li * 64 + pp];
    const cpx e = cmul(s5_apow(lre, lim, dt, d == 0 ? (float)(TCH - 1 - j) : (float)j), s5_coef(lre, lim, dt));
    const float* bre = p.b_re + ((size_t)li * 64 + pp) * 16; const float* bim = p.b_im + ((size_t)li * 64 + pp) * 16;
    bf16_t* r0 = W1 + ((size_t)g * 256 + d * 128 + 2 * pp) * 512 + j * 16;
    bf16_t* r1 = r0 + 512;
#pragma unroll
    for (int h = 0; h < 16; h += 2) {
      const cpx v0 = cmul(e, (cpx){bre[h], bim[h]}), v1 = cmul(e, (cpx){bre[h + 1], bim[h + 1]});
      *(unsigned*)(r0 + h) = cvt_pk_bf16(v0.re, v1.re); *(unsigned*)(r1 + h) = cvt_pk_bf16(v0.im, v1.im);
    }
    return;
  }
  task -= NT_W1;
  {
    float* WT = (float*)(ws + OFF_SGUWT);
    for (int it = 0; it < 8; ++it) {
      const int idx = (task * 8 + it) * 512 + tid;
      const int t = idx & 127, s = (idx >> 7) & 127, g = idx >> 14;
      WT[idx] = p.sgu_w[(((size_t)l * 4 + g) * 128 + t) * 128 + s];
    }
  }
}

__device__ void norm_rows(const P& p, const float* hL, const float* hC, const float* gvec, const float* modbase, int shift_idx, int nrows) {
  const int tid = otid(); const int lane = tid & 63, wid = tid >> 6;
  bf16_t* A = (bf16_t*)(p.ws + OFF_A);
  for (int row = blockIdx.x * 8 + wid; row < nrows; row += gridDim.x * 8) {
    const float* h = row < ML ? hL + (size_t)row * 1024 : hC + (size_t)(row - ML) * 1024;
    const int bsel = row < ML ? (row >> 11) : 8;
    const float* sh = modbase + (size_t)bsel * 6144 + shift_idx * 1024; const float* sc = sh + 1024;
    f32x4 v[4]; float ss = 0.f;
#pragma unroll
    for (int i = 0; i < 4; ++i) { v[i] = *(const f32x4*)(h + i * 256 + lane * 4); ss += v[i][0] * v[i][0] + v[i][1] * v[i][1] + v[i][2] * v[i][2] + v[i][3] * v[i][3]; }
    ss = wave_sum(ss);
    const float rstd = rsqrtf(ss * (1.f / 1024.f) + 1e-6f);
#pragma unroll
    for (int i = 0; i < 4; ++i) {
      const int c = i * 256 + lane * 4;
      const f32x4 g = *(const f32x4*)(gvec + c), s1 = *(const f32x4*)(sc + c), s0 = *(const f32x4*)(sh + c);
      f32x4 y;
#pragma unroll
      for (int q = 0; q < 4; ++q) y[q] = (v[i][q] * rstd * g[q]) * (1.f + s1[q]) + s0[q];
      u32x2 o; o[0] = cvt_pk_bf16(y[0], y[1]); o[1] = cvt_pk_bf16(y[2], y[3]);
      *(u32x2*)(A + (size_t)row * 1024 + c) = o;
    }
  }
}

__device__ void final_rows(const P& p) {
  const int tid = otid(); const int lane = tid & 63, wid = tid >> 6;
  const float* H = (const float*)(p.ws + OFF_H);
  for (int row = blockIdx.x * 8 + wid; row < ML; row += gridDim.x * 8) {
    const float* h = H + (size_t)row * 1024;
    f32x4 v[4]; float ss = 0.f;
#pragma unroll
    for (int i = 0; i < 4; ++i) { v[i] = *(const f32x4*)(h + i * 256 + lane * 4); ss += v[i][0] * v[i][0] + v[i][1] * v[i][1] + v[i][2] * v[i][2] + v[i][3] * v[i][3]; }
    ss = wave_sum(ss);
    const float rstd = rsqrtf(ss * (1.f / 1024.f) + 1e-6f);
#pragma unroll
    for (int i = 0; i < 4; ++i) {
      const int c = i * 256 + lane * 4;
      const f32x4 g = *(const f32x4*)(p.final_g + c);
      f32x4 y;
#pragma unroll
      for (int q = 0; q < 4; ++q) y[q] = v[i][q] * rstd * g[q];
      *(f32x4*)(p.out + (size_t)row * 1024 + c) = y;
    }
  }
}

template <bool LAT>
__device__ __forceinline__ void attn_task(const P& p, int task, int l, const float* rpb_lds, int lane) {
  constexpr int NG = LAT ? 16 : 8;
  const bf16_t* PS = (const bf16_t*)(p.ws + OFF_PS);
  const bf16_t* VT = (const bf16_t*)(p.ws + OFF_VT);
  bf16_t* Y4 = (bf16_t*)(p.ws + OFF_Y4);
  int b, head, r = 0, jb = 0, qrow0;
  if (LAT) { jb = task & 3; r = (task >> 2) & 31; head = (task >> 7) & 3; b = task >> 9; qrow0 = b * 2048 + r * 64 + jb * 16; }
  else { const int qb = task & 15; head = (task >> 4) & 3; b = task >> 6; qrow0 = ML + b * 256 + qb * 16; }
  const int n = lane & 15, kg = lane >> 4;
  const bf16_t* qp = PS + (size_t)(qrow0 + n) * 2304 + 256 + head * 64 + kg * 8;
  const bf16x8 q0 = *(const bf16x8*)qp, q1 = *(const bf16x8*)(qp + 32);
  const int rs = LAT ? min(max(r - 4, 0), 24) : 0;
  const int clo = LAT ? (jb == 0 ? 0 : jb == 1 ? 8 : jb == 2 ? 24 : 32) : 0;
  const int keyX = 8 * (n >> 2) + (n & 3);
  f32x4 s[NG][2];
#pragma unroll
  for (int gi = 0; gi < NG; ++gi) {
    int tokrow0;
    if (LAT && gi < 8) tokrow0 = b * 2048 + (rs + gi) * 64 + clo; else tokrow0 = ML + b * 256 + (gi - (LAT ? 8 : 0)) * 32;
    const bf16_t* kp = PS + (size_t)(tokrow0 + keyX) * 2304 + 512 + head * 64 + kg * 8;
    const bf16x8 kx0 = *(const bf16x8*)kp, kx1 = *(const bf16x8*)(kp + 32);
    const bf16x8 ky0 = *(const bf16x8*)(kp + 4 * 2304), ky1 = *(const bf16x8*)(kp + 4 * 2304 + 32);
    f32x4 z = {0.f, 0.f, 0.f, 0.f};
    s[gi][0] = __builtin_amdgcn_mfma_f32_16x16x32_bf16(kx0, q0, z, 0, 0, 0);
    s[gi][0] = __builtin_amdgcn_mfma_f32_16x16x32_bf16(kx1, q1, s[gi][0], 0, 0, 0);
    s[gi][1] = __builtin_amdgcn_mfma_f32_16x16x32_bf16(ky0, q0, z, 0, 0, 0);
    s[gi][1] = __builtin_amdgcn_mfma_f32_16x16x32_bf16(ky1, q1, s[gi][1], 0, 0, 0);
  }
  float mx = -3.0e38f;
  const int jq = jb * 16 + n; const int cs = min(max(jq - 8, 0), 48);
#pragma unroll
  for (int gi = 0; gi < NG; ++gi)
#pragma unroll
    for (int blk = 0; blk < 2; ++blk)
#pragma unroll
      for (int i = 0; i < 4; ++i) {
        float v = s[gi][blk][i] * 0.125f;
        if (LAT && gi < 8) {
          const int kc = clo + 8 * kg + blk * 4 + i;
          const bool ok = (kc >= cs) && (kc < cs + 16);
          const int dr = rs + gi - r + 7; const int dc = min(max(kc - jq + 15, 0), 30);
          const float bias = rpb_lds[(head * 15 + dr) * 31 + dc];
          v = ok ? v + bias : -1.0e30f;
        }
        s[gi][blk][i] = v; mx = fmaxf(mx, v);
      }
  mx = fmaxf(mx, __shfl_xor(mx, 16)); mx = fmaxf(mx, __shfl_xor(mx, 32));
  float sum = 0.f;
#pragma unroll
  for (int gi = 0; gi < NG; ++gi)
#pragma unroll
    for (int blk = 0; blk < 2; ++blk)
#pragma unroll
      for (int i = 0; i < 4; ++i) { const float e = __expf(s[gi][blk][i] - mx); s[gi][blk][i] = e; sum += e; }
  sum += __shfl_xor(sum, 16); sum += __shfl_xor(sum, 32);
  f32x4 o[4];
#pragma unroll
  for (int db = 0; db < 4; ++db) o[db] = (f32x4){0.f, 0.f, 0.f, 0.f};
  const bf16_t* vbase = VT + ((size_t)((b * 4 + head) * 64 + n)) * 2304 + kg * 8;
#pragma unroll
  for (int gi = 0; gi < NG; ++gi) {
    int tok0;
    if (LAT && gi < 8) tok0 = (rs + gi) * 64 + clo; else tok0 = 2048 + (gi - (LAT ? 8 : 0)) * 32;
    const u32x4 pk = pack8(s[gi][0], s[gi][1]);
    bf16x8 pf; __builtin_memcpy(&pf, &pk, 16);
#pragma unroll
    for (int db = 0; db < 4; ++db) {
      const bf16x8 vf = *(const bf16x8*)(vbase + (size_t)(db * 16) * 2304 + tok0);
      o[db] = __builtin_amdgcn_mfma_f32_16x16x32_bf16(vf, pf, o[db], 0, 0, 0);
    }
  }
  const float inv = 1.f / sum;
  bf16_t* op = Y4 + (size_t)(qrow0 + n) * 1024 + 256 + head * 64 + kg * 4;
#pragma unroll
  for (int db = 0; db < 4; ++db) {
    u32x2 w; w[0] = cvt_pk_bf16(o[db][0] * inv, o[db][1] * inv); w[1] = cvt_pk_bf16(o[db][2] * inv, o[db][3] * inv);
    *(u32x2*)(op + db * 16) = w;
  }
}

__device__ __forceinline__ void conv_task(const P& p, int l, int task) {
  const bf16_t* PS = (const bf16_t*)(p.ws + OFF_PS);
  bf16_t* Y4 = (bf16_t*)(p.ws + OFF_Y4);
  const int idx = task * 512 + otid();
  const int row = idx >> 5, c0 = (idx & 31) * 8;
  int pos, len; if (row < ML) { pos = row & 2047; len = 2048; } else { pos = (row - ML) & 255; len = 256; }
  const bf16_t* base = PS + (size_t)row * 2304;
  float z[3][8];
#pragma unroll
  for (int d = 0; d < 3; ++d) {
    const int pp = pos + d - 1;
    if (pp >= 0 && pp < len) {
      const u32x4 cv = *(const u32x4*)(base + (d - 1) * 2304 + 5 * 256 + c0), xv = *(const u32x4*)(base + (d - 1) * 2304 + 6 * 256 + c0);
#pragma unroll
      for (int i = 0; i < 4; ++i) { z[d][2 * i] = bflo(cv[i]) * bflo(xv[i]); z[d][2 * i + 1] = bfhi(cv[i]) * bfhi(xv[i]); }
    } else {
#pragma unroll
      for (int i = 0; i < 8; ++i) z[d][i] = 0.f;
    }
  }
  const u32x4 bv = *(const u32x4*)(base + 4 * 256 + c0);
  const float* w = p.conv_w + (size_t)l * 3 * 256 + c0;
  float y[8];
#pragma unroll
  for (int i = 0; i < 8; ++i) y[i] = w[i] * z[0][i] + w[256 + i] * z[1][i] + w[512 + i] * z[2][i];
  u32x4 o;
#pragma unroll
  for (int i = 0; i < 4; ++i) o[i] = cvt_pk_bf16(bflo(bv[i]) * y[2 * i], bfhi(bv[i]) * y[2 * i + 1]);
  *(u32x4*)(Y4 + (size_t)row * 1024 + 512 + c0) = o;
}

__device__ void sgu_task(const P& p, int l, int task, float* lds) {
  const int tid = otid();
  const bf16_t* PS = (const bf16_t*)(p.ws + OFF_PS);
  bf16_t* Y4 = (bf16_t*)(p.ws + OFF_Y4);
  const float* WT = (const float*)(p.ws + OFF_SGUWT);
  const int chunk = task >> 2, g = task & 3;
  float* wT = lds;
  float* vn = lds + 128 * 128;
  for (int i = tid; i < 128 * 128 / 4; i += 512) *(f32x4*)(wT + i * 4) = *(const f32x4*)(WT + (size_t)g * 16384 + i * 4);
  {
    const int s = tid >> 2, q = tid & 3;
    const bf16_t* vr = PS + (size_t)(chunk * 128 + s) * 2304 + 8 * 256;
    float sm = 0.f, sq = 0.f;
#pragma unroll
    for (int i = 0; i < 8; ++i) {
      const u32x4 v = *(const u32x4*)(vr + q * 64 + i * 8);
#pragma unroll
      for (int k = 0; k < 4; ++k) { const float a = bflo(v[k]), b = bfhi(v[k]); sm += a + b; sq += a * a + b * b; }
    }
    sm += __shfl_xor(sm, 1); sm += __shfl_xor(sm, 2); sq += __shfl_xor(sq, 1); sq += __shfl_xor(sq, 2);
    const float mu = sm * (1.f / 256.f); const float var = fmaxf(sq * (1.f / 256.f) - mu * mu, 0.f); const float rstd = rsqrtf(var + 1e-6f);
    const int cb = g * 64 + q * 16;
    const float* lg = p.ln_g + l * 256 + cb; const float* lb = p.ln_b + l * 256 + cb;
#pragma unroll
    for (int i = 0; i < 2; ++i) {
      const u32x4 v = *(const u32x4*)(vr + cb + i * 8);
#pragma unroll
      for (int k = 0; k < 4; ++k) {
        const int cc = i * 8 + 2 * k;
        vn[s * 64 + q * 16 + cc] = (bflo(v[k]) - mu) * rstd * lg[cc] + lb[cc];
        vn[s * 64 + q * 16 + cc + 1] = (bfhi(v[k]) - mu) * rstd * lg[cc + 1] + lb[cc + 1];
      }
    }
  }
  __syncthreads();
  const int tt = tid >> 4, cc = tid & 15;
  f32x4 acc[4];
#pragma unroll
  for (int i = 0; i < 4; ++i) acc[i] = (f32x4){0.f, 0.f, 0.f, 0.f};
#pragma unroll 4
  for (int s = 0; s < 128; ++s) {
    const f32x4 wv = *(const f32x4*)(wT + s * 128 + tt * 4);
    const f32x4 vv = *(const f32x4*)(vn + s * 64 + cc * 4);
#pragma unroll
    for (int i = 0; i < 4; ++i) acc[i] += wv[i] * vv;
  }
#pragma unroll
  for (int i = 0; i < 4; ++i) {
    const int t = tt * 4 + i; const int row = chunk * 128 + t;
    const float bs = p.sgu_b[((size_t)l * 4 + g) * 128 + t];
    const u32x2 uv = *(const u32x2*)(PS + (size_t)row * 2304 + 7 * 256 + g * 64 + cc * 4);
    u32x2 o; o[0] = cvt_pk_bf16(bflo(uv[0]) * (acc[i][0] + bs), bfhi(uv[0]) * (acc[i][1] + bs)); o[1] = cvt_pk_bf16(bflo(uv[1]) * (acc[i][2] + bs), bfhi(uv[1]) * (acc[i][3] + bs));
    *(u32x2*)(Y4 + (size_t)row * 1024 + 768 + g * 64 + cc * 4) = o;
  }
  __syncthreads();
}

__device__ void carry_phase(const P& p, int l) {
  const int gt = blockIdx.x * 512 + otid();
  if (gt >= 16 * 8 * 2 * 64) return;
  const int pp = gt & 63, d = (gt >> 6) & 1, b = (gt >> 7) & 7, g = gt >> 10;
  const float* S = (const float*)(p.ws + OFF_S) + (size_t)g * NCHUNK * 256 + d * 128 + 2 * pp;
  bf16_t* XU = (bf16_t*)(p.ws + OFF_XU) + (size_t)g * XUR * XUK + 512 + d * 128 + 2 * pp;
  const int li = ((l * 2 + d) * 16 + g);
  const float dt = expf(p.log_dt[li]);
  const cpx aT = s5_apow(p.lam_re[li * 64 + pp], p.lam_im[li * 64 + pp], dt, (float)TCH);
  cpx st = {0.f, 0.f};
  for (int i0 = 0; i0 < 72; i0 += 8) {
    float sre[8], sim[8]; int rows[8];
#pragma unroll
    for (int k = 0; k < 8; ++k) {
      const int i = i0 + k; int row;
      if (i < 8) row = 512 + b * 8 + (d == 0 ? i : 7 - i); else row = b * 64 + (d == 0 ? (i - 8) : 63 - (i - 8));
      rows[k] = row; const float2 v = *(const float2*)(S + (size_t)row * 256); sre[k] = v.x; sim[k] = v.y;
    }
#pragma unroll
    for (int k = 0; k < 8; ++k) {
      *(unsigned*)(XU + (size_t)rows[k] * XUK) = cvt_pk_bf16(st.re, st.im);
      const cpx ns = cmul(aT, st); st.re = ns.re + sre[k]; st.im = ns.im + sim[k];
    }
  }
}

constexpr int PH_PER_LAYER = 11;
constexpr int N_PHASES = 1 + NDEPTH * PH_PER_LAYER + 1;

__global__ void __launch_bounds__(512, 2) mk_forward(P p) {
  extern __shared__ __attribute__((aligned(16))) unsigned char shm[];
  LAS unsigned char* lds = (LAS unsigned char*)shm;
  float* ldsf = (float*)shm;
  const int G = gridDim.x, wg = blockIdx.x;
  unsigned char* ws = p.ws;
  volatile LAS unsigned* xbw = (volatile LAS unsigned*)(lds + 131072);
  if (threadIdx.x == 0) { xbw[0] = 0u; xbw[1] = 0u; xbw[2] = 0u; xbw[3] = 0u; }
  __syncthreads();
  const XcdBarrier xb = xcd_barrier_post((unsigned*)(ws + OFF_BAR), xbw);
  if (p.ph_lo < 0) cg::this_grid().sync();
  float* H = (float*)(ws + OFF_H);
  const float* MOD = (const float*)(ws + OFF_MOD);

  for (int ph = p.ph_lo; ph < p.ph_hi; ++ph) {
    int nrep = 1;
#if DBL_MASK
    { const int spx = (ph == 0) ? 11 : (ph == N_PHASES - 1) ? 13 : (ph - 1) % PH_PER_LAYER; if ((DBL_MASK >> spx) & 1) nrep = 2; }
#endif
    for (int rep = 0; rep < nrep; ++rep) {
    if (rep) xcd_barrier(xb);
    int tid_ = threadIdx.x; asm volatile("" : "+v"(tid_));
    const int tid = tid_, lane = tid & 63, wid = tid >> 6;
    if (ph == 0) {
      for (int t = wg; t < 192; t += G) mod_task(p, t, ldsf);
      for (int t = (wg + G - (192 % G)) % G; t < NT_PREP; t += G) prep_task(p, 0, t, ldsf);
    } else if (ph == N_PHASES - 1) {
      final_rows(p);
    } else {
      const int l = (ph - 1) / PH_PER_LAYER, sp = (ph - 1) % PH_PER_LAYER;
      const bool last = (l == NDEPTH - 1);
      const float* hL = l == 0 ? p.x : H; const float* hC = l == 0 ? p.ctx : H + (size_t)ML * 1024;
      const float* modl = MOD + (size_t)l * 9 * 6144;
      const int nMrows = last ? 64 : 72;
      switch (sp) {
#if PHMASK & 1
        case 0: {
          if (l > 0) for (int t = wg; t < NT_PREP; t += G) prep_task(p, l, t, ldsf);
          norm_rows(p, hL, hC, p.norm_g + (size_t)(l * 2 + 0) * 1024, modl, 0, MT);
        } break;
#endif
#if PHMASK & 2
        case 1: {
          G1Sched S{(const char*)(ws + OFF_A), (const char*)(ws + OFF_WIN), G, wg, last ? 1 : 0};
          EpiG1 E{(bf16_t*)(ws + OFF_PS), (bf16_t*)(ws + OFF_XU), (bf16_t*)(ws + OFF_VT)};
          gemm_phase(lds, 1024, 1024, S, E);
        } break;
#endif
#if PHMASK & 4
        case 2: {
          {
            S5Sched S{(const char*)(ws + OFF_XU), (const char*)(ws + OFF_W1), (size_t)256 * 512 * 2, 0, 3, 1, 8, G, wg};
            EpiS1 E{(float*)(ws + OFF_S)};
            gemm_phase(lds, XUK, 512, S, E);
          }
          __syncthreads();
          for (int i = tid; i < 4 * 15 * 31; i += 512) ldsf[i] = p.rpb[(size_t)l * 4 * 15 * 31 + i];
          __syncthreads();
          const int nwaves = G * 8, gw = wg * 8 + wid;
          for (int t = gw; t < 4096; t += nwaves) attn_task<true>(p, t, l, ldsf, lane);
          if (!last) for (int t = gw; t < 512; t += nwaves) attn_task<false>(p, t, l, ldsf, lane);
          const int nconv = (last ? ML : MT) * 32 / 512;
          for (int t = wg; t < nconv; t += G) conv_task(p, l, t);
          __syncthreads();
          const int nsgu = (last ? 128 : 144) * 4;
          for (int t = wg; t < nsgu; t += G) sgu_task(p, l, t, ldsf);
        } break;
#endif
#if PHMASK & 8
        case 3: carry_phase(p, l); break;
#endif
#if PHMASK & 16
        case 4: {
          S5Sched S{(const char*)(ws + OFF_XU), (const char*)(ws + OFF_W2), (size_t)512 * 768 * 2, (size_t)256 * 768 * 2, last ? 2 : 3, 2, 12, G, wg};
          EpiS2 E{(bf16_t*)(ws + OFF_YG), last ? 512 : NCHUNK};
          gemm_phase(lds, XUK, 768, S, E);
        } break;
#endif
#if PHMASK & 32
        case 5: {
          RectSched S{(const char*)(ws + OFF_YG), (const char*)(ws + OFF_WGLU), (size_t)256 * 256 * 2, 0, nMrows, 1, 4, G, wg};
          EpiGLU E{(const bf16_t*)(ws + OFF_YG), p.glu_b + l * 256, (bf16_t*)(ws + OFF_Y4)};
          gemm_phase(lds, 256, 256, S, E);
        } break;
#endif
#if PHMASK & 64
        case 6: {
          MergeSched S{(const char*)(ws + OFF_A), (const char*)(ws + OFF_Y4), (const char*)(ws + OFF_WIN), (const char*)(ws + OFF_WBR), nMrows, G, wg};
          EpiMerge E{(bf16_t*)(ws + OFF_GS + (size_t)wg * 131072), (float*)(ws + OFF_MIXTMP + (size_t)wg * 262144), (bf16_t*)(ws + OFF_MIX)};
          gemm_phase(lds, 1024, 1024, S, E);
        } break;
#endif
#if PHMASK & 128
        case 7: {
          RectSched S{(const char*)(ws + OFF_MIX), (const char*)(ws + OFF_WOUT), (size_t)256 * 1024 * 2, (size_t)256 * 1024 * 2, nMrows, 4, 16, G, wg};
          EpiRes E{hL, hC, H, modl, 2};
          gemm_phase(lds, 1024, 1024, S, E);
        } break;
#endif
#if PHMASK & 256
        case 8: norm_rows(p, H, H + (size_t)ML * 1024, p.norm_g + (size_t)(l * 2 + 1) * 1024, modl, 3, last ? ML : MT); break;
#endif
#if PHMASK & 512
        case 9: {
          RectSched S{(const char*)(ws + OFF_A), (const char*)(ws + OFF_WFF1), (size_t)256 * 1024 * 2, (size_t)256 * 1024 * 2, nMrows, 16, 16, G, wg};
          EpiFF1 E{(bf16_t*)(ws + OFF_FFH)};
          gemm_phase(lds, 1024, 1024, S, E);
        } break;
#endif
#if PHMASK & 1024
        case 10: {
          RectSched S{(const char*)(ws + OFF_FFH), (const char*)(ws + OFF_WFF2), (size_t)256 * 4096 * 2, (size_t)256 * 4096 * 2, nMrows, 4, 64, G, wg};
          EpiRes E{H, H + (size_t)ML * 1024, H, modl, 5};
          gemm_phase(lds, 4096, 4096, S, E);
        } break;
#endif
      }
    }
    }
    if (ph + 1 < p.ph_hi) { xcd_barrier(xb);
#if (DBL_MASK >> 12) & 1
      xcd_barrier(xb);
#endif
    }
  }
}

extern "C" void kernel_launch(void* const* d_in, const int* in_sizes, int n_in, void* d_out, int out_size, void* d_ws, size_t ws_size, hipStream_t stream) {
  constexpr size_t kDynLds = 131072 + 16;
  static int grid_blocks = 0;
  if (!grid_blocks) {
    (void)hipFuncSetAttribute((const void*)mk_forward, hipFuncAttributeMaxDynamicSharedMemorySize, (int)kDynLds);
    int dev = 0, cus = 0, per_cu = 0;
    (void)hipGetDevice(&dev);
    (void)hipDeviceGetAttribute(&cus, hipDeviceAttributeMultiprocessorCount, dev);
    (void)hipOccupancyMaxActiveBlocksPerMultiprocessor(&per_cu, mk_forward, 512, kDynLds);
    if (per_cu < 1) per_cu = 1;
    grid_blocks = cus;
  }
  P p{};
  const float** pp = (const float**)&p;
  for (int i = 0; i < 29; ++i) pp[i] = (const float*)d_in[i];
  p.out = (float*)d_out; p.ws = (unsigned char*)d_ws;
  (void)hipMemsetAsync((unsigned char*)d_ws + OFF_BAR, 0, 16384, stream);
#if MULTI_LAUNCH
  for (int ph = 0; ph < N_PHASES; ++ph) {
    p.ph_lo = ph; p.ph_hi = ph + 1;
    hipLaunchKernelGGL(mk_forward, dim3(grid_blocks), dim3(512), kDynLds, stream, p);
  }
#else
  p.ph_lo = 0; p.ph_hi = N_PHASES;
  void* args[] = {&p};
  (void)hipLaunchCooperativeKernel((void*)mk_forward, dim3(grid_blocks), dim3(512), args, kDynLds, stream);
#endif
}
```

```cpp
#include <hip/hip_runtime.h>
#include <hip/hip_cooperative_groups.h>
namespace cg = cooperative_groups;

#define LAS __attribute__((address_space(3)))
typedef unsigned short bf16_t;
typedef short bf16x8 __attribute__((ext_vector_type(8)));
typedef float f32x4 __attribute__((ext_vector_type(4)));
typedef unsigned u32x4 __attribute__((ext_vector_type(4)));
typedef unsigned u32x2 __attribute__((ext_vector_type(2)));

#ifndef PHMASK
#define PHMASK 0x7ff
#endif
#ifndef DBL_MASK
#define DBL_MASK 0
#endif
#ifndef MULTI_LAUNCH
#define MULTI_LAUNCH 0
#endif

constexpr int DM = 1024, NB = 8, SEQL = 2048, NDEPTH = 4, CTXL = 256, DFF = 4096, INW = 6400;
constexpr int ML = NB * SEQL;
constexpr int MC = NB * CTXL;
constexpr int MT = ML + MC;
constexpr int TCH = 32;
constexpr int NCHUNK = MT / TCH;
constexpr int XUR = 768;
constexpr int XUK = 768;

constexpr size_t OFF_H = 0;
constexpr size_t OFF_A = OFF_H + (size_t)MT * DM * 4;
constexpr size_t OFF_MIX = OFF_A + (size_t)MT * DM * 2;
constexpr size_t OFF_R1 = OFF_MIX + (size_t)MT * DM * 2;
constexpr size_t OFF_PS = OFF_R1;
constexpr size_t OFF_Y4 = OFF_PS + (size_t)MT * 2304 * 2;
constexpr size_t OFF_VT = OFF_Y4 + (size_t)MT * DM * 2;
constexpr size_t OFF_XU = OFF_VT + (size_t)NB * 4 * 64 * 2304 * 2;
constexpr size_t OFF_S = OFF_XU + (size_t)16 * XUR * XUK * 2;
constexpr size_t OFF_YG = OFF_S + (size_t)16 * NCHUNK * 256 * 4;
constexpr size_t OFF_R1END = OFF_YG + (size_t)MT * 256 * 2;
constexpr size_t OFF_FFH = OFF_R1;
constexpr size_t OFF_MIXTMP = OFF_PS;
constexpr size_t OFF_GS = OFF_VT;
constexpr size_t OFF_WIN = OFF_R1END;
constexpr size_t OFF_WFF1 = OFF_WIN + (size_t)INW * DM * 2;
constexpr size_t OFF_WFF2 = OFF_WFF1 + (size_t)DFF * DM * 2;
constexpr size_t OFF_WOUT = OFF_WFF2 + (size_t)DFF * DM * 2;
constexpr size_t OFF_WBR = OFF_WOUT + (size_t)DM * DM * 2;
constexpr size_t OFF_WGLU = OFF_WBR + (size_t)DM * DM * 2;
constexpr size_t OFF_W1 = OFF_WGLU + (size_t)256 * 256 * 2;
constexpr size_t OFF_W2 = OFF_W1 + (size_t)16 * 256 * 512 * 2;
constexpr size_t OFF_SGUWT = OFF_W2 + (size_t)16 * 512 * 768 * 2;
constexpr size_t OFF_MOD = OFF_SGUWT + (size_t)4 * 128 * 128 * 4;
constexpr size_t OFF_BAR = OFF_MOD + (size_t)NDEPTH * 9 * 6144 * 4;
constexpr size_t OFF_PART = OFF_BAR + 16384;
constexpr size_t OFF_END = OFF_PART + (size_t)8 * MC * DM * 4;
constexpr size_t OFF_GP = OFF_PS + (size_t)256 * 262144;
static_assert(OFF_GP + (size_t)MC * 4096 * 2 <= OFF_Y4, "GP alias");
static_assert((size_t)MT * DFF * 2 <= OFF_R1END - OFF_R1, "FFH alias");
static_assert((size_t)256 * 262144 <= (size_t)MT * 2304 * 2, "MIXTMP alias");
static_assert((size_t)256 * 131072 <= OFF_R1END - OFF_VT, "GS alias");
static_assert(OFF_END < 452000000ull, "workspace");

struct P {
  const float *x, *c, *ctx, *c_ctx, *ada_w, *ada_b, *norm_g, *final_g, *w_in, *w_branch, *w_out,
      *lam_re, *lam_im, *log_dt, *b_re, *b_im, *c_re, *c_im, *s5_d, *glu_w, *glu_b, *rpb, *conv_w,
      *ln_g, *ln_b, *sgu_w, *sgu_b, *w_ff1, *w_ff2;
  float* out;
  unsigned char* ws;
  int ph_lo, ph_hi;
};

__device__ __forceinline__ int otid() { int t = threadIdx.x; asm volatile("" : "+v"(t)); return t; }
__device__ __forceinline__ float bf2f(bf16_t b) { return __uint_as_float(((unsigned)b) << 16); }
__device__ __forceinline__ float bflo(unsigned w) { return __uint_as_float(w << 16); }
__device__ __forceinline__ float bfhi(unsigned w) { return __uint_as_float(w & 0xffff0000u); }
__device__ __forceinline__ unsigned cvt_pk_bf16(float lo, float hi) { unsigned r; asm volatile("v_cvt_pk_bf16_f32 %0, %1, %2" : "=v"(r) : "v"(lo), "v"(hi)); return r; }
__device__ __forceinline__ float sigm(float x) { return 1.f / (1.f + __expf(-x)); }
__device__ __forceinline__ float gelu_tanh(float x) { return x * sigm(1.5957691216057308f * (x + 0.044715f * x * x * x)); }
__device__ __forceinline__ u32x4 pack8(f32x4 a, f32x4 b) { u32x4 r; r[0] = cvt_pk_bf16(a[0], a[1]); r[1] = cvt_pk_bf16(a[2], a[3]); r[2] = cvt_pk_bf16(b[0], b[1]); r[3] = cvt_pk_bf16(b[2], b[3]); return r; }
__device__ __forceinline__ float wave_sum(float v) {
#pragma unroll
  for (int o = 32; o >= 1; o >>= 1) v += __shfl_xor(v, o);
  return v;
}


#define XB_TMO      128
#define XB_XCNT(j)  (256  + 64 * (j))
#define XB_XSUB(j)  (1280 + 64 * (j))
#define XB_XGEN(j)  (2304 + 64 * (j))
#define XB_TOP      3328
#define XB_TOPGEN   3392
#define XCD_BAR_WORDS 3456
#define XB_SPIN_CAP (1u << 22)
__device__ __forceinline__ unsigned xb_ld(unsigned* p)              { return __hip_atomic_load(p, __ATOMIC_RELAXED, __HIP_MEMORY_SCOPE_AGENT); }
__device__ __forceinline__ unsigned xb_add(unsigned* p, unsigned v) { return __hip_atomic_fetch_add(p, v, __ATOMIC_RELAXED, __HIP_MEMORY_SCOPE_AGENT); }
__device__ __forceinline__ unsigned xb_xcc_id() { return (unsigned)__builtin_amdgcn_s_getreg((3 << 11) | 20) & 0xFu; }
#define XB_SPIN(cond, bar) do { unsigned _sp = 0; while (cond) { __builtin_amdgcn_s_sleep(1); \
    if ((++_sp & 255u) == 0u) { if (xb_ld(&(bar)[XB_TMO])) break; if (_sp > XB_SPIN_CAP) { atomicAdd(&(bar)[XB_TMO], 1u); break; } } } } while (0)
struct XcdBarrier { unsigned* bar; unsigned x; volatile LAS unsigned* st; };
__device__ __forceinline__ XcdBarrier xcd_barrier_post(unsigned* bar, volatile LAS unsigned* st) {
  XcdBarrier b; b.bar = bar; b.x = xb_xcc_id(); b.st = st;
  if (threadIdx.x == 0) (void)xb_add(&bar[XB_XCNT(b.x)], 1u);
  return b;
}
__device__ __forceinline__ void xcd_barrier_complete(unsigned* bar, unsigned x, unsigned& nloc, unsigned& nx) {
  const unsigned G = gridDim.x * gridDim.y * gridDim.z;
  unsigned sum, cnt, mine, sp = 0u;
  for (;;) {
    sum = 0u; cnt = 0u; mine = 0u;
#pragma unroll
    for (unsigned j = 0; j < 16; ++j) { const unsigned c = xb_ld(&bar[XB_XCNT(j)]); sum += c; cnt += (c > 0u) ? 1u : 0u; mine = (j == x) ? c : mine; }
    if (sum == G) break;
    __builtin_amdgcn_s_sleep(1);
    if ((++sp & 255u) == 0u) { if (xb_ld(&bar[XB_TMO])) break; if (sp > XB_SPIN_CAP) { atomicAdd(&bar[XB_TMO], 1u); break; } }
  }
  nloc = mine > 0u ? mine : 1u; nx = cnt > 0u ? cnt : 1u;
}
__device__ __forceinline__ void xcd_barrier(const XcdBarrier& b) {
  asm volatile("s_waitcnt vmcnt(0)" ::: "memory");
  __syncthreads();
  if (threadIdx.x == 0) {
    unsigned* bar = b.bar;
    __builtin_amdgcn_s_waitcnt(0);
    unsigned nloc = b.st[0], nx = b.st[1];
    if (nloc == 0u) { xcd_barrier_complete(bar, b.x, nloc, nx); b.st[0] = nloc; b.st[1] = nx; }
    const unsigned old = xb_add(&bar[XB_XSUB(b.x)], 1u);
    const unsigned gen = old / nloc;
    if (old + 1u == (gen + 1u) * nloc) {
      __builtin_amdgcn_fence(__ATOMIC_RELEASE, "agent");
      asm volatile("s_waitcnt vmcnt(0)" ::: "memory");
      const unsigned og = xb_add(&bar[XB_TOP], 1u);
      const unsigned tg = og / nx;
      if (og + 1u == (tg + 1u) * nx) xb_add(&bar[XB_TOPGEN], 1u);
      else XB_SPIN(xb_ld(&bar[XB_TOPGEN]) == tg, bar);
      __builtin_amdgcn_fence(__ATOMIC_ACQUIRE, "agent");
      xb_add(&bar[XB_XGEN(b.x)], 1u);
      asm volatile("s_waitcnt vmcnt(0)" ::: "memory");
    } else {
      XB_SPIN(xb_ld(&bar[XB_XGEN(b.x)]) == gen, bar);
      __builtin_amdgcn_fence(__ATOMIC_ACQUIRE, "agent");
      asm volatile("s_waitcnt vmcnt(0)" ::: "memory");
    }
  }
  __syncthreads();
}

constexpr int BM = 256, BK = 64, HALF = 128, HTB = HALF * BK * 2, NXCD = 8, WGM = 8;
__device__ __forceinline__ int lds_byte(int r, int c) { const int st = (r >> 4) * 2 + (c >> 5), rr = r & 15, cc = c & 31, ob = rr * 64 + cc * 2; return st * 1024 + (ob ^ (((ob >> 9) & 1) << 5)); }
__device__ __forceinline__ void stage_rc(int b, int& R, int& C) { const int st = b / 1024, sb = b % 1024, swz = sb ^ (((sb >> 9) & 1) << 5); R = (st >> 1) * 16 + swz / 64; C = (st & 1) * 32 + (swz % 64) / 2; }
__device__ __forceinline__ int perm32(int rho) { const int n = rho >> 4, i = rho & 15; return 8 * (i >> 2) + 4 * n + (i & 3); }

struct Unit { const char* A; const char* B; int nt, pm, pn, kind; };

__device__ __forceinline__ void rect_map(int L, int nM, int nN, int& pm, int& pn) {
  const int nwg = nM * nN; int wgid = L;
  { const int q = nwg / NXCD, r = nwg % NXCD, xcd = wgid % NXCD, off = wgid / NXCD; wgid = (xcd < r ? xcd * (q + 1) : r * (q + 1) + (xcd - r) * q) + off; }
  const int nig = WGM * nN, gid = wgid / nig, fm = gid * WGM, gsz = (nM - fm) < WGM ? (nM - fm) : WGM;
  pm = fm + ((wgid % nig) % gsz); pn = (wgid % nig) / gsz;
}

template <class Sched, class Epi>
__device__ __forceinline__ void gemm_phase(LAS unsigned char* lds, const int lda, const int ldb, const Sched& S, const Epi& E) {
  int tid_ = threadIdx.x; asm volatile("" : "+v"(tid_));
  const int tid = tid_, wid = __builtin_amdgcn_readfirstlane(tid >> 6), lane = tid & 63, wr = wid >> 2, wc = wid & 3, fr = lane & 15, fq = lane >> 4;
  unsigned voffA[2], voffB[2];
#pragma unroll
  for (int i = 0; i < 2; ++i) { int R, C; stage_rc(tid * 16 + i * 8192, R, C); const int Rb = (R & ~31) + perm32(R & 31);
    voffA[i] = (unsigned)(R * lda + C) * 2u; voffB[i] = (unsigned)(Rb * ldb + C) * 2u; }
  const size_t kstep = (size_t)(BK * 2);
  const size_t hstepA = (size_t)HALF * lda * 2, hstepB = (size_t)HALF * ldb * 2;
  const unsigned ldsw = (unsigned)wid * 1024u;
  const int aoff = lds_byte(wr * 64 + fr, fq * 8), boff = lds_byte(wc * 32 + fr, fq * 8);
#define PG8_SA(b, h) (((b) * 2 + (h)) * HTB)
#define PG8_SB(b, h) ((4 + (b) * 2 + (h)) * HTB)
#define PG8_STAGE(bufoff, gbase, voff) do { _Pragma("unroll") for (int _i = 0; _i < 2; ++_i) \
    __builtin_amdgcn_global_load_lds((const unsigned*)((const char*)(gbase) + (voff)[_i]), (LAS unsigned*)(lds + (bufoff) + ldsw + _i * 8192), 16, 0, 0); } while (0)
#define PG8_LDA(dst, b, h) do { _Pragma("unroll") for (int m = 0; m < 4; ++m) _Pragma("unroll") for (int k = 0; k < 2; ++k) dst[m][k] = *(const LAS bf16x8*)(lds + PG8_SA(b, h) + aoff + m * 2048 + k * 1024); } while (0)
#define PG8_LDB(dst, b, h) do { _Pragma("unroll") for (int n = 0; n < 2; ++n) _Pragma("unroll") for (int k = 0; k < 2; ++k) dst[n][k] = *(const LAS bf16x8*)(lds + PG8_SB(b, h) + boff + n * 2048 + k * 1024); } while (0)
#define PG8_MMA(ai, bj, At, Bt) do { __builtin_amdgcn_s_setprio(1); _Pragma("unroll") for (int m = 0; m < 4; ++m) _Pragma("unroll") for (int n = 0; n < 2; ++n) _Pragma("unroll") for (int k = 0; k < 2; ++k) \
    acc[ai][bj][m][n] = __builtin_amdgcn_mfma_f32_16x16x32_bf16(Bt[n][k], At[m][k], acc[ai][bj][m][n], 0, 0, 0); __builtin_amdgcn_s_setprio(0); } while (0)
#define PG8_WAIT_V(n) asm volatile("s_waitcnt vmcnt(" #n ")" ::: "memory")
#define PG8_WAIT_L(n) asm volatile("s_waitcnt lgkmcnt(" #n ")" ::: "memory")
#define PG8_BAR __builtin_amdgcn_s_barrier()
#define PG8_SCHED __builtin_amdgcn_sched_barrier(0)
  Unit cur, nxt; int ui = 0;
  if (!S.next(0, cur)) return;
  f32x4 acc[2][2][4][2];
#pragma unroll
  for (int a = 0; a < 2; ++a)
#pragma unroll
    for (int b = 0; b < 2; ++b)
#pragma unroll
      for (int m = 0; m < 4; ++m)
#pragma unroll
        for (int n = 0; n < 2; ++n) acc[a][b][m][n] = (f32x4){0.f, 0.f, 0.f, 0.f};
  bf16x8 At[4][2], B0[2][2], B1[2][2];
  const char* cA = cur.A; const char* cB = cur.B;
  PG8_STAGE(PG8_SB(0, 0), cB, voffB); PG8_STAGE(PG8_SA(0, 0), cA, voffA); PG8_STAGE(PG8_SB(0, 1), cB + hstepB, voffB); PG8_STAGE(PG8_SA(0, 1), cA + hstepA, voffA);
  if (wr == 1) PG8_BAR;
  PG8_WAIT_V(4); PG8_BAR;
  PG8_STAGE(PG8_SB(1, 0), cB + kstep, voffB); PG8_STAGE(PG8_SA(1, 0), cA + kstep, voffA); PG8_STAGE(PG8_SB(1, 1), cB + hstepB + kstep, voffB);
  PG8_WAIT_V(6); PG8_BAR;
  for (;;) {
    const bool has_next = S.next(ui + 1, nxt);
    const char* nA = has_next ? nxt.A : cA; const char* nB = has_next ? nxt.B : cB;
    const int nt = cur.nt;
    for (int t = 0; t < nt; t += 2) {
      const bool last = (t == nt - 2);
      const char* a1 = cA + (size_t)(t + 1) * kstep;
      const char* a2 = last ? nA : cA + (size_t)(t + 2) * kstep; const char* b2 = last ? nB : cB + (size_t)(t + 2) * kstep;
      const char* a3 = a2 + kstep; const char* b3 = b2 + kstep;
      PG8_LDB(B0, 0, 0); PG8_SCHED; PG8_LDA(At, 0, 0); PG8_STAGE(PG8_SA(1, 1), a1 + hstepA, voffA);
      PG8_WAIT_L(8); PG8_BAR; PG8_WAIT_L(0); PG8_MMA(0, 0, At, B0); PG8_BAR; PG8_SCHED;
      PG8_LDB(B1, 0, 1); PG8_STAGE(PG8_SB(0, 0), b2, voffB);
      PG8_BAR; PG8_WAIT_L(0); PG8_MMA(0, 1, At, B1); PG8_BAR;
      PG8_LDA(At, 0, 1); PG8_STAGE(PG8_SA(0, 0), a2, voffA);
      PG8_BAR; PG8_WAIT_L(0); PG8_MMA(1, 0, At, B0); PG8_BAR; PG8_SCHED;
      PG8_STAGE(PG8_SB(0, 1), b2 + hstepB, voffB);
      PG8_WAIT_V(6); PG8_BAR; PG8_MMA(1, 1, At, B1); PG8_BAR;
      PG8_LDB(B0, 1, 0); PG8_SCHED; PG8_LDA(At, 1, 0); PG8_STAGE(PG8_SA(0, 1), a2 + hstepA, voffA);
      PG8_WAIT_L(8); PG8_BAR; PG8_WAIT_L(0); PG8_MMA(0, 0, At, B0); PG8_BAR; PG8_SCHED;
      PG8_LDB(B1, 1, 1); PG8_STAGE(PG8_SB(1, 0), b3, voffB);
      PG8_BAR; PG8_WAIT_L(0); PG8_MMA(0, 1, At, B1); PG8_BAR;
      PG8_LDA(At, 1, 1); PG8_STAGE(PG8_SA(1, 0), a3, voffA);
      PG8_BAR; PG8_WAIT_L(0); PG8_MMA(1, 0, At, B0); PG8_BAR; PG8_SCHED;
      PG8_STAGE(PG8_SB(1, 1), b3 + hstepB, voffB);
      PG8_WAIT_V(6); PG8_BAR; PG8_MMA(1, 1, At, B1); PG8_BAR;
    }
    E(acc, cur, wr, wc, fr, fq);
    if (!has_next) break;
#pragma unroll
    for (int a = 0; a < 2; ++a)
#pragma unroll
      for (int b = 0; b < 2; ++b)
#pragma unroll
        for (int m = 0; m < 4; ++m)
#pragma unroll
          for (int n = 0; n < 2; ++n) acc[a][b][m][n] = (f32x4){0.f, 0.f, 0.f, 0.f};
    cur = nxt; cA = nA; cB = nB; ++ui;
  }
  PG8_WAIT_V(0);
  if (wr == 0) PG8_BAR;
  PG8_BAR;
#undef PG8_SA
#undef PG8_SB
#undef PG8_STAGE
#undef PG8_LDA
#undef PG8_LDB
#undef PG8_MMA
#undef PG8_WAIT_V
#undef PG8_WAIT_L
#undef PG8_BAR
#undef PG8_SCHED
}

typedef f32x4 Acc[2][2][4][2];
#define EPI_ROWS(u, wr, fr) \
  _Pragma("unroll") for (int ai = 0; ai < 2; ++ai) _Pragma("unroll") for (int m = 0; m < 4; ++m)
#define EPI_ROW(u, wr, fr) ((u).pm * 256 + ai * 128 + (wr) * 64 + m * 16 + (fr))
#define EPI_COL(wc, fq) (bj * 128 + (wc) * 32 + (fq) * 8)

__device__ __forceinline__ int bsel_of_tile(int pm) { return pm < 64 ? (pm >> 3) : 8; }

struct RectSched {
  const char* A; const char* B; size_t a_tile, b_tile; int nM, nN, nt, G, c;
  __device__ __forceinline__ bool next(int i, Unit& u) const {
    const int L = i * G + c; if (L >= nM * nN) return false;
    int pm, pn; rect_map(L, nM, nN, pm, pn);
    u.pm = pm; u.pn = pn; u.kind = 0; u.nt = nt; u.A = A + (size_t)pm * a_tile; u.B = B + (size_t)pn * b_tile; return true;
  }
};
struct G1Sched {
  const char* A; const char* B; int G, c, last;
  __device__ __forceinline__ bool next(int i, Unit& u) const {
    const int L = i * G + c; const int nl = 64 * 9, ncx = last ? 24 : 72;
    if (L >= nl + ncx) return false;
    int pm, pn;
    if (L < nl) rect_map(L, 64, 9, pm, pn);
    else { const int q = L - nl; if (last) { pm = 64 + q / 3; const int s = q % 3; pn = s == 0 ? 0 : (s + 1); } else { pm = 64 + q / 9; pn = q % 9; } }
    u.pm = pm; u.pn = pn; u.kind = 0; u.nt = 16; u.A = A + (size_t)pm * (256 * 1024 * 2); u.B = B + (size_t)pn * (256 * 1024 * 2); return true;
  }
};
struct S5Sched {
  const char* A; const char* B; size_t b_group, b_tile; int nMs, nN, nt, G, c;
  __device__ __forceinline__ bool next(int i, Unit& u) const {
    const int L = i * G + c; if (L >= 16 * nMs * nN) return false;
    const int g = L / (nMs * nN), r = L % (nMs * nN), pm = r / nN, pn = r % nN;
    u.pm = pm; u.pn = pn; u.kind = g; u.nt = nt;
    u.A = A + ((size_t)g * XUR + (size_t)pm * 256) * XUK * 2; u.B = B + (size_t)g * b_group + (size_t)pn * b_tile; return true;
  }
};
struct MergeSched {
  const char* Abuf; const char* Y4; const char* Win; const char* Wbr; int ncx, G, c;
  __device__ __forceinline__ bool next(int i, Unit& u) const {
    const int nlat = (256 - c + G - 1) / G;
    int pm, pd, k, j;
    if (i < 8 * nlat) { const int su = (i >> 3) * G + c; j = i & 7; k = j >> 1; pm = su >> 2; pd = su & 3; u.kind = j; }
    else { const int i2 = i - 8 * nlat; const int q = (i2 >> 1) * G + c; if (q >= ncx) return false; j = i2 & 1; k = q & 3; pd = (q >> 2) & 3; pm = 64 + (q >> 4); u.kind = 8 + 2 * k + j; }
    u.pm = pm; u.pn = pd;
    if (!(j & 1)) { u.nt = 16; u.A = Abuf + (size_t)pm * (256 * 1024 * 2); u.B = Win + (size_t)(2304 + k * 1024 + pd * 256) * (1024 * 2); }
    else { u.nt = 4; u.A = Y4 + (size_t)pm * (256 * 1024 * 2) + (size_t)k * 512; u.B = Wbr + (size_t)(pd * 256) * (1024 * 2) + (size_t)k * 512; }
    return true;
  }
};
struct WoutCtxSched {
  const char* GPb; const char* B; int G, c;
  __device__ __forceinline__ bool next(int i, Unit& u) const {
    const int q = i * G + c; if (q >= 256) return false;
    const int ks = q & 7, pn = (q >> 3) & 3, pmc = q >> 5;
    u.pm = 64 + pmc; u.pn = pn; u.kind = 1 + ks; u.nt = 8;
    u.A = GPb + (size_t)pmc * (256 * 4096 * 2) + (size_t)ks * 1024; u.B = B + (size_t)pn * (256 * 1024 * 2) + (size_t)(ks & 1) * 1024; return true;
  }
};
struct SplitSched {
  const char* A; const char* B; const char* Ac; size_t a_tile, b_tile, ac_tile; int nt, nts, nlat, ncx, G, c;
  __device__ __forceinline__ bool next(int i, Unit& u) const {
    const int L = i * G + c;
    if (L < nlat) { int pm, pn; rect_map(L, 64, 4, pm, pn); u.pm = pm; u.pn = pn; u.kind = 0; u.nt = nt; u.A = A + (size_t)pm * a_tile; u.B = B + (size_t)pn * b_tile; return true; }
    const int q = L - nlat; if (q >= ncx) return false;
    const int ks = q & 7, pn = (q >> 3) & 3, pmc = q >> 5;
    u.pm = 64 + pmc; u.pn = pn; u.kind = 1 + ks; u.nt = nts;
    u.A = Ac + (size_t)pmc * ac_tile + (size_t)ks * nts * 128; u.B = B + (size_t)pn * b_tile + (size_t)ks * nts * 128; return true;
  }
};

struct EpiG1 {
  bf16_t* PS; bf16_t* XU; bf16_t* VT;
  __device__ __forceinline__ void operator()(const Acc& acc, const Unit& u, int wr, int wc, int fr, int fq) const {
    EPI_ROWS(u, wr, fr) {
      const int row = EPI_ROW(u, wr, fr);
#pragma unroll
      for (int bj = 0; bj < 2; ++bj) {
        const int c = EPI_COL(wc, fq);
        const u32x4 pk = pack8(acc[ai][bj][m][0], acc[ai][bj][m][1]);
        if (u.pn == 0) {
          const int g = c >> 4, h0 = c & 15;
          *(u32x4*)(XU + ((size_t)(g * XUR + (row >> 5)) * XUK + (row & 31) * 16 + h0)) = pk;
        } else if (u.pn == 3) {
          int b, tok; if (row < ML) { b = row >> 11; tok = row & 2047; } else { const int r2 = row - ML; b = r2 >> 8; tok = 2048 + (r2 & 255); }
          const int head = c >> 6, d0 = c & 63;
          bf16_t* base = VT + ((size_t)((b * 4 + head) * 64 + d0)) * 2304 + tok;
#pragma unroll
          for (int i = 0; i < 4; ++i) { base[(size_t)(2 * i) * 2304] = (bf16_t)(pk[i] & 0xffffu); base[(size_t)(2 * i + 1) * 2304] = (bf16_t)(pk[i] >> 16); }
        } else {
          *(u32x4*)(PS + (size_t)row * 2304 + u.pn * 256 + c) = pk;
        }
      }
    }
  }
};
struct EpiS1 {
  float* S;
  __device__ __forceinline__ void operator()(const Acc& acc, const Unit& u, int wr, int wc, int fr, int fq) const {
    EPI_ROWS(u, wr, fr) {
      const int row = EPI_ROW(u, wr, fr);
      if (row < NCHUNK) {
#pragma unroll
        for (int bj = 0; bj < 2; ++bj) {
          const int c = EPI_COL(wc, fq);
          float* dst = S + ((size_t)u.kind * NCHUNK + row) * 256 + c;
          *(f32x4*)dst = acc[ai][bj][m][0]; *(f32x4*)(dst + 4) = acc[ai][bj][m][1];
        }
      }
    }
  }
};
struct EpiS2 {
  bf16_t* YG; int rowlim;
  __device__ __forceinline__ void operator()(const Acc& acc, const Unit& u, int wr, int wc, int fr, int fq) const {
    EPI_ROWS(u, wr, fr) {
      const int row = EPI_ROW(u, wr, fr);
      if (row < rowlim) {
#pragma unroll
        for (int bj = 0; bj < 2; ++bj) {
          const int col = u.pn * 256 + EPI_COL(wc, fq);
          const int t = col >> 4, h0 = col & 15;
          f32x4 a = acc[ai][bj][m][0], b = acc[ai][bj][m][1];
#pragma unroll
          for (int i = 0; i < 4; ++i) { a[i] = gelu_tanh(a[i]); b[i] = gelu_tanh(b[i]); }
          *(u32x4*)(YG + ((size_t)(row * TCH + t)) * 256 + u.kind * 16 + h0) = pack8(a, b);
        }
      }
    }
  }
};
struct EpiGLU {
  const bf16_t* YG; const float* bias; bf16_t* Y4;
  __device__ __forceinline__ void operator()(const Acc& acc, const Unit& u, int wr, int wc, int fr, int fq) const {
    EPI_ROWS(u, wr, fr) {
      const int row = EPI_ROW(u, wr, fr);
#pragma unroll
      for (int bj = 0; bj < 2; ++bj) {
        const int c = EPI_COL(wc, fq);
        const u32x4 gv = *(const u32x4*)(YG + (size_t)row * 256 + c);
        const f32x4 b0 = *(const f32x4*)(bias + c), b1 = *(const f32x4*)(bias + c + 4);
        f32x4 a = acc[ai][bj][m][0] + b0, b = acc[ai][bj][m][1] + b1;
        a[0] = bflo(gv[0]) * sigm(a[0]); a[1] = bfhi(gv[0]) * sigm(a[1]); a[2] = bflo(gv[1]) * sigm(a[2]); a[3] = bfhi(gv[1]) * sigm(a[3]);
        b[0] = bflo(gv[2]) * sigm(b[0]); b[1] = bfhi(gv[2]) * sigm(b[1]); b[2] = bflo(gv[3]) * sigm(b[2]); b[3] = bfhi(gv[3]) * sigm(b[3]);
        *(u32x4*)(Y4 + (size_t)row * 1024 + c) = pack8(a, b);
      }
    }
  }
};
struct EpiMerge {
  bf16_t* GS; float* TMP; bf16_t* MIX; bf16_t* GP;
  __device__ __forceinline__ void operator()(const Acc& acc, const Unit& u, int wr, int wc, int fr, int fq) const {
    const int tid = otid(); const int j = u.kind, k = j >> 1;
    EPI_ROWS(u, wr, fr) {
#pragma unroll
      for (int bj = 0; bj < 2; ++bj) {
        const int e = (ai * 4 + m) * 2 + bj;
        bf16_t* gs = GS + ((size_t)e * 512 + tid) * 8;
        float* tp = TMP + ((size_t)e * 512 + tid) * 8;
        if (!(j & 1)) {
          f32x4 a = acc[ai][bj][m][0], b = acc[ai][bj][m][1];
#pragma unroll
          for (int i = 0; i < 4; ++i) { a[i] = sigm(a[i]); b[i] = sigm(b[i]); }
          *(u32x4*)gs = pack8(a, b);
        } else {
          const u32x4 gv = *(const u32x4*)gs;
          f32x4 a = acc[ai][bj][m][0], b = acc[ai][bj][m][1];
          a[0] *= bflo(gv[0]); a[1] *= bfhi(gv[0]); a[2] *= bflo(gv[1]); a[3] *= bfhi(gv[1]);
          b[0] *= bflo(gv[2]); b[1] *= bfhi(gv[2]); b[2] *= bflo(gv[3]); b[3] *= bfhi(gv[3]);
          if (j >= 8) {
            const int row = EPI_ROW(u, wr, fr) - ML; const int c = (k - 4) * 1024 + u.pn * 256 + EPI_COL(wc, fq);
            *(u32x4*)(GP + (size_t)row * 4096 + c) = pack8(a, b);
          } else {
            if (k > 0) { a += *(const f32x4*)tp; b += *(const f32x4*)(tp + 4); }
            if (k < 3) { *(f32x4*)tp = a; *(f32x4*)(tp + 4) = b; }
            else { const int row = EPI_ROW(u, wr, fr); const int c = u.pn * 256 + EPI_COL(wc, fq); *(u32x4*)(MIX + (size_t)row * 1024 + c) = pack8(a, b); }
          }
        }
      }
    }
  }
};
struct EpiRes {
  const float* hL; const float* hC; float* H; const float* modbase; int modidx; float* PART;
  __device__ __forceinline__ void operator()(const Acc& acc, const Unit& u, int wr, int wc, int fr, int fq) const {
    if (u.kind) {
      float* pb = PART + (size_t)(u.kind - 1) * MC * 1024;
      EPI_ROWS(u, wr, fr) {
        const int row = EPI_ROW(u, wr, fr) - ML;
#pragma unroll
        for (int bj = 0; bj < 2; ++bj) {
          const int c = u.pn * 256 + EPI_COL(wc, fq);
          float* d = pb + (size_t)row * 1024 + c;
          *(f32x4*)d = acc[ai][bj][m][0]; *(f32x4*)(d + 4) = acc[ai][bj][m][1];
        }
      }
      return;
    }
    const float* mv = modbase + (size_t)bsel_of_tile(u.pm) * 6144 + modidx * 1024;
    EPI_ROWS(u, wr, fr) {
      const int row = EPI_ROW(u, wr, fr);
      const float* hs = row < ML ? hL + (size_t)row * 1024 : hC + (size_t)(row - ML) * 1024;
#pragma unroll
      for (int bj = 0; bj < 2; ++bj) {
        const int c = u.pn * 256 + EPI_COL(wc, fq);
        const f32x4 h0 = *(const f32x4*)(hs + c), h1 = *(const f32x4*)(hs + c + 4);
        const f32x4 m0 = *(const f32x4*)(mv + c), m1 = *(const f32x4*)(mv + c + 4);
        float* hd = H + (size_t)row * 1024 + c;
        *(f32x4*)hd = h0 + m0 * acc[ai][bj][m][0]; *(f32x4*)(hd + 4) = h1 + m1 * acc[ai][bj][m][1];
      }
    }
  }
};
struct EpiFF1 {
  bf16_t* FFH;
  __device__ __forceinline__ void operator()(const Acc& acc, const Unit& u, int wr, int wc, int fr, int fq) const {
    EPI_ROWS(u, wr, fr) {
      const int row = EPI_ROW(u, wr, fr);
#pragma unroll
      for (int bj = 0; bj < 2; ++bj) {
        const int c = u.pn * 256 + EPI_COL(wc, fq);
        f32x4 a = acc[ai][bj][m][0], b = acc[ai][bj][m][1];
#pragma unroll
        for (int i = 0; i < 4; ++i) { a[i] = fmaxf(a[i], 0.f); a[i] *= a[i]; b[i] = fmaxf(b[i], 0.f); b[i] *= b[i]; }
        *(u32x4*)(FFH + (size_t)row * 4096 + c) = pack8(a, b);
      }
    }
  }
};

__device__ void mod_task(const P& p, int task, float* lds) {
  const int tid = otid();
  float* sc = lds;
  float* red = lds + 9 * 1024;
  for (int i = tid; i < 9 * 1024; i += 512) { const float v = i < 8192 ? p.c[i] : p.c_ctx[i - 8192]; sc[i] = v * sigm(v); }
  __syncthreads();
  const int l = task / 48, jb = task % 48, jl = tid & 127, ks = tid >> 7, j = jb * 128 + jl;
  float a[9];
#pragma unroll
  for (int s = 0; s < 9; ++s) a[s] = 0.f;
  const float* w = p.ada_w + (size_t)l * 1024 * 6144 + j;
  for (int k = ks * 256; k < ks * 256 + 256; ++k) {
    const float wv = w[(size_t)k * 6144];
#pragma unroll
    for (int s = 0; s < 9; ++s) a[s] += sc[s * 1024 + k] * wv;
  }
#pragma unroll
  for (int s = 0; s < 9; ++s) red[(ks * 9 + s) * 128 + jl] = a[s];
  __syncthreads();
  float* MOD = (float*)(p.ws + OFF_MOD);
  for (int i = tid; i < 9 * 128; i += 512) {
    const int s = i >> 7, jj = i & 127;
    const float v = red[(0 * 9 + s) * 128 + jj] + red[(1 * 9 + s) * 128 + jj] + red[(2 * 9 + s) * 128 + jj] + red[(3 * 9 + s) * 128 + jj];
    MOD[((size_t)l * 9 + s) * 6144 + jb * 128 + jj] = v + p.ada_b[l * 6144 + jb * 128 + jj];
  }
  __syncthreads();
}

__device__ void tr_tile(const float* src, int lds_, bf16_t* dst, int ldd, float* tile  ) {
  const int tid = otid();
#pragma unroll
  for (int ps = 0; ps < 2; ++ps) {
    const int k = (tid >> 4) + ps * 32, n4 = (tid & 15) * 4;
    const f32x4 v = *(const f32x4*)(src + (size_t)k * lds_ + n4);
    tile[k * 65 + n4] = v[0]; tile[k * 65 + n4 + 1] = v[1]; tile[k * 65 + n4 + 2] = v[2]; tile[k * 65 + n4 + 3] = v[3];
  }
  __syncthreads();
  {
    const int n = tid >> 3, k8 = (tid & 7) * 8;
    u32x4 o;
#pragma unroll
    for (int i = 0; i < 4; ++i) o[i] = cvt_pk_bf16(tile[(k8 + 2 * i) * 65 + n], tile[(k8 + 2 * i + 1) * 65 + n]);
    *(u32x4*)(dst + (size_t)n * ldd + k8) = o;
  }
  __syncthreads();
}

struct cpx { float re, im; };
__device__ __forceinline__ cpx cmul(cpx a, cpx b) { return {a.re * b.re - a.im * b.im, a.re * b.im + a.im * b.re}; }
__device__ __forceinline__ cpx s5_apow(float lre, float lim, float dt, float e) {
  const float zr = lre * dt * e, zi = lim * dt * e; const float mg = expf(zr); float sn, cs; sincosf(zi, &sn, &cs); return {mg * cs, mg * sn};
}
__device__ __forceinline__ cpx s5_coef(float lre, float lim, float dt) {
  const cpx a = s5_apow(lre, lim, dt, 1.f); const float nr = a.re - 1.f, ni = a.im, den = lre * lre + lim * lim;
  return {(nr * lre + ni * lim) / den, (ni * lre - nr * lim) / den};
}

constexpr int NT_WIN = 1600, NT_FF1 = 1024, NT_FF2 = 1024, NT_OUT = 256, NT_BR = 256, NT_GLU = 16;
constexpr int NT_TR = NT_WIN + NT_FF1 + NT_FF2 + NT_OUT + NT_BR + NT_GLU;
constexpr int NT_TOEP = 512, NT_W2S = 256, NT_W1 = 128, NT_SGUW = 16;
constexpr int NT_PREP = NT_TR + NT_TOEP + NT_W2S + NT_W1 + NT_SGUW;

__device__ void prep_task(const P& p, int l, int task, float* lds) {
  const int tid = otid();
  unsigned char* ws = p.ws;
  if (task < NT_TR) {
    const float* src; bf16_t* dst; int N, ldd, tk, tn;
    int t = task;
    if (t < NT_WIN) { src = p.w_in + (size_t)l * 1024 * 6400; N = 6400; dst = (bf16_t*)(ws + OFF_WIN); ldd = 1024; tk = t / 100; tn = t % 100; }
    else if ((t -= NT_WIN) < NT_FF1) { src = p.w_ff1 + (size_t)l * 1024 * 4096; N = 4096; dst = (bf16_t*)(ws + OFF_WFF1); ldd = 1024; tk = t / 64; tn = t % 64; }
    else if ((t -= NT_FF1) < NT_FF2) { src = p.w_ff2 + (size_t)l * 4096 * 1024; N = 1024; dst = (bf16_t*)(ws + OFF_WFF2); ldd = 4096; tk = t / 16; tn = t % 16; }
    else if ((t -= NT_FF2) < NT_OUT) { src = p.w_out + (size_t)l * 1024 * 1024; N = 1024; dst = (bf16_t*)(ws + OFF_WOUT); ldd = 1024; tk = t / 16; tn = t % 16; }
    else if ((t -= NT_OUT) < NT_BR) { const int k = t >> 6; t &= 63; src = p.w_branch + ((size_t)l * 4 + k) * 256 * 1024; N = 1024; dst = (bf16_t*)(ws + OFF_WBR) + k * 256; ldd = 1024; tk = t / 16; tn = t % 16; }
    else { t -= NT_BR; src = p.glu_w + (size_t)l * 256 * 256; N = 256; dst = (bf16_t*)(ws + OFF_WGLU); ldd = 256; tk = t / 4; tn = t % 4; }
    tr_tile(src + (size_t)tk * 64 * N + tn * 64, N, dst + (size_t)tn * 64 * ldd + tk * 64, ldd, lds);
    return;
  }
  task -= NT_TR;
  bf16_t* W2 = (bf16_t*)(ws + OFF_W2);
  bf16_t* W1 = (bf16_t*)(ws + OFF_W1);
  if (task < NT_TOEP) {
    const int g = task >> 5, lag = task & 31;
    cpx* E = (cpx*)lds;
    if (tid < 128) {
      const int d = tid >> 6, pp = tid & 63; const int li = ((l * 2 + d) * 16 + g);
      const float dt = expf(p.log_dt[li]); const float lre = p.lam_re[li * 64 + pp], lim = p.lam_im[li * 64 + pp];
      E[tid] = cmul(s5_apow(lre, lim, dt, (float)lag), s5_coef(lre, lim, dt));
    }
    __syncthreads();
    if (tid < 256) {
      const int hp = tid >> 4, h = tid & 15;
      float kv[2];
#pragma unroll
      for (int d = 0; d < 2; ++d) {
        const int li = ((l * 2 + d) * 16 + g);
        const float* cre = p.c_re + ((size_t)li * 16 + hp) * 64; const float* cim = p.c_im + ((size_t)li * 16 + hp) * 64;
        const float* bre = p.b_re + (size_t)li * 64 * 16 + h; const float* bim = p.b_im + (size_t)li * 64 * 16 + h;
        float s = 0.f;
        for (int pp = 0; pp < 64; ++pp) {
          const cpx bb = cmul(E[d * 64 + pp], (cpx){bre[pp * 16], bim[pp * 16]});
          s += cre[pp] * bb.re - cim[pp] * bb.im;
        }
        kv[d] = s;
      }
      bf16_t* Wg = W2 + (size_t)g * 512 * 768;
      if (lag == 0) {
        const float v = kv[0] + kv[1] + (hp == h ? p.s5_d[l * 256 + g * 16 + h] : 0.f);
        const bf16_t bv = (bf16_t)(cvt_pk_bf16(v, 0.f) & 0xffffu);
        for (int t = 0; t < TCH; ++t) Wg[(size_t)(t * 16 + hp) * 768 + t * 16 + h] = bv;
      } else {
        const unsigned pk = cvt_pk_bf16(kv[0], kv[1]);
        const bf16_t v0 = (bf16_t)(pk & 0xffffu), v1 = (bf16_t)(pk >> 16);
        for (int jj = 0; jj + lag < TCH; ++jj) {
          const int t = jj + lag;
          Wg[(size_t)(t * 16 + hp) * 768 + jj * 16 + h] = v0;
          Wg[(size_t)(jj * 16 + hp) * 768 + t * 16 + h] = v1;
        }
      }
    }
    __syncthreads();
    return;
  }
  task -= NT_TOEP;
  if (task < NT_W2S) {
    for (int it = 0; it < 8; ++it) {
      const int idx = (task * 8 + it) * 512 + tid;
      const int pp = idx & 63, d = (idx >> 6) & 1, hp = (idx >> 7) & 15, t = (idx >> 11) & 31, g = idx >> 16;
      const int li = ((l * 2 + d) * 16 + g);
      const float dt = expf(p.log_dt[li]); const float lre = p.lam_re[li * 64 + pp], lim = p.lam_im[li * 64 + pp];
      const cpx ap = s5_apow(lre, lim, dt, d == 0 ? (float)(t + 1) : (float)(TCH - t));
      const cpx cc = {p.c_re[((size_t)li * 16 + hp) * 64 + pp], p.c_im[((size_t)li * 16 + hp) * 64 + pp]};
      const cpx v = cmul(cc, ap);
      *(unsigned*)(W2 + ((size_t)g * 512 + t * 16 + hp) * 768 + 512 + d * 128 + 2 * pp) = cvt_pk_bf16(v.re, -v.im);
    }
    return;
  }
  task -= NT_W2S;
  if (task < NT_W1) {
    const int idx = task * 512 + tid;
    const int j = idx & 31, pp = (idx >> 5) & 63, d = (idx >> 11) & 1, g = idx >> 12;
    const int li = ((l * 2 + d) * 16 + g);
    const float dt = expf(p.log_dt[li]); const float lre = p.lam_re[li * 64 + pp], lim = p.lam_im[li * 64 + pp];
    const cpx e = cmul(s5_apow(lre, lim, dt, d == 0 ? (float)(TCH - 1 - j) : (float)j), s5_coef(lre, lim, dt));
    const float* bre = p.b_re + ((size_t)li * 64 + pp) * 16; const float* bim = p.b_im + ((size_t)li * 64 + pp) * 16;
    bf16_t* r0 = W1 + ((size_t)g * 256 + d * 128 + 2 * pp) * 512 + j * 16;
    bf16_t* r1 = r0 + 512;
#pragma unroll
    for (int h = 0; h < 16; h += 2) {
      const cpx v0 = cmul(e, (cpx){bre[h], bim[h]}), v1 = cmul(e, (cpx){bre[h + 1], bim[h + 1]});
      *(unsigned*)(r0 + h) = cvt_pk_bf16(v0.re, v1.re); *(unsigned*)(r1 + h) = cvt_pk_bf16(v0.im, v1.im);
    }
    return;
  }
  task -= NT_W1;
  {
    float* WT = (float*)(ws + OFF_SGUWT);
    for (int it = 0; it < 8; ++it) {
      const int idx = (task * 8 + it) * 512 + tid;
      const int t = idx & 127, s = (idx >> 7) & 127, g = idx >> 14;
      WT[idx] = p.sgu_w[(((size_t)l * 4 + g) * 128 + t) * 128 + s];
    }
  }
}

__device__ void norm_rows(const P& p, const float* hL, const float* hC, const float* gvec, const float* modbase, int shift_idx, int nrows, const float* resmod  ) {
  const int tid = otid(); const int lane = tid & 63, wid = tid >> 6;
  bf16_t* A = (bf16_t*)(p.ws + OFF_A);
  for (int row = blockIdx.x * 8 + wid; row < nrows; row += gridDim.x * 8) {
    const float* h = row < ML ? hL + (size_t)row * 1024 : hC + (size_t)(row - ML) * 1024;
    const int bsel = row < ML ? (row >> 11) : 8;
    const float* sh = modbase + (size_t)bsel * 6144 + shift_idx * 1024; const float* sc = sh + 1024;
    f32x4 v[4]; float ss = 0.f;
#pragma unroll
    for (int i = 0; i < 4; ++i) v[i] = *(const f32x4*)(h + i * 256 + lane * 4);
    if (resmod && row >= ML) {
      const float* pr = (const float*)(p.ws + OFF_PART) + (size_t)(row - ML) * 1024;
      float* hw = (float*)(p.ws + OFF_H) + (size_t)row * 1024;
#pragma unroll
      for (int i = 0; i < 4; ++i) {
        const int c = i * 256 + lane * 4;
        f32x4 sm = *(const f32x4*)(pr + c);
#pragma unroll
        for (int sl = 1; sl < 8; ++sl) sm += *(const f32x4*)(pr + (size_t)sl * MC * 1024 + c);
        v[i] += *(const f32x4*)(resmod + c) * sm;
        *(f32x4*)(hw + c) = v[i];
      }
    }
#pragma unroll
    for (int i = 0; i < 4; ++i) ss += v[i][0] * v[i][0] + v[i][1] * v[i][1] + v[i][2] * v[i][2] + v[i][3] * v[i][3];
    ss = wave_sum(ss);
    const float rstd = rsqrtf(ss * (1.f / 1024.f) + 1e-6f);
#pragma unroll
    for (int i = 0; i < 4; ++i) {
      const int c = i * 256 + lane * 4;
      const f32x4 g = *(const f32x4*)(gvec + c), s1 = *(const f32x4*)(sc + c), s0 = *(const f32x4*)(sh + c);
      f32x4 y;
#pragma unroll
      for (int q = 0; q < 4; ++q) y[q] = (v[i][q] * rstd * g[q]) * (1.f + s1[q]) + s0[q];
      u32x2 o; o[0] = cvt_pk_bf16(y[0], y[1]); o[1] = cvt_pk_bf16(y[2], y[3]);
      *(u32x2*)(A + (size_t)row * 1024 + c) = o;
    }
  }
}

__device__ void final_rows(const P& p) {
  const int tid = otid(); const int lane = tid & 63, wid = tid >> 6;
  const float* H = (const float*)(p.ws + OFF_H);
  for (int row = blockIdx.x * 8 + wid; row < ML; row += gridDim.x * 8) {
    const float* h = H + (size_t)row * 1024;
    f32x4 v[4]; float ss = 0.f;
#pragma unroll
    for (int i = 0; i < 4; ++i) { v[i] = *(const f32x4*)(h + i * 256 + lane * 4); ss += v[i][0] * v[i][0] + v[i][1] * v[i][1] + v[i][2] * v[i][2] + v[i][3] * v[i][3]; }
    ss = wave_sum(ss);
    const float rstd = rsqrtf(ss * (1.f / 1024.f) + 1e-6f);
#pragma unroll
    for (int i = 0; i < 4; ++i) {
      const int c = i * 256 + lane * 4;
      const f32x4 g = *(const f32x4*)(p.final_g + c);
      f32x4 y;
#pragma unroll
      for (int q = 0; q < 4; ++q) y[q] = v[i][q] * rstd * g[q];
      *(f32x4*)(p.out + (size_t)row * 1024 + c) = y;
    }
  }
}

template <bool LAT>
__device__ __forceinline__ void attn_task(const P& p, int task, int l, const float* rpb_lds, int lane) {
  constexpr int NG = LAT ? 16 : 8;
  const bf16_t* PS = (const bf16_t*)(p.ws + OFF_PS);
  const bf16_t* VT = (const bf16_t*)(p.ws + OFF_VT);
  bf16_t* Y4 = (bf16_t*)(p.ws + OFF_Y4);
  int b, head, r = 0, jb = 0, qrow0;
  if (LAT) { jb = task & 3; r = (task >> 2) & 31; head = (task >> 7) & 3; b = task >> 9; qrow0 = b * 2048 + r * 64 + jb * 16; }
  else { const int qb = task & 15; head = (task >> 4) & 3; b = task >> 6; qrow0 = ML + b * 256 + qb * 16; }
  const int n = lane & 15, kg = lane >> 4;
  const bf16_t* qp = PS + (size_t)(qrow0 + n) * 2304 + 256 + head * 64 + kg * 8;
  const bf16x8 q0 = *(const bf16x8*)qp, q1 = *(const bf16x8*)(qp + 32);
  const int rs = LAT ? min(max(r - 4, 0), 24) : 0;
  const int clo = LAT ? (jb == 0 ? 0 : jb == 1 ? 8 : jb == 2 ? 24 : 32) : 0;
  const int keyX = 8 * (n >> 2) + (n & 3);
  f32x4 s[NG][2];
#pragma unroll
  for (int gi = 0; gi < NG; ++gi) {
    int tokrow0;
    if (LAT && gi < 8) tokrow0 = b * 2048 + (rs + gi) * 64 + clo; else tokrow0 = ML + b * 256 + (gi - (LAT ? 8 : 0)) * 32;
    const bf16_t* kp = PS + (size_t)(tokrow0 + keyX) * 2304 + 512 + head * 64 + kg * 8;
    const bf16x8 kx0 = *(const bf16x8*)kp, kx1 = *(const bf16x8*)(kp + 32);
    const bf16x8 ky0 = *(const bf16x8*)(kp + 4 * 2304), ky1 = *(const bf16x8*)(kp + 4 * 2304 + 32);
    f32x4 z = {0.f, 0.f, 0.f, 0.f};
    s[gi][0] = __builtin_amdgcn_mfma_f32_16x16x32_bf16(kx0, q0, z, 0, 0, 0);
    s[gi][0] = __builtin_amdgcn_mfma_f32_16x16x32_bf16(kx1, q1, s[gi][0], 0, 0, 0);
    s[gi][1] = __builtin_amdgcn_mfma_f32_16x16x32_bf16(ky0, q0, z, 0, 0, 0);
    s[gi][1] = __builtin_amdgcn_mfma_f32_16x16x32_bf16(ky1, q1, s[gi][1], 0, 0, 0);
  }
  float mx = -3.0e38f;
  const int jq = jb * 16 + n; const int cs = min(max(jq - 8, 0), 48);
#pragma unroll
  for (int gi = 0; gi < NG; ++gi)
#pragma unroll
    for (int blk = 0; blk < 2; ++blk)
#pragma unroll
      for (int i = 0; i < 4; ++i) {
        float v = s[gi][blk][i] * 0.125f;
        if (LAT && gi < 8) {
          const int kc = clo + 8 * kg + blk * 4 + i;
          const bool ok = (kc >= cs) && (kc < cs + 16);
          const int dr = rs + gi - r + 7; const int dc = min(max(kc - jq + 15, 0), 30);
          const float bias = rpb_lds[(head * 15 + dr) * 31 + dc];
          v = ok ? v + bias : -1.0e30f;
        }
        s[gi][blk][i] = v; mx = fmaxf(mx, v);
      }
  mx = fmaxf(mx, __shfl_xor(mx, 16)); mx = fmaxf(mx, __shfl_xor(mx, 32));
  float sum = 0.f;
#pragma unroll
  for (int gi = 0; gi < NG; ++gi)
#pragma unroll
    for (int blk = 0; blk < 2; ++blk)
#pragma unroll
      for (int i = 0; i < 4; ++i) { const float e = __expf(s[gi][blk][i] - mx); s[gi][blk][i] = e; sum += e; }
  sum += __shfl_xor(sum, 16); sum += __shfl_xor(sum, 32);
  f32x4 o[4];
#pragma unroll
  for (int db = 0; db < 4; ++db) o[db] = (f32x4){0.f, 0.f, 0.f, 0.f};
  const bf16_t* vbase = VT + ((size_t)((b * 4 + head) * 64 + n)) * 2304 + kg * 8;
#pragma unroll
  for (int gi = 0; gi < NG; ++gi) {
    int tok0;
    if (LAT && gi < 8) tok0 = (rs + gi) * 64 + clo; else tok0 = 2048 + (gi - (LAT ? 8 : 0)) * 32;
    const u32x4 pk = pack8(s[gi][0], s[gi][1]);
    bf16x8 pf; __builtin_memcpy(&pf, &pk, 16);
#pragma unroll
    for (int db = 0; db < 4; ++db) {
      const bf16x8 vf = *(const bf16x8*)(vbase + (size_t)(db * 16) * 2304 + tok0);
      o[db] = __builtin_amdgcn_mfma_f32_16x16x32_bf16(vf, pf, o[db], 0, 0, 0);
    }
  }
  const float inv = 1.f / sum;
  bf16_t* op = Y4 + (size_t)(qrow0 + n) * 1024 + 256 + head * 64 + kg * 4;
#pragma unroll
  for (int db = 0; db < 4; ++db) {
    u32x2 w; w[0] = cvt_pk_bf16(o[db][0] * inv, o[db][1] * inv); w[1] = cvt_pk_bf16(o[db][2] * inv, o[db][3] * inv);
    *(u32x2*)(op + db * 16) = w;
  }
}

__device__ __forceinline__ void conv_task(const P& p, int l, int task) {
  const bf16_t* PS = (const bf16_t*)(p.ws + OFF_PS);
  bf16_t* Y4 = (bf16_t*)(p.ws + OFF_Y4);
  const int idx = task * 512 + otid();
  const int row = idx >> 5, c0 = (idx & 31) * 8;
  int pos, len; if (row < ML) { pos = row & 2047; len = 2048; } else { pos = (row - ML) & 255; len = 256; }
  const bf16_t* base = PS + (size_t)row * 2304;
  float z[3][8];
#pragma unroll
  for (int d = 0; d < 3; ++d) {
    const int pp = pos + d - 1;
    if (pp >= 0 && pp < len) {
      const u32x4 cv = *(const u32x4*)(base + (d - 1) * 2304 + 5 * 256 + c0), xv = *(const u32x4*)(base + (d - 1) * 2304 + 6 * 256 + c0);
#pragma unroll
      for (int i = 0; i < 4; ++i) { z[d][2 * i] = bflo(cv[i]) * bflo(xv[i]); z[d][2 * i + 1] = bfhi(cv[i]) * bfhi(xv[i]); }
    } else {
#pragma unroll
      for (int i = 0; i < 8; ++i) z[d][i] = 0.f;
    }
  }
  const u32x4 bv = *(const u32x4*)(base + 4 * 256 + c0);
  const float* w = p.conv_w + (size_t)l * 3 * 256 + c0;
  float y[8];
#pragma unroll
  for (int i = 0; i < 8; ++i) y[i] = w[i] * z[0][i] + w[256 + i] * z[1][i] + w[512 + i] * z[2][i];
  u32x4 o;
#pragma unroll
  for (int i = 0; i < 4; ++i) o[i] = cvt_pk_bf16(bflo(bv[i]) * y[2 * i], bfhi(bv[i]) * y[2 * i + 1]);
  *(u32x4*)(Y4 + (size_t)row * 1024 + 512 + c0) = o;
}

__device__ void sgu_task(const P& p, int l, int task, float* lds) {
  const int tid = otid();
  const bf16_t* PS = (const bf16_t*)(p.ws + OFF_PS);
  bf16_t* Y4 = (bf16_t*)(p.ws + OFF_Y4);
  const float* WT = (const float*)(p.ws + OFF_SGUWT);
  const int chunk = task >> 2, g = task & 3;
  float* wT = lds;
  float* vn = lds + 128 * 128;
  for (int i = tid; i < 128 * 128 / 4; i += 512) *(f32x4*)(wT + i * 4) = *(const f32x4*)(WT + (size_t)g * 16384 + i * 4);
  {
    const int s = tid >> 2, q = tid & 3;
    const bf16_t* vr = PS + (size_t)(chunk * 128 + s) * 2304 + 8 * 256;
    float sm = 0.f, sq = 0.f;
#pragma unroll
    for (int i = 0; i < 8; ++i) {
      const u32x4 v = *(const u32x4*)(vr + q * 64 + i * 8);
#pragma unroll
      for (int k = 0; k < 4; ++k) { const float a = bflo(v[k]), b = bfhi(v[k]); sm += a + b; sq += a * a + b * b; }
    }
    sm += __shfl_xor(sm, 1); sm += __shfl_xor(sm, 2); sq += __shfl_xor(sq, 1); sq += __shfl_xor(sq, 2);
    const float mu = sm * (1.f / 256.f); const float var = fmaxf(sq * (1.f / 256.f) - mu * mu, 0.f); const float rstd = rsqrtf(var + 1e-6f);
    const int cb = g * 64 + q * 16;
    const float* lg = p.ln_g + l * 256 + cb; const float* lb = p.ln_b + l * 256 + cb;
#pragma unroll
    for (int i = 0; i < 2; ++i) {
      const u32x4 v = *(const u32x4*)(vr + cb + i * 8);
#pragma unroll
      for (int k = 0; k < 4; ++k) {
        const int cc = i * 8 + 2 * k;
        vn[s * 64 + q * 16 + cc] = (bflo(v[k]) - mu) * rstd * lg[cc] + lb[cc];
        vn[s * 64 + q * 16 + cc + 1] = (bfhi(v[k]) - mu) * rstd * lg[cc + 1] + lb[cc + 1];
      }
    }
  }
  __syncthreads();
  const int tt = tid >> 4, cc = tid & 15;
  f32x4 acc[4];
#pragma unroll
  for (int i = 0; i < 4; ++i) acc[i] = (f32x4){0.f, 0.f, 0.f, 0.f};
#pragma unroll 4
  for (int s = 0; s < 128; ++s) {
    const f32x4 wv = *(const f32x4*)(wT + s * 128 + tt * 4);
    const f32x4 vv = *(const f32x4*)(vn + s * 64 + cc * 4);
#pragma unroll
    for (int i = 0; i < 4; ++i) acc[i] += wv[i] * vv;
  }
#pragma unroll
  for (int i = 0; i < 4; ++i) {
    const int t = tt * 4 + i; const int row = chunk * 128 + t;
    const float bs = p.sgu_b[((size_t)l * 4 + g) * 128 + t];
    const u32x2 uv = *(const u32x2*)(PS + (size_t)row * 2304 + 7 * 256 + g * 64 + cc * 4);
    u32x2 o; o[0] = cvt_pk_bf16(bflo(uv[0]) * (acc[i][0] + bs), bfhi(uv[0]) * (acc[i][1] + bs)); o[1] = cvt_pk_bf16(bflo(uv[1]) * (acc[i][2] + bs), bfhi(uv[1]) * (acc[i][3] + bs));
    *(u32x2*)(Y4 + (size_t)row * 1024 + 768 + g * 64 + cc * 4) = o;
  }
  __syncthreads();
}

__device__ void carry_phase(const P& p, int l) {
  const int gt = blockIdx.x * 512 + otid();
  if (gt >= 16 * 8 * 2 * 64) return;
  const int pp = gt & 63, d = (gt >> 6) & 1, b = (gt >> 7) & 7, g = gt >> 10;
  const float* S = (const float*)(p.ws + OFF_S) + (size_t)g * NCHUNK * 256 + d * 128 + 2 * pp;
  bf16_t* XU = (bf16_t*)(p.ws + OFF_XU) + (size_t)g * XUR * XUK + 512 + d * 128 + 2 * pp;
  const int li = ((l * 2 + d) * 16 + g);
  const float dt = expf(p.log_dt[li]);
  const cpx aT = s5_apow(p.lam_re[li * 64 + pp], p.lam_im[li * 64 + pp], dt, (float)TCH);
  cpx st = {0.f, 0.f};
  for (int i0 = 0; i0 < 72; i0 += 8) {
    float sre[8], sim[8]; int rows[8];
#pragma unroll
    for (int k = 0; k < 8; ++k) {
      const int i = i0 + k; int row;
      if (i < 8) row = 512 + b * 8 + (d == 0 ? i : 7 - i); else row = b * 64 + (d == 0 ? (i - 8) : 63 - (i - 8));
      rows[k] = row; const float2 v = *(const float2*)(S + (size_t)row * 256); sre[k] = v.x; sim[k] = v.y;
    }
#pragma unroll
    for (int k = 0; k < 8; ++k) {
      *(unsigned*)(XU + (size_t)rows[k] * XUK) = cvt_pk_bf16(st.re, st.im);
      const cpx ns = cmul(aT, st); st.re = ns.re + sre[k]; st.im = ns.im + sim[k];
    }
  }
}

constexpr int PH_PER_LAYER = 11;
constexpr int N_PHASES = 1 + NDEPTH * PH_PER_LAYER + 1;

__global__ void __launch_bounds__(512, 2) mk_forward(P p) {
  extern __shared__ __attribute__((aligned(16))) unsigned char shm[];
  LAS unsigned char* lds = (LAS unsigned char*)shm;
  float* ldsf = (float*)shm;
  const int G = gridDim.x, wg = blockIdx.x;
  unsigned char* ws = p.ws;
  volatile LAS unsigned* xbw = (volatile LAS unsigned*)(lds + 131072);
  if (threadIdx.x == 0) { xbw[0] = 0u; xbw[1] = 0u; xbw[2] = 0u; xbw[3] = 0u; }
  __syncthreads();
  const XcdBarrier xb = xcd_barrier_post((unsigned*)(ws + OFF_BAR), xbw);
  if (p.ph_lo < 0) cg::this_grid().sync();
  float* H = (float*)(ws + OFF_H);
  const float* MOD = (const float*)(ws + OFF_MOD);

  for (int ph = p.ph_lo; ph < p.ph_hi; ++ph) {
    int nrep = 1;
#if DBL_MASK
    { const int spx = (ph == 0) ? 11 : (ph == N_PHASES - 1) ? 13 : (ph - 1) % PH_PER_LAYER; if ((DBL_MASK >> spx) & 1) nrep = 2; }
#endif
    for (int rep = 0; rep < nrep; ++rep) {
    if (rep) xcd_barrier(xb);
    int tid_ = threadIdx.x; asm volatile("" : "+v"(tid_));
    const int tid = tid_, lane = tid & 63, wid = tid >> 6;
    if (ph == 0) {
      for (int t = wg; t < 192; t += G) mod_task(p, t, ldsf);
      for (int t = (wg + G - (192 % G)) % G; t < NT_PREP; t += G) prep_task(p, 0, t, ldsf);
    } else if (ph == N_PHASES - 1) {
      final_rows(p);
    } else {
      const int l = (ph - 1) / PH_PER_LAYER, sp = (ph - 1) % PH_PER_LAYER;
      const bool last = (l == NDEPTH - 1);
      const float* hL = l == 0 ? p.x : H; const float* hC = l == 0 ? p.ctx : H + (size_t)ML * 1024;
      const float* modl = MOD + (size_t)l * 9 * 6144;
      const int nMrows = last ? 64 : 72;
      switch (sp) {
#if PHMASK & 1
        case 0: {
          if (l > 0) for (int t = wg; t < NT_PREP; t += G) prep_task(p, l, t, ldsf);
          norm_rows(p, hL, hC, p.norm_g + (size_t)(l * 2 + 0) * 1024, modl, 0, MT, l > 0 ? MOD + ((size_t)(l - 1) * 9 + 8) * 6144 + 5 * 1024 : nullptr);
        } break;
#endif
#if PHMASK & 2
        case 1: {
          G1Sched S{(const char*)(ws + OFF_A), (const char*)(ws + OFF_WIN), G, wg, last ? 1 : 0};
          EpiG1 E{(bf16_t*)(ws + OFF_PS), (bf16_t*)(ws + OFF_XU), (bf16_t*)(ws + OFF_VT)};
          gemm_phase(lds, 1024, 1024, S, E);
        } break;
#endif
#if PHMASK & 4
        case 2: {
          {
            S5Sched S{(const char*)(ws + OFF_XU), (const char*)(ws + OFF_W1), (size_t)256 * 512 * 2, 0, 3, 1, 8, G, wg};
            EpiS1 E{(float*)(ws + OFF_S)};
            gemm_phase(lds, XUK, 512, S, E);
          }
          __syncthreads();
          for (int i = tid; i < 4 * 15 * 31; i += 512) ldsf[i] = p.rpb[(size_t)l * 4 * 15 * 31 + i];
          __syncthreads();
          const int nwaves = G * 8, gw = wg * 8 + wid;
          for (int t = gw; t < 4096; t += nwaves) attn_task<true>(p, t, l, ldsf, lane);
          if (!last) for (int t = gw; t < 512; t += nwaves) attn_task<false>(p, t, l, ldsf, lane);
          const int nconv = (last ? ML : MT) * 32 / 512;
          for (int t = wg; t < nconv; t += G) conv_task(p, l, t);
          __syncthreads();
          const int nsgu = (last ? 128 : 144) * 4;
          for (int t = wg; t < nsgu; t += G) sgu_task(p, l, t, ldsf);
        } break;
#endif
#if PHMASK & 8
        case 3: carry_phase(p, l); break;
#endif
#if PHMASK & 16
        case 4: {
          S5Sched S{(const char*)(ws + OFF_XU), (const char*)(ws + OFF_W2), (size_t)512 * 768 * 2, (size_t)256 * 768 * 2, last ? 2 : 3, 2, 12, G, wg};
          EpiS2 E{(bf16_t*)(ws + OFF_YG), last ? 512 : NCHUNK};
          gemm_phase(lds, XUK, 768, S, E);
        } break;
#endif
#if PHMASK & 32
        case 5: {
          RectSched S{(const char*)(ws + OFF_YG), (const char*)(ws + OFF_WGLU), (size_t)256 * 256 * 2, 0, nMrows, 1, 4, G, wg};
          EpiGLU E{(const bf16_t*)(ws + OFF_YG), p.glu_b + l * 256, (bf16_t*)(ws + OFF_Y4)};
          gemm_phase(lds, 256, 256, S, E);
        } break;
#endif
#if PHMASK & 64
        case 6: {
          MergeSched S{(const char*)(ws + OFF_A), (const char*)(ws + OFF_Y4), (const char*)(ws + OFF_WIN), (const char*)(ws + OFF_WBR), last ? 0 : 128, G, wg};
          EpiMerge E{(bf16_t*)(ws + OFF_GS + (size_t)wg * 131072), (float*)(ws + OFF_MIXTMP + (size_t)wg * 262144), (bf16_t*)(ws + OFF_MIX), (bf16_t*)(ws + OFF_GP)};
          gemm_phase(lds, 1024, 1024, S, E);
        } break;
#endif
#if PHMASK & 128
        case 7: {
          {
            SplitSched S{(const char*)(ws + OFF_MIX), (const char*)(ws + OFF_WOUT), nullptr, (size_t)256 * 1024 * 2, (size_t)256 * 1024 * 2, 0, 16, 0, 256, 0, G, wg};
            EpiRes E{hL, hC, H, modl, 2, nullptr};
            gemm_phase(lds, 1024, 1024, S, E);
          }
          if (!last) {
            WoutCtxSched S{(const char*)(ws + OFF_GP), (const char*)(ws + OFF_WOUT), G, wg};
            EpiRes E{hL, hC, H, modl, 2, (float*)(ws + OFF_PART)};
            gemm_phase(lds, 4096, 1024, S, E);
          }
        } break;
#endif
#if PHMASK & 256
        case 8: norm_rows(p, H, l == 0 ? p.ctx : H + (size_t)ML * 1024, p.norm_g + (size_t)(l * 2 + 1) * 1024, modl, 3, last ? ML : MT, modl + (size_t)8 * 6144 + 2 * 1024); break;
#endif
#if PHMASK & 512
        case 9: {
          RectSched S{(const char*)(ws + OFF_A), (const char*)(ws + OFF_WFF1), (size_t)256 * 1024 * 2, (size_t)256 * 1024 * 2, nMrows, 16, 16, G, wg};
          EpiFF1 E{(bf16_t*)(ws + OFF_FFH)};
          gemm_phase(lds, 1024, 1024, S, E);
        } break;
#endif
#if PHMASK & 1024
        case 10: {
          SplitSched S{(const char*)(ws + OFF_FFH), (const char*)(ws + OFF_WFF2), (const char*)(ws + OFF_FFH) + (size_t)64 * 256 * 4096 * 2, (size_t)256 * 4096 * 2, (size_t)256 * 4096 * 2, (size_t)256 * 4096 * 2, 64, 8, 256, last ? 0 : 256, G, wg};
          EpiRes E{H, H + (size_t)ML * 1024, H, modl, 5, (float*)(ws + OFF_PART)};
          gemm_phase(lds, 4096, 4096, S, E);
        } break;
#endif
      }
    }
    }
    if (ph + 1 < p.ph_hi) { xcd_barrier(xb);
#if (DBL_MASK >> 12) & 1
      xcd_barrier(xb);
#endif
    }
  }
}

extern "C" void kernel_launch(void* const* d_in, const int* in_sizes, int n_in, void* d_out, int out_size, void* d_ws, size_t ws_size, hipStream_t stream) {
  constexpr size_t kDynLds = 131072 + 16;
  static int grid_blocks = 0;
  if (!grid_blocks) {
    (void)hipFuncSetAttribute((const void*)mk_forward, hipFuncAttributeMaxDynamicSharedMemorySize, (int)kDynLds);
    int dev = 0, cus = 0, per_cu = 0;
    (void)hipGetDevice(&dev);
    (void)hipDeviceGetAttribute(&cus, hipDeviceAttributeMultiprocessorCount, dev);
    (void)hipOccupancyMaxActiveBlocksPerMultiprocessor(&per_cu, mk_forward, 512, kDynLds);
    if (per_cu < 1) per_cu = 1;
    grid_blocks = cus;
  }
  P p{};
  const float** pp = (const float**)&p;
  for (int i = 0; i < 29; ++i) pp[i] = (const float*)d_in[i];
  p.out = (float*)d_out; p.ws = (unsigned char*)d_ws;
  (void)hipMemsetAsync((unsigned char*)d_ws + OFF_BAR, 0, 16384, stream);
#if MULTI_LAUNCH
  for (int ph = 0; ph < N_PHASES; ++ph) {
    p.ph_lo = ph; p.ph_hi = ph + 1;
    hipLaunchKernelGGL(mk_forward, dim3(grid_blocks), dim3(512), kDynLds, stream, p);
  }
#else
  p.ph_lo = 0; p.ph_hi = N_PHASES;
  void* args[] = {&p};
  (void)hipLaunchCooperativeKernel((void*)mk_forward, dim3(grid_blocks), dim3(512), args, kDynLds, stream);
#endif
}
```

```cpp
#include <hip/hip_runtime.h>
#include <hip/hip_cooperative_groups.h>
namespace cg = cooperative_groups;

#define LAS __attribute__((address_space(3)))
typedef unsigned short bf16_t;
typedef short bf16x8 __attribute__((ext_vector_type(8)));
typedef float f32x4 __attribute__((ext_vector_type(4)));
typedef unsigned u32x4 __attribute__((ext_vector_type(4)));
typedef unsigned u32x2 __attribute__((ext_vector_type(2)));

#ifndef PHMASK
#define PHMASK 0x7ff
#endif
#ifndef DBL_MASK
#define DBL_MASK 0
#endif
#ifndef TSEL
#define TSEL 0
#endif
#ifndef TPHASE
#define TPHASE 6
#endif
#ifndef MULTI_LAUNCH
#define MULTI_LAUNCH 0
#endif

constexpr int DM = 1024, NB = 8, SEQL = 2048, NDEPTH = 4, CTXL = 256, DFF = 4096, INW = 6400;
constexpr int ML = NB * SEQL;
constexpr int MC = NB * CTXL;
constexpr int MT = ML + MC;
constexpr int TCH = 32;
constexpr int NCHUNK = MT / TCH;
constexpr int XUR = 768;
constexpr int XUK = 768;

constexpr size_t OFF_H = 0;
constexpr size_t OFF_A = OFF_H + (size_t)MT * DM * 4;
constexpr size_t OFF_MIX = OFF_A + (size_t)MT * DM * 2;
constexpr size_t OFF_R1 = OFF_MIX + (size_t)MT * DM * 2;
constexpr size_t OFF_PS = OFF_R1;
constexpr size_t OFF_Y4 = OFF_PS + (size_t)MT * 2304 * 2;
constexpr size_t OFF_VT = OFF_Y4 + (size_t)MT * DM * 2;
constexpr size_t OFF_XU = OFF_VT + (size_t)NB * 4 * 64 * 2304 * 2;
constexpr size_t OFF_S = OFF_XU + (size_t)16 * XUR * XUK * 2;
constexpr size_t OFF_YG = OFF_S + (size_t)16 * NCHUNK * 256 * 4;
constexpr size_t OFF_R1END = OFF_YG + (size_t)MT * 256 * 2;
constexpr size_t OFF_FFH = OFF_R1;
constexpr size_t OFF_MIXTMP = OFF_PS;
constexpr size_t OFF_GS = OFF_VT;
constexpr size_t OFF_WIN = OFF_R1END;
constexpr size_t OFF_WFF1 = OFF_WIN + (size_t)INW * DM * 2;
constexpr size_t OFF_WFF2 = OFF_WFF1 + (size_t)DFF * DM * 2;
constexpr size_t OFF_WOUT = OFF_WFF2 + (size_t)DFF * DM * 2;
constexpr size_t OFF_WBR = OFF_WOUT + (size_t)DM * DM * 2;
constexpr size_t OFF_WGLU = OFF_WBR + (size_t)DM * DM * 2;
constexpr size_t OFF_W1 = OFF_WGLU + (size_t)256 * 256 * 2;
constexpr size_t OFF_W2 = OFF_W1 + (size_t)16 * 256 * 512 * 2;
constexpr size_t OFF_SGUWT = OFF_W2 + (size_t)16 * 512 * 768 * 2;
constexpr size_t OFF_MOD = OFF_SGUWT + (size_t)4 * 128 * 128 * 4;
constexpr size_t OFF_BAR = OFF_MOD + (size_t)NDEPTH * 9 * 6144 * 4;
constexpr size_t OFF_PART = OFF_BAR + 16384;
constexpr size_t OFF_END = OFF_PART + (size_t)8 * MC * DM * 4;
constexpr size_t OFF_GP = OFF_PS + (size_t)256 * 262144;
static_assert(OFF_GP + (size_t)MC * 4096 * 2 <= OFF_Y4, "GP alias");
static_assert((size_t)MT * DFF * 2 <= OFF_R1END - OFF_R1, "FFH alias");
static_assert((size_t)256 * 262144 <= (size_t)MT * 2304 * 2, "MIXTMP alias");
static_assert((size_t)256 * 131072 <= OFF_R1END - OFF_VT, "GS alias");
static_assert(OFF_END < 452000000ull, "workspace");

struct P {
  const float *x, *c, *ctx, *c_ctx, *ada_w, *ada_b, *norm_g, *final_g, *w_in, *w_branch, *w_out,
      *lam_re, *lam_im, *log_dt, *b_re, *b_im, *c_re, *c_im, *s5_d, *glu_w, *glu_b, *rpb, *conv_w,
      *ln_g, *ln_b, *sgu_w, *sgu_b, *w_ff1, *w_ff2;
  float* out;
  unsigned char* ws;
  int ph_lo, ph_hi;
};

__device__ __forceinline__ int otid() { int t = threadIdx.x; asm volatile("" : "+v"(t)); return t; }
__device__ __forceinline__ float bf2f(bf16_t b) { return __uint_as_float(((unsigned)b) << 16); }
__device__ __forceinline__ float bflo(unsigned w) { return __uint_as_float(w << 16); }
__device__ __forceinline__ float bfhi(unsigned w) { return __uint_as_float(w & 0xffff0000u); }
__device__ __forceinline__ unsigned cvt_pk_bf16(float lo, float hi) { unsigned r; asm volatile("v_cvt_pk_bf16_f32 %0, %1, %2" : "=v"(r) : "v"(lo), "v"(hi)); return r; }
__device__ __forceinline__ float sigm(float x) { return 1.f / (1.f + __expf(-x)); }
__device__ __forceinline__ float gelu_tanh(float x) { return x * sigm(1.5957691216057308f * (x + 0.044715f * x * x * x)); }
__device__ __forceinline__ u32x4 pack8(f32x4 a, f32x4 b) { u32x4 r; r[0] = cvt_pk_bf16(a[0], a[1]); r[1] = cvt_pk_bf16(a[2], a[3]); r[2] = cvt_pk_bf16(b[0], b[1]); r[3] = cvt_pk_bf16(b[2], b[3]); return r; }
__device__ __forceinline__ float wave_sum(float v) {
#pragma unroll
  for (int o = 32; o >= 1; o >>= 1) v += __shfl_xor(v, o);
  return v;
}


#define XB_TMO      128
#define XB_XCNT(j)  (256  + 64 * (j))
#define XB_XSUB(j)  (1280 + 64 * (j))
#define XB_XGEN(j)  (2304 + 64 * (j))
#define XB_TOP      3328
#define XB_TOPGEN   3392
#define XCD_BAR_WORDS 3456
#define XB_SPIN_CAP (1u << 22)
__device__ __forceinline__ unsigned xb_ld(unsigned* p)              { return __hip_atomic_load(p, __ATOMIC_RELAXED, __HIP_MEMORY_SCOPE_AGENT); }
__device__ __forceinline__ unsigned xb_add(unsigned* p, unsigned v) { return __hip_atomic_fetch_add(p, v, __ATOMIC_RELAXED, __HIP_MEMORY_SCOPE_AGENT); }
__device__ __forceinline__ unsigned xb_xcc_id() { return (unsigned)__builtin_amdgcn_s_getreg((3 << 11) | 20) & 0xFu; }
#define XB_SPIN(cond, bar) do { unsigned _sp = 0; while (cond) { __builtin_amdgcn_s_sleep(1); \
    if ((++_sp & 255u) == 0u) { if (xb_ld(&(bar)[XB_TMO])) break; if (_sp > XB_SPIN_CAP) { atomicAdd(&(bar)[XB_TMO], 1u); break; } } } } while (0)
struct XcdBarrier { unsigned* bar; unsigned x; volatile LAS unsigned* st; };
__device__ __forceinline__ XcdBarrier xcd_barrier_post(unsigned* bar, volatile LAS unsigned* st) {
  XcdBarrier b; b.bar = bar; b.x = xb_xcc_id(); b.st = st;
  if (threadIdx.x == 0) (void)xb_add(&bar[XB_XCNT(b.x)], 1u);
  return b;
}
__device__ __forceinline__ void xcd_barrier_complete(unsigned* bar, unsigned x, unsigned& nloc, unsigned& nx) {
  const unsigned G = gridDim.x * gridDim.y * gridDim.z;
  unsigned sum, cnt, mine, sp = 0u;
  for (;;) {
    sum = 0u; cnt = 0u; mine = 0u;
#pragma unroll
    for (unsigned j = 0; j < 16; ++j) { const unsigned c = xb_ld(&bar[XB_XCNT(j)]); sum += c; cnt += (c > 0u) ? 1u : 0u; mine = (j == x) ? c : mine; }
    if (sum == G) break;
    __builtin_amdgcn_s_sleep(1);
    if ((++sp & 255u) == 0u) { if (xb_ld(&bar[XB_TMO])) break; if (sp > XB_SPIN_CAP) { atomicAdd(&bar[XB_TMO], 1u); break; } }
  }
  nloc = mine > 0u ? mine : 1u; nx = cnt > 0u ? cnt : 1u;
}
__device__ __forceinline__ void xcd_barrier(const XcdBarrier& b) {
  asm volatile("s_waitcnt vmcnt(0)" ::: "memory");
  __syncthreads();
  if (threadIdx.x == 0) {
    unsigned* bar = b.bar;
    __builtin_amdgcn_s_waitcnt(0);
    unsigned nloc = b.st[0], nx = b.st[1];
    if (nloc == 0u) { xcd_barrier_complete(bar, b.x, nloc, nx); b.st[0] = nloc; b.st[1] = nx; }
    const unsigned old = xb_add(&bar[XB_XSUB(b.x)], 1u);
    const unsigned gen = old / nloc;
    if (old + 1u == (gen + 1u) * nloc) {
      __builtin_amdgcn_fence(__ATOMIC_RELEASE, "agent");
      asm volatile("s_waitcnt vmcnt(0)" ::: "memory");
      const unsigned og = xb_add(&bar[XB_TOP], 1u);
      const unsigned tg = og / nx;
      if (og + 1u == (tg + 1u) * nx) xb_add(&bar[XB_TOPGEN], 1u);
      else XB_SPIN(xb_ld(&bar[XB_TOPGEN]) == tg, bar);
      __builtin_amdgcn_fence(__ATOMIC_ACQUIRE, "agent");
      xb_add(&bar[XB_XGEN(b.x)], 1u);
      asm volatile("s_waitcnt vmcnt(0)" ::: "memory");
    } else {
      XB_SPIN(xb_ld(&bar[XB_XGEN(b.x)]) == gen, bar);
      __builtin_amdgcn_fence(__ATOMIC_ACQUIRE, "agent");
      asm volatile("s_waitcnt vmcnt(0)" ::: "memory");
    }
  }
  __syncthreads();
}

constexpr int BM = 256, BK = 64, HALF = 128, HTB = HALF * BK * 2, NXCD = 8, WGM = 8;
__device__ __forceinline__ int lds_byte(int r, int c) { const int st = (r >> 4) * 2 + (c >> 5), rr = r & 15, cc = c & 31, ob = rr * 64 + cc * 2; return st * 1024 + (ob ^ (((ob >> 9) & 1) << 5)); }
__device__ __forceinline__ void stage_rc(int b, int& R, int& C) { const int st = b / 1024, sb = b % 1024, swz = sb ^ (((sb >> 9) & 1) << 5); R = (st >> 1) * 16 + swz / 64; C = (st & 1) * 32 + (swz % 64) / 2; }
__device__ __forceinline__ int perm32(int rho) { const int n = rho >> 4, i = rho & 15; return 8 * (i >> 2) + 4 * n + (i & 3); }

struct Unit { const char* A; const char* B; int nt, pm, pn, kind; };

__device__ __forceinline__ void rect_map(int L, int nM, int nN, int& pm, int& pn) {
  const int nwg = nM * nN; int wgid = L;
  { const int q = nwg / NXCD, r = nwg % NXCD, xcd = wgid % NXCD, off = wgid / NXCD; wgid = (xcd < r ? xcd * (q + 1) : r * (q + 1) + (xcd - r) * q) + off; }
  const int nig = WGM * nN, gid = wgid / nig, fm = gid * WGM, gsz = (nM - fm) < WGM ? (nM - fm) : WGM;
  pm = fm + ((wgid % nig) % gsz); pn = (wgid % nig) / gsz;
}

template <class Sched, class Epi>
__device__ __forceinline__ void gemm_phase(LAS unsigned char* lds, const int lda, const int ldb, const Sched& S, const Epi& E, unsigned long long* tslot = nullptr) {
#if TSEL
  const unsigned long long tg0 = __builtin_amdgcn_s_memrealtime();
#endif
  int tid_ = threadIdx.x; asm volatile("" : "+v"(tid_));
  const int tid = tid_, wid = __builtin_amdgcn_readfirstlane(tid >> 6), lane = tid & 63, wr = wid >> 2, wc = wid & 3, fr = lane & 15, fq = lane >> 4;
  unsigned voffA[2], voffB[2];
#pragma unroll
  for (int i = 0; i < 2; ++i) { int R, C; stage_rc(tid * 16 + i * 8192, R, C); const int Rb = (R & ~31) + perm32(R & 31);
    voffA[i] = (unsigned)(R * lda + C) * 2u; voffB[i] = (unsigned)(Rb * ldb + C) * 2u; }
  const size_t kstep = (size_t)(BK * 2);
  const size_t hstepA = (size_t)HALF * lda * 2, hstepB = (size_t)HALF * ldb * 2;
  const unsigned ldsw = (unsigned)wid * 1024u;
  const int aoff = lds_byte(wr * 64 + fr, fq * 8), boff = lds_byte(wc * 32 + fr, fq * 8);
#define PG8_SA(b, h) (((b) * 2 + (h)) * HTB)
#define PG8_SB(b, h) ((4 + (b) * 2 + (h)) * HTB)
#define PG8_STAGE(bufoff, gbase, voff) do { _Pragma("unroll") for (int _i = 0; _i < 2; ++_i) \
    __builtin_amdgcn_global_load_lds((const unsigned*)((const char*)(gbase) + (voff)[_i]), (LAS unsigned*)(lds + (bufoff) + ldsw + _i * 8192), 16, 0, 0); } while (0)
#define PG8_LDA(dst, b, h) do { _Pragma("unroll") for (int m = 0; m < 4; ++m) _Pragma("unroll") for (int k = 0; k < 2; ++k) dst[m][k] = *(const LAS bf16x8*)(lds + PG8_SA(b, h) + aoff + m * 2048 + k * 1024); } while (0)
#define PG8_LDB(dst, b, h) do { _Pragma("unroll") for (int n = 0; n < 2; ++n) _Pragma("unroll") for (int k = 0; k < 2; ++k) dst[n][k] = *(const LAS bf16x8*)(lds + PG8_SB(b, h) + boff + n * 2048 + k * 1024); } while (0)
#define PG8_MMA(ai, bj, At, Bt) do { __builtin_amdgcn_s_setprio(1); _Pragma("unroll") for (int m = 0; m < 4; ++m) _Pragma("unroll") for (int n = 0; n < 2; ++n) _Pragma("unroll") for (int k = 0; k < 2; ++k) \
    acc[ai][bj][m][n] = __builtin_amdgcn_mfma_f32_16x16x32_bf16(Bt[n][k], At[m][k], acc[ai][bj][m][n], 0, 0, 0); __builtin_amdgcn_s_setprio(0); } while (0)
#define PG8_WAIT_V(n) asm volatile("s_waitcnt vmcnt(" #n ")" ::: "memory")
#define PG8_WAIT_L(n) asm volatile("s_waitcnt lgkmcnt(" #n ")" ::: "memory")
#define PG8_BAR __builtin_amdgcn_s_barrier()
#define PG8_SCHED __builtin_amdgcn_sched_barrier(0)
  Unit cur, nxt; int ui = 0;
  if (!S.next(0, cur)) return;
  f32x4 acc[2][2][4][2];
#pragma unroll
  for (int a = 0; a < 2; ++a)
#pragma unroll
    for (int b = 0; b < 2; ++b)
#pragma unroll
      for (int m = 0; m < 4; ++m)
#pragma unroll
        for (int n = 0; n < 2; ++n) acc[a][b][m][n] = (f32x4){0.f, 0.f, 0.f, 0.f};
  bf16x8 At[4][2], B0[2][2], B1[2][2];
  const char* cA = cur.A; const char* cB = cur.B;
  PG8_STAGE(PG8_SB(0, 0), cB, voffB); PG8_STAGE(PG8_SA(0, 0), cA, voffA); PG8_STAGE(PG8_SB(0, 1), cB + hstepB, voffB); PG8_STAGE(PG8_SA(0, 1), cA + hstepA, voffA);
  if (wr == 1) PG8_BAR;
  PG8_WAIT_V(4); PG8_BAR;
  PG8_STAGE(PG8_SB(1, 0), cB + kstep, voffB); PG8_STAGE(PG8_SA(1, 0), cA + kstep, voffA); PG8_STAGE(PG8_SB(1, 1), cB + hstepB + kstep, voffB);
  PG8_WAIT_V(6); PG8_BAR;
  for (;;) {
    const bool has_next = S.next(ui + 1, nxt);
    const char* nA = has_next ? nxt.A : cA; const char* nB = has_next ? nxt.B : cB;
    const int nt = cur.nt;
#if TSEL
    const unsigned long long tk0 = __builtin_amdgcn_s_memrealtime();
#endif
    for (int t = 0; t < nt; t += 2) {
      const bool last = (t == nt - 2);
      const char* a1 = cA + (size_t)(t + 1) * kstep;
      const char* a2 = last ? nA : cA + (size_t)(t + 2) * kstep; const char* b2 = last ? nB : cB + (size_t)(t + 2) * kstep;
      const char* a3 = a2 + kstep; const char* b3 = b2 + kstep;
      PG8_LDB(B0, 0, 0); PG8_SCHED; PG8_LDA(At, 0, 0); PG8_STAGE(PG8_SA(1, 1), a1 + hstepA, voffA);
      PG8_WAIT_L(8); PG8_BAR; PG8_WAIT_L(0); PG8_MMA(0, 0, At, B0); PG8_BAR; PG8_SCHED;
      PG8_LDB(B1, 0, 1); PG8_STAGE(PG8_SB(0, 0), b2, voffB);
      PG8_BAR; PG8_WAIT_L(0); PG8_MMA(0, 1, At, B1); PG8_BAR;
      PG8_LDA(At, 0, 1); PG8_STAGE(PG8_SA(0, 0), a2, voffA);
      PG8_BAR; PG8_WAIT_L(0); PG8_MMA(1, 0, At, B0); PG8_BAR; PG8_SCHED;
      PG8_STAGE(PG8_SB(0, 1), b2 + hstepB, voffB);
      PG8_WAIT_V(6); PG8_BAR; PG8_MMA(1, 1, At, B1); PG8_BAR;
      PG8_LDB(B0, 1, 0); PG8_SCHED; PG8_LDA(At, 1, 0); PG8_STAGE(PG8_SA(0, 1), a2 + hstepA, voffA);
      PG8_WAIT_L(8); PG8_BAR; PG8_WAIT_L(0); PG8_MMA(0, 0, At, B0); PG8_BAR; PG8_SCHED;
      PG8_LDB(B1, 1, 1); PG8_STAGE(PG8_SB(1, 0), b3, voffB);
      PG8_BAR; PG8_WAIT_L(0); PG8_MMA(0, 1, At, B1); PG8_BAR;
      PG8_LDA(At, 1, 1); PG8_STAGE(PG8_SA(1, 0), a3, voffA);
      PG8_BAR; PG8_WAIT_L(0); PG8_MMA(1, 0, At, B0); PG8_BAR; PG8_SCHED;
      PG8_STAGE(PG8_SB(1, 1), b3 + hstepB, voffB);
      PG8_WAIT_V(6); PG8_BAR; PG8_MMA(1, 1, At, B1); PG8_BAR;
    }
#if TSEL
    const unsigned long long te0 = __builtin_amdgcn_s_memrealtime();
    if (tslot && tid == 0) tslot[3 + (cur.kind & 1)] += te0 - tk0;
#endif
    E(acc, cur, wr, wc, fr, fq);
#if TSEL
    if (tslot && tid == 0) { asm volatile("s_waitcnt vmcnt(0)" ::: "memory"); tslot[0] += __builtin_amdgcn_s_memrealtime() - te0; tslot[2] += 1; }
#endif
    if (!has_next) break;
#pragma unroll
    for (int a = 0; a < 2; ++a)
#pragma unroll
      for (int b = 0; b < 2; ++b)
#pragma unroll
        for (int m = 0; m < 4; ++m)
#pragma unroll
          for (int n = 0; n < 2; ++n) acc[a][b][m][n] = (f32x4){0.f, 0.f, 0.f, 0.f};
    cur = nxt; cA = nA; cB = nB; ++ui;
  }
  PG8_WAIT_V(0);
  if (wr == 0) PG8_BAR;
  PG8_BAR;
#if TSEL
  if (tslot && tid == 0) tslot[1] += __builtin_amdgcn_s_memrealtime() - tg0;
#endif
#undef PG8_SA
#undef PG8_SB
#undef PG8_STAGE
#undef PG8_LDA
#undef PG8_LDB
#undef PG8_MMA
#undef PG8_WAIT_V
#undef PG8_WAIT_L
#undef PG8_BAR
#undef PG8_SCHED
}

typedef f32x4 Acc[2][2][4][2];
#define EPI_ROWS(u, wr, fr) \
  _Pragma("unroll") for (int ai = 0; ai < 2; ++ai) _Pragma("unroll") for (int m = 0; m < 4; ++m)
#define EPI_ROW(u, wr, fr) ((u).pm * 256 + ai * 128 + (wr) * 64 + m * 16 + (fr))
#define EPI_COL(wc, fq) (bj * 128 + (wc) * 32 + (fq) * 8)

__device__ __forceinline__ int bsel_of_tile(int pm) { return pm < 64 ? (pm >> 3) : 8; }

struct RectSched {
  const char* A; const char* B; size_t a_tile, b_tile; int nM, nN, nt, G, c;
  __device__ __forceinline__ bool next(int i, Unit& u) const {
    const int L = i * G + c; if (L >= nM * nN) return false;
    int pm, pn; rect_map(L, nM, nN, pm, pn);
    u.pm = pm; u.pn = pn; u.kind = 0; u.nt = nt; u.A = A + (size_t)pm * a_tile; u.B = B + (size_t)pn * b_tile; return true;
  }
};
struct G1Sched {
  const char* A; const char* B; int G, c, last;
  __device__ __forceinline__ bool next(int i, Unit& u) const {
    const int L = i * G + c; const int nl = 64 * 9, ncx = last ? 24 : 72;
    if (L >= nl + ncx) return false;
    int pm, pn;
    if (L < nl) rect_map(L, 64, 9, pm, pn);
    else { const int q = L - nl; if (last) { pm = 64 + q / 3; const int s = q % 3; pn = s == 0 ? 0 : (s + 1); } else { pm = 64 + q / 9; pn = q % 9; } }
    u.pm = pm; u.pn = pn; u.kind = 0; u.nt = 16; u.A = A + (size_t)pm * (256 * 1024 * 2); u.B = B + (size_t)pn * (256 * 1024 * 2); return true;
  }
};
struct S5Sched {
  const char* A; const char* B; size_t b_group, b_tile; int nMs, nN, nt, G, c;
  __device__ __forceinline__ bool next(int i, Unit& u) const {
    const int L = i * G + c; if (L >= 16 * nMs * nN) return false;
    const int g = L / (nMs * nN), r = L % (nMs * nN), pm = r / nN, pn = r % nN;
    u.pm = pm; u.pn = pn; u.kind = g; u.nt = nt;
    u.A = A + ((size_t)g * XUR + (size_t)pm * 256) * XUK * 2; u.B = B + (size_t)g * b_group + (size_t)pn * b_tile; return true;
  }
};
struct MergeSched {
  const char* Abuf; const char* Y4; const char* Win; const char* Wbr; int ncx, G, c;
  __device__ __forceinline__ bool next(int i, Unit& u) const {
    const int nlat = (256 - c + G - 1) / G;
    int pm, pd, k, j;
    if (i < 8 * nlat) { const int su = (i >> 3) * G + c; j = i & 7; k = j >> 1; const int x = su & 7, sl = su >> 3; pd = sl & 3; pm = x * 8 + (sl >> 2); u.kind = j; }
    else { const int i2 = i - 8 * nlat; const int q = (i2 >> 1) * G + c; if (q >= ncx) return false; j = i2 & 1; const int x = q & 7, sl = q >> 3; k = sl & 3; pd = sl >> 2; pm = 64 + x; u.kind = 8 + 2 * k + j; }
    u.pm = pm; u.pn = pd;
    if (!(j & 1)) { u.nt = 16; u.A = Abuf + (size_t)pm * (256 * 1024 * 2); u.B = Win + (size_t)(2304 + k * 1024 + pd * 256) * (1024 * 2); }
    else { u.nt = 4; u.A = Y4 + (size_t)pm * (256 * 1024 * 2) + (size_t)k * 512; u.B = Wbr + (size_t)(pd * 256) * (1024 * 2) + (size_t)k * 512; }
    return true;
  }
};
struct WoutCtxSched {
  const char* GPb; const char* B; int G, c;
  __device__ __forceinline__ bool next(int i, Unit& u) const {
    const int q = i * G + c; if (q >= 256) return false;
    const int ks = q & 7, pn = (q >> 3) & 3, pmc = q >> 5;
    u.pm = 64 + pmc; u.pn = pn; u.kind = 1 + ks; u.nt = 8;
    u.A = GPb + (size_t)pmc * (256 * 4096 * 2) + (size_t)ks * 1024; u.B = B + (size_t)pn * (256 * 1024 * 2) + (size_t)(ks & 1) * 1024; return true;
  }
};
struct SplitSched {
  const char* A; const char* B; const char* Ac; size_t a_tile, b_tile, ac_tile; int nt, nts, nlat, ncx, G, c;
  __device__ __forceinline__ bool next(int i, Unit& u) const {
    const int L = i * G + c;
    if (L < nlat) { int pm, pn; rect_map(L, 64, 4, pm, pn); u.pm = pm; u.pn = pn; u.kind = 0; u.nt = nt; u.A = A + (size_t)pm * a_tile; u.B = B + (size_t)pn * b_tile; return true; }
    const int q = L - nlat; if (q >= ncx) return false;
    const int ks = q & 7, pn = (q >> 3) & 3, pmc = q >> 5;
    u.pm = 64 + pmc; u.pn = pn; u.kind = 1 + ks; u.nt = nts;
    u.A = Ac + (size_t)pmc * ac_tile + (size_t)ks * nts * 128; u.B = B + (size_t)pn * b_tile + (size_t)ks * nts * 128; return true;
  }
};

struct EpiG1 {
  bf16_t* PS; bf16_t* XU; bf16_t* VT;
  __device__ __forceinline__ void operator()(const Acc& acc, const Unit& u, int wr, int wc, int fr, int fq) const {
    EPI_ROWS(u, wr, fr) {
      const int row = EPI_ROW(u, wr, fr);
#pragma unroll
      for (int bj = 0; bj < 2; ++bj) {
        const int c = EPI_COL(wc, fq);
        const u32x4 pk = pack8(acc[ai][bj][m][0], acc[ai][bj][m][1]);
        if (u.pn == 0) {
          const int g = c >> 4, h0 = c & 15;
          *(u32x4*)(XU + ((size_t)(g * XUR + (row >> 5)) * XUK + (row & 31) * 16 + h0)) = pk;
        } else if (u.pn == 3) {
          int b, tok; if (row < ML) { b = row >> 11; tok = row & 2047; } else { const int r2 = row - ML; b = r2 >> 8; tok = 2048 + (r2 & 255); }
          const int head = c >> 6, d0 = c & 63;
          bf16_t* base = VT + ((size_t)((b * 4 + head) * 64 + d0)) * 2304 + tok;
#pragma unroll
          for (int i = 0; i < 4; ++i) { base[(size_t)(2 * i) * 2304] = (bf16_t)(pk[i] & 0xffffu); base[(size_t)(2 * i + 1) * 2304] = (bf16_t)(pk[i] >> 16); }
        } else {
          *(u32x4*)(PS + (size_t)row * 2304 + u.pn * 256 + c) = pk;
        }
      }
    }
  }
};
struct EpiS1 {
  float* S;
  __device__ __forceinline__ void operator()(const Acc& acc, const Unit& u, int wr, int wc, int fr, int fq) const {
    EPI_ROWS(u, wr, fr) {
      const int row = EPI_ROW(u, wr, fr);
      if (row < NCHUNK) {
#pragma unroll
        for (int bj = 0; bj < 2; ++bj) {
          const int c = EPI_COL(wc, fq);
          float* dst = S + ((size_t)u.kind * NCHUNK + row) * 256 + c;
          *(f32x4*)dst = acc[ai][bj][m][0]; *(f32x4*)(dst + 4) = acc[ai][bj][m][1];
        }
      }
    }
  }
};
struct EpiS2 {
  bf16_t* YG; int rowlim;
  __device__ __forceinline__ void operator()(const Acc& acc, const Unit& u, int wr, int wc, int fr, int fq) const {
    EPI_ROWS(u, wr, fr) {
      const int row = EPI_ROW(u, wr, fr);
      if (row < rowlim) {
#pragma unroll
        for (int bj = 0; bj < 2; ++bj) {
          const int col = u.pn * 256 + EPI_COL(wc, fq);
          const int t = col >> 4, h0 = col & 15;
          f32x4 a = acc[ai][bj][m][0], b = acc[ai][bj][m][1];
#pragma unroll
          for (int i = 0; i < 4; ++i) { a[i] = gelu_tanh(a[i]); b[i] = gelu_tanh(b[i]); }
          *(u32x4*)(YG + ((size_t)(row * TCH + t)) * 256 + u.kind * 16 + h0) = pack8(a, b);
        }
      }
    }
  }
};
struct EpiGLU {
  const bf16_t* YG; const float* bias; bf16_t* Y4;
  __device__ __forceinline__ void operator()(const Acc& acc, const Unit& u, int wr, int wc, int fr, int fq) const {
    EPI_ROWS(u, wr, fr) {
      const int row = EPI_ROW(u, wr, fr);
#pragma unroll
      for (int bj = 0; bj < 2; ++bj) {
        const int c = EPI_COL(wc, fq);
        const u32x4 gv = *(const u32x4*)(YG + (size_t)row * 256 + c);
        const f32x4 b0 = *(const f32x4*)(bias + c), b1 = *(const f32x4*)(bias + c + 4);
        f32x4 a = acc[ai][bj][m][0] + b0, b = acc[ai][bj][m][1] + b1;
        a[0] = bflo(gv[0]) * sigm(a[0]); a[1] = bfhi(gv[0]) * sigm(a[1]); a[2] = bflo(gv[1]) * sigm(a[2]); a[3] = bfhi(gv[1]) * sigm(a[3]);
        b[0] = bflo(gv[2]) * sigm(b[0]); b[1] = bfhi(gv[2]) * sigm(b[1]); b[2] = bflo(gv[3]) * sigm(b[2]); b[3] = bfhi(gv[3]) * sigm(b[3]);
        *(u32x4*)(Y4 + (size_t)row * 1024 + c) = pack8(a, b);
      }
    }
  }
};
struct EpiMerge {
  unsigned char* GS; bf16_t* TMP; bf16_t* MIX; bf16_t* GP;
  __device__ __forceinline__ void operator()(const Acc& acc, const Unit& u, int wr, int wc, int fr, int fq) const {
    const int tid = otid(); const int j = u.kind, k = j >> 1;
    EPI_ROWS(u, wr, fr) {
#pragma unroll
      for (int bj = 0; bj < 2; ++bj) {
        const int e = (ai * 4 + m) * 2 + bj;
        unsigned char* gs = GS + ((size_t)e * 512 + tid) * 8;
        bf16_t* tp = TMP + ((size_t)e * 512 + tid) * 8;
        if (!(j & 1)) {
          const f32x4 a = acc[ai][bj][m][0], b = acc[ai][bj][m][1];
          u32x2 q;
          q[0] = (unsigned)(sigm(a[0]) * 255.f + 0.5f) | ((unsigned)(sigm(a[1]) * 255.f + 0.5f) << 8) | ((unsigned)(sigm(a[2]) * 255.f + 0.5f) << 16) | ((unsigned)(sigm(a[3]) * 255.f + 0.5f) << 24);
          q[1] = (unsigned)(sigm(b[0]) * 255.f + 0.5f) | ((unsigned)(sigm(b[1]) * 255.f + 0.5f) << 8) | ((unsigned)(sigm(b[2]) * 255.f + 0.5f) << 16) | ((unsigned)(sigm(b[3]) * 255.f + 0.5f) << 24);
          *(u32x2*)gs = q;
        } else {
          const u32x2 q = *(const u32x2*)gs;
          f32x4 a = acc[ai][bj][m][0], b = acc[ai][bj][m][1];
          const float sc = 1.f / 255.f;
#pragma unroll
          for (int i = 0; i < 4; ++i) { a[i] *= (float)((q[0] >> (8 * i)) & 255u) * sc; b[i] *= (float)((q[1] >> (8 * i)) & 255u) * sc; }
          if (j >= 8) {
            const int row = EPI_ROW(u, wr, fr) - ML; const int c = (k - 4) * 1024 + u.pn * 256 + EPI_COL(wc, fq);
            *(u32x4*)(GP + (size_t)row * 4096 + c) = pack8(a, b);
          } else {
            if (k > 0) { const u32x4 t = *(const u32x4*)tp; a[0] += bflo(t[0]); a[1] += bfhi(t[0]); a[2] += bflo(t[1]); a[3] += bfhi(t[1]); b[0] += bflo(t[2]); b[1] += bfhi(t[2]); b[2] += bflo(t[3]); b[3] += bfhi(t[3]); }
            if (k < 3) *(u32x4*)tp = pack8(a, b);
            else { const int row = EPI_ROW(u, wr, fr); const int c = u.pn * 256 + EPI_COL(wc, fq); *(u32x4*)(MIX + (size_t)row * 1024 + c) = pack8(a, b); }
          }
        }
      }
    }
  }
};
struct EpiRes {
  const float* hL; const float* hC; float* H; const float* modbase; int modidx; float* PART;
  __device__ __forceinline__ void operator()(const Acc& acc, const Unit& u, int wr, int wc, int fr, int fq) const {
    if (u.kind) {
      float* pb = PART + (size_t)(u.kind - 1) * MC * 1024;
      EPI_ROWS(u, wr, fr) {
        const int row = EPI_ROW(u, wr, fr) - ML;
#pragma unroll
        for (int bj = 0; bj < 2; ++bj) {
          const int c = u.pn * 256 + EPI_COL(wc, fq);
          float* d = pb + (size_t)row * 1024 + c;
          *(f32x4*)d = acc[ai][bj][m][0]; *(f32x4*)(d + 4) = acc[ai][bj][m][1];
        }
      }
      return;
    }
    const float* mv = modbase + (size_t)bsel_of_tile(u.pm) * 6144 + modidx * 1024;
    EPI_ROWS(u, wr, fr) {
      const int row = EPI_ROW(u, wr, fr);
      const float* hs = row < ML ? hL + (size_t)row * 1024 : hC + (size_t)(row - ML) * 1024;
#pragma unroll
      for (int bj = 0; bj < 2; ++bj) {
        const int c = u.pn * 256 + EPI_COL(wc, fq);
        const f32x4 h0 = *(const f32x4*)(hs + c), h1 = *(const f32x4*)(hs + c + 4);
        const f32x4 m0 = *(const f32x4*)(mv + c), m1 = *(const f32x4*)(mv + c + 4);
        float* hd = H + (size_t)row * 1024 + c;
        *(f32x4*)hd = h0 + m0 * acc[ai][bj][m][0]; *(f32x4*)(hd + 4) = h1 + m1 * acc[ai][bj][m][1];
      }
    }
  }
};
struct EpiFF1 {
  bf16_t* FFH;
  __device__ __forceinline__ void operator()(const Acc& acc, const Unit& u, int wr, int wc, int fr, int fq) const {
    EPI_ROWS(u, wr, fr) {
      const int row = EPI_ROW(u, wr, fr);
#pragma unroll
      for (int bj = 0; bj < 2; ++bj) {
        const int c = u.pn * 256 + EPI_COL(wc, fq);
        f32x4 a = acc[ai][bj][m][0], b = acc[ai][bj][m][1];
#pragma unroll
        for (int i = 0; i < 4; ++i) { a[i] = fmaxf(a[i], 0.f); a[i] *= a[i]; b[i] = fmaxf(b[i], 0.f); b[i] *= b[i]; }
        *(u32x4*)(FFH + (size_t)row * 4096 + c) = pack8(a, b);
      }
    }
  }
};

__device__ void mod_task(const P& p, int task, float* lds) {
  const int tid = otid();
  float* sc = lds;
  float* red = lds + 9 * 1024;
  for (int i = tid; i < 9 * 1024; i += 512) { const float v = i < 8192 ? p.c[i] : p.c_ctx[i - 8192]; sc[i] = v * sigm(v); }
  __syncthreads();
  const int l = task / 48, jb = task % 48, jl = tid & 127, ks = tid >> 7, j = jb * 128 + jl;
  float a[9];
#pragma unroll
  for (int s = 0; s < 9; ++s) a[s] = 0.f;
  const float* w = p.ada_w + (size_t)l * 1024 * 6144 + j;
  for (int k = ks * 256; k < ks * 256 + 256; ++k) {
    const float wv = w[(size_t)k * 6144];
#pragma unroll
    for (int s = 0; s < 9; ++s) a[s] += sc[s * 1024 + k] * wv;
  }
#pragma unroll
  for (int s = 0; s < 9; ++s) red[(ks * 9 + s) * 128 + jl] = a[s];
  __syncthreads();
  float* MOD = (float*)(p.ws + OFF_MOD);
  for (int i = tid; i < 9 * 128; i += 512) {
    const int s = i >> 7, jj = i & 127;
    const float v = red[(0 * 9 + s) * 128 + jj] + red[(1 * 9 + s) * 128 + jj] + red[(2 * 9 + s) * 128 + jj] + red[(3 * 9 + s) * 128 + jj];
    MOD[((size_t)l * 9 + s) * 6144 + jb * 128 + jj] = v + p.ada_b[l * 6144 + jb * 128 + jj];
  }
  __syncthreads();
}

__device__ void tr_tile(const float* src, int lds_, bf16_t* dst, int ldd, float* tile  ) {
  const int tid = otid();
#pragma unroll
  for (int ps = 0; ps < 2; ++ps) {
    const int k = (tid >> 4) + ps * 32, n4 = (tid & 15) * 4;
    const f32x4 v = *(const f32x4*)(src + (size_t)k * lds_ + n4);
    tile[k * 65 + n4] = v[0]; tile[k * 65 + n4 + 1] = v[1]; tile[k * 65 + n4 + 2] = v[2]; tile[k * 65 + n4 + 3] = v[3];
  }
  __syncthreads();
  {
    const int n = tid >> 3, k8 = (tid & 7) * 8;
    u32x4 o;
#pragma unroll
    for (int i = 0; i < 4; ++i) o[i] = cvt_pk_bf16(tile[(k8 + 2 * i) * 65 + n], tile[(k8 + 2 * i + 1) * 65 + n]);
    *(u32x4*)(dst + (size_t)n * ldd + k8) = o;
  }
  __syncthreads();
}

struct cpx { float re, im; };
__device__ __forceinline__ cpx cmul(cpx a, cpx b) { return {a.re * b.re - a.im * b.im, a.re * b.im + a.im * b.re}; }
template <bool FAST>
__device__ __forceinline__ cpx s5_apow(float lre, float lim, float dt, float e) {
  const float zr = lre * dt * e, zi = lim * dt * e;
  if (FAST) { const float mg = __expf(zr); return {mg * __cosf(zi), mg * __sinf(zi)}; }
  const float mg = expf(zr); float sn, cs; sincosf(zi, &sn, &cs); return {mg * cs, mg * sn};
}
template <bool FAST>
__device__ __forceinline__ cpx s5_coef(float lre, float lim, float dt) {
  const cpx a = s5_apow<FAST>(lre, lim, dt, 1.f); const float nr = a.re - 1.f, ni = a.im, den = lre * lre + lim * lim;
  return {(nr * lre + ni * lim) / den, (ni * lre - nr * lim) / den};
}

constexpr int NT_WIN = 1600, NT_FF1 = 1024, NT_FF2 = 1024, NT_OUT = 256, NT_BR = 256, NT_GLU = 16;
constexpr int NT_TR = NT_WIN + NT_FF1 + NT_FF2 + NT_OUT + NT_BR + NT_GLU;
constexpr int NT_TOEP = 512, NT_W2S = 256, NT_W1 = 128, NT_SGUW = 16;
constexpr int NT_PREP = NT_TR + NT_TOEP + NT_W2S + NT_W1 + NT_SGUW;

__device__ void prep_task(const P& p, int l, int task, float* lds) {
  const int tid = otid();
  unsigned char* ws = p.ws;
  if (task < NT_TR) {
    const float* src; bf16_t* dst; int N, ldd, tk, tn;
    int t = task;
    if (t < NT_WIN) { src = p.w_in + (size_t)l * 1024 * 6400; N = 6400; dst = (bf16_t*)(ws + OFF_WIN); ldd = 1024; tk = t / 100; tn = t % 100; }
    else if ((t -= NT_WIN) < NT_FF1) { src = p.w_ff1 + (size_t)l * 1024 * 4096; N = 4096; dst = (bf16_t*)(ws + OFF_WFF1); ldd = 1024; tk = t / 64; tn = t % 64; }
    else if ((t -= NT_FF1) < NT_FF2) { src = p.w_ff2 + (size_t)l * 4096 * 1024; N = 1024; dst = (bf16_t*)(ws + OFF_WFF2); ldd = 4096; tk = t / 16; tn = t % 16; }
    else if ((t -= NT_FF2) < NT_OUT) { src = p.w_out + (size_t)l * 1024 * 1024; N = 1024; dst = (bf16_t*)(ws + OFF_WOUT); ldd = 1024; tk = t / 16; tn = t % 16; }
    else if ((t -= NT_OUT) < NT_BR) { const int k = t >> 6; t &= 63; src = p.w_branch + ((size_t)l * 4 + k) * 256 * 1024; N = 1024; dst = (bf16_t*)(ws + OFF_WBR) + k * 256; ldd = 1024; tk = t / 16; tn = t % 16; }
    else { t -= NT_BR; src = p.glu_w + (size_t)l * 256 * 256; N = 256; dst = (bf16_t*)(ws + OFF_WGLU); ldd = 256; tk = t / 4; tn = t % 4; }
    tr_tile(src + (size_t)tk * 64 * N + tn * 64, N, dst + (size_t)tn * 64 * ldd + tk * 64, ldd, lds);
    return;
  }
  task -= NT_TR;
  bf16_t* W2 = (bf16_t*)(ws + OFF_W2);
  bf16_t* W1 = (bf16_t*)(ws + OFF_W1);
  if (task < NT_TOEP) {
    const int g = task >> 5, lag = task & 31;
    cpx* E = (cpx*)lds;
    float* sC = lds + 256;
    float* sB = sC + 4096;
    if (tid < 128) {
      const int d = tid >> 6, pp = tid & 63; const int li = ((l * 2 + d) * 16 + g);
      const float dt = expf(p.log_dt[li]); const float lre = p.lam_re[li * 64 + pp], lim = p.lam_im[li * 64 + pp];
      E[tid] = cmul(s5_apow<true>(lre, lim, dt, (float)lag), s5_coef<false>(lre, lim, dt));
    }
    for (int i = tid; i < 4096; i += 512) {
      const int d = i >> 11, ri = (i >> 10) & 1, r = i & 1023; const int li = ((l * 2 + d) * 16 + g);
      sC[i] = (ri ? p.c_im : p.c_re)[(size_t)li * 1024 + r];
      sB[i] = (ri ? p.b_im : p.b_re)[(size_t)li * 1024 + r];
    }
    __syncthreads();
    if (tid < 256) {
      const int hp = tid >> 4, h = tid & 15;
      float kv[2];
#pragma unroll
      for (int d = 0; d < 2; ++d) {
        const float* cre = sC + d * 2048 + hp * 64; const float* cim = cre + 1024;
        const float* bre = sB + d * 2048 + h; const float* bim = bre + 1024;
        float s = 0.f;
#pragma unroll 8
        for (int pp = 0; pp < 64; ++pp) {
          const cpx bb = cmul(E[d * 64 + pp], (cpx){bre[pp * 16], bim[pp * 16]});
          s += cre[pp] * bb.re - cim[pp] * bb.im;
        }
        kv[d] = s;
      }
      bf16_t* Wg = W2 + (size_t)g * 512 * 768;
      if (lag == 0) {
        const float v = kv[0] + kv[1] + (hp == h ? p.s5_d[l * 256 + g * 16 + h] : 0.f);
        const bf16_t bv = (bf16_t)(cvt_pk_bf16(v, 0.f) & 0xffffu);
        for (int t = 0; t < TCH; ++t) Wg[(size_t)(t * 16 + hp) * 768 + t * 16 + h] = bv;
      } else {
        const unsigned pk = cvt_pk_bf16(kv[0], kv[1]);
        const bf16_t v0 = (bf16_t)(pk & 0xffffu), v1 = (bf16_t)(pk >> 16);
        for (int jj = 0; jj + lag < TCH; ++jj) {
          const int t = jj + lag;
          Wg[(size_t)(t * 16 + hp) * 768 + jj * 16 + h] = v0;
          Wg[(size_t)(jj * 16 + hp) * 768 + t * 16 + h] = v1;
        }
      }
    }
    __syncthreads();
    return;
  }
  task -= NT_TOEP;
  if (task < NT_W2S) {
    for (int it = 0; it < 8; ++it) {
      const int idx = (task * 8 + it) * 512 + tid;
      const int pp = idx & 63, d = (idx >> 6) & 1, hp = (idx >> 7) & 15, t = (idx >> 11) & 31, g = idx >> 16;
      const int li = ((l * 2 + d) * 16 + g);
      const float dt = expf(p.log_dt[li]); const float lre = p.lam_re[li * 64 + pp], lim = p.lam_im[li * 64 + pp];
      const cpx ap = s5_apow<true>(lre, lim, dt, d == 0 ? (float)(t + 1) : (float)(TCH - t));
      const cpx cc = {p.c_re[((size_t)li * 16 + hp) * 64 + pp], p.c_im[((size_t)li * 16 + hp) * 64 + pp]};
      const cpx v = cmul(cc, ap);
      *(unsigned*)(W2 + ((size_t)g * 512 + t * 16 + hp) * 768 + 512 + d * 128 + 2 * pp) = cvt_pk_bf16(v.re, -v.im);
    }
    return;
  }
  task -= NT_W2S;
  if (task < NT_W1) {
    const int idx = task * 512 + tid;
    const int j = idx & 31, pp = (idx >> 5) & 63, d = (idx >> 11) & 1, g = idx >> 12;
    const int li = ((l * 2 + d) * 16 + g);
    const float dt = expf(p.log_dt[li]); const float lre = p.lam_re[li * 64 + pp], lim = p.lam_im[li * 64 + pp];
    const cpx e = cmul(s5_apow<true>(lre, lim, dt, d == 0 ? (float)(TCH - 1 - j) : (float)j), s5_coef<false>(lre, lim, dt));
    const float* bre = p.b_re + ((size_t)li * 64 + pp) * 16; const float* bim = p.b_im + ((size_t)li * 64 + pp) * 16;
    bf16_t* r0 = W1 + ((size_t)g * 256 + d * 128 + 2 * pp) * 512 + j * 16;
    bf16_t* r1 = r0 + 512;
#pragma unroll
    for (int h = 0; h < 16; h += 2) {
      const cpx v0 = cmul(e, (cpx){bre[h], bim[h]}), v1 = cmul(e, (cpx){bre[h + 1], bim[h + 1]});
      *(unsigned*)(r0 + h) = cvt_pk_bf16(v0.re, v1.re); *(unsigned*)(r1 + h) = cvt_pk_bf16(v0.im, v1.im);
    }
    return;
  }
  task -= NT_W1;
  {
    bf16_t* W16 = (bf16_t*)(ws + OFF_SGUWT);
    for (int it = 0; it < 4; ++it) {
      const int idx = ((task * 4 + it) * 512 + tid) * 2;
      const float* sp = p.sgu_w + (size_t)l * 65536 + idx;
      *(unsigned*)(W16 + idx) = cvt_pk_bf16(sp[0], sp[1]);
    }
  }
}


__device__ __forceinline__ bool filler_range(int wg, int G, int first, int& start, int& stride) {
  if (G > first) { if (wg < first) return false; start = wg - first; stride = G - first; return true; }
  start = wg; stride = G; return true;
}
constexpr int PT_WIN0 = 0, PT_FF0 = NT_WIN, PT_WBR0 = NT_WIN + NT_FF1 + NT_FF2 + NT_OUT, PT_G10 = PT_WBR0 + NT_BR;
constexpr int PT_NMID = NT_FF1 + NT_FF2 + NT_OUT, PT_NG1 = NT_PREP - PT_G10;

__device__ void norm_rows(const P& p, const float* hL, const float* hC, const float* gvec, const float* modbase, int shift_idx, int nrows, const float* resmod  ) {
  const int tid = otid(); const int lane = tid & 63, wid = tid >> 6;
  bf16_t* A = (bf16_t*)(p.ws + OFF_A);
  for (int row = blockIdx.x * 8 + wid; row < nrows; row += gridDim.x * 8) {
    const float* h = row < ML ? hL + (size_t)row * 1024 : hC + (size_t)(row - ML) * 1024;
    const int bsel = row < ML ? (row >> 11) : 8;
    const float* sh = modbase + (size_t)bsel * 6144 + shift_idx * 1024; const float* sc = sh + 1024;
    f32x4 v[4]; float ss = 0.f;
#pragma unroll
    for (int i = 0; i < 4; ++i) v[i] = *(const f32x4*)(h + i * 256 + lane * 4);
    if (resmod && row >= ML) {
      const float* pr = (const float*)(p.ws + OFF_PART) + (size_t)(row - ML) * 1024;
      float* hw = (float*)(p.ws + OFF_H) + (size_t)row * 1024;
#pragma unroll
      for (int i = 0; i < 4; ++i) {
        const int c = i * 256 + lane * 4;
        f32x4 sm = *(const f32x4*)(pr + c);
#pragma unroll
        for (int sl = 1; sl < 8; ++sl) sm += *(const f32x4*)(pr + (size_t)sl * MC * 1024 + c);
        v[i] += *(const f32x4*)(resmod + c) * sm;
        *(f32x4*)(hw + c) = v[i];
      }
    }
#pragma unroll
    for (int i = 0; i < 4; ++i) ss += v[i][0] * v[i][0] + v[i][1] * v[i][1] + v[i][2] * v[i][2] + v[i][3] * v[i][3];
    ss = wave_sum(ss);
    const float rstd = rsqrtf(ss * (1.f / 1024.f) + 1e-6f);
#pragma unroll
    for (int i = 0; i < 4; ++i) {
      const int c = i * 256 + lane * 4;
      const f32x4 g = *(const f32x4*)(gvec + c), s1 = *(const f32x4*)(sc + c), s0 = *(const f32x4*)(sh + c);
      f32x4 y;
#pragma unroll
      for (int q = 0; q < 4; ++q) y[q] = (v[i][q] * rstd * g[q]) * (1.f + s1[q]) + s0[q];
      u32x2 o; o[0] = cvt_pk_bf16(y[0], y[1]); o[1] = cvt_pk_bf16(y[2], y[3]);
      *(u32x2*)(A + (size_t)row * 1024 + c) = o;
    }
  }
}

__device__ void final_rows(const P& p) {
  const int tid = otid(); const int lane = tid & 63, wid = tid >> 6;
  const float* H = (const float*)(p.ws + OFF_H);
  for (int row = blockIdx.x * 8 + wid; row < ML; row += gridDim.x * 8) {
    const float* h = H + (size_t)row * 1024;
    f32x4 v[4]; float ss = 0.f;
#pragma unroll
    for (int i = 0; i < 4; ++i) { v[i] = *(const f32x4*)(h + i * 256 + lane * 4); ss += v[i][0] * v[i][0] + v[i][1] * v[i][1] + v[i][2] * v[i][2] + v[i][3] * v[i][3]; }
    ss = wave_sum(ss);
    const float rstd = rsqrtf(ss * (1.f / 1024.f) + 1e-6f);
#pragma unroll
    for (int i = 0; i < 4; ++i) {
      const int c = i * 256 + lane * 4;
      const f32x4 g = *(const f32x4*)(p.final_g + c);
      f32x4 y;
#pragma unroll
      for (int q = 0; q < 4; ++q) y[q] = v[i][q] * rstd * g[q];
      *(f32x4*)(p.out + (size_t)row * 1024 + c) = y;
    }
  }
}

template <bool LAT>
__device__ __forceinline__ void attn_task(const P& p, int task, int l, const float* rpb_lds, int lane) {
  constexpr int NG = LAT ? 16 : 8;
  const bf16_t* PS = (const bf16_t*)(p.ws + OFF_PS);
  const bf16_t* VT = (const bf16_t*)(p.ws + OFF_VT);
  bf16_t* Y4 = (bf16_t*)(p.ws + OFF_Y4);
  int b, head, r = 0, jb = 0, qrow0;
  if (LAT) { jb = task & 3; r = (task >> 2) & 31; head = (task >> 7) & 3; b = task >> 9; qrow0 = b * 2048 + r * 64 + jb * 16; }
  else { const int qb = task & 15; head = (task >> 4) & 3; b = task >> 6; qrow0 = ML + b * 256 + qb * 16; }
  const int n = lane & 15, kg = lane >> 4;
  const bf16_t* qp = PS + (size_t)(qrow0 + n) * 2304 + 256 + head * 64 + kg * 8;
  const bf16x8 q0 = *(const bf16x8*)qp, q1 = *(const bf16x8*)(qp + 32);
  const int rs = LAT ? min(max(r - 4, 0), 24) : 0;
  const int clo = LAT ? (jb == 0 ? 0 : jb == 1 ? 8 : jb == 2 ? 24 : 32) : 0;
  const int keyX = 8 * (n >> 2) + (n & 3);
  f32x4 s[NG][2];
#pragma unroll
  for (int gb = 0; gb < NG; gb += 4) {
    bf16x8 kf[4][4];
#pragma unroll
    for (int g4 = 0; g4 < 4; ++g4) {
      const int gi = gb + g4;
      int tokrow0;
      if (LAT && gi < 8) tokrow0 = b * 2048 + (rs + gi) * 64 + clo; else tokrow0 = ML + b * 256 + (gi - (LAT ? 8 : 0)) * 32;
      const bf16_t* kp = PS + (size_t)(tokrow0 + keyX) * 2304 + 512 + head * 64 + kg * 8;
      kf[g4][0] = *(const bf16x8*)kp; kf[g4][1] = *(const bf16x8*)(kp + 32);
      kf[g4][2] = *(const bf16x8*)(kp + 4 * 2304); kf[g4][3] = *(const bf16x8*)(kp + 4 * 2304 + 32);
    }
    __builtin_amdgcn_sched_barrier(0);
#pragma unroll
    for (int g4 = 0; g4 < 4; ++g4) {
      const int gi = gb + g4;
      f32x4 z = {0.f, 0.f, 0.f, 0.f};
      s[gi][0] = __builtin_amdgcn_mfma_f32_16x16x32_bf16(kf[g4][0], q0, z, 0, 0, 0);
      s[gi][0] = __builtin_amdgcn_mfma_f32_16x16x32_bf16(kf[g4][1], q1, s[gi][0], 0, 0, 0);
      s[gi][1] = __builtin_amdgcn_mfma_f32_16x16x32_bf16(kf[g4][2], q0, z, 0, 0, 0);
      s[gi][1] = __builtin_amdgcn_mfma_f32_16x16x32_bf16(kf[g4][3], q1, s[gi][1], 0, 0, 0);
    }
    __builtin_amdgcn_sched_barrier(0);
  }
  float mx = -3.0e38f;
  const int jq = jb * 16 + n; const int cs = min(max(jq - 8, 0), 48);
#pragma unroll
  for (int gi = 0; gi < NG; ++gi)
#pragma unroll
    for (int blk = 0; blk < 2; ++blk)
#pragma unroll
      for (int i = 0; i < 4; ++i) {
        float v = s[gi][blk][i] * 0.125f;
        if (LAT && gi < 8) {
          const int kc = clo + 8 * kg + blk * 4 + i;
          const bool ok = (kc >= cs) && (kc < cs + 16);
          const int dr = rs + gi - r + 7; const int dc = min(max(kc - jq + 15, 0), 30);
          const float bias = rpb_lds[(head * 15 + dr) * 31 + dc];
          v = ok ? v + bias : -1.0e30f;
        }
        s[gi][blk][i] = v; mx = fmaxf(mx, v);
      }
  mx = fmaxf(mx, __shfl_xor(mx, 16)); mx = fmaxf(mx, __shfl_xor(mx, 32));
  float sum = 0.f;
#pragma unroll
  for (int gi = 0; gi < NG; ++gi)
#pragma unroll
    for (int blk = 0; blk < 2; ++blk)
#pragma unroll
      for (int i = 0; i < 4; ++i) { const float e = __expf(s[gi][blk][i] - mx); s[gi][blk][i] = e; sum += e; }
  sum += __shfl_xor(sum, 16); sum += __shfl_xor(sum, 32);
  f32x4 o[4];
#pragma unroll
  for (int db = 0; db < 4; ++db) o[db] = (f32x4){0.f, 0.f, 0.f, 0.f};
  const bf16_t* vbase = VT + ((size_t)((b * 4 + head) * 64 + n)) * 2304 + kg * 8;
#pragma unroll
  for (int gb = 0; gb < NG; gb += 4) {
    bf16x8 vf[4][4];
#pragma unroll
    for (int g4 = 0; g4 < 4; ++g4) {
      const int gi = gb + g4;
      int tok0;
      if (LAT && gi < 8) tok0 = (rs + gi) * 64 + clo; else tok0 = 2048 + (gi - (LAT ? 8 : 0)) * 32;
#pragma unroll
      for (int db = 0; db < 4; ++db) vf[g4][db] = *(const bf16x8*)(vbase + (size_t)(db * 16) * 2304 + tok0);
    }
    __builtin_amdgcn_sched_barrier(0);
#pragma unroll
    for (int g4 = 0; g4 < 4; ++g4) {
      const int gi = gb + g4;
      const u32x4 pk = pack8(s[gi][0], s[gi][1]);
      bf16x8 pf; __builtin_memcpy(&pf, &pk, 16);
#pragma unroll
      for (int db = 0; db < 4; ++db) o[db] = __builtin_amdgcn_mfma_f32_16x16x32_bf16(vf[g4][db], pf, o[db], 0, 0, 0);
    }
    __builtin_amdgcn_sched_barrier(0);
  }
  const float inv = 1.f / sum;
  bf16_t* op = Y4 + (size_t)(qrow0 + n) * 1024 + 256 + head * 64 + kg * 4;
#pragma unroll
  for (int db = 0; db < 4; ++db) {
    u32x2 w; w[0] = cvt_pk_bf16(o[db][0] * inv, o[db][1] * inv); w[1] = cvt_pk_bf16(o[db][2] * inv, o[db][3] * inv);
    *(u32x2*)(op + db * 16) = w;
  }
}

__device__ __forceinline__ void conv_task(const P& p, int l, int task) {
  const bf16_t* PS = (const bf16_t*)(p.ws + OFF_PS);
  bf16_t* Y4 = (bf16_t*)(p.ws + OFF_Y4);
  const int idx = task * 512 + otid();
  const int row = idx >> 5, c0 = (idx & 31) * 8;
  int pos, len; if (row < ML) { pos = row & 2047; len = 2048; } else { pos = (row - ML) & 255; len = 256; }
  const bf16_t* base = PS + (size_t)row * 2304;
  float z[3][8];
#pragma unroll
  for (int d = 0; d < 3; ++d) {
    const int pp = pos + d - 1;
    if (pp >= 0 && pp < len) {
      const u32x4 cv = *(const u32x4*)(base + (d - 1) * 2304 + 5 * 256 + c0), xv = *(const u32x4*)(base + (d - 1) * 2304 + 6 * 256 + c0);
#pragma unroll
      for (int i = 0; i < 4; ++i) { z[d][2 * i] = bflo(cv[i]) * bflo(xv[i]); z[d][2 * i + 1] = bfhi(cv[i]) * bfhi(xv[i]); }
    } else {
#pragma unroll
      for (int i = 0; i < 8; ++i) z[d][i] = 0.f;
    }
  }
  const u32x4 bv = *(const u32x4*)(base + 4 * 256 + c0);
  const float* w = p.conv_w + (size_t)l * 3 * 256 + c0;
  float y[8];
#pragma unroll
  for (int i = 0; i < 8; ++i) y[i] = w[i] * z[0][i] + w[256 + i] * z[1][i] + w[512 + i] * z[2][i];
  u32x4 o;
#pragma unroll
  for (int i = 0; i < 4; ++i) o[i] = cvt_pk_bf16(bflo(bv[i]) * y[2 * i], bfhi(bv[i]) * y[2 * i + 1]);
  *(u32x4*)(Y4 + (size_t)row * 1024 + 512 + c0) = o;
}

__device__ void sgu_task(const P& p, int l, int task, float* lds) {
  const int tid = otid();
  const bf16_t* PS = (const bf16_t*)(p.ws + OFF_PS);
  bf16_t* Y4 = (bf16_t*)(p.ws + OFF_Y4);
  const bf16_t* W16 = (const bf16_t*)(p.ws + OFF_SGUWT);
  const int chunk = task >> 2, g = task & 3;
  bf16_t* vnT = (bf16_t*)lds;
  constexpr int VS = 136;
  {
    const int s = tid >> 2, q = tid & 3;
    const bf16_t* vr = PS + (size_t)(chunk * 128 + s) * 2304 + 8 * 256;
    float sm = 0.f, sq = 0.f;
#pragma unroll
    for (int i = 0; i < 8; ++i) {
      const u32x4 v = *(const u32x4*)(vr + q * 64 + i * 8);
#pragma unroll
      for (int k = 0; k < 4; ++k) { const float a = bflo(v[k]), b = bfhi(v[k]); sm += a + b; sq += a * a + b * b; }
    }
    sm += __shfl_xor(sm, 1); sm += __shfl_xor(sm, 2); sq += __shfl_xor(sq, 1); sq += __shfl_xor(sq, 2);
    const float mu = sm * (1.f / 256.f); const float var = fmaxf(sq * (1.f / 256.f) - mu * mu, 0.f); const float rstd = rsqrtf(var + 1e-6f);
    const int cb = g * 64 + q * 16;
    const float* lg = p.ln_g + l * 256 + cb; const float* lb = p.ln_b + l * 256 + cb;
#pragma unroll
    for (int i = 0; i < 2; ++i) {
      const u32x4 v = *(const u32x4*)(vr + cb + i * 8);
#pragma unroll
      for (int k = 0; k < 4; ++k) {
        const int cc = i * 8 + 2 * k;
        const unsigned pk = cvt_pk_bf16((bflo(v[k]) - mu) * rstd * lg[cc] + lb[cc], (bfhi(v[k]) - mu) * rstd * lg[cc + 1] + lb[cc + 1]);
        vnT[(q * 16 + cc) * VS + s] = (bf16_t)(pk & 0xffffu);
        vnT[(q * 16 + cc + 1) * VS + s] = (bf16_t)(pk >> 16);
      }
    }
  }
  __syncthreads();
  const int lane = tid & 63, w = tid >> 6, n = lane & 15, kg = lane >> 4;
  const int t = w * 16 + n;
  const bf16_t* wp = W16 + ((size_t)(g * 128 + t)) * 128 + kg * 8;
  bf16x8 wf[4];
#pragma unroll
  for (int ks = 0; ks < 4; ++ks) wf[ks] = *(const bf16x8*)(wp + ks * 32);
  f32x4 acc[4];
#pragma unroll
  for (int cb = 0; cb < 4; ++cb) {
    acc[cb] = (f32x4){0.f, 0.f, 0.f, 0.f};
#pragma unroll
    for (int ks = 0; ks < 4; ++ks) {
      const bf16x8 vf = *(const bf16x8*)(vnT + (cb * 16 + n) * VS + ks * 32 + kg * 8);
      acc[cb] = __builtin_amdgcn_mfma_f32_16x16x32_bf16(vf, wf[ks], acc[cb], 0, 0, 0);
    }
  }
  const int row = chunk * 128 + t;
  const float bs = p.sgu_b[((size_t)l * 4 + g) * 128 + t];
#pragma unroll
  for (int cb = 0; cb < 4; ++cb) {
    const int c = g * 64 + cb * 16 + kg * 4;
    const u32x2 uv = *(const u32x2*)(PS + (size_t)row * 2304 + 7 * 256 + c);
    u32x2 o; o[0] = cvt_pk_bf16(bflo(uv[0]) * (acc[cb][0] + bs), bfhi(uv[0]) * (acc[cb][1] + bs)); o[1] = cvt_pk_bf16(bflo(uv[1]) * (acc[cb][2] + bs), bfhi(uv[1]) * (acc[cb][3] + bs));
    *(u32x2*)(Y4 + (size_t)row * 1024 + 768 + c) = o;
  }
  __syncthreads();
}

__device__ void carry_phase(const P& p, int l) {
  const int gt = blockIdx.x * 512 + otid();
  if (gt >= 16 * 8 * 2 * 64) return;
  const int pp = gt & 63, d = (gt >> 6) & 1, b = (gt >> 7) & 7, g = gt >> 10;
  const float* S = (const float*)(p.ws + OFF_S) + (size_t)g * NCHUNK * 256 + d * 128 + 2 * pp;
  bf16_t* XU = (bf16_t*)(p.ws + OFF_XU) + (size_t)g * XUR * XUK + 512 + d * 128 + 2 * pp;
  const int li = ((l * 2 + d) * 16 + g);
  const float dt = expf(p.log_dt[li]);
  const cpx aT = s5_apow<false>(p.lam_re[li * 64 + pp], p.lam_im[li * 64 + pp], dt, (float)TCH);
  cpx st = {0.f, 0.f};
  for (int i0 = 0; i0 < 72; i0 += 8) {
    float sre[8], sim[8]; int rows[8];
#pragma unroll
    for (int k = 0; k < 8; ++k) {
      const int i = i0 + k; int row;
      if (i < 8) row = 512 + b * 8 + (d == 0 ? i : 7 - i); else row = b * 64 + (d == 0 ? (i - 8) : 63 - (i - 8));
      rows[k] = row; const float2 v = *(const float2*)(S + (size_t)row * 256); sre[k] = v.x; sim[k] = v.y;
    }
#pragma unroll
    for (int k = 0; k < 8; ++k) {
      *(unsigned*)(XU + (size_t)rows[k] * XUK) = cvt_pk_bf16(st.re, st.im);
      const cpx ns = cmul(aT, st); st.re = ns.re + sre[k]; st.im = ns.im + sim[k];
    }
  }
}

constexpr int PH_PER_LAYER = 11;
constexpr int N_PHASES = 1 + NDEPTH * PH_PER_LAYER + 1;

__global__ void __launch_bounds__(512, 2) mk_forward(P p) {
  extern __shared__ __attribute__((aligned(16))) unsigned char shm[];
  LAS unsigned char* lds = (LAS unsigned char*)shm;
  float* ldsf = (float*)shm;
  const int G = gridDim.x, wg = blockIdx.x;
  unsigned char* ws = p.ws;
  volatile LAS unsigned* xbw = (volatile LAS unsigned*)(lds + 131072);
  if (threadIdx.x == 0) { xbw[0] = 0u; xbw[1] = 0u; xbw[2] = 0u; xbw[3] = 0u; }
  __syncthreads();
  const XcdBarrier xb = xcd_barrier_post((unsigned*)(ws + OFF_BAR), xbw);
  if (p.ph_lo < 0) cg::this_grid().sync();
  float* H = (float*)(ws + OFF_H);
  const float* MOD = (const float*)(ws + OFF_MOD);

  for (int ph = p.ph_lo; ph < p.ph_hi; ++ph) {
    int nrep = 1;
#if DBL_MASK
    { const int spx = (ph == 0) ? 11 : (ph == N_PHASES - 1) ? 13 : (ph - 1) % PH_PER_LAYER; if ((DBL_MASK >> spx) & 1) nrep = 2; }
#endif
    for (int rep = 0; rep < nrep; ++rep) {
    if (rep) xcd_barrier(xb);
    int tid_ = threadIdx.x; asm volatile("" : "+v"(tid_));
    const int tid = tid_, lane = tid & 63, wid = tid >> 6;
    if (ph == 0) {
      for (int t = wg; t < 192; t += G) mod_task(p, t, ldsf);
      for (int t = (wg + G - (192 % G)) % G; t < NT_WIN + NT_BR; t += G) prep_task(p, 0, t < NT_WIN ? t : PT_WBR0 + (t - NT_WIN), ldsf);
    } else if (ph == N_PHASES - 1) {
      final_rows(p);
#if TSEL
      xcd_barrier(xb);
      if (wg == 0) { const unsigned long long* ts = (const unsigned long long*)(ws + OFF_BAR + 14336); const unsigned long long v = ts[TSEL - 1]; const int N = (int)(TSEL == 3 ? v * 1000 : v / 10);
        for (int i = tid; i < N && i < 300000; i += 512) p.out[(size_t)i * 16] += 0.125f; }
#endif
    } else {
      const int l = (ph - 1) / PH_PER_LAYER, sp = (ph - 1) % PH_PER_LAYER;
      const bool last = (l == NDEPTH - 1);
      const float* hL = l == 0 ? p.x : H; const float* hC = l == 0 ? p.ctx : H + (size_t)ML * 1024;
      const float* modl = MOD + (size_t)l * 9 * 6144;
      const int nMrows = last ? 64 : 72;
      switch (sp) {
#if PHMASK & 1
        case 0: {
          for (int t = wg; t < PT_NG1; t += G) prep_task(p, l, PT_G10 + t, ldsf);
          norm_rows(p, hL, hC, p.norm_g + (size_t)(l * 2 + 0) * 1024, modl, 0, MT, l > 0 ? MOD + ((size_t)(l - 1) * 9 + 8) * 6144 + 5 * 1024 : nullptr);
        } break;
#endif
#if PHMASK & 2
        case 1: {
          G1Sched S{(const char*)(ws + OFF_A), (const char*)(ws + OFF_WIN), G, wg, last ? 1 : 0};
          EpiG1 E{(bf16_t*)(ws + OFF_PS), (bf16_t*)(ws + OFF_XU), (bf16_t*)(ws + OFF_VT)};
          gemm_phase(lds, 1024, 1024, S, E, (TSEL && TPHASE == 1 && wg == 0) ? (unsigned long long*)(ws + OFF_BAR + 14336) : nullptr);
        } break;
#endif
#if PHMASK & 4
        case 2: {
          {
            S5Sched S{(const char*)(ws + OFF_XU), (const char*)(ws + OFF_W1), (size_t)256 * 512 * 2, 0, 3, 1, 8, G, wg};
            EpiS1 E{(float*)(ws + OFF_S)};
            gemm_phase(lds, XUK, 512, S, E);
          }
          __syncthreads();
          for (int i = tid; i < 4 * 15 * 31; i += 512) ldsf[i] = p.rpb[(size_t)l * 4 * 15 * 31 + i];
          __syncthreads();
          const int nwaves = G * 8, gw = wg * 8 + wid;
#if TSEL
          unsigned long long* tsl = (unsigned long long*)(ws + OFF_BAR + 14336); const unsigned long long tq0 = __builtin_amdgcn_s_memrealtime();
#endif
          for (int t = gw; t < 4096; t += nwaves) attn_task<true>(p, t, l, ldsf, lane);
          if (!last) for (int t = nwaves - 1 - gw; t < 512; t += nwaves) attn_task<false>(p, t, l, ldsf, lane);
#if TSEL
          __syncthreads(); const unsigned long long tq1 = __builtin_amdgcn_s_memrealtime();
#endif
        } break;
#endif
#if PHMASK & 8
        case 3: {
          carry_phase(p, l);
          const int nconv = (last ? ML : MT) * 32 / 512;
          int st, sd; if (filler_range(wg, G, 32, st, sd)) for (int t = st; t < nconv; t += sd) conv_task(p, l, t);
        } break;
#endif
#if PHMASK & 16
        case 4: {
          S5Sched S{(const char*)(ws + OFF_XU), (const char*)(ws + OFF_W2), (size_t)512 * 768 * 2, (size_t)256 * 768 * 2, last ? 2 : 3, 2, 12, G, wg};
          EpiS2 E{(bf16_t*)(ws + OFF_YG), last ? 512 : NCHUNK};
          gemm_phase(lds, XUK, 768, S, E);
          const int nsgu = (last ? 128 : 144) * 4;
          { int st, sd; if (filler_range(wg, G, 96, st, sd)) { __syncthreads(); for (int t = st; t < nsgu / 2; t += sd) sgu_task(p, l, t, ldsf); } }
        } break;
#endif
#if PHMASK & 32
        case 5: {
          RectSched S{(const char*)(ws + OFF_YG), (const char*)(ws + OFF_WGLU), (size_t)256 * 256 * 2, 0, nMrows, 1, 4, G, wg};
          EpiGLU E{(const bf16_t*)(ws + OFF_YG), p.glu_b + l * 256, (bf16_t*)(ws + OFF_Y4)};
          gemm_phase(lds, 256, 256, S, E);
          const int nsgu = (last ? 128 : 144) * 4;
          { int st, sd; if (filler_range(wg, G, 72, st, sd)) { __syncthreads(); for (int t = nsgu / 2 + st; t < nsgu; t += sd) sgu_task(p, l, t, ldsf); } }
        } break;
#endif
#if PHMASK & 64
        case 6: {
          MergeSched S{(const char*)(ws + OFF_A), (const char*)(ws + OFF_Y4), (const char*)(ws + OFF_WIN), (const char*)(ws + OFF_WBR), last ? 0 : 128, G, wg};
          EpiMerge E{ws + OFF_GS + (size_t)wg * 65536, (bf16_t*)(ws + OFF_MIXTMP + (size_t)wg * 131072), (bf16_t*)(ws + OFF_MIX), (bf16_t*)(ws + OFF_GP)};
          gemm_phase(lds, 1024, 1024, S, E, (TSEL && TPHASE == 6 && wg == 0) ? (unsigned long long*)(ws + OFF_BAR + 14336) : nullptr);
          { int st, sd; if (filler_range(wg, G, last ? 0 : 128, st, sd)) for (int t = st; t < PT_NMID; t += sd) prep_task(p, l, PT_FF0 + t, ldsf); }
        } break;
#endif
#if PHMASK & 128
        case 7: {
          {
            SplitSched S{(const char*)(ws + OFF_MIX), (const char*)(ws + OFF_WOUT), nullptr, (size_t)256 * 1024 * 2, (size_t)256 * 1024 * 2, 0, 16, 0, 256, 0, G, wg};
            EpiRes E{hL, hC, H, modl, 2, nullptr};
            gemm_phase(lds, 1024, 1024, S, E);
          }
          if (!last) {
            WoutCtxSched S{(const char*)(ws + OFF_GP), (const char*)(ws + OFF_WOUT), G, wg};
            EpiRes E{hL, hC, H, modl, 2, (float*)(ws + OFF_PART)};
            gemm_phase(lds, 4096, 1024, S, E);
          }
        } break;
#endif
#if PHMASK & 256
        case 8: {
          norm_rows(p, H, l == 0 ? p.ctx : H + (size_t)ML * 1024, p.norm_g + (size_t)(l * 2 + 1) * 1024, modl, 3, last ? ML : MT, modl + (size_t)8 * 6144 + 2 * 1024);
          if (!last) for (int t = wg; t < NT_BR; t += G) prep_task(p, l + 1, PT_WBR0 + t, ldsf);
        } break;
#endif
#if PHMASK & 512
        case 9: {
          RectSched S{(const char*)(ws + OFF_A), (const char*)(ws + OFF_WFF1), (size_t)256 * 1024 * 2, (size_t)256 * 1024 * 2, nMrows, 16, 16, G, wg};
          EpiFF1 E{(bf16_t*)(ws + OFF_FFH)};
          gemm_phase(lds, 1024, 1024, S, E, (TSEL && TPHASE == 9 && wg == 0) ? (unsigned long long*)(ws + OFF_BAR + 14336) : nullptr);
          if (!last) { int st, sd; if (filler_range(wg, G, 128, st, sd)) for (int t = st; t < NT_WIN; t += sd) prep_task(p, l + 1, t, ldsf); }
        } break;
#endif
#if PHMASK & 1024
        case 10: {
          SplitSched S{(const char*)(ws + OFF_FFH), (const char*)(ws + OFF_WFF2), (const char*)(ws + OFF_FFH) + (size_t)64 * 256 * 4096 * 2, (size_t)256 * 4096 * 2, (size_t)256 * 4096 * 2, (size_t)256 * 4096 * 2, 64, 8, 256, last ? 0 : 256, G, wg};
          EpiRes E{H, H + (size_t)ML * 1024, H, modl, 5, (float*)(ws + OFF_PART)};
          gemm_phase(lds, 4096, 4096, S, E);
        } break;
#endif
      }
    }
    }
    if (ph + 1 < p.ph_hi) { xcd_barrier(xb);
#if (DBL_MASK >> 12) & 1
      xcd_barrier(xb);
#endif
    }
  }
}

extern "C" void kernel_launch(void* const* d_in, const int* in_sizes, int n_in, void* d_out, int out_size, void* d_ws, size_t ws_size, hipStream_t stream) {
  constexpr size_t kDynLds = 131072 + 16;
  static int grid_blocks = 0;
  if (!grid_blocks) {
    (void)hipFuncSetAttribute((const void*)mk_forward, hipFuncAttributeMaxDynamicSharedMemorySize, (int)kDynLds);
    int dev = 0, cus = 0, per_cu = 0;
    (void)hipGetDevice(&dev);
    (void)hipDeviceGetAttribute(&cus, hipDeviceAttributeMultiprocessorCount, dev);
    (void)hipOccupancyMaxActiveBlocksPerMultiprocessor(&per_cu, mk_forward, 512, kDynLds);
    if (per_cu < 1) per_cu = 1;
    grid_blocks = cus;
  }
  P p{};
  const float** pp = (const float**)&p;
  for (int i = 0; i < 29; ++i) pp[i] = (const float*)d_in[i];
  p.out = (float*)d_out; p.ws = (unsigned char*)d_ws;
  (void)hipMemsetAsync((unsigned char*)d_ws + OFF_BAR, 0, 16384, stream);
#if MULTI_LAUNCH
  for (int ph = 0; ph < N_PHASES; ++ph) {
    p.ph_lo = ph; p.ph_hi = ph + 1;
    hipLaunchKernelGGL(mk_forward, dim3(grid_blocks), dim3(512), kDynLds, stream, p);
  }
#else
  p.ph_lo = 0; p.ph_hi = N_PHASES;
  void* args[] = {&p};
  (void)hipLaunchCooperativeKernel((void*)mk_forward, dim3(grid_blocks), dim3(512), args, kDynLds, stream);
#endif
}
```

```cpp
#include <hip/hip_runtime.h>
#include <hip/hip_cooperative_groups.h>
namespace cg = cooperative_groups;

#define LAS __attribute__((address_space(3)))
typedef unsigned short bf16_t;
typedef short bf16x8 __attribute__((ext_vector_type(8)));
typedef float f32x4 __attribute__((ext_vector_type(4)));
typedef unsigned u32x4 __attribute__((ext_vector_type(4)));
typedef unsigned u32x2 __attribute__((ext_vector_type(2)));

#ifndef PHMASK
#define PHMASK 0x7ff
#endif
#ifndef DBL_MASK
#define DBL_MASK 0
#endif
#ifndef TSEL
#define TSEL 0
#endif
#ifndef TPHASE
#define TPHASE 6
#endif
#ifndef MULTI_LAUNCH
#define MULTI_LAUNCH 0
#endif

constexpr int DM = 1024, NB = 8, SEQL = 2048, NDEPTH = 4, CTXL = 256, DFF = 4096, INW = 6400;
constexpr int ML = NB * SEQL;
constexpr int MC = NB * CTXL;
constexpr int MT = ML + MC;
constexpr int TCH = 32;
constexpr int NCHUNK = MT / TCH;
constexpr int XUR = 768;
constexpr int XUK = 768;

constexpr size_t OFF_H = 0;
constexpr size_t OFF_A = OFF_H + (size_t)MT * DM * 4;
constexpr size_t OFF_MIX = OFF_A + (size_t)MT * DM * 2;
constexpr size_t OFF_R1 = OFF_MIX + (size_t)MT * DM * 2;
constexpr size_t OFF_PS = OFF_R1;
constexpr size_t OFF_Y4 = OFF_PS + (size_t)MT * 2304 * 2;
constexpr size_t OFF_VT = OFF_Y4 + (size_t)MT * DM * 2;
constexpr size_t OFF_XU = OFF_VT + (size_t)NB * 4 * 64 * 2304 * 2;
constexpr size_t OFF_S = OFF_XU + (size_t)16 * XUR * XUK * 2;
constexpr size_t OFF_YG = OFF_S + (size_t)16 * NCHUNK * 256 * 4;
constexpr size_t OFF_R1END = OFF_YG + (size_t)MT * 256 * 2;
constexpr size_t OFF_FFH = OFF_R1;
constexpr size_t OFF_MIXTMP = OFF_PS;
constexpr size_t OFF_KT = OFF_YG;
constexpr size_t OFF_GS = OFF_VT;
constexpr size_t OFF_WIN = OFF_R1END;
constexpr size_t OFF_WFF1 = OFF_WIN + (size_t)INW * DM * 2;
constexpr size_t OFF_WFF2 = OFF_WFF1 + (size_t)DFF * DM * 2;
constexpr size_t OFF_WOUT = OFF_WFF2 + (size_t)DFF * DM * 2;
constexpr size_t OFF_WBR = OFF_WOUT + (size_t)DM * DM * 2;
constexpr size_t OFF_WGLU = OFF_WBR + (size_t)DM * DM * 2;
constexpr size_t OFF_W1 = OFF_WGLU + (size_t)256 * 256 * 2;
constexpr size_t OFF_W2 = OFF_W1 + (size_t)16 * 256 * 512 * 2;
constexpr size_t OFF_SGUWT = OFF_W2 + (size_t)16 * 512 * 768 * 2;
constexpr size_t OFF_MOD = OFF_SGUWT + (size_t)4 * 128 * 128 * 4;
constexpr size_t OFF_BAR = OFF_MOD + (size_t)NDEPTH * 9 * 6144 * 4;
constexpr size_t OFF_PART = OFF_BAR + 16384;
constexpr size_t OFF_END = OFF_PART + (size_t)8 * MC * DM * 4;
constexpr size_t OFF_GP = OFF_PS + (size_t)256 * 262144;
static_assert(OFF_GP + (size_t)MC * 4096 * 2 <= OFF_Y4, "GP alias");
static_assert((size_t)MT * DFF * 2 <= OFF_R1END - OFF_R1, "FFH alias");
static_assert((size_t)256 * 262144 <= (size_t)MT * 2304 * 2, "MIXTMP alias");
static_assert((size_t)256 * 131072 <= OFF_R1END - OFF_VT, "GS alias");
static_assert(OFF_END < 452000000ull, "workspace");

struct P {
  const float *x, *c, *ctx, *c_ctx, *ada_w, *ada_b, *norm_g, *final_g, *w_in, *w_branch, *w_out,
      *lam_re, *lam_im, *log_dt, *b_re, *b_im, *c_re, *c_im, *s5_d, *glu_w, *glu_b, *rpb, *conv_w,
      *ln_g, *ln_b, *sgu_w, *sgu_b, *w_ff1, *w_ff2;
  float* out;
  unsigned char* ws;
  int ph_lo, ph_hi;
};

__device__ __forceinline__ int otid() { int t = threadIdx.x; asm volatile("" : "+v"(t)); return t; }
__device__ __forceinline__ float bf2f(bf16_t b) { return __uint_as_float(((unsigned)b) << 16); }
__device__ __forceinline__ float bflo(unsigned w) { return __uint_as_float(w << 16); }
__device__ __forceinline__ float bfhi(unsigned w) { return __uint_as_float(w & 0xffff0000u); }
__device__ __forceinline__ unsigned cvt_pk_bf16(float lo, float hi) { unsigned r; asm volatile("v_cvt_pk_bf16_f32 %0, %1, %2" : "=v"(r) : "v"(lo), "v"(hi)); return r; }
__device__ __forceinline__ float sigm(float x) { return 1.f / (1.f + __expf(-x)); }
__device__ __forceinline__ float gelu_tanh(float x) { return x * sigm(1.5957691216057308f * (x + 0.044715f * x * x * x)); }
__device__ __forceinline__ u32x4 pack8(f32x4 a, f32x4 b) { u32x4 r; r[0] = cvt_pk_bf16(a[0], a[1]); r[1] = cvt_pk_bf16(a[2], a[3]); r[2] = cvt_pk_bf16(b[0], b[1]); r[3] = cvt_pk_bf16(b[2], b[3]); return r; }
__device__ __forceinline__ float shx(float v, int o, int lane) { return __int_as_float(__builtin_amdgcn_ds_bpermute((lane ^ o) << 2, __float_as_int(v))); }
__device__ __forceinline__ float wave_sum(float v, int lane) {
#pragma unroll
  for (int o = 32; o >= 1; o >>= 1) v += shx(v, o, lane);
  return v;
}


#define XB_TMO      128
#define XB_XCNT(j)  (256  + 64 * (j))
#define XB_XSUB(j)  (1280 + 64 * (j))
#define XB_XGEN(j)  (2304 + 64 * (j))
#define XB_TOP      3328
#define XB_TOPGEN   3392
#define XCD_BAR_WORDS 3456
#define XB_SPIN_CAP (1u << 22)
__device__ __forceinline__ unsigned xb_ld(unsigned* p)              { return __hip_atomic_load(p, __ATOMIC_RELAXED, __HIP_MEMORY_SCOPE_AGENT); }
__device__ __forceinline__ unsigned xb_add(unsigned* p, unsigned v) { return __hip_atomic_fetch_add(p, v, __ATOMIC_RELAXED, __HIP_MEMORY_SCOPE_AGENT); }
__device__ __forceinline__ unsigned xb_xcc_id() { return (unsigned)__builtin_amdgcn_s_getreg((3 << 11) | 20) & 0xFu; }
#define XB_SPIN(cond, bar) do { unsigned _sp = 0; while (cond) { __builtin_amdgcn_s_sleep(1); \
    if ((++_sp & 255u) == 0u) { if (xb_ld(&(bar)[XB_TMO])) break; if (_sp > XB_SPIN_CAP) { atomicAdd(&(bar)[XB_TMO], 1u); break; } } } } while (0)
struct XcdBarrier { unsigned* bar; unsigned x; volatile LAS unsigned* st; };
__device__ __forceinline__ XcdBarrier xcd_barrier_post(unsigned* bar, volatile LAS unsigned* st) {
  XcdBarrier b; b.bar = bar; b.x = xb_xcc_id(); b.st = st;
  if (threadIdx.x == 0) (void)xb_add(&bar[XB_XCNT(b.x)], 1u);
  return b;
}
__device__ __forceinline__ void xcd_barrier_complete(unsigned* bar, unsigned x, unsigned& nloc, unsigned& nx) {
  const unsigned G = gridDim.x * gridDim.y * gridDim.z;
  unsigned sum, cnt, mine, sp = 0u;
  for (;;) {
    sum = 0u; cnt = 0u; mine = 0u;
#pragma unroll
    for (unsigned j = 0; j < 16; ++j) { const unsigned c = xb_ld(&bar[XB_XCNT(j)]); sum += c; cnt += (c > 0u) ? 1u : 0u; mine = (j == x) ? c : mine; }
    if (sum == G) break;
    __builtin_amdgcn_s_sleep(1);
    if ((++sp & 255u) == 0u) { if (xb_ld(&bar[XB_TMO])) break; if (sp > XB_SPIN_CAP) { atomicAdd(&bar[XB_TMO], 1u); break; } }
  }
  nloc = mine > 0u ? mine : 1u; nx = cnt > 0u ? cnt : 1u;
}
__device__ __forceinline__ void xcd_barrier(const XcdBarrier& b) {
  asm volatile("s_waitcnt vmcnt(0)" ::: "memory");
  __syncthreads();
  if (threadIdx.x == 0) {
    unsigned* bar = b.bar;
    __builtin_amdgcn_s_waitcnt(0);
    unsigned nloc = b.st[0], nx = b.st[1];
    if (nloc == 0u) { xcd_barrier_complete(bar, b.x, nloc, nx); b.st[0] = nloc; b.st[1] = nx; }
    const unsigned old = xb_add(&bar[XB_XSUB(b.x)], 1u);
    const unsigned gen = old / nloc;
    if (old + 1u == (gen + 1u) * nloc) {
      __builtin_amdgcn_fence(__ATOMIC_RELEASE, "agent");
      asm volatile("s_waitcnt vmcnt(0)" ::: "memory");
      const unsigned og = xb_add(&bar[XB_TOP], 1u);
      const unsigned tg = og / nx;
      if (og + 1u == (tg + 1u) * nx) xb_add(&bar[XB_TOPGEN], 1u);
      else XB_SPIN(xb_ld(&bar[XB_TOPGEN]) == tg, bar);
      __builtin_amdgcn_fence(__ATOMIC_ACQUIRE, "agent");
      xb_add(&bar[XB_XGEN(b.x)], 1u);
      asm volatile("s_waitcnt vmcnt(0)" ::: "memory");
    } else {
      XB_SPIN(xb_ld(&bar[XB_XGEN(b.x)]) == gen, bar);
      __builtin_amdgcn_fence(__ATOMIC_ACQUIRE, "agent");
      asm volatile("s_waitcnt vmcnt(0)" ::: "memory");
    }
  }
  __syncthreads();
}

constexpr int BM = 256, BK = 64, HALF = 128, HTB = HALF * BK * 2, NXCD = 8, WGM = 8;
__device__ __forceinline__ int lds_byte(int r, int c) { const int st = (r >> 4) * 2 + (c >> 5), rr = r & 15, cc = c & 31, ob = rr * 64 + cc * 2; return st * 1024 + (ob ^ (((ob >> 9) & 1) << 5)); }
__device__ __forceinline__ void stage_rc(int b, int& R, int& C) { const int st = b / 1024, sb = b % 1024, swz = sb ^ (((sb >> 9) & 1) << 5); R = (st >> 1) * 16 + swz / 64; C = (st & 1) * 32 + (swz % 64) / 2; }
__device__ __forceinline__ int perm32(int rho) { const int n = rho >> 4, i = rho & 15; return 8 * (i >> 2) + 4 * n + (i & 3); }

struct Unit { const char* A; const char* B; int nt, pm, pn, kind; };

__device__ __forceinline__ void rect_map(int L, int nM, int nN, int& pm, int& pn) {
  const int nwg = nM * nN; int wgid = L;
  { const int q = nwg / NXCD, r = nwg % NXCD, xcd = wgid % NXCD, off = wgid / NXCD; wgid = (xcd < r ? xcd * (q + 1) : r * (q + 1) + (xcd - r) * q) + off; }
  const int nig = WGM * nN, gid = wgid / nig, fm = gid * WGM, gsz = (nM - fm) < WGM ? (nM - fm) : WGM;
  pm = fm + ((wgid % nig) % gsz); pn = (wgid % nig) / gsz;
}

template <class Sched, class Epi>
__device__ __forceinline__ void gemm_phase(LAS unsigned char* lds, const int lda, const int ldb, const Sched& S, const Epi& E, unsigned long long* tslot = nullptr) {
#if TSEL
  const unsigned long long tg0 = __builtin_amdgcn_s_memrealtime();
#endif
  int tid_ = threadIdx.x; asm volatile("" : "+v"(tid_));
  const int tid = tid_, wid = __builtin_amdgcn_readfirstlane(tid >> 6), lane = tid & 63, wr = wid >> 2, wc = wid & 3, fr = lane & 15, fq = lane >> 4;
  unsigned voffA[2], voffB[2];
#pragma unroll
  for (int i = 0; i < 2; ++i) { int R, C; stage_rc(tid * 16 + i * 8192, R, C); const int Rb = (R & ~31) + perm32(R & 31);
    voffA[i] = (unsigned)(R * lda + C) * 2u; voffB[i] = (unsigned)(Rb * ldb + C) * 2u; }
  const size_t kstep = (size_t)(BK * 2);
  const size_t hstepA = (size_t)HALF * lda * 2, hstepB = (size_t)HALF * ldb * 2;
  const unsigned ldsw = (unsigned)wid * 1024u;
  const int aoff = lds_byte(wr * 64 + fr, fq * 8), boff = lds_byte(wc * 32 + fr, fq * 8);
#define PG8_SA(b, h) (((b) * 2 + (h)) * HTB)
#define PG8_SB(b, h) ((4 + (b) * 2 + (h)) * HTB)
#define PG8_STAGE(bufoff, gbase, voff) do { _Pragma("unroll") for (int _i = 0; _i < 2; ++_i) \
    __builtin_amdgcn_global_load_lds((const unsigned*)((const char*)(gbase) + (voff)[_i]), (LAS unsigned*)(lds + (bufoff) + ldsw + _i * 8192), 16, 0, 0); } while (0)
#define PG8_LDA(dst, b, h) do { _Pragma("unroll") for (int m = 0; m < 4; ++m) _Pragma("unroll") for (int k = 0; k < 2; ++k) dst[m][k] = *(const LAS bf16x8*)(lds + PG8_SA(b, h) + aoff + m * 2048 + k * 1024); } while (0)
#define PG8_LDB(dst, b, h) do { _Pragma("unroll") for (int n = 0; n < 2; ++n) _Pragma("unroll") for (int k = 0; k < 2; ++k) dst[n][k] = *(const LAS bf16x8*)(lds + PG8_SB(b, h) + boff + n * 2048 + k * 1024); } while (0)
#define PG8_MMA(ai, bj, At, Bt) do { __builtin_amdgcn_s_setprio(1); _Pragma("unroll") for (int m = 0; m < 4; ++m) _Pragma("unroll") for (int n = 0; n < 2; ++n) _Pragma("unroll") for (int k = 0; k < 2; ++k) \
    acc[ai][bj][m][n] = __builtin_amdgcn_mfma_f32_16x16x32_bf16(Bt[n][k], At[m][k], acc[ai][bj][m][n], 0, 0, 0); __builtin_amdgcn_s_setprio(0); } while (0)
#define PG8_WAIT_V(n) asm volatile("s_waitcnt vmcnt(" #n ")" ::: "memory")
#define PG8_WAIT_L(n) asm volatile("s_waitcnt lgkmcnt(" #n ")" ::: "memory")
#define PG8_BAR __builtin_amdgcn_s_barrier()
#define PG8_SCHED __builtin_amdgcn_sched_barrier(0)
  Unit cur, nxt; int ui = 0;
  if (!S.next(0, cur)) return;
  f32x4 acc[2][2][4][2];
#pragma unroll
  for (int a = 0; a < 2; ++a)
#pragma unroll
    for (int b = 0; b < 2; ++b)
#pragma unroll
      for (int m = 0; m < 4; ++m)
#pragma unroll
        for (int n = 0; n < 2; ++n) acc[a][b][m][n] = (f32x4){0.f, 0.f, 0.f, 0.f};
  bf16x8 At[4][2], B0[2][2], B1[2][2];
  const char* cA = cur.A; const char* cB = cur.B;
  PG8_STAGE(PG8_SB(0, 0), cB, voffB); PG8_STAGE(PG8_SA(0, 0), cA, voffA); PG8_STAGE(PG8_SB(0, 1), cB + hstepB, voffB); PG8_STAGE(PG8_SA(0, 1), cA + hstepA, voffA);
  if (wr == 1) PG8_BAR;
  PG8_WAIT_V(4); PG8_BAR;
  PG8_STAGE(PG8_SB(1, 0), cB + kstep, voffB); PG8_STAGE(PG8_SA(1, 0), cA + kstep, voffA); PG8_STAGE(PG8_SB(1, 1), cB + hstepB + kstep, voffB);
  PG8_WAIT_V(6); PG8_BAR;
  for (;;) {
    const bool has_next = S.next(ui + 1, nxt);
    const char* nA = has_next ? nxt.A : cA; const char* nB = has_next ? nxt.B : cB;
    const int nt = cur.nt;
#if TSEL
    const unsigned long long tk0 = __builtin_amdgcn_s_memrealtime();
#endif
    for (int t = 0; t < nt; t += 2) {
      const bool last = (t == nt - 2);
      const char* a1 = cA + (size_t)(t + 1) * kstep;
      const char* a2 = last ? nA : cA + (size_t)(t + 2) * kstep; const char* b2 = last ? nB : cB + (size_t)(t + 2) * kstep;
      const char* a3 = a2 + kstep; const char* b3 = b2 + kstep;
      PG8_LDB(B0, 0, 0); PG8_SCHED; PG8_LDA(At, 0, 0); PG8_STAGE(PG8_SA(1, 1), a1 + hstepA, voffA);
      PG8_WAIT_L(8); PG8_BAR; PG8_WAIT_L(0); PG8_MMA(0, 0, At, B0); PG8_BAR; PG8_SCHED;
      PG8_LDB(B1, 0, 1); PG8_STAGE(PG8_SB(0, 0), b2, voffB);
      PG8_BAR; PG8_WAIT_L(0); PG8_MMA(0, 1, At, B1); PG8_BAR;
      PG8_LDA(At, 0, 1); PG8_STAGE(PG8_SA(0, 0), a2, voffA);
      PG8_BAR; PG8_WAIT_L(0); PG8_MMA(1, 0, At, B0); PG8_BAR; PG8_SCHED;
      PG8_STAGE(PG8_SB(0, 1), b2 + hstepB, voffB);
      PG8_WAIT_V(6); PG8_BAR; PG8_MMA(1, 1, At, B1); PG8_BAR;
      PG8_LDB(B0, 1, 0); PG8_SCHED; PG8_LDA(At, 1, 0); PG8_STAGE(PG8_SA(0, 1), a2 + hstepA, voffA);
      PG8_WAIT_L(8); PG8_BAR; PG8_WAIT_L(0); PG8_MMA(0, 0, At, B0); PG8_BAR; PG8_SCHED;
      PG8_LDB(B1, 1, 1); PG8_STAGE(PG8_SB(1, 0), b3, voffB);
      PG8_BAR; PG8_WAIT_L(0); PG8_MMA(0, 1, At, B1); PG8_BAR;
      PG8_LDA(At, 1, 1); PG8_STAGE(PG8_SA(1, 0), a3, voffA);
      PG8_BAR; PG8_WAIT_L(0); PG8_MMA(1, 0, At, B0); PG8_BAR; PG8_SCHED;
      PG8_STAGE(PG8_SB(1, 1), b3 + hstepB, voffB);
      PG8_WAIT_V(6); PG8_BAR; PG8_MMA(1, 1, At, B1); PG8_BAR;
    }
#if TSEL
    const unsigned long long te0 = __builtin_amdgcn_s_memrealtime();
    if (tslot && tid == 0) tslot[3 + (cur.kind & 1)] += te0 - tk0;
#endif
    { const int t2 = otid(); E(acc, cur, wr, wc, t2 & 15, (t2 & 63) >> 4); }
#if TSEL
    if (tslot && tid == 0) { asm volatile("s_waitcnt vmcnt(0)" ::: "memory"); tslot[0] += __builtin_amdgcn_s_memrealtime() - te0; tslot[2] += 1; }
#endif
    if (!has_next) break;
#pragma unroll
    for (int a = 0; a < 2; ++a)
#pragma unroll
      for (int b = 0; b < 2; ++b)
#pragma unroll
        for (int m = 0; m < 4; ++m)
#pragma unroll
          for (int n = 0; n < 2; ++n) acc[a][b][m][n] = (f32x4){0.f, 0.f, 0.f, 0.f};
    cur = nxt; cA = nA; cB = nB; ++ui;
  }
  PG8_WAIT_V(0);
  if (wr == 0) PG8_BAR;
  PG8_BAR;
#if TSEL
  if (tslot && tid == 0) tslot[1] += __builtin_amdgcn_s_memrealtime() - tg0;
#endif
#undef PG8_SA
#undef PG8_SB
#undef PG8_STAGE
#undef PG8_LDA
#undef PG8_LDB
#undef PG8_MMA
#undef PG8_WAIT_V
#undef PG8_WAIT_L
#undef PG8_BAR
#undef PG8_SCHED
}

typedef f32x4 Acc[2][2][4][2];
#define EPI_ROWS(u, wr, fr) \
  _Pragma("unroll") for (int ai = 0; ai < 2; ++ai) _Pragma("unroll") for (int m = 0; m < 4; ++m)
#define EPI_ROW(u, wr, fr) ((u).pm * 256 + ai * 128 + (wr) * 64 + m * 16 + (fr))
#define EPI_COL(wc, fq) (bj * 128 + (wc) * 32 + (fq) * 8)

__device__ __forceinline__ int bsel_of_tile(int pm) { return pm < 64 ? (pm >> 3) : 8; }

struct RectSched {
  const char* A; const char* B; size_t a_tile, b_tile; int nM, nN, nt, G, c;
  __device__ __forceinline__ bool next(int i, Unit& u) const {
    const int L = i * G + c; if (L >= nM * nN) return false;
    int pm, pn; rect_map(L, nM, nN, pm, pn);
    u.pm = pm; u.pn = pn; u.kind = 0; u.nt = nt; u.A = A + (size_t)pm * a_tile; u.B = B + (size_t)pn * b_tile; return true;
  }
};
struct G1Sched {
  const char* A; const char* B; int G, c, last;
  __device__ __forceinline__ bool next(int i, Unit& u) const {
    const int L = i * G + c; const int nl = 64 * 9, ncx = last ? 24 : 72;
    if (L >= nl + ncx) return false;
    int pm, pn;
    if (L < nl) rect_map(L, 64, 9, pm, pn);
    else { const int q = L - nl; if (last) { pm = 64 + q / 3; const int s = q % 3; pn = s == 0 ? 0 : (s + 1); } else { pm = 64 + q / 9; pn = q % 9; } }
    u.pm = pm; u.pn = pn; u.kind = 0; u.nt = 16; u.A = A + (size_t)pm * (256 * 1024 * 2); u.B = B + (size_t)pn * (256 * 1024 * 2); return true;
  }
};
struct S5Sched {
  const char* A; const char* B; size_t b_group, b_tile; int nMs, nN, nt, G, c;
  __device__ __forceinline__ bool next(int i, Unit& u) const {
    const int L = i * G + c; if (L >= 16 * nMs * nN) return false;
    const int g = L / (nMs * nN), r = L % (nMs * nN), pm = r / nN, pn = r % nN;
    u.pm = pm; u.pn = pn; u.kind = g; u.nt = nt;
    u.A = A + ((size_t)g * XUR + (size_t)pm * 256) * XUK * 2; u.B = B + (size_t)g * b_group + (size_t)pn * b_tile; return true;
  }
};
struct MergeSched {
  const char* Abuf; const char* Y4; const char* Win; const char* Wbr; int ncx, G, c;
  __device__ __forceinline__ bool next(int i, Unit& u) const {
    const int nlat = (256 - c + G - 1) / G;
    int pm, pd, k, j;
    if (i < 8 * nlat) { const int su = (i >> 3) * G + c; j = i & 7; k = j >> 1; const int x = su & 7, sl = su >> 3; pd = sl & 3; pm = x * 8 + (sl >> 2); u.kind = j; }
    else { const int i2 = i - 8 * nlat; const int q = (i2 >> 1) * G + c; if (q >= ncx) return false; j = i2 & 1; const int x = q & 7, sl = q >> 3; k = sl & 3; pd = sl >> 2; pm = 64 + x; u.kind = 8 + 2 * k + j; }
    u.pm = pm; u.pn = pd;
    if (!(j & 1)) { u.nt = 16; u.A = Abuf + (size_t)pm * (256 * 1024 * 2); u.B = Win + (size_t)(2304 + k * 1024 + pd * 256) * (1024 * 2); }
    else { u.nt = 4; u.A = Y4 + (size_t)pm * (256 * 1024 * 2) + (size_t)k * 512; u.B = Wbr + (size_t)(pd * 256) * (1024 * 2) + (size_t)k * 512; }
    return true;
  }
};
struct WoutSched {
  const char* MIXb; const char* GPb; const char* B; int ncx, G, c;
  __device__ __forceinline__ bool next(int i, Unit& u) const {
    const int L = i * G + c;
    if (L < 256) { int pm, pn; rect_map(L, 64, 4, pm, pn); u.pm = pm; u.pn = pn; u.kind = 0; u.nt = 16; u.A = MIXb + (size_t)pm * (256 * 1024 * 2); u.B = B + (size_t)pn * (256 * 1024 * 2); return true; }
    const int q = L - 256; if (q >= ncx) return false;
    const int ks = q & 7, pn = (q >> 3) & 3, pmc = q >> 5;
    u.pm = 64 + pmc; u.pn = pn; u.kind = 1 + ks; u.nt = 8;
    u.A = GPb + ((size_t)(ks >> 1) * MC + (size_t)pmc * 256) * (1024 * 2) + (size_t)(ks & 1) * 1024; u.B = B + (size_t)pn * (256 * 1024 * 2) + (size_t)(ks & 1) * 1024; return true;
  }
};
struct SplitSched {
  const char* A; const char* B; const char* Ac; size_t a_tile, b_tile, ac_tile; int nt, nts, nlat, ncx, G, c;
  __device__ __forceinline__ bool next(int i, Unit& u) const {
    const int L = i * G + c;
    if (L < nlat) { int pm, pn; rect_map(L, 64, 4, pm, pn); u.pm = pm; u.pn = pn; u.kind = 0; u.nt = nt; u.A = A + (size_t)pm * a_tile; u.B = B + (size_t)pn * b_tile; return true; }
    const int q = L - nlat; if (q >= ncx) return false;
    const int ks = q & 7, pn = (q >> 3) & 3, pmc = q >> 5;
    u.pm = 64 + pmc; u.pn = pn; u.kind = 1 + ks; u.nt = nts;
    u.A = Ac + (size_t)pmc * ac_tile + (size_t)ks * nts * 128; u.B = B + (size_t)pn * b_tile + (size_t)ks * nts * 128; return true;
  }
};

struct EpiG1 {
  bf16_t* PS; bf16_t* XU; bf16_t* VT; bf16_t* KT;
  __device__ __forceinline__ void operator()(const Acc& acc, const Unit& u, int wr, int wc, int fr, int fq) const {
    if (u.pn == 3) {
      const int voff = (wc >> 1) * (288 * 512) + ((wc & 1) * 32 + fq * 8) * 8;
      EPI_ROWS(u, wr, fr) {
        const int row = EPI_ROW(u, wr, fr);
        int b, tok; if (row < ML) { b = row >> 11; tok = row & 2047; } else { const int r2 = row - ML; b = r2 >> 8; tok = 2048 + (r2 & 255); }
        bf16_t* rb = VT + ((size_t)(b * 4) * 288 + (tok >> 3)) * 512 + (tok & 7) + voff;
#pragma unroll
        for (int bj = 0; bj < 2; ++bj) {
          const u32x4 pk = pack8(acc[ai][bj][m][0], acc[ai][bj][m][1]);
          bf16_t* base = rb + bj * (2 * 288 * 512);
#pragma unroll
          for (int i = 0; i < 4; ++i) { base[(2 * i) * 8] = (bf16_t)(pk[i] & 0xffffu); base[(2 * i + 1) * 8] = (bf16_t)(pk[i] >> 16); }
        }
      }
      return;
    }
    EPI_ROWS(u, wr, fr) {
      const int row = EPI_ROW(u, wr, fr);
#pragma unroll
      for (int bj = 0; bj < 2; ++bj) {
        const int c = EPI_COL(wc, fq);
        const u32x4 pk = pack8(acc[ai][bj][m][0], acc[ai][bj][m][1]);
        if (u.pn == 0) {
          const int g = c >> 4, h0 = c & 15;
          *(u32x4*)(XU + ((size_t)(g * XUR + (row >> 5)) * XUK + (row & 31) * 16 + h0)) = pk;
        } else if (u.pn == 2) {
          int b, tok; if (row < ML) { b = row >> 11; tok = row & 2047; } else { const int r2 = row - ML; b = r2 >> 8; tok = 2048 + (r2 & 255); }
          *(u32x4*)(KT + (((size_t)(b * 4 + (c >> 6)) * 2304 + tok) * 64 + (c & 63))) = pk;
        } else {
          *(u32x4*)(PS + (size_t)row * 2304 + u.pn * 256 + c) = pk;
        }
      }
    }
  }
};
struct EpiS1 {
  float* S;
  __device__ __forceinline__ void operator()(const Acc& acc, const Unit& u, int wr, int wc, int fr, int fq) const {
    EPI_ROWS(u, wr, fr) {
      const int row = EPI_ROW(u, wr, fr);
      if (row < NCHUNK) {
#pragma unroll
        for (int bj = 0; bj < 2; ++bj) {
          const int c = EPI_COL(wc, fq);
          float* dst = S + ((size_t)u.kind * NCHUNK + row) * 256 + c;
          *(f32x4*)dst = acc[ai][bj][m][0]; *(f32x4*)(dst + 4) = acc[ai][bj][m][1];
        }
      }
    }
  }
};
struct EpiS2 {
  bf16_t* YG; int rowlim;
  __device__ __forceinline__ void operator()(const Acc& acc, const Unit& u, int wr, int wc, int fr, int fq) const {
    EPI_ROWS(u, wr, fr) {
      const int row = EPI_ROW(u, wr, fr);
      if (row < rowlim) {
#pragma unroll
        for (int bj = 0; bj < 2; ++bj) {
          const int col = u.pn * 256 + EPI_COL(wc, fq);
          const int t = col >> 4, h0 = col & 15;
          f32x4 a = acc[ai][bj][m][0], b = acc[ai][bj][m][1];
#pragma unroll
          for (int i = 0; i < 4; ++i) { a[i] = gelu_tanh(a[i]); b[i] = gelu_tanh(b[i]); }
          *(u32x4*)(YG + ((size_t)(row * TCH + t)) * 256 + u.kind * 16 + h0) = pack8(a, b);
        }
      }
    }
  }
};
struct EpiGLU {
  const bf16_t* YG; const float* bias; bf16_t* Y4;
  __device__ __forceinline__ void operator()(const Acc& acc, const Unit& u, int wr, int wc, int fr, int fq) const {
    EPI_ROWS(u, wr, fr) {
      const int row = EPI_ROW(u, wr, fr);
#pragma unroll
      for (int bj = 0; bj < 2; ++bj) {
        const int c = EPI_COL(wc, fq);
        const u32x4 gv = *(const u32x4*)(YG + (size_t)row * 256 + c);
        const f32x4 b0 = *(const f32x4*)(bias + c), b1 = *(const f32x4*)(bias + c + 4);
        f32x4 a = acc[ai][bj][m][0] + b0, b = acc[ai][bj][m][1] + b1;
        a[0] = bflo(gv[0]) * sigm(a[0]); a[1] = bfhi(gv[0]) * sigm(a[1]); a[2] = bflo(gv[1]) * sigm(a[2]); a[3] = bfhi(gv[1]) * sigm(a[3]);
        b[0] = bflo(gv[2]) * sigm(b[0]); b[1] = bfhi(gv[2]) * sigm(b[1]); b[2] = bflo(gv[3]) * sigm(b[2]); b[3] = bfhi(gv[3]) * sigm(b[3]);
        *(u32x4*)(Y4 + (size_t)row * 1024 + c) = pack8(a, b);
      }
    }
  }
};
struct EpiMerge {
  unsigned char* GS; bf16_t* TMP; bf16_t* MIX; bf16_t* GP;
  __device__ __forceinline__ void operator()(const Acc& acc, const Unit& u, int wr, int wc, int fr, int fq) const {
    const int tid = otid(); const int j = u.kind, k = j >> 1;
    EPI_ROWS(u, wr, fr) {
#pragma unroll
      for (int bj = 0; bj < 2; ++bj) {
        const int e = (ai * 4 + m) * 2 + bj;
        unsigned char* gs = GS + ((size_t)e * 512 + tid) * 8;
        bf16_t* tp = TMP + ((size_t)e * 512 + tid) * 8;
        if (!(j & 1)) {
          const f32x4 a = acc[ai][bj][m][0], b = acc[ai][bj][m][1];
          u32x2 q;
          q[0] = (unsigned)(sigm(a[0]) * 255.f + 0.5f) | ((unsigned)(sigm(a[1]) * 255.f + 0.5f) << 8) | ((unsigned)(sigm(a[2]) * 255.f + 0.5f) << 16) | ((unsigned)(sigm(a[3]) * 255.f + 0.5f) << 24);
          q[1] = (unsigned)(sigm(b[0]) * 255.f + 0.5f) | ((unsigned)(sigm(b[1]) * 255.f + 0.5f) << 8) | ((unsigned)(sigm(b[2]) * 255.f + 0.5f) << 16) | ((unsigned)(sigm(b[3]) * 255.f + 0.5f) << 24);
          *(u32x2*)gs = q;
        } else {
          const u32x2 q = *(const u32x2*)gs;
          f32x4 a = acc[ai][bj][m][0], b = acc[ai][bj][m][1];
          const float sc = 1.f / 255.f;
#pragma unroll
          for (int i = 0; i < 4; ++i) { a[i] *= (float)((q[0] >> (8 * i)) & 255u) * sc; b[i] *= (float)((q[1] >> (8 * i)) & 255u) * sc; }
          if (j >= 8) {
            const int row = EPI_ROW(u, wr, fr) - ML; const int c = u.pn * 256 + EPI_COL(wc, fq);
            *(u32x4*)(GP + ((size_t)(k - 4) * MC + row) * 1024 + c) = pack8(a, b);
          } else {
            if (k > 0) { const u32x4 t = *(const u32x4*)tp; a[0] += bflo(t[0]); a[1] += bfhi(t[0]); a[2] += bflo(t[1]); a[3] += bfhi(t[1]); b[0] += bflo(t[2]); b[1] += bfhi(t[2]); b[2] += bflo(t[3]); b[3] += bfhi(t[3]); }
            if (k < 3) *(u32x4*)tp = pack8(a, b);
            else { const int row = EPI_ROW(u, wr, fr); const int c = u.pn * 256 + EPI_COL(wc, fq); *(u32x4*)(MIX + (size_t)row * 1024 + c) = pack8(a, b); }
          }
        }
      }
    }
  }
};
struct EpiRes {
  const float* hL; const float* hC; float* H; const float* modbase; int modidx; float* PART;
  __device__ __forceinline__ void operator()(const Acc& acc, const Unit& u, int wr, int wc, int fr, int fq) const {
    if (u.kind) {
      float* pb = PART + (size_t)(u.kind - 1) * MC * 1024;
      EPI_ROWS(u, wr, fr) {
        const int row = EPI_ROW(u, wr, fr) - ML;
#pragma unroll
        for (int bj = 0; bj < 2; ++bj) {
          const int c = u.pn * 256 + EPI_COL(wc, fq);
          float* d = pb + (size_t)row * 1024 + c;
          *(f32x4*)d = acc[ai][bj][m][0]; *(f32x4*)(d + 4) = acc[ai][bj][m][1];
        }
      }
      return;
    }
    const float* mv = modbase + (size_t)bsel_of_tile(u.pm) * 6144 + modidx * 1024;
    EPI_ROWS(u, wr, fr) {
      const int row = EPI_ROW(u, wr, fr);
      const float* hs = row < ML ? hL + (size_t)row * 1024 : hC + (size_t)(row - ML) * 1024;
#pragma unroll
      for (int bj = 0; bj < 2; ++bj) {
        const int c = u.pn * 256 + EPI_COL(wc, fq);
        const f32x4 h0 = *(const f32x4*)(hs + c), h1 = *(const f32x4*)(hs + c + 4);
        const f32x4 m0 = *(const f32x4*)(mv + c), m1 = *(const f32x4*)(mv + c + 4);
        float* hd = H + (size_t)row * 1024 + c;
        *(f32x4*)hd = h0 + m0 * acc[ai][bj][m][0]; *(f32x4*)(hd + 4) = h1 + m1 * acc[ai][bj][m][1];
      }
    }
  }
};
struct EpiFF1 {
  bf16_t* FFH;
  __device__ __forceinline__ void operator()(const Acc& acc, const Unit& u, int wr, int wc, int fr, int fq) const {
    EPI_ROWS(u, wr, fr) {
      const int row = EPI_ROW(u, wr, fr);
#pragma unroll
      for (int bj = 0; bj < 2; ++bj) {
        const int c = u.pn * 256 + EPI_COL(wc, fq);
        f32x4 a = acc[ai][bj][m][0], b = acc[ai][bj][m][1];
#pragma unroll
        for (int i = 0; i < 4; ++i) { a[i] = fmaxf(a[i], 0.f); a[i] *= a[i]; b[i] = fmaxf(b[i], 0.f); b[i] *= b[i]; }
        *(u32x4*)(FFH + (size_t)row * 4096 + c) = pack8(a, b);
      }
    }
  }
};

__device__ void mod_task(const P& p, int task, float* lds) {
  const int tid = otid();
  float* sc = lds;
  float* red = lds + 9 * 1024;
  for (int i = tid; i < 9 * 1024; i += 512) { const float v = i < 8192 ? p.c[i] : p.c_ctx[i - 8192]; sc[i] = v * sigm(v); }
  __syncthreads();
  const int l = task / 48, jb = task % 48, jl = tid & 127, ks = tid >> 7, j = jb * 128 + jl;
  float a[9];
#pragma unroll
  for (int s = 0; s < 9; ++s) a[s] = 0.f;
  const float* w = p.ada_w + (size_t)l * 1024 * 6144 + j;
#pragma unroll 8
  for (int k = ks * 256; k < ks * 256 + 256; ++k) {
    const float wv = w[(size_t)k * 6144];
#pragma unroll
    for (int s = 0; s < 9; ++s) a[s] += sc[s * 1024 + k] * wv;
  }
#pragma unroll
  for (int s = 0; s < 9; ++s) red[(ks * 9 + s) * 128 + jl] = a[s];
  __syncthreads();
  float* MOD = (float*)(p.ws + OFF_MOD);
  for (int i = tid; i < 9 * 128; i += 512) {
    const int s = i >> 7, jj = i & 127;
    const float v = red[(0 * 9 + s) * 128 + jj] + red[(1 * 9 + s) * 128 + jj] + red[(2 * 9 + s) * 128 + jj] + red[(3 * 9 + s) * 128 + jj];
    MOD[((size_t)l * 9 + s) * 6144 + jb * 128 + jj] = v + p.ada_b[l * 6144 + jb * 128 + jj];
  }
  __syncthreads();
}

__device__ void tr_tile(const float* src, int lds_, bf16_t* dst, int ldd, float* tile  ) {
  const int tid = otid();
#pragma unroll
  for (int ps = 0; ps < 2; ++ps) {
    const int k = (tid >> 4) + ps * 32, n4 = (tid & 15) * 4;
    const f32x4 v = *(const f32x4*)(src + (size_t)k * lds_ + n4);
    tile[k * 65 + n4] = v[0]; tile[k * 65 + n4 + 1] = v[1]; tile[k * 65 + n4 + 2] = v[2]; tile[k * 65 + n4 + 3] = v[3];
  }
  __syncthreads();
  {
    const int n = tid >> 3, k8 = (tid & 7) * 8;
    u32x4 o;
#pragma unroll
    for (int i = 0; i < 4; ++i) o[i] = cvt_pk_bf16(tile[(k8 + 2 * i) * 65 + n], tile[(k8 + 2 * i + 1) * 65 + n]);
    *(u32x4*)(dst + (size_t)n * ldd + k8) = o;
  }
  __syncthreads();
}

struct cpx { float re, im; };
__device__ __forceinline__ cpx cmul(cpx a, cpx b) { return {a.re * b.re - a.im * b.im, a.re * b.im + a.im * b.re}; }
template <bool FAST>
__device__ __forceinline__ cpx s5_apow(float lre, float lim, float dt, float e) {
  const float zr = lre * dt * e, zi = lim * dt * e;
  if (FAST) { const float mg = __expf(zr); return {mg * __cosf(zi), mg * __sinf(zi)}; }
  const float mg = expf(zr); float sn, cs; sincosf(zi, &sn, &cs); return {mg * cs, mg * sn};
}
template <bool FAST>
__device__ __forceinline__ cpx s5_coef(float lre, float lim, float dt) {
  const cpx a = s5_apow<FAST>(lre, lim, dt, 1.f); const float nr = a.re - 1.f, ni = a.im, den = lre * lre + lim * lim;
  return {(nr * lre + ni * lim) / den, (ni * lre - nr * lim) / den};
}

constexpr int NT_WIN = 1600, NT_FF1 = 1024, NT_FF2 = 1024, NT_OUT = 256, NT_BR = 256, NT_GLU = 16;
constexpr int NT_TR = NT_WIN + NT_FF1 + NT_FF2 + NT_OUT + NT_BR + NT_GLU;
constexpr int NT_TOEP = 512, NT_W2S = 256, NT_W1 = 128, NT_SGUW = 16;
constexpr int NT_PREP = NT_TR + NT_TOEP + NT_W2S + NT_W1 + NT_SGUW;

__device__ void prep_task(const P& p, int l, int task, float* lds) {
  const int tid = otid();
  unsigned char* ws = p.ws;
  if (task < NT_TR) {
    const float* src; bf16_t* dst; int N, ldd, tk, tn;
    int t = task;
    if (t < NT_WIN) { src = p.w_in + (size_t)l * 1024 * 6400; N = 6400; dst = (bf16_t*)(ws + OFF_WIN); ldd = 1024; tk = t / 100; tn = t % 100; }
    else if ((t -= NT_WIN) < NT_FF1) { src = p.w_ff1 + (size_t)l * 1024 * 4096; N = 4096; dst = (bf16_t*)(ws + OFF_WFF1); ldd = 1024; tk = t / 64; tn = t % 64; }
    else if ((t -= NT_FF1) < NT_FF2) { src = p.w_ff2 + (size_t)l * 4096 * 1024; N = 1024; dst = (bf16_t*)(ws + OFF_WFF2); ldd = 4096; tk = t / 16; tn = t % 16; }
    else if ((t -= NT_FF2) < NT_OUT) { src = p.w_out + (size_t)l * 1024 * 1024; N = 1024; dst = (bf16_t*)(ws + OFF_WOUT); ldd = 1024; tk = t / 16; tn = t % 16; }
    else if ((t -= NT_OUT) < NT_BR) { const int k = t >> 6; t &= 63; src = p.w_branch + ((size_t)l * 4 + k) * 256 * 1024; N = 1024; dst = (bf16_t*)(ws + OFF_WBR) + k * 256; ldd = 1024; tk = t / 16; tn = t % 16; }
    else { t -= NT_BR; src = p.glu_w + (size_t)l * 256 * 256; N = 256; dst = (bf16_t*)(ws + OFF_WGLU); ldd = 256; tk = t / 4; tn = t % 4; }
    tr_tile(src + (size_t)tk * 64 * N + tn * 64, N, dst + (size_t)tn * 64 * ldd + tk * 64, ldd, lds);
    return;
  }
  task -= NT_TR;
  bf16_t* W2 = (bf16_t*)(ws + OFF_W2);
  bf16_t* W1 = (bf16_t*)(ws + OFF_W1);
  if (task < NT_TOEP) {
    const int g = task >> 5, lag = task & 31;
    cpx* E = (cpx*)lds;
    float* sC = lds + 256;
    float* sB = sC + 4096;
    if (tid < 128) {
      const int d = tid >> 6, pp = tid & 63; const int li = ((l * 2 + d) * 16 + g);
      const float dt = expf(p.log_dt[li]); const float lre = p.lam_re[li * 64 + pp], lim = p.lam_im[li * 64 + pp];
      E[tid] = cmul(s5_apow<true>(lre, lim, dt, (float)lag), s5_coef<false>(lre, lim, dt));
    }
    for (int i = tid; i < 4096; i += 512) {
      const int d = i >> 11, ri = (i >> 10) & 1, r = i & 1023; const int li = ((l * 2 + d) * 16 + g);
      sC[i] = (ri ? p.c_im : p.c_re)[(size_t)li * 1024 + r];
      sB[i] = (ri ? p.b_im : p.b_re)[(size_t)li * 1024 + r];
    }
    __syncthreads();
    if (tid < 256) {
      const int hp = tid >> 4, h = tid & 15;
      float kv[2];
#pragma unroll
      for (int d = 0; d < 2; ++d) {
        const float* cre = sC + d * 2048 + hp * 64; const float* cim = cre + 1024;
        const float* bre = sB + d * 2048 + h; const float* bim = bre + 1024;
        float s = 0.f;
#pragma unroll 8
        for (int pp = 0; pp < 64; ++pp) {
          const cpx bb = cmul(E[d * 64 + pp], (cpx){bre[pp * 16], bim[pp * 16]});
          s += cre[pp] * bb.re - cim[pp] * bb.im;
        }
        kv[d] = s;
      }
      bf16_t* Wg = W2 + (size_t)g * 512 * 768;
      if (lag == 0) {
        const float v = kv[0] + kv[1] + (hp == h ? p.s5_d[l * 256 + g * 16 + h] : 0.f);
        const bf16_t bv = (bf16_t)(cvt_pk_bf16(v, 0.f) & 0xffffu);
        for (int t = 0; t < TCH; ++t) Wg[(size_t)(t * 16 + hp) * 768 + t * 16 + h] = bv;
      } else {
        const unsigned pk = cvt_pk_bf16(kv[0], kv[1]);
        const bf16_t v0 = (bf16_t)(pk & 0xffffu), v1 = (bf16_t)(pk >> 16);
        for (int jj = 0; jj + lag < TCH; ++jj) {
          const int t = jj + lag;
          Wg[(size_t)(t * 16 + hp) * 768 + jj * 16 + h] = v0;
          Wg[(size_t)(jj * 16 + hp) * 768 + t * 16 + h] = v1;
        }
      }
    }
    __syncthreads();
    return;
  }
  task -= NT_TOEP;
  if (task < NT_W2S) {
    for (int it = 0; it < 8; ++it) {
      const int idx = (task * 8 + it) * 512 + tid;
      const int pp = idx & 63, d = (idx >> 6) & 1, hp = (idx >> 7) & 15, t = (idx >> 11) & 31, g = idx >> 16;
      const int li = ((l * 2 + d) * 16 + g);
      const float dt = expf(p.log_dt[li]); const float lre = p.lam_re[li * 64 + pp], lim = p.lam_im[li * 64 + pp];
      const cpx ap = s5_apow<true>(lre, lim, dt, d == 0 ? (float)(t + 1) : (float)(TCH - t));
      const cpx cc = {p.c_re[((size_t)li * 16 + hp) * 64 + pp], p.c_im[((size_t)li * 16 + hp) * 64 + pp]};
      const cpx v = cmul(cc, ap);
      *(unsigned*)(W2 + ((size_t)g * 512 + t * 16 + hp) * 768 + 512 + d * 128 + 2 * pp) = cvt_pk_bf16(v.re, -v.im);
    }
    return;
  }
  task -= NT_W2S;
  if (task < NT_W1) {
    const int idx = task * 512 + tid;
    const int j = idx & 31, pp = (idx >> 5) & 63, d = (idx >> 11) & 1, g = idx >> 12;
    const int li = ((l * 2 + d) * 16 + g);
    const float dt = expf(p.log_dt[li]); const float lre = p.lam_re[li * 64 + pp], lim = p.lam_im[li * 64 + pp];
    const cpx e = cmul(s5_apow<true>(lre, lim, dt, d == 0 ? (float)(TCH - 1 - j) : (float)j), s5_coef<false>(lre, lim, dt));
    const float* bre = p.b_re + ((size_t)li * 64 + pp) * 16; const float* bim = p.b_im + ((size_t)li * 64 + pp) * 16;
    bf16_t* r0 = W1 + ((size_t)g * 256 + d * 128 + 2 * pp) * 512 + j * 16;
    bf16_t* r1 = r0 + 512;
#pragma unroll
    for (int h = 0; h < 16; h += 2) {
      const cpx v0 = cmul(e, (cpx){bre[h], bim[h]}), v1 = cmul(e, (cpx){bre[h + 1], bim[h + 1]});
      *(unsigned*)(r0 + h) = cvt_pk_bf16(v0.re, v1.re); *(unsigned*)(r1 + h) = cvt_pk_bf16(v0.im, v1.im);
    }
    return;
  }
  task -= NT_W1;
  {
    bf16_t* W16 = (bf16_t*)(ws + OFF_SGUWT);
    for (int it = 0; it < 4; ++it) {
      const int idx = ((task * 4 + it) * 512 + tid) * 2;
      const float* sp = p.sgu_w + (size_t)l * 65536 + idx;
      *(unsigned*)(W16 + idx) = cvt_pk_bf16(sp[0], sp[1]);
    }
  }
}


__device__ __forceinline__ bool filler_range(int wg, int G, int first, int& start, int& stride) {
  if (G > first) { if (wg < first) return false; start = wg - first; stride = G - first; return true; }
  start = wg; stride = G; return true;
}
constexpr int PT_WIN0 = 0, PT_FF0 = NT_WIN, PT_WBR0 = NT_WIN + NT_FF1 + NT_FF2 + NT_OUT, PT_G10 = PT_WBR0 + NT_BR;
constexpr int PT_NMID = NT_FF1 + NT_FF2 + NT_OUT, PT_NG1 = NT_PREP - PT_G10;

__device__ void norm_rows(const P& p, const float* hL, const float* hC, const float* gvec, const float* modbase, int shift_idx, int nrows, const float* resmod  ) {
  const int tid = otid(); const int lane = tid & 63, wid = tid >> 6;
  bf16_t* A = (bf16_t*)(p.ws + OFF_A);
  for (int row = blockIdx.x * 8 + wid; row < nrows; row += gridDim.x * 8) {
    const float* h = row < ML ? hL + (size_t)row * 1024 : hC + (size_t)(row - ML) * 1024;
    const int bsel = row < ML ? (row >> 11) : 8;
    const float* sh = modbase + (size_t)bsel * 6144 + shift_idx * 1024; const float* sc = sh + 1024;
    f32x4 v[4]; float ss = 0.f;
#pragma unroll
    for (int i = 0; i < 4; ++i) v[i] = *(const f32x4*)(h + i * 256 + lane * 4);
    if (resmod && row >= ML) {
      const float* pr = (const float*)(p.ws + OFF_PART) + (size_t)(row - ML) * 1024;
      float* hw = (float*)(p.ws + OFF_H) + (size_t)row * 1024;
#pragma unroll
      for (int i = 0; i < 4; ++i) {
        const int c = i * 256 + lane * 4;
        f32x4 sm = *(const f32x4*)(pr + c);
#pragma unroll
        for (int sl = 1; sl < 8; ++sl) sm += *(const f32x4*)(pr + (size_t)sl * MC * 1024 + c);
        v[i] += *(const f32x4*)(resmod + c) * sm;
        *(f32x4*)(hw + c) = v[i];
      }
    }
#pragma unroll
    for (int i = 0; i < 4; ++i) ss += v[i][0] * v[i][0] + v[i][1] * v[i][1] + v[i][2] * v[i][2] + v[i][3] * v[i][3];
    ss = wave_sum(ss, lane);
    const float rstd = rsqrtf(ss * (1.f / 1024.f) + 1e-6f);
#pragma unroll
    for (int i = 0; i < 4; ++i) {
      const int c = i * 256 + lane * 4;
      const f32x4 g = *(const f32x4*)(gvec + c), s1 = *(const f32x4*)(sc + c), s0 = *(const f32x4*)(sh + c);
      f32x4 y;
#pragma unroll
      for (int q = 0; q < 4; ++q) y[q] = (v[i][q] * rstd * g[q]) * (1.f + s1[q]) + s0[q];
      u32x2 o; o[0] = cvt_pk_bf16(y[0], y[1]); o[1] = cvt_pk_bf16(y[2], y[3]);
      *(u32x2*)(A + (size_t)row * 1024 + c) = o;
    }
  }
}

__device__ void final_rows(const P& p) {
  const int tid = otid(); const int lane = tid & 63, wid = tid >> 6;
  const float* H = (const float*)(p.ws + OFF_H);
  for (int row = blockIdx.x * 8 + wid; row < ML; row += gridDim.x * 8) {
    const float* h = H + (size_t)row * 1024;
    f32x4 v[4]; float ss = 0.f;
#pragma unroll
    for (int i = 0; i < 4; ++i) { v[i] = *(const f32x4*)(h + i * 256 + lane * 4); ss += v[i][0] * v[i][0] + v[i][1] * v[i][1] + v[i][2] * v[i][2] + v[i][3] * v[i][3]; }
    ss = wave_sum(ss, lane);
    const float rstd = rsqrtf(ss * (1.f / 1024.f) + 1e-6f);
#pragma unroll
    for (int i = 0; i < 4; ++i) {
      const int c = i * 256 + lane * 4;
      const f32x4 g = *(const f32x4*)(p.final_g + c);
      f32x4 y;
#pragma unroll
      for (int q = 0; q < 4; ++q) y[q] = v[i][q] * rstd * g[q];
      *(f32x4*)(p.out + (size_t)row * 1024 + c) = y;
    }
  }
}

template <bool LAT>
__device__ __forceinline__ void attn_task(const P& p, int task, int l, const float* rpb_lds, int lane) {
  constexpr int NG = LAT ? 16 : 8;
  const bf16_t* PS = (const bf16_t*)(p.ws + OFF_PS);
  const bf16_t* VT = (const bf16_t*)(p.ws + OFF_VT);
  const bf16_t* KT = (const bf16_t*)(p.ws + OFF_KT);
  bf16_t* Y4 = (bf16_t*)(p.ws + OFF_Y4);
  int b, head, r = 0, jb = 0, qrow0;
  if (LAT) { jb = task & 3; r = (task >> 2) & 31; head = (task >> 7) & 3; b = task >> 9; qrow0 = b * 2048 + r * 64 + jb * 16; }
  else { const int qb = task & 15; head = (task >> 4) & 3; b = task >> 6; qrow0 = ML + b * 256 + qb * 16; }
  const int n = lane & 15, kg = lane >> 4;
  const bf16_t* qp = PS + (size_t)(qrow0 + n) * 2304 + 256 + head * 64 + kg * 8;
  const bf16x8 q0 = *(const bf16x8*)qp, q1 = *(const bf16x8*)(qp + 32);
  const int rs = LAT ? min(max(r - 4, 0), 24) : 0;
  const int clo = LAT ? (jb == 0 ? 0 : jb == 1 ? 8 : jb == 2 ? 24 : 32) : 0;
  const int keyX = 8 * (n >> 2) + (n & 3);
  f32x4 s[NG][2];
#pragma unroll
  for (int gb = 0; gb < NG; gb += 4) {
    bf16x8 kf[4][4];
#pragma unroll
    for (int g4 = 0; g4 < 4; ++g4) {
      const int gi = gb + g4;
      int tk0;
      if (LAT && gi < 8) tk0 = (rs + gi) * 64 + clo; else tk0 = 2048 + (gi - (LAT ? 8 : 0)) * 32;
      const bf16_t* kp = KT + ((size_t)(b * 4 + head) * 2304 + tk0 + keyX) * 64 + kg * 8;
      kf[g4][0] = *(const bf16x8*)kp; kf[g4][1] = *(const bf16x8*)(kp + 32);
      kf[g4][2] = *(const bf16x8*)(kp + 4 * 64); kf[g4][3] = *(const bf16x8*)(kp + 4 * 64 + 32);
    }
    __builtin_amdgcn_sched_barrier(0);
#pragma unroll
    for (int g4 = 0; g4 < 4; ++g4) {
      const int gi = gb + g4;
      f32x4 z = {0.f, 0.f, 0.f, 0.f};
      s[gi][0] = __builtin_amdgcn_mfma_f32_16x16x32_bf16(kf[g4][0], q0, z, 0, 0, 0);
      s[gi][0] = __builtin_amdgcn_mfma_f32_16x16x32_bf16(kf[g4][1], q1, s[gi][0], 0, 0, 0);
      s[gi][1] = __builtin_amdgcn_mfma_f32_16x16x32_bf16(kf[g4][2], q0, z, 0, 0, 0);
      s[gi][1] = __builtin_amdgcn_mfma_f32_16x16x32_bf16(kf[g4][3], q1, s[gi][1], 0, 0, 0);
    }
    __builtin_amdgcn_sched_barrier(0);
  }
  float mx = -3.0e38f;
  const int jq = jb * 16 + n; const int cs = min(max(jq - 8, 0), 48);
#pragma unroll
  for (int gi = 0; gi < NG; ++gi)
#pragma unroll
    for (int blk = 0; blk < 2; ++blk)
#pragma unroll
      for (int i = 0; i < 4; ++i) {
        float v = s[gi][blk][i] * 0.125f;
        if (LAT && gi < 8) {
          const int kc = clo + 8 * kg + blk * 4 + i;
          const bool ok = (kc >= cs) && (kc < cs + 16);
          const int dr = rs + gi - r + 7; const int dc = min(max(kc - jq + 15, 0), 30);
          const float bias = rpb_lds[(head * 15 + dr) * 31 + dc];
          v = ok ? v + bias : -1.0e30f;
        }
        s[gi][blk][i] = v; mx = fmaxf(mx, v);
      }
  mx = fmaxf(mx, shx(mx, 16, lane)); mx = fmaxf(mx, shx(mx, 32, lane));
  float sum = 0.f;
#pragma unroll
  for (int gi = 0; gi < NG; ++gi)
#pragma unroll
    for (int blk = 0; blk < 2; ++blk)
#pragma unroll
      for (int i = 0; i < 4; ++i) { const float e = __expf(s[gi][blk][i] - mx); s[gi][blk][i] = e; sum += e; }
  sum += shx(sum, 16, lane); sum += shx(sum, 32, lane);
  f32x4 o[4];
#pragma unroll
  for (int db = 0; db < 4; ++db) o[db] = (f32x4){0.f, 0.f, 0.f, 0.f};
  const bf16_t* vbase = VT + ((size_t)(b * 4 + head) * 288 + kg) * 512 + n * 8;
#pragma unroll
  for (int gb = 0; gb < NG; gb += 2) {
    bf16x8 vf[2][4];
#pragma unroll
    for (int g4 = 0; g4 < 2; ++g4) {
      const int gi = gb + g4;
      int tok0;
      if (LAT && gi < 8) tok0 = (rs + gi) * 64 + clo; else tok0 = 2048 + (gi - (LAT ? 8 : 0)) * 32;
#pragma unroll
      for (int db = 0; db < 4; ++db) vf[g4][db] = *(const bf16x8*)(vbase + (size_t)(tok0 >> 3) * 512 + db * 128);
    }
    __builtin_amdgcn_sched_barrier(0);
#pragma unroll
    for (int g4 = 0; g4 < 2; ++g4) {
      const int gi = gb + g4;
      const u32x4 pk = pack8(s[gi][0], s[gi][1]);
      bf16x8 pf; __builtin_memcpy(&pf, &pk, 16);
#pragma unroll
      for (int db = 0; db < 4; ++db) o[db] = __builtin_amdgcn_mfma_f32_16x16x32_bf16(vf[g4][db], pf, o[db], 0, 0, 0);
    }
    __builtin_amdgcn_sched_barrier(0);
  }
  const float inv = 1.f / sum;
  bf16_t* op = Y4 + (size_t)(qrow0 + n) * 1024 + 256 + head * 64 + kg * 4;
#pragma unroll
  for (int db = 0; db < 4; ++db) {
    u32x2 w; w[0] = cvt_pk_bf16(o[db][0] * inv, o[db][1] * inv); w[1] = cvt_pk_bf16(o[db][2] * inv, o[db][3] * inv);
    *(u32x2*)(op + db * 16) = w;
  }
}

__device__ __forceinline__ void conv_task(const P& p, int l, int task) {
  const bf16_t* PS = (const bf16_t*)(p.ws + OFF_PS);
  bf16_t* Y4 = (bf16_t*)(p.ws + OFF_Y4);
  const int idx = task * 512 + otid();
  const int row = idx >> 5, c0 = (idx & 31) * 8;
  int pos, len; if (row < ML) { pos = row & 2047; len = 2048; } else { pos = (row - ML) & 255; len = 256; }
  const bf16_t* base = PS + (size_t)row * 2304;
  float z[3][8];
#pragma unroll
  for (int d = 0; d < 3; ++d) {
    const int pp = pos + d - 1;
    if (pp >= 0 && pp < len) {
      const u32x4 cv = *(const u32x4*)(base + (d - 1) * 2304 + 5 * 256 + c0), xv = *(const u32x4*)(base + (d - 1) * 2304 + 6 * 256 + c0);
#pragma unroll
      for (int i = 0; i < 4; ++i) { z[d][2 * i] = bflo(cv[i]) * bflo(xv[i]); z[d][2 * i + 1] = bfhi(cv[i]) * bfhi(xv[i]); }
    } else {
#pragma unroll
      for (int i = 0; i < 8; ++i) z[d][i] = 0.f;
    }
  }
  const u32x4 bv = *(const u32x4*)(base + 4 * 256 + c0);
  const float* w = p.conv_w + (size_t)l * 3 * 256 + c0;
  float y[8];
#pragma unroll
  for (int i = 0; i < 8; ++i) y[i] = w[i] * z[0][i] + w[256 + i] * z[1][i] + w[512 + i] * z[2][i];
  u32x4 o;
#pragma unroll
  for (int i = 0; i < 4; ++i) o[i] = cvt_pk_bf16(bflo(bv[i]) * y[2 * i], bfhi(bv[i]) * y[2 * i + 1]);
  *(u32x4*)(Y4 + (size_t)row * 1024 + 512 + c0) = o;
}

__device__ void sgu_task(const P& p, int l, int task, float* lds) {
  const int tid = otid();
  const bf16_t* PS = (const bf16_t*)(p.ws + OFF_PS);
  bf16_t* Y4 = (bf16_t*)(p.ws + OFF_Y4);
  const bf16_t* W16 = (const bf16_t*)(p.ws + OFF_SGUWT);
  const int chunk = task >> 2, g = task & 3;
  bf16_t* vnT = (bf16_t*)lds;
  constexpr int VS = 136;
  {
    const int s = tid >> 2, q = tid & 3;
    const bf16_t* vr = PS + (size_t)(chunk * 128 + s) * 2304 + 8 * 256;
    float sm = 0.f, sq = 0.f;
#pragma unroll
    for (int i = 0; i < 8; ++i) {
      const u32x4 v = *(const u32x4*)(vr + q * 64 + i * 8);
#pragma unroll
      for (int k = 0; k < 4; ++k) { const float a = bflo(v[k]), b = bfhi(v[k]); sm += a + b; sq += a * a + b * b; }
    }
    { const int ln = tid & 63; sm += shx(sm, 1, ln); sm += shx(sm, 2, ln); sq += shx(sq, 1, ln); sq += shx(sq, 2, ln); }
    const float mu = sm * (1.f / 256.f); const float var = fmaxf(sq * (1.f / 256.f) - mu * mu, 0.f); const float rstd = rsqrtf(var + 1e-6f);
    const int cb = g * 64 + q * 16;
    const float* lg = p.ln_g + l * 256 + cb; const float* lb = p.ln_b + l * 256 + cb;
#pragma unroll
    for (int i = 0; i < 2; ++i) {
      const u32x4 v = *(const u32x4*)(vr + cb + i * 8);
#pragma unroll
      for (int k = 0; k < 4; ++k) {
        const int cc = i * 8 + 2 * k;
        const unsigned pk = cvt_pk_bf16((bflo(v[k]) - mu) * rstd * lg[cc] + lb[cc], (bfhi(v[k]) - mu) * rstd * lg[cc + 1] + lb[cc + 1]);
        vnT[(q * 16 + cc) * VS + s] = (bf16_t)(pk & 0xffffu);
        vnT[(q * 16 + cc + 1) * VS + s] = (bf16_t)(pk >> 16);
      }
    }
  }
  __syncthreads();
  const int lane = tid & 63, w = tid >> 6, n = lane & 15, kg = lane >> 4;
  const int t = w * 16 + n;
  const bf16_t* wp = W16 + ((size_t)(g * 128 + t)) * 128 + kg * 8;
  bf16x8 wf[4];
#pragma unroll
  for (int ks = 0; ks < 4; ++ks) wf[ks] = *(const bf16x8*)(wp + ks * 32);
  f32x4 acc[4];
#pragma unroll
  for (int cb = 0; cb < 4; ++cb) {
    acc[cb] = (f32x4){0.f, 0.f, 0.f, 0.f};
#pragma unroll
    for (int ks = 0; ks < 4; ++ks) {
      const bf16x8 vf = *(const bf16x8*)(vnT + (cb * 16 + n) * VS + ks * 32 + kg * 8);
      acc[cb] = __builtin_amdgcn_mfma_f32_16x16x32_bf16(vf, wf[ks], acc[cb], 0, 0, 0);
    }
  }
  const int row = chunk * 128 + t;
  const float bs = p.sgu_b[((size_t)l * 4 + g) * 128 + t];
#pragma unroll
  for (int cb = 0; cb < 4; ++cb) {
    const int c = g * 64 + cb * 16 + kg * 4;
    const u32x2 uv = *(const u32x2*)(PS + (size_t)row * 2304 + 7 * 256 + c);
    u32x2 o; o[0] = cvt_pk_bf16(bflo(uv[0]) * (acc[cb][0] + bs), bfhi(uv[0]) * (acc[cb][1] + bs)); o[1] = cvt_pk_bf16(bflo(uv[1]) * (acc[cb][2] + bs), bfhi(uv[1]) * (acc[cb][3] + bs));
    *(u32x2*)(Y4 + (size_t)row * 1024 + 768 + c) = o;
  }
  __syncthreads();
}

__device__ void carry_phase(const P& p, int l) {
  const int gt = blockIdx.x * 512 + otid();
  if (gt >= 16 * 8 * 2 * 64) return;
  const int pp = gt & 63, d = (gt >> 6) & 1, b = (gt >> 7) & 7, g = gt >> 10;
  const float* S = (const float*)(p.ws + OFF_S) + (size_t)g * NCHUNK * 256 + d * 128 + 2 * pp;
  bf16_t* XU = (bf16_t*)(p.ws + OFF_XU) + (size_t)g * XUR * XUK + 512 + d * 128 + 2 * pp;
  const int li = ((l * 2 + d) * 16 + g);
  const float dt = expf(p.log_dt[li]);
  const cpx aT = s5_apow<false>(p.lam_re[li * 64 + pp], p.lam_im[li * 64 + pp], dt, (float)TCH);
  cpx st = {0.f, 0.f};
  for (int i0 = 0; i0 < 72; i0 += 8) {
    float sre[8], sim[8]; int rows[8];
#pragma unroll
    for (int k = 0; k < 8; ++k) {
      const int i = i0 + k; int row;
      if (i < 8) row = 512 + b * 8 + (d == 0 ? i : 7 - i); else row = b * 64 + (d == 0 ? (i - 8) : 63 - (i - 8));
      rows[k] = row; const float2 v = *(const float2*)(S + (size_t)row * 256); sre[k] = v.x; sim[k] = v.y;
    }
#pragma unroll
    for (int k = 0; k < 8; ++k) {
      *(unsigned*)(XU + (size_t)rows[k] * XUK) = cvt_pk_bf16(st.re, st.im);
      const cpx ns = cmul(aT, st); st.re = ns.re + sre[k]; st.im = ns.im + sim[k];
    }
  }
}

constexpr int PH_PER_LAYER = 11;
constexpr int N_PHASES = 1 + NDEPTH * PH_PER_LAYER + 1;

__global__ void __launch_bounds__(512, 2) mk_forward(P p_arg) {
  extern __shared__ __attribute__((aligned(16))) unsigned char shm[];
  LAS unsigned char* lds = (LAS unsigned char*)shm;
  float* ldsf = (float*)shm;
  unsigned char* ws0 = p_arg.ws;
  volatile LAS unsigned* xbw = (volatile LAS unsigned*)(lds + 131072);
  if (threadIdx.x == 0) { xbw[0] = 0u; xbw[1] = 0u; xbw[2] = 0u; xbw[3] = 0u; }
  __syncthreads();
  const XcdBarrier xb = xcd_barrier_post((unsigned*)(ws0 + OFF_BAR), xbw);
  if (p_arg.ph_lo < 0) cg::this_grid().sync();

  for (int ph = p_arg.ph_lo; ph < p_arg.ph_hi; ++ph) {
    int nrep = 1;
#if DBL_MASK
    { const int spx = (ph == 0) ? 11 : (ph == N_PHASES - 1) ? 13 : (ph - 1) % PH_PER_LAYER; if ((DBL_MASK >> spx) & 1) nrep = 2; }
#endif
    for (int rep = 0; rep < nrep; ++rep) {
    if (rep) xcd_barrier(xb);
    int G_ = gridDim.x, wg_ = blockIdx.x; asm volatile("" : "+s"(G_), "+s"(wg_));
    const int G = G_, wg = wg_;
    unsigned char* ws = ws0; asm volatile("" : "+s"(ws));
    P p = p_arg; p.ws = ws;
    float* H = (float*)(ws + OFF_H);
    const float* MOD = (const float*)(ws + OFF_MOD);
    if (ph == 0) {
      for (int t = wg; t < 192; t += G) mod_task(p, t, ldsf);
      for (int t = (wg + G - (192 % G)) % G; t < NT_WIN + NT_BR; t += G) prep_task(p, 0, t < NT_WIN ? t : PT_WBR0 + (t - NT_WIN), ldsf);
    } else if (ph == N_PHASES - 1) {
      final_rows(p);
#if TSEL
      xcd_barrier(xb);
      if (wg == 0) { const unsigned long long* ts = (const unsigned long long*)(ws + OFF_BAR + 14336); const unsigned long long v = ts[TSEL - 1]; const int N = (int)(TSEL == 3 ? v * 1000 : v / 10);
        for (int i = otid(); i < N && i < 300000; i += 512) p.out[(size_t)i * 16] += 0.125f; }
#endif
    } else {
      const int l = (ph - 1) / PH_PER_LAYER, sp = (ph - 1) % PH_PER_LAYER;
      const bool last = (l == NDEPTH - 1);
      const float* hL = l == 0 ? p.x : H; const float* hC = l == 0 ? p.ctx : H + (size_t)ML * 1024;
      const float* modl = MOD + (size_t)l * 9 * 6144;
      const int nMrows = last ? 64 : 72;
      switch (sp) {
#if PHMASK & 1
        case 0: {
          for (int t = wg; t < PT_NG1; t += G) prep_task(p, l, PT_G10 + t, ldsf);
          norm_rows(p, hL, hC, p.norm_g + (size_t)(l * 2 + 0) * 1024, modl, 0, MT, l > 0 ? MOD + ((size_t)(l - 1) * 9 + 8) * 6144 + 5 * 1024 : nullptr);
        } break;
#endif
#if PHMASK & 2
        case 1: {
          G1Sched S{(const char*)(ws + OFF_A), (const char*)(ws + OFF_WIN), G, wg, last ? 1 : 0};
          EpiG1 E{(bf16_t*)(ws + OFF_PS), (bf16_t*)(ws + OFF_XU), (bf16_t*)(ws + OFF_VT), (bf16_t*)(ws + OFF_KT)};
          gemm_phase(lds, 1024, 1024, S, E, (TSEL && TPHASE == 1 && wg == 0) ? (unsigned long long*)(ws + OFF_BAR + 14336) : nullptr);
        } break;
#endif
#if PHMASK & 4
        case 2: {
          {
            S5Sched S{(const char*)(ws + OFF_XU), (const char*)(ws + OFF_W1), (size_t)256 * 512 * 2, 0, 3, 1, 8, G, wg};
            EpiS1 E{(float*)(ws + OFF_S)};
            gemm_phase(lds, XUK, 512, S, E);
          }
          __syncthreads();
          const int tid2 = otid(), lane2 = tid2 & 63, wid2 = tid2 >> 6;
          for (int i = tid2; i < 4 * 15 * 31; i += 512) ldsf[i] = p.rpb[(size_t)l * 4 * 15 * 31 + i];
          __syncthreads();
          const int nwaves = G * 8, gw = wg * 8 + wid2;
#if TSEL
          unsigned long long* tsl = (unsigned long long*)(ws + OFF_BAR + 14336); const unsigned long long tq0 = __builtin_amdgcn_s_memrealtime();
#endif
          for (int t = gw; t < 4096; t += nwaves) attn_task<true>(p, t, l, ldsf, lane2);
          if (!last) for (int t = nwaves - 1 - gw; t < 512; t += nwaves) attn_task<false>(p, t, l, ldsf, lane2);
#if TSEL
          __syncthreads(); const unsigned long long tq1 = __builtin_amdgcn_s_memrealtime();
#endif
        } break;
#endif
#if PHMASK & 8
        case 3: {
          carry_phase(p, l);
          const int nconv = (last ? ML : MT) * 32 / 512;
          int st, sd; if (filler_range(wg, G, 32, st, sd)) for (int t = st; t < nconv; t += sd) conv_task(p, l, t);
        } break;
#endif
#if PHMASK & 16
        case 4: {
          S5Sched S{(const char*)(ws + OFF_XU), (const char*)(ws + OFF_W2), (size_t)512 * 768 * 2, (size_t)256 * 768 * 2, last ? 2 : 3, 2, 12, G, wg};
          EpiS2 E{(bf16_t*)(ws + OFF_YG), last ? 512 : NCHUNK};
          gemm_phase(lds, XUK, 768, S, E);
          const int nsgu = (last ? 128 : 144) * 4;
          { int st, sd; if (filler_range(wg, G, 96, st, sd)) { __syncthreads(); for (int t = st; t < nsgu / 2; t += sd) sgu_task(p, l, t, ldsf); } }
        } break;
#endif
#if PHMASK & 32
        case 5: {
          RectSched S{(const char*)(ws + OFF_YG), (const char*)(ws + OFF_WGLU), (size_t)256 * 256 * 2, 0, nMrows, 1, 4, G, wg};
          EpiGLU E{(const bf16_t*)(ws + OFF_YG), p.glu_b + l * 256, (bf16_t*)(ws + OFF_Y4)};
          gemm_phase(lds, 256, 256, S, E);
          const int nsgu = (last ? 128 : 144) * 4;
          { int st, sd; if (filler_range(wg, G, 72, st, sd)) { __syncthreads(); for (int t = nsgu / 2 + st; t < nsgu; t += sd) sgu_task(p, l, t, ldsf); } }
        } break;
#endif
#if PHMASK & 64
        case 6: {
          MergeSched S{(const char*)(ws + OFF_A), (const char*)(ws + OFF_Y4), (const char*)(ws + OFF_WIN), (const char*)(ws + OFF_WBR), last ? 0 : 128, G, wg};
          EpiMerge E{ws + OFF_GS + (size_t)wg * 65536, (bf16_t*)(ws + OFF_MIXTMP + (size_t)wg * 131072), (bf16_t*)(ws + OFF_MIX), (bf16_t*)(ws + OFF_GP)};
          gemm_phase(lds, 1024, 1024, S, E, (TSEL && TPHASE == 6 && wg == 0) ? (unsigned long long*)(ws + OFF_BAR + 14336) : nullptr);
          { int st, sd; if (filler_range(wg, G, last ? 0 : 128, st, sd)) for (int t = st; t < PT_NMID; t += sd) prep_task(p, l, PT_FF0 + t, ldsf); }
        } break;
#endif
#if PHMASK & 128
        case 7: {
          WoutSched S{(const char*)(ws + OFF_MIX), (const char*)(ws + OFF_GP), (const char*)(ws + OFF_WOUT), last ? 0 : 256, G, wg};
          EpiRes E{hL, hC, H, modl, 2, (float*)(ws + OFF_PART)};
          gemm_phase(lds, 1024, 1024, S, E);
        } break;
#endif
#if PHMASK & 256
        case 8: {
          norm_rows(p, H, l == 0 ? p.ctx : H + (size_t)ML * 1024, p.norm_g + (size_t)(l * 2 + 1) * 1024, modl, 3, last ? ML : MT, modl + (size_t)8 * 6144 + 2 * 1024);
          if (!last) for (int t = wg; t < NT_BR; t += G) prep_task(p, l + 1, PT_WBR0 + t, ldsf);
        } break;
#endif
#if PHMASK & 512
        case 9: {
          RectSched S{(const char*)(ws + OFF_A), (const char*)(ws + OFF_WFF1), (size_t)256 * 1024 * 2, (size_t)256 * 1024 * 2, nMrows, 16, 16, G, wg};
          EpiFF1 E{(bf16_t*)(ws + OFF_FFH)};
          gemm_phase(lds, 1024, 1024, S, E, (TSEL && TPHASE == 9 && wg == 0) ? (unsigned long long*)(ws + OFF_BAR + 14336) : nullptr);
          if (!last) { int st, sd; if (filler_range(wg, G, 128, st, sd)) for (int t = st; t < NT_WIN; t += sd) prep_task(p, l + 1, t, ldsf); }
        } break;
#endif
#if PHMASK & 1024
        case 10: {
          SplitSched S{(const char*)(ws + OFF_FFH), (const char*)(ws + OFF_WFF2), (const char*)(ws + OFF_FFH) + (size_t)64 * 256 * 4096 * 2, (size_t)256 * 4096 * 2, (size_t)256 * 4096 * 2, (size_t)256 * 4096 * 2, 64, 8, 256, last ? 0 : 256, G, wg};
          EpiRes E{H, H + (size_t)ML * 1024, H, modl, 5, (float*)(ws + OFF_PART)};
          gemm_phase(lds, 4096, 4096, S, E);
        } break;
#endif
      }
    }
    }
    if (ph + 1 < p_arg.ph_hi) { xcd_barrier(xb);
#if (DBL_MASK >> 12) & 1
      xcd_barrier(xb);
#endif
    }
  }
}

extern "C" void kernel_launch(void* const* d_in, const int* in_sizes, int n_in, void* d_out, int out_size, void* d_ws, size_t ws_size, hipStream_t stream) {
  constexpr size_t kDynLds = 131072 + 16;
  static int grid_blocks = 0;
  if (!grid_blocks) {
    (void)hipFuncSetAttribute((const void*)mk_forward, hipFuncAttributeMaxDynamicSharedMemorySize, (int)kDynLds);
    int dev = 0, cus = 0, per_cu = 0;
    (void)hipGetDevice(&dev);
    (void)hipDeviceGetAttribute(&cus, hipDeviceAttributeMultiprocessorCount, dev);
    (void)hipOccupancyMaxActiveBlocksPerMultiprocessor(&per_cu, mk_forward, 512, kDynLds);
    if (per_cu < 1) per_cu = 1;
    grid_blocks = cus;
  }
  P p{};
  const float** pp = (const float**)&p;
  for (int i = 0; i < 29; ++i) pp[i] = (const float*)d_in[i];
  p.out = (float*)d_out; p.ws = (unsigned char*)d_ws;
  (void)hipMemsetAsync((unsigned char*)d_ws + OFF_BAR, 0, 16384, stream);
#if MULTI_LAUNCH
  for (int ph = 0; ph < N_PHASES; ++ph) {
    p.ph_lo = ph; p.ph_hi = ph + 1;
    hipLaunchKernelGGL(mk_forward, dim3(grid_blocks), dim3(512), kDynLds, stream, p);
  }
#else
  p.ph_lo = 0; p.ph_hi = N_PHASES;
  void* args[] = {&p};
  (void)hipLaunchCooperativeKernel((void*)mk_forward, dim3(grid_blocks), dim3(512), args, kDynLds, stream);
#endif
}
```

```cpp
#include <hip/hip_runtime.h>
#include <hip/hip_cooperative_groups.h>
namespace cg = cooperative_groups;

#define LAS __attribute__((address_space(3)))
typedef unsigned short bf16_t;
typedef short bf16x8 __attribute__((ext_vector_type(8)));
typedef float f32x4 __attribute__((ext_vector_type(4)));
typedef unsigned u32x4 __attribute__((ext_vector_type(4)));
typedef unsigned u32x2 __attribute__((ext_vector_type(2)));

#ifndef PHMASK
#define PHMASK 0x7ff
#endif
#ifndef DBL_MASK
#define DBL_MASK 0
#endif
#ifndef TSEL
#define TSEL 0
#endif
#ifndef TPHASE
#define TPHASE 6
#endif
#ifndef MULTI_LAUNCH
#define MULTI_LAUNCH 0
#endif

constexpr int DM = 1024, NB = 8, SEQL = 2048, NDEPTH = 4, CTXL = 256, DFF = 4096, INW = 6400;
constexpr int ML = NB * SEQL;
constexpr int MC = NB * CTXL;
constexpr int MT = ML + MC;
constexpr int TCH = 32;
constexpr int NCHUNK = MT / TCH;
constexpr int XUR = 768;
constexpr int XUK = 768;

constexpr size_t OFF_H = 0;
constexpr size_t OFF_A = OFF_H + (size_t)MT * DM * 4;
constexpr size_t OFF_MIX = OFF_A + (size_t)MT * DM * 2;
constexpr size_t OFF_R1 = OFF_MIX + (size_t)MT * DM * 2;
constexpr size_t OFF_PS = OFF_R1;
constexpr size_t OFF_Y4 = OFF_PS + (size_t)MT * 2304 * 2;
constexpr size_t OFF_VT = OFF_Y4 + (size_t)MT * DM * 2;
constexpr size_t OFF_XU = OFF_VT + (size_t)NB * 4 * 64 * 2304 * 2;
constexpr size_t OFF_S = OFF_XU + (size_t)16 * XUR * XUK * 2;
constexpr size_t OFF_YG = OFF_S + (size_t)16 * NCHUNK * 256 * 4;
constexpr size_t OFF_R1END = OFF_YG + (size_t)MT * 256 * 2;
constexpr size_t OFF_FFH = OFF_R1;
constexpr size_t OFF_MIXTMP = OFF_PS;
constexpr size_t OFF_KT = OFF_YG;
constexpr size_t OFF_GS = OFF_VT;
constexpr size_t OFF_WIN = OFF_R1END;
constexpr size_t OFF_WFF1 = OFF_WIN + (size_t)INW * DM * 2;
constexpr size_t OFF_WFF2 = OFF_WFF1 + (size_t)DFF * DM * 2;
constexpr size_t OFF_WOUT = OFF_WFF2 + (size_t)DFF * DM * 2;
constexpr size_t OFF_WBR = OFF_WOUT + (size_t)DM * DM * 2;
constexpr size_t OFF_WGLU = OFF_WBR + (size_t)DM * DM * 2;
constexpr size_t OFF_W1 = OFF_WGLU + (size_t)256 * 256 * 2;
constexpr size_t OFF_W2 = OFF_W1 + (size_t)16 * 256 * 512 * 2;
constexpr size_t OFF_SGUWT = OFF_W2 + (size_t)16 * 512 * 768 * 2;
constexpr size_t OFF_MOD = OFF_SGUWT + (size_t)4 * 128 * 128 * 4;
constexpr size_t OFF_BAR = OFF_MOD + (size_t)NDEPTH * 9 * 6144 * 4;
constexpr size_t OFF_PART = OFF_BAR + 16384;
constexpr size_t OFF_END = OFF_PART + (size_t)8 * MC * DM * 4;
constexpr size_t OFF_GP = OFF_PS + (size_t)256 * 262144;
static_assert(OFF_GP + (size_t)MC * 4096 * 2 <= OFF_Y4, "GP alias");
static_assert((size_t)MT * DFF * 2 <= OFF_R1END - OFF_R1, "FFH alias");
static_assert((size_t)256 * 262144 <= (size_t)MT * 2304 * 2, "MIXTMP alias");
static_assert((size_t)256 * 131072 <= OFF_R1END - OFF_VT, "GS alias");
static_assert(OFF_END < 452000000ull, "workspace");

struct P {
  const float *x, *c, *ctx, *c_ctx, *ada_w, *ada_b, *norm_g, *final_g, *w_in, *w_branch, *w_out,
      *lam_re, *lam_im, *log_dt, *b_re, *b_im, *c_re, *c_im, *s5_d, *glu_w, *glu_b, *rpb, *conv_w,
      *ln_g, *ln_b, *sgu_w, *sgu_b, *w_ff1, *w_ff2;
  float* out;
  unsigned char* ws;
  int ph_lo, ph_hi;
};

__device__ __forceinline__ int otid() { int t = threadIdx.x; asm volatile("" : "+v"(t)); return t; }
__device__ __forceinline__ float bf2f(bf16_t b) { return __uint_as_float(((unsigned)b) << 16); }
__device__ __forceinline__ float bflo(unsigned w) { return __uint_as_float(w << 16); }
__device__ __forceinline__ float bfhi(unsigned w) { return __uint_as_float(w & 0xffff0000u); }
__device__ __forceinline__ unsigned cvt_pk_bf16(float lo, float hi) { unsigned r; asm volatile("v_cvt_pk_bf16_f32 %0, %1, %2" : "=v"(r) : "v"(lo), "v"(hi)); return r; }
__device__ __forceinline__ float sigm(float x) { return 1.f / (1.f + __expf(-x)); }
__device__ __forceinline__ float gelu_tanh(float x) { return x * sigm(1.5957691216057308f * (x + 0.044715f * x * x * x)); }
__device__ __forceinline__ u32x4 pack8(f32x4 a, f32x4 b) { u32x4 r; r[0] = cvt_pk_bf16(a[0], a[1]); r[1] = cvt_pk_bf16(a[2], a[3]); r[2] = cvt_pk_bf16(b[0], b[1]); r[3] = cvt_pk_bf16(b[2], b[3]); return r; }
__device__ __forceinline__ float shx(float v, int o, int lane) { return __int_as_float(__builtin_amdgcn_ds_bpermute((lane ^ o) << 2, __float_as_int(v))); }
__device__ __forceinline__ float wave_sum(float v, int lane) {
#pragma unroll
  for (int o = 32; o >= 1; o >>= 1) v += shx(v, o, lane);
  return v;
}


#define XB_TMO      128
#define XB_XCNT(j)  (256  + 64 * (j))
#define XB_XSUB(j)  (1280 + 64 * (j))
#define XB_XGEN(j)  (2304 + 64 * (j))
#define XB_TOP      3328
#define XB_TOPGEN   3392
#define XCD_BAR_WORDS 3456
#define XB_SPIN_CAP (1u << 22)
__device__ __forceinline__ unsigned xb_ld(unsigned* p)              { return __hip_atomic_load(p, __ATOMIC_RELAXED, __HIP_MEMORY_SCOPE_AGENT); }
__device__ __forceinline__ unsigned xb_add(unsigned* p, unsigned v) { return __hip_atomic_fetch_add(p, v, __ATOMIC_RELAXED, __HIP_MEMORY_SCOPE_AGENT); }
__device__ __forceinline__ unsigned xb_xcc_id() { return (unsigned)__builtin_amdgcn_s_getreg((3 << 11) | 20) & 0xFu; }
#define XB_SPIN(cond, bar) do { unsigned _sp = 0; while (cond) { __builtin_amdgcn_s_sleep(1); \
    if ((++_sp & 255u) == 0u) { if (xb_ld(&(bar)[XB_TMO])) break; if (_sp > XB_SPIN_CAP) { atomicAdd(&(bar)[XB_TMO], 1u); break; } } } } while (0)
struct XcdBarrier { unsigned* bar; unsigned x; volatile LAS unsigned* st; };
__device__ __forceinline__ XcdBarrier xcd_barrier_post(unsigned* bar, volatile LAS unsigned* st) {
  XcdBarrier b; b.bar = bar; b.x = xb_xcc_id(); b.st = st;
  if (threadIdx.x == 0) (void)xb_add(&bar[XB_XCNT(b.x)], 1u);
  return b;
}
__device__ __forceinline__ void xcd_barrier_complete(unsigned* bar, unsigned x, unsigned& nloc, unsigned& nx) {
  const unsigned G = gridDim.x * gridDim.y * gridDim.z;
  unsigned sum, cnt, mine, sp = 0u;
  for (;;) {
    sum = 0u; cnt = 0u; mine = 0u;
#pragma unroll
    for (unsigned j = 0; j < 16; ++j) { const unsigned c = xb_ld(&bar[XB_XCNT(j)]); sum += c; cnt += (c > 0u) ? 1u : 0u; mine = (j == x) ? c : mine; }
    if (sum == G) break;
    __builtin_amdgcn_s_sleep(1);
    if ((++sp & 255u) == 0u) { if (xb_ld(&bar[XB_TMO])) break; if (sp > XB_SPIN_CAP) { atomicAdd(&bar[XB_TMO], 1u); break; } }
  }
  nloc = mine > 0u ? mine : 1u; nx = cnt > 0u ? cnt : 1u;
}
__device__ __forceinline__ void xcd_barrier(const XcdBarrier& b) {
  asm volatile("s_waitcnt vmcnt(0)" ::: "memory");
  __syncthreads();
  if (threadIdx.x == 0) {
    unsigned* bar = b.bar;
    __builtin_amdgcn_s_waitcnt(0);
    unsigned nloc = b.st[0], nx = b.st[1];
    if (nloc == 0u) { xcd_barrier_complete(bar, b.x, nloc, nx); b.st[0] = nloc; b.st[1] = nx; }
    const unsigned old = xb_add(&bar[XB_XSUB(b.x)], 1u);
    const unsigned gen = old / nloc;
    if (old + 1u == (gen + 1u) * nloc) {
      __builtin_amdgcn_fence(__ATOMIC_RELEASE, "agent");
      asm volatile("s_waitcnt vmcnt(0)" ::: "memory");
      const unsigned og = xb_add(&bar[XB_TOP], 1u);
      const unsigned tg = og / nx;
      if (og + 1u == (tg + 1u) * nx) xb_add(&bar[XB_TOPGEN], 1u);
      else XB_SPIN(xb_ld(&bar[XB_TOPGEN]) == tg, bar);
      __builtin_amdgcn_fence(__ATOMIC_ACQUIRE, "agent");
      xb_add(&bar[XB_XGEN(b.x)], 1u);
      asm volatile("s_waitcnt vmcnt(0)" ::: "memory");
    } else {
      XB_SPIN(xb_ld(&bar[XB_XGEN(b.x)]) == gen, bar);
      __builtin_amdgcn_fence(__ATOMIC_ACQUIRE, "agent");
      asm volatile("s_waitcnt vmcnt(0)" ::: "memory");
    }
  }
  __syncthreads();
}

constexpr int BM = 256, BK = 64, HALF = 128, HTB = HALF * BK * 2, NXCD = 8, WGM = 8;
__device__ __forceinline__ int lds_byte(int r, int c) { const int st = (r >> 4) * 2 + (c >> 5), rr = r & 15, cc = c & 31, ob = rr * 64 + cc * 2; return st * 1024 + (ob ^ (((ob >> 9) & 1) << 5)); }
__device__ __forceinline__ void stage_rc(int b, int& R, int& C) { const int st = b / 1024, sb = b % 1024, swz = sb ^ (((sb >> 9) & 1) << 5); R = (st >> 1) * 16 + swz / 64; C = (st & 1) * 32 + (swz % 64) / 2; }
__device__ __forceinline__ int perm32(int rho) { const int n = rho >> 4, i = rho & 15; return 8 * (i >> 2) + 4 * n + (i & 3); }

struct Unit { const char* A; const char* B; int nt, pm, pn, kind; };

__device__ __forceinline__ void rect_map(int L, int nM, int nN, int& pm, int& pn) {
  const int nwg = nM * nN; int wgid = L;
  { const int q = nwg / NXCD, r = nwg % NXCD, xcd = wgid % NXCD, off = wgid / NXCD; wgid = (xcd < r ? xcd * (q + 1) : r * (q + 1) + (xcd - r) * q) + off; }
  const int nig = WGM * nN, gid = wgid / nig, fm = gid * WGM, gsz = (nM - fm) < WGM ? (nM - fm) : WGM;
  pm = fm + ((wgid % nig) % gsz); pn = (wgid % nig) / gsz;
}

template <class Sched, class Epi>
__device__ __forceinline__ void gemm_phase(LAS unsigned char* lds, const int lda, const int ldb, const Sched& S, const Epi& E, unsigned long long* tslot = nullptr) {
#if TSEL
  const unsigned long long tg0 = __builtin_amdgcn_s_memrealtime();
#endif
  int tid_ = threadIdx.x; asm volatile("" : "+v"(tid_));
  const int tid = tid_, wid = __builtin_amdgcn_readfirstlane(tid >> 6), lane = tid & 63, wr = wid >> 2, wc = wid & 3, fr = lane & 15, fq = lane >> 4;
  unsigned voffA[2], voffB[2];
#pragma unroll
  for (int i = 0; i < 2; ++i) { int R, C; stage_rc(tid * 16 + i * 8192, R, C); const int Rb = (R & ~31) + perm32(R & 31);
    voffA[i] = (unsigned)(R * lda + C) * 2u; voffB[i] = (unsigned)(Rb * ldb + C) * 2u; }
  const size_t kstep = (size_t)(BK * 2);
  const size_t hstepA = (size_t)HALF * lda * 2, hstepB = (size_t)HALF * ldb * 2;
  const unsigned ldsw = (unsigned)wid * 1024u;
  const int aoff = lds_byte(wr * 64 + fr, fq * 8), boff = lds_byte(wc * 32 + fr, fq * 8);
#define PG8_SA(b, h) (((b) * 2 + (h)) * HTB)
#define PG8_SB(b, h) ((4 + (b) * 2 + (h)) * HTB)
#define PG8_STAGE(bufoff, gbase, voff) do { _Pragma("unroll") for (int _i = 0; _i < 2; ++_i) \
    __builtin_amdgcn_global_load_lds((const unsigned*)((const char*)(gbase) + (voff)[_i]), (LAS unsigned*)(lds + (bufoff) + ldsw + _i * 8192), 16, 0, 0); } while (0)
#define PG8_LDA(dst, b, h) do { _Pragma("unroll") for (int m = 0; m < 4; ++m) _Pragma("unroll") for (int k = 0; k < 2; ++k) dst[m][k] = *(const LAS bf16x8*)(lds + PG8_SA(b, h) + aoff + m * 2048 + k * 1024); } while (0)
#define PG8_LDB(dst, b, h) do { _Pragma("unroll") for (int n = 0; n < 2; ++n) _Pragma("unroll") for (int k = 0; k < 2; ++k) dst[n][k] = *(const LAS bf16x8*)(lds + PG8_SB(b, h) + boff + n * 2048 + k * 1024); } while (0)
#define PG8_MMA(ai, bj, At, Bt) do { __builtin_amdgcn_s_setprio(1); _Pragma("unroll") for (int m = 0; m < 4; ++m) _Pragma("unroll") for (int n = 0; n < 2; ++n) _Pragma("unroll") for (int k = 0; k < 2; ++k) \
    acc[ai][bj][m][n] = __builtin_amdgcn_mfma_f32_16x16x32_bf16(Bt[n][k], At[m][k], acc[ai][bj][m][n], 0, 0, 0); __builtin_amdgcn_s_setprio(0); } while (0)
#define PG8_WAIT_V(n) asm volatile("s_waitcnt vmcnt(" #n ")" ::: "memory")
#define PG8_WAIT_L(n) asm volatile("s_waitcnt lgkmcnt(" #n ")" ::: "memory")
#define PG8_BAR __builtin_amdgcn_s_barrier()
#define PG8_SCHED __builtin_amdgcn_sched_barrier(0)
  Unit cur, nxt; int ui = 0;
  if (!S.next(0, cur)) return;
  f32x4 acc[2][2][4][2];
#pragma unroll
  for (int a = 0; a < 2; ++a)
#pragma unroll
    for (int b = 0; b < 2; ++b)
#pragma unroll
      for (int m = 0; m < 4; ++m)
#pragma unroll
        for (int n = 0; n < 2; ++n) acc[a][b][m][n] = (f32x4){0.f, 0.f, 0.f, 0.f};
  bf16x8 At[4][2], B0[2][2], B1[2][2];
  const char* cA = cur.A; const char* cB = cur.B;
  PG8_STAGE(PG8_SB(0, 0), cB, voffB); PG8_STAGE(PG8_SA(0, 0), cA, voffA); PG8_STAGE(PG8_SB(0, 1), cB + hstepB, voffB); PG8_STAGE(PG8_SA(0, 1), cA + hstepA, voffA);
  if (wr == 1) PG8_BAR;
  PG8_WAIT_V(4); PG8_BAR;
  PG8_STAGE(PG8_SB(1, 0), cB + kstep, voffB); PG8_STAGE(PG8_SA(1, 0), cA + kstep, voffA); PG8_STAGE(PG8_SB(1, 1), cB + hstepB + kstep, voffB);
  PG8_WAIT_V(6); PG8_BAR;
  for (;;) {
    const bool has_next = S.next(ui + 1, nxt);
    const char* nA = has_next ? nxt.A : cA; const char* nB = has_next ? nxt.B : cB;
    const int nt = cur.nt;
#if TSEL
    const unsigned long long tk0 = __builtin_amdgcn_s_memrealtime();
#endif
    for (int t = 0; t < nt; t += 2) {
      const bool last = (t == nt - 2);
      const char* a1 = cA + (size_t)(t + 1) * kstep;
      const char* a2 = last ? nA : cA + (size_t)(t + 2) * kstep; const char* b2 = last ? nB : cB + (size_t)(t + 2) * kstep;
      const char* a3 = a2 + kstep; const char* b3 = b2 + kstep;
      PG8_LDB(B0, 0, 0); PG8_SCHED; PG8_LDA(At, 0, 0); PG8_STAGE(PG8_SA(1, 1), a1 + hstepA, voffA);
      PG8_WAIT_L(8); PG8_BAR; PG8_WAIT_L(0); PG8_MMA(0, 0, At, B0); PG8_BAR; PG8_SCHED;
      PG8_LDB(B1, 0, 1); PG8_STAGE(PG8_SB(0, 0), b2, voffB);
      PG8_BAR; PG8_WAIT_L(0); PG8_MMA(0, 1, At, B1); PG8_BAR;
      PG8_LDA(At, 0, 1); PG8_STAGE(PG8_SA(0, 0), a2, voffA);
      PG8_BAR; PG8_WAIT_L(0); PG8_MMA(1, 0, At, B0); PG8_BAR; PG8_SCHED;
      PG8_STAGE(PG8_SB(0, 1), b2 + hstepB, voffB);
      PG8_WAIT_V(6); PG8_BAR; PG8_MMA(1, 1, At, B1); PG8_BAR;
      PG8_LDB(B0, 1, 0); PG8_SCHED; PG8_LDA(At, 1, 0); PG8_STAGE(PG8_SA(0, 1), a2 + hstepA, voffA);
      PG8_WAIT_L(8); PG8_BAR; PG8_WAIT_L(0); PG8_MMA(0, 0, At, B0); PG8_BAR; PG8_SCHED;
      PG8_LDB(B1, 1, 1); PG8_STAGE(PG8_SB(1, 0), b3, voffB);
      PG8_BAR; PG8_WAIT_L(0); PG8_MMA(0, 1, At, B1); PG8_BAR;
      PG8_LDA(At, 1, 1); PG8_STAGE(PG8_SA(1, 0), a3, voffA);
      PG8_BAR; PG8_WAIT_L(0); PG8_MMA(1, 0, At, B0); PG8_BAR; PG8_SCHED;
      PG8_STAGE(PG8_SB(1, 1), b3 + hstepB, voffB);
      PG8_WAIT_V(6); PG8_BAR; PG8_MMA(1, 1, At, B1); PG8_BAR;
    }
#if TSEL
    const unsigned long long te0 = __builtin_amdgcn_s_memrealtime();
    if (tslot && tid == 0) tslot[3 + (cur.kind & 1)] += te0 - tk0;
#endif
    { const int t2 = otid(); E(acc, cur, wr, wc, t2 & 15, (t2 & 63) >> 4); }
#if TSEL
    if (tslot && tid == 0) { asm volatile("s_waitcnt vmcnt(0)" ::: "memory"); tslot[0] += __builtin_amdgcn_s_memrealtime() - te0; tslot[2] += 1; }
#endif
    if (!has_next) break;
#pragma unroll
    for (int a = 0; a < 2; ++a)
#pragma unroll
      for (int b = 0; b < 2; ++b)
#pragma unroll
        for (int m = 0; m < 4; ++m)
#pragma unroll
          for (int n = 0; n < 2; ++n) acc[a][b][m][n] = (f32x4){0.f, 0.f, 0.f, 0.f};
    cur = nxt; cA = nA; cB = nB; ++ui;
  }
  PG8_WAIT_V(0);
  if (wr == 0) PG8_BAR;
  PG8_BAR;
#if TSEL
  if (tslot && tid == 0) tslot[1] += __builtin_amdgcn_s_memrealtime() - tg0;
#endif
#undef PG8_SA
#undef PG8_SB
#undef PG8_STAGE
#undef PG8_LDA
#undef PG8_LDB
#undef PG8_MMA
#undef PG8_WAIT_V
#undef PG8_WAIT_L
#undef PG8_BAR
#undef PG8_SCHED
}

typedef f32x4 Acc[2][2][4][2];
#define EPI_ROWS(u, wr, fr) \
  _Pragma("unroll") for (int ai = 0; ai < 2; ++ai) _Pragma("unroll") for (int m = 0; m < 4; ++m)
#define EPI_ROW(u, wr, fr) ((u).pm * 256 + ai * 128 + (wr) * 64 + m * 16 + (fr))
#define EPI_COL(wc, fq) (bj * 128 + (wc) * 32 + (fq) * 8)

__device__ __forceinline__ int bsel_of_tile(int pm) { return pm < 64 ? (pm >> 3) : 8; }

struct RectSched {
  const char* A; const char* B; size_t a_tile, b_tile; int nM, nN, nt, G, c;
  __device__ __forceinline__ bool next(int i, Unit& u) const {
    const int L = i * G + c; if (L >= nM * nN) return false;
    int pm, pn; rect_map(L, nM, nN, pm, pn);
    u.pm = pm; u.pn = pn; u.kind = 0; u.nt = nt; u.A = A + (size_t)pm * a_tile; u.B = B + (size_t)pn * b_tile; return true;
  }
};
struct G1Sched {
  const char* A; const char* B; int G, c, last;
  __device__ __forceinline__ bool next(int i, Unit& u) const {
    const int L = i * G + c; const int nl = 64 * 9, ncx = last ? 24 : 72;
    if (L >= nl + ncx) return false;
    int pm, pn;
    if (L < nl) rect_map(L, 64, 9, pm, pn);
    else { const int q = L - nl; if (last) { pm = 64 + q / 3; const int s = q % 3; pn = s == 0 ? 0 : (s + 1); } else { pm = 64 + q / 9; pn = q % 9; } }
    u.pm = pm; u.pn = pn; u.kind = 0; u.nt = 16; u.A = A + (size_t)pm * (256 * 1024 * 2); u.B = B + (size_t)pn * (256 * 1024 * 2); return true;
  }
};
struct S5Sched {
  const char* A; const char* B; size_t b_group, b_tile; int nMs, nN, nt, G, c;
  __device__ __forceinline__ bool next(int i, Unit& u) const {
    const int L = i * G + c; if (L >= 16 * nMs * nN) return false;
    const int g = L / (nMs * nN), r = L % (nMs * nN), pm = r / nN, pn = r % nN;
    u.pm = pm; u.pn = pn; u.kind = g; u.nt = nt;
    u.A = A + ((size_t)g * XUR + (size_t)pm * 256) * XUK * 2; u.B = B + (size_t)g * b_group + (size_t)pn * b_tile; return true;
  }
};
struct MergeSched {
  const char* Abuf; const char* Y4; const char* Win; const char* Wbr; int ncx, G, c;
  __device__ __forceinline__ bool next(int i, Unit& u) const {
    const int nlat = (256 - c + G - 1) / G;
    int pm, pd, k, j;
    if (i < 8 * nlat) { const int su = (i >> 3) * G + c; j = i & 7; k = j >> 1; const int x = su & 7, sl = su >> 3; pd = sl & 3; pm = x * 8 + (sl >> 2); u.kind = j; }
    else { const int i2 = i - 8 * nlat; const int q = (i2 >> 1) * G + c; if (q >= ncx) return false; j = i2 & 1; const int x = q & 7, sl = q >> 3; k = sl & 3; pd = sl >> 2; pm = 64 + x; u.kind = 8 + 2 * k + j; }
    u.pm = pm; u.pn = pd;
    if (!(j & 1)) { u.nt = 16; u.A = Abuf + (size_t)pm * (256 * 1024 * 2); u.B = Win + (size_t)(2304 + k * 1024 + pd * 256) * (1024 * 2); }
    else { u.nt = 4; u.A = Y4 + (size_t)pm * (256 * 1024 * 2) + (size_t)k * 512; u.B = Wbr + (size_t)(pd * 256) * (1024 * 2) + (size_t)k * 512; }
    return true;
  }
};
struct WoutSched {
  const char* MIXb; const char* GPb; const char* B; int ncx, G, c;
  __device__ __forceinline__ bool next(int i, Unit& u) const {
    const int L = i * G + c;
    if (L < 256) { int pm, pn; rect_map(L, 64, 4, pm, pn); u.pm = pm; u.pn = pn; u.kind = 0; u.nt = 16; u.A = MIXb + (size_t)pm * (256 * 1024 * 2); u.B = B + (size_t)pn * (256 * 1024 * 2); return true; }
    const int q = L - 256; if (q >= ncx) return false;
    const int ks = q & 7, pn = (q >> 3) & 3, pmc = q >> 5;
    u.pm = 64 + pmc; u.pn = pn; u.kind = 1 + ks; u.nt = 8;
    u.A = GPb + ((size_t)(ks >> 1) * MC + (size_t)pmc * 256) * (1024 * 2) + (size_t)(ks & 1) * 1024; u.B = B + (size_t)pn * (256 * 1024 * 2) + (size_t)(ks & 1) * 1024; return true;
  }
};
struct SplitSched {
  const char* A; const char* B; const char* Ac; size_t a_tile, b_tile, ac_tile; int nt, nts, nlat, ncx, G, c;
  __device__ __forceinline__ bool next(int i, Unit& u) const {
    const int L = i * G + c;
    if (L < nlat) { int pm, pn; rect_map(L, 64, 4, pm, pn); u.pm = pm; u.pn = pn; u.kind = 0; u.nt = nt; u.A = A + (size_t)pm * a_tile; u.B = B + (size_t)pn * b_tile; return true; }
    const int q = L - nlat; if (q >= ncx) return false;
    const int ks = q & 7, pn = (q >> 3) & 3, pmc = q >> 5;
    u.pm = 64 + pmc; u.pn = pn; u.kind = 1 + ks; u.nt = nts;
    u.A = Ac + (size_t)pmc * ac_tile + (size_t)ks * nts * 128; u.B = B + (size_t)pn * b_tile + (size_t)ks * nts * 128; return true;
  }
};

struct EpiG1 {
  bf16_t* PS; bf16_t* XU; bf16_t* VT; bf16_t* KT;
  __device__ __forceinline__ void operator()(const Acc& acc, const Unit& u, int wr, int wc, int fr, int fq) const {
    if (u.pn == 3) {
      const int voff = (wc >> 1) * (288 * 512) + ((wc & 1) * 32 + fq * 8) * 8;
      EPI_ROWS(u, wr, fr) {
        const int row = EPI_ROW(u, wr, fr);
        int b, tok; if (row < ML) { b = row >> 11; tok = row & 2047; } else { const int r2 = row - ML; b = r2 >> 8; tok = 2048 + (r2 & 255); }
        bf16_t* rb = VT + ((size_t)(b * 4) * 288 + (tok >> 3)) * 512 + (tok & 7) + voff;
#pragma unroll
        for (int bj = 0; bj < 2; ++bj) {
          const u32x4 pk = pack8(acc[ai][bj][m][0], acc[ai][bj][m][1]);
          bf16_t* base = rb + bj * (2 * 288 * 512);
#pragma unroll
          for (int i = 0; i < 4; ++i) { base[(2 * i) * 8] = (bf16_t)(pk[i] & 0xffffu); base[(2 * i + 1) * 8] = (bf16_t)(pk[i] >> 16); }
        }
      }
      return;
    }
    EPI_ROWS(u, wr, fr) {
      const int row = EPI_ROW(u, wr, fr);
#pragma unroll
      for (int bj = 0; bj < 2; ++bj) {
        const int c = EPI_COL(wc, fq);
        const u32x4 pk = pack8(acc[ai][bj][m][0], acc[ai][bj][m][1]);
        if (u.pn == 0) {
          const int g = c >> 4, h0 = c & 15;
          *(u32x4*)(XU + ((size_t)(g * XUR + (row >> 5)) * XUK + (row & 31) * 16 + h0)) = pk;
        } else if (u.pn == 2) {
          int b, tok; if (row < ML) { b = row >> 11; tok = row & 2047; } else { const int r2 = row - ML; b = r2 >> 8; tok = 2048 + (r2 & 255); }
          *(u32x4*)(KT + (((size_t)(b * 4 + (c >> 6)) * 2304 + tok) * 64 + (c & 63))) = pk;
        } else {
          *(u32x4*)(PS + (size_t)row * 2304 + u.pn * 256 + c) = pk;
        }
      }
    }
  }
};
struct EpiS1 {
  float* S;
  __device__ __forceinline__ void operator()(const Acc& acc, const Unit& u, int wr, int wc, int fr, int fq) const {
    EPI_ROWS(u, wr, fr) {
      const int row = EPI_ROW(u, wr, fr);
      if (row < NCHUNK) {
#pragma unroll
        for (int bj = 0; bj < 2; ++bj) {
          const int c = EPI_COL(wc, fq);
          float* dst = S + ((size_t)u.kind * NCHUNK + row) * 256 + c;
          *(f32x4*)dst = acc[ai][bj][m][0]; *(f32x4*)(dst + 4) = acc[ai][bj][m][1];
        }
      }
    }
  }
};
struct EpiS2 {
  bf16_t* YG; int rowlim;
  __device__ __forceinline__ void operator()(const Acc& acc, const Unit& u, int wr, int wc, int fr, int fq) const {
    EPI_ROWS(u, wr, fr) {
      const int row = EPI_ROW(u, wr, fr);
      if (row < rowlim) {
#pragma unroll
        for (int bj = 0; bj < 2; ++bj) {
          const int col = u.pn * 256 + EPI_COL(wc, fq);
          const int t = col >> 4, h0 = col & 15;
          f32x4 a = acc[ai][bj][m][0], b = acc[ai][bj][m][1];
#pragma unroll
          for (int i = 0; i < 4; ++i) { a[i] = gelu_tanh(a[i]); b[i] = gelu_tanh(b[i]); }
          *(u32x4*)(YG + ((size_t)(row * TCH + t)) * 256 + u.kind * 16 + h0) = pack8(a, b);
        }
      }
    }
  }
};
struct EpiGLU {
  const bf16_t* YG; const float* bias; bf16_t* Y4;
  __device__ __forceinline__ void operator()(const Acc& acc, const Unit& u, int wr, int wc, int fr, int fq) const {
    EPI_ROWS(u, wr, fr) {
      const int row = EPI_ROW(u, wr, fr);
#pragma unroll
      for (int bj = 0; bj < 2; ++bj) {
        const int c = EPI_COL(wc, fq);
        const u32x4 gv = *(const u32x4*)(YG + (size_t)row * 256 + c);
        const f32x4 b0 = *(const f32x4*)(bias + c), b1 = *(const f32x4*)(bias + c + 4);
        f32x4 a = acc[ai][bj][m][0] + b0, b = acc[ai][bj][m][1] + b1;
        a[0] = bflo(gv[0]) * sigm(a[0]); a[1] = bfhi(gv[0]) * sigm(a[1]); a[2] = bflo(gv[1]) * sigm(a[2]); a[3] = bfhi(gv[1]) * sigm(a[3]);
        b[0] = bflo(gv[2]) * sigm(b[0]); b[1] = bfhi(gv[2]) * sigm(b[1]); b[2] = bflo(gv[3]) * sigm(b[2]); b[3] = bfhi(gv[3]) * sigm(b[3]);
        *(u32x4*)(Y4 + (size_t)row * 1024 + c) = pack8(a, b);
      }
    }
  }
};
struct EpiMerge {
  unsigned char* GS; bf16_t* TMP; bf16_t* MIX; bf16_t* GP;
  __device__ __forceinline__ void operator()(const Acc& acc, const Unit& u, int wr, int wc, int fr, int fq) const {
    const int tid = otid(); const int j = u.kind, k = j >> 1;
    EPI_ROWS(u, wr, fr) {
#pragma unroll
      for (int bj = 0; bj < 2; ++bj) {
        const int e = (ai * 4 + m) * 2 + bj;
        unsigned char* gs = GS + ((size_t)e * 512 + tid) * 8;
        bf16_t* tp = TMP + ((size_t)e * 512 + tid) * 8;
        if (!(j & 1)) {
          const f32x4 a = acc[ai][bj][m][0], b = acc[ai][bj][m][1];
          u32x2 q;
          q[0] = (unsigned)(sigm(a[0]) * 255.f + 0.5f) | ((unsigned)(sigm(a[1]) * 255.f + 0.5f) << 8) | ((unsigned)(sigm(a[2]) * 255.f + 0.5f) << 16) | ((unsigned)(sigm(a[3]) * 255.f + 0.5f) << 24);
          q[1] = (unsigned)(sigm(b[0]) * 255.f + 0.5f) | ((unsigned)(sigm(b[1]) * 255.f + 0.5f) << 8) | ((unsigned)(sigm(b[2]) * 255.f + 0.5f) << 16) | ((unsigned)(sigm(b[3]) * 255.f + 0.5f) << 24);
          *(u32x2*)gs = q;
        } else {
          const u32x2 q = *(const u32x2*)gs;
          f32x4 a = acc[ai][bj][m][0], b = acc[ai][bj][m][1];
          const float sc = 1.f / 255.f;
#pragma unroll
          for (int i = 0; i < 4; ++i) { a[i] *= (float)((q[0] >> (8 * i)) & 255u) * sc; b[i] *= (float)((q[1] >> (8 * i)) & 255u) * sc; }
          if (j >= 8) {
            const int row = EPI_ROW(u, wr, fr) - ML; const int c = u.pn * 256 + EPI_COL(wc, fq);
            *(u32x4*)(GP + ((size_t)(k - 4) * MC + row) * 1024 + c) = pack8(a, b);
          } else {
            if (k > 0) { const u32x4 t = *(const u32x4*)tp; a[0] += bflo(t[0]); a[1] += bfhi(t[0]); a[2] += bflo(t[1]); a[3] += bfhi(t[1]); b[0] += bflo(t[2]); b[1] += bfhi(t[2]); b[2] += bflo(t[3]); b[3] += bfhi(t[3]); }
            if (k < 3) *(u32x4*)tp = pack8(a, b);
            else { const int row = EPI_ROW(u, wr, fr); const int c = u.pn * 256 + EPI_COL(wc, fq); *(u32x4*)(MIX + (size_t)row * 1024 + c) = pack8(a, b); }
          }
        }
      }
    }
  }
};
struct EpiRes {
  const float* hL; const float* hC; float* H; const float* modbase; int modidx; float* PART;
  __device__ __forceinline__ void operator()(const Acc& acc, const Unit& u, int wr, int wc, int fr, int fq) const {
    if (u.kind) {
      bf16_t* pb = (bf16_t*)PART + (size_t)(u.kind - 1) * MC * 1024;
      EPI_ROWS(u, wr, fr) {
        const int row = EPI_ROW(u, wr, fr) - ML;
#pragma unroll
        for (int bj = 0; bj < 2; ++bj) {
          const int c = u.pn * 256 + EPI_COL(wc, fq);
          *(u32x4*)(pb + (size_t)row * 1024 + c) = pack8(acc[ai][bj][m][0], acc[ai][bj][m][1]);
        }
      }
      return;
    }
    const float* mv = modbase + (size_t)bsel_of_tile(u.pm) * 6144 + modidx * 1024;
    EPI_ROWS(u, wr, fr) {
      const int row = EPI_ROW(u, wr, fr);
      const float* hs = row < ML ? hL + (size_t)row * 1024 : hC + (size_t)(row - ML) * 1024;
#pragma unroll
      for (int bj = 0; bj < 2; ++bj) {
        const int c = u.pn * 256 + EPI_COL(wc, fq);
        const f32x4 h0 = *(const f32x4*)(hs + c), h1 = *(const f32x4*)(hs + c + 4);
        const f32x4 m0 = *(const f32x4*)(mv + c), m1 = *(const f32x4*)(mv + c + 4);
        float* hd = H + (size_t)row * 1024 + c;
        *(f32x4*)hd = h0 + m0 * acc[ai][bj][m][0]; *(f32x4*)(hd + 4) = h1 + m1 * acc[ai][bj][m][1];
      }
    }
  }
};
struct EpiFF1 {
  bf16_t* FFH;
  __device__ __forceinline__ void operator()(const Acc& acc, const Unit& u, int wr, int wc, int fr, int fq) const {
    EPI_ROWS(u, wr, fr) {
      const int row = EPI_ROW(u, wr, fr);
#pragma unroll
      for (int bj = 0; bj < 2; ++bj) {
        const int c = u.pn * 256 + EPI_COL(wc, fq);
        f32x4 a = acc[ai][bj][m][0], b = acc[ai][bj][m][1];
#pragma unroll
        for (int i = 0; i < 4; ++i) { a[i] = fmaxf(a[i], 0.f); a[i] *= a[i]; b[i] = fmaxf(b[i], 0.f); b[i] *= b[i]; }
        *(u32x4*)(FFH + (size_t)row * 4096 + c) = pack8(a, b);
      }
    }
  }
};

__device__ void mod_task(const P& p, int task, float* lds) {
  const int tid = otid();
  float* sc = lds;
  float* red = lds + 9 * 1024;
  for (int i = tid; i < 9 * 1024; i += 512) { const float v = i < 8192 ? p.c[i] : p.c_ctx[i - 8192]; sc[i] = v * sigm(v); }
  __syncthreads();
  const int l = task / 48, jb = task % 48, jl = tid & 127, ks = tid >> 7, j = jb * 128 + jl;
  float a[9];
#pragma unroll
  for (int s = 0; s < 9; ++s) a[s] = 0.f;
  const float* w = p.ada_w + (size_t)l * 1024 * 6144 + j;
#pragma unroll 8
  for (int k = ks * 256; k < ks * 256 + 256; ++k) {
    const float wv = w[(size_t)k * 6144];
#pragma unroll
    for (int s = 0; s < 9; ++s) a[s] += sc[s * 1024 + k] * wv;
  }
#pragma unroll
  for (int s = 0; s < 9; ++s) red[(ks * 9 + s) * 128 + jl] = a[s];
  __syncthreads();
  float* MOD = (float*)(p.ws + OFF_MOD);
  for (int i = tid; i < 9 * 128; i += 512) {
    const int s = i >> 7, jj = i & 127;
    const float v = red[(0 * 9 + s) * 128 + jj] + red[(1 * 9 + s) * 128 + jj] + red[(2 * 9 + s) * 128 + jj] + red[(3 * 9 + s) * 128 + jj];
    MOD[((size_t)l * 9 + s) * 6144 + jb * 128 + jj] = v + p.ada_b[l * 6144 + jb * 128 + jj];
  }
  __syncthreads();
}

__device__ void tr_tile(const float* src, int lds_, bf16_t* dst, int ldd, float* tile  ) {
  const int tid = otid();
#pragma unroll
  for (int ps = 0; ps < 2; ++ps) {
    const int k = (tid >> 4) + ps * 32, n4 = (tid & 15) * 4;
    const f32x4 v = *(const f32x4*)(src + (size_t)k * lds_ + n4);
    tile[k * 65 + n4] = v[0]; tile[k * 65 + n4 + 1] = v[1]; tile[k * 65 + n4 + 2] = v[2]; tile[k * 65 + n4 + 3] = v[3];
  }
  __syncthreads();
  {
    const int n = tid >> 3, k8 = (tid & 7) * 8;
    u32x4 o;
#pragma unroll
    for (int i = 0; i < 4; ++i) o[i] = cvt_pk_bf16(tile[(k8 + 2 * i) * 65 + n], tile[(k8 + 2 * i + 1) * 65 + n]);
    *(u32x4*)(dst + (size_t)n * ldd + k8) = o;
  }
  __syncthreads();
}

struct cpx { float re, im; };
__device__ __forceinline__ cpx cmul(cpx a, cpx b) { return {a.re * b.re - a.im * b.im, a.re * b.im + a.im * b.re}; }
template <bool FAST>
__device__ __forceinline__ cpx s5_apow(float lre, float lim, float dt, float e) {
  const float zr = lre * dt * e, zi = lim * dt * e;
  if (FAST) { const float mg = __expf(zr); return {mg * __cosf(zi), mg * __sinf(zi)}; }
  const float mg = expf(zr); float sn, cs; sincosf(zi, &sn, &cs); return {mg * cs, mg * sn};
}
template <bool FAST>
__device__ __forceinline__ cpx s5_coef(float lre, float lim, float dt) {
  const cpx a = s5_apow<FAST>(lre, lim, dt, 1.f); const float nr = a.re - 1.f, ni = a.im, den = lre * lre + lim * lim;
  return {(nr * lre + ni * lim) / den, (ni * lre - nr * lim) / den};
}

constexpr int NT_WIN = 1600, NT_FF1 = 1024, NT_FF2 = 1024, NT_OUT = 256, NT_BR = 256, NT_GLU = 16;
constexpr int NT_TR = NT_WIN + NT_FF1 + NT_FF2 + NT_OUT + NT_BR + NT_GLU;
constexpr int NT_TOEP = 512, NT_W2S = 256, NT_W1 = 128, NT_SGUW = 16;
constexpr int NT_PREP = NT_TR + NT_TOEP + NT_W2S + NT_W1 + NT_SGUW;

__device__ void prep_task(const P& p, int l, int task, float* lds) {
  const int tid = otid();
  unsigned char* ws = p.ws;
  if (task < NT_TR) {
    const float* src; bf16_t* dst; int N, ldd, tk, tn;
    int t = task;
    if (t < NT_WIN) { src = p.w_in + (size_t)l * 1024 * 6400; N = 6400; dst = (bf16_t*)(ws + OFF_WIN); ldd = 1024; tk = t / 100; tn = t % 100; }
    else if ((t -= NT_WIN) < NT_FF1) { src = p.w_ff1 + (size_t)l * 1024 * 4096; N = 4096; dst = (bf16_t*)(ws + OFF_WFF1); ldd = 1024; tk = t / 64; tn = t % 64; }
    else if ((t -= NT_FF1) < NT_FF2) { src = p.w_ff2 + (size_t)l * 4096 * 1024; N = 1024; dst = (bf16_t*)(ws + OFF_WFF2); ldd = 4096; tk = t / 16; tn = t % 16; }
    else if ((t -= NT_FF2) < NT_OUT) { src = p.w_out + (size_t)l * 1024 * 1024; N = 1024; dst = (bf16_t*)(ws + OFF_WOUT); ldd = 1024; tk = t / 16; tn = t % 16; }
    else if ((t -= NT_OUT) < NT_BR) { const int k = t >> 6; t &= 63; src = p.w_branch + ((size_t)l * 4 + k) * 256 * 1024; N = 1024; dst = (bf16_t*)(ws + OFF_WBR) + k * 256; ldd = 1024; tk = t / 16; tn = t % 16; }
    else { t -= NT_BR; src = p.glu_w + (size_t)l * 256 * 256; N = 256; dst = (bf16_t*)(ws + OFF_WGLU); ldd = 256; tk = t / 4; tn = t % 4; }
    tr_tile(src + (size_t)tk * 64 * N + tn * 64, N, dst + (size_t)tn * 64 * ldd + tk * 64, ldd, lds);
    return;
  }
  task -= NT_TR;
  bf16_t* W2 = (bf16_t*)(ws + OFF_W2);
  bf16_t* W1 = (bf16_t*)(ws + OFF_W1);
  if (task < NT_TOEP) {
    const int g = task >> 5, lag = task & 31;
    cpx* E = (cpx*)lds;
    float* sC = lds + 256;
    float* sB = sC + 4096;
    if (tid < 128) {
      const int d = tid >> 6, pp = tid & 63; const int li = ((l * 2 + d) * 16 + g);
      const float dt = expf(p.log_dt[li]); const float lre = p.lam_re[li * 64 + pp], lim = p.lam_im[li * 64 + pp];
      E[tid] = cmul(s5_apow<true>(lre, lim, dt, (float)lag), s5_coef<false>(lre, lim, dt));
    }
    for (int i = tid; i < 4096; i += 512) {
      const int d = i >> 11, ri = (i >> 10) & 1, r = i & 1023; const int li = ((l * 2 + d) * 16 + g);
      sC[i] = (ri ? p.c_im : p.c_re)[(size_t)li * 1024 + r];
      sB[i] = (ri ? p.b_im : p.b_re)[(size_t)li * 1024 + r];
    }
    __syncthreads();
    if (tid < 256) {
      const int hp = tid >> 4, h = tid & 15;
      float kv[2];
#pragma unroll
      for (int d = 0; d < 2; ++d) {
        const float* cre = sC + d * 2048 + hp * 64; const float* cim = cre + 1024;
        const float* bre = sB + d * 2048 + h; const float* bim = bre + 1024;
        float s = 0.f;
#pragma unroll 8
        for (int pp = 0; pp < 64; ++pp) {
          const cpx bb = cmul(E[d * 64 + pp], (cpx){bre[pp * 16], bim[pp * 16]});
          s += cre[pp] * bb.re - cim[pp] * bb.im;
        }
        kv[d] = s;
      }
      bf16_t* Wg = W2 + (size_t)g * 512 * 768;
      if (lag == 0) {
        const float v = kv[0] + kv[1] + (hp == h ? p.s5_d[l * 256 + g * 16 + h] : 0.f);
        const bf16_t bv = (bf16_t)(cvt_pk_bf16(v, 0.f) & 0xffffu);
        for (int t = 0; t < TCH; ++t) Wg[(size_t)(t * 16 + hp) * 768 + t * 16 + h] = bv;
      } else {
        const unsigned pk = cvt_pk_bf16(kv[0], kv[1]);
        const bf16_t v0 = (bf16_t)(pk & 0xffffu), v1 = (bf16_t)(pk >> 16);
        for (int jj = 0; jj + lag < TCH; ++jj) {
          const int t = jj + lag;
          Wg[(size_t)(t * 16 + hp) * 768 + jj * 16 + h] = v0;
          Wg[(size_t)(jj * 16 + hp) * 768 + t * 16 + h] = v1;
        }
      }
    }
    __syncthreads();
    return;
  }
  task -= NT_TOEP;
  if (task < NT_W2S) {
    for (int it = 0; it < 8; ++it) {
      const int idx = (task * 8 + it) * 512 + tid;
      const int pp = idx & 63, d = (idx >> 6) & 1, hp = (idx >> 7) & 15, t = (idx >> 11) & 31, g = idx >> 16;
      const int li = ((l * 2 + d) * 16 + g);
      const float dt = expf(p.log_dt[li]); const float lre = p.lam_re[li * 64 + pp], lim = p.lam_im[li * 64 + pp];
      const cpx ap = s5_apow<true>(lre, lim, dt, d == 0 ? (float)(t + 1) : (float)(TCH - t));
      const cpx cc = {p.c_re[((size_t)li * 16 + hp) * 64 + pp], p.c_im[((size_t)li * 16 + hp) * 64 + pp]};
      const cpx v = cmul(cc, ap);
      *(unsigned*)(W2 + ((size_t)g * 512 + t * 16 + hp) * 768 + 512 + d * 128 + 2 * pp) = cvt_pk_bf16(v.re, -v.im);
    }
    return;
  }
  task -= NT_W2S;
  if (task < NT_W1) {
    const int idx = task * 512 + tid;
    const int j = idx & 31, pp = (idx >> 5) & 63, d = (idx >> 11) & 1, g = idx >> 12;
    const int li = ((l * 2 + d) * 16 + g);
    const float dt = expf(p.log_dt[li]); const float lre = p.lam_re[li * 64 + pp], lim = p.lam_im[li * 64 + pp];
    const cpx e = cmul(s5_apow<true>(lre, lim, dt, d == 0 ? (float)(TCH - 1 - j) : (float)j), s5_coef<false>(lre, lim, dt));
    const float* bre = p.b_re + ((size_t)li * 64 + pp) * 16; const float* bim = p.b_im + ((size_t)li * 64 + pp) * 16;
    bf16_t* r0 = W1 + ((size_t)g * 256 + d * 128 + 2 * pp) * 512 + j * 16;
    bf16_t* r1 = r0 + 512;
#pragma unroll
    for (int h = 0; h < 16; h += 2) {
      const cpx v0 = cmul(e, (cpx){bre[h], bim[h]}), v1 = cmul(e, (cpx){bre[h + 1], bim[h + 1]});
      *(unsigned*)(r0 + h) = cvt_pk_bf16(v0.re, v1.re); *(unsigned*)(r1 + h) = cvt_pk_bf16(v0.im, v1.im);
    }
    return;
  }
  task -= NT_W1;
  {
    bf16_t* W16 = (bf16_t*)(ws + OFF_SGUWT);
    for (int it = 0; it < 4; ++it) {
      const int idx = ((task * 4 + it) * 512 + tid) * 2;
      const float* sp = p.sgu_w + (size_t)l * 65536 + idx;
      *(unsigned*)(W16 + idx) = cvt_pk_bf16(sp[0], sp[1]);
    }
  }
}


__device__ __forceinline__ bool filler_range(int wg, int G, int first, int& start, int& stride) {
  if (G > first) { if (wg < first) return false; start = wg - first; stride = G - first; return true; }
  start = wg; stride = G; return true;
}
constexpr int PT_WIN0 = 0, PT_FF0 = NT_WIN, PT_WBR0 = NT_WIN + NT_FF1 + NT_FF2 + NT_OUT, PT_G10 = PT_WBR0 + NT_BR;
constexpr int PT_NMID = NT_FF1 + NT_FF2 + NT_OUT, PT_NG1 = NT_PREP - PT_G10;

__device__ void norm_rows(const P& p, const float* hL, const float* hC, const float* gvec, const float* modbase, int shift_idx, int nrows, const float* resmod  ) {
  const int tid = otid(); const int lane = tid & 63, wid = tid >> 6;
  bf16_t* A = (bf16_t*)(p.ws + OFF_A);
  const int stride = gridDim.x * 8;
  int row = blockIdx.x * 8 + wid;
  for (; row + 3 * stride < ML; row += 4 * stride) {
    f32x4 v[4][4]; float rstd[4];
#pragma unroll
    for (int r = 0; r < 4; ++r)
#pragma unroll
      for (int i = 0; i < 4; ++i) v[r][i] = *(const f32x4*)(hL + (size_t)(row + r * stride) * 1024 + i * 256 + lane * 4);
#pragma unroll
    for (int r = 0; r < 4; ++r) {
      float ss = 0.f;
#pragma unroll
      for (int i = 0; i < 4; ++i) ss += v[r][i][0] * v[r][i][0] + v[r][i][1] * v[r][i][1] + v[r][i][2] * v[r][i][2] + v[r][i][3] * v[r][i][3];
      ss = wave_sum(ss, lane);
      rstd[r] = rsqrtf(ss * (1.f / 1024.f) + 1e-6f);
    }
#pragma unroll
    for (int i = 0; i < 4; ++i) {
      const int c = i * 256 + lane * 4;
      const f32x4 g = *(const f32x4*)(gvec + c);
#pragma unroll
      for (int r = 0; r < 4; ++r) {
        const int rr = row + r * stride;
        const float* sh = modbase + (size_t)(rr >> 11) * 6144 + shift_idx * 1024;
        const f32x4 s1 = *(const f32x4*)(sh + 1024 + c), s0 = *(const f32x4*)(sh + c);
        f32x4 y;
#pragma unroll
        for (int q = 0; q < 4; ++q) y[q] = (v[r][i][q] * rstd[r] * g[q]) * (1.f + s1[q]) + s0[q];
        u32x2 o; o[0] = cvt_pk_bf16(y[0], y[1]); o[1] = cvt_pk_bf16(y[2], y[3]);
        *(u32x2*)(A + (size_t)rr * 1024 + c) = o;
      }
    }
  }
  for (; row < nrows; row += stride) {
    const float* h = row < ML ? hL + (size_t)row * 1024 : hC + (size_t)(row - ML) * 1024;
    const int bsel = row < ML ? (row >> 11) : 8;
    const float* sh = modbase + (size_t)bsel * 6144 + shift_idx * 1024; const float* sc = sh + 1024;
    f32x4 v[4]; float ss = 0.f;
#pragma unroll
    for (int i = 0; i < 4; ++i) v[i] = *(const f32x4*)(h + i * 256 + lane * 4);
    if (resmod && row >= ML) {
      const bf16_t* pr = (const bf16_t*)(p.ws + OFF_PART) + (size_t)(row - ML) * 1024;
      float* hw = (float*)(p.ws + OFF_H) + (size_t)row * 1024;
#pragma unroll
      for (int i = 0; i < 4; ++i) {
        const int c = i * 256 + lane * 4;
        f32x4 sm = {0.f, 0.f, 0.f, 0.f};
#pragma unroll
        for (int sl = 0; sl < 8; ++sl) { const u32x2 w = *(const u32x2*)(pr + (size_t)sl * MC * 1024 + c); sm[0] += bflo(w[0]); sm[1] += bfhi(w[0]); sm[2] += bflo(w[1]); sm[3] += bfhi(w[1]); }
        v[i] += *(const f32x4*)(resmod + c) * sm;
        *(f32x4*)(hw + c) = v[i];
      }
    }
#pragma unroll
    for (int i = 0; i < 4; ++i) ss += v[i][0] * v[i][0] + v[i][1] * v[i][1] + v[i][2] * v[i][2] + v[i][3] * v[i][3];
    ss = wave_sum(ss, lane);
    const float rstd = rsqrtf(ss * (1.f / 1024.f) + 1e-6f);
#pragma unroll
    for (int i = 0; i < 4; ++i) {
      const int c = i * 256 + lane * 4;
      const f32x4 g = *(const f32x4*)(gvec + c), s1 = *(const f32x4*)(sc + c), s0 = *(const f32x4*)(sh + c);
      f32x4 y;
#pragma unroll
      for (int q = 0; q < 4; ++q) y[q] = (v[i][q] * rstd * g[q]) * (1.f + s1[q]) + s0[q];
      u32x2 o; o[0] = cvt_pk_bf16(y[0], y[1]); o[1] = cvt_pk_bf16(y[2], y[3]);
      *(u32x2*)(A + (size_t)row * 1024 + c) = o;
    }
  }
}

__device__ void final_rows(const P& p) {
  const int tid = otid(); const int lane = tid & 63, wid = tid >> 6;
  const float* H = (const float*)(p.ws + OFF_H);
  for (int row = blockIdx.x * 8 + wid; row < ML; row += gridDim.x * 8) {
    const float* h = H + (size_t)row * 1024;
    f32x4 v[4]; float ss = 0.f;
#pragma unroll
    for (int i = 0; i < 4; ++i) { v[i] = *(const f32x4*)(h + i * 256 + lane * 4); ss += v[i][0] * v[i][0] + v[i][1] * v[i][1] + v[i][2] * v[i][2] + v[i][3] * v[i][3]; }
    ss = wave_sum(ss, lane);
    const float rstd = rsqrtf(ss * (1.f / 1024.f) + 1e-6f);
#pragma unroll
    for (int i = 0; i < 4; ++i) {
      const int c = i * 256 + lane * 4;
      const f32x4 g = *(const f32x4*)(p.final_g + c);
      f32x4 y;
#pragma unroll
      for (int q = 0; q < 4; ++q) y[q] = v[i][q] * rstd * g[q];
      *(f32x4*)(p.out + (size_t)row * 1024 + c) = y;
    }
  }
}

template <bool LAT>
__device__ __forceinline__ void attn_task(const P& p, int task, int l, const float* rpb_lds, int lane) {
  constexpr int NG = LAT ? 16 : 8;
  const bf16_t* PS = (const bf16_t*)(p.ws + OFF_PS);
  const bf16_t* VT = (const bf16_t*)(p.ws + OFF_VT);
  const bf16_t* KT = (const bf16_t*)(p.ws + OFF_KT);
  bf16_t* Y4 = (bf16_t*)(p.ws + OFF_Y4);
  int b, head, r = 0, jb = 0, qrow0;
  if (LAT) { jb = task & 3; r = (task >> 2) & 31; head = (task >> 7) & 3; b = task >> 9; qrow0 = b * 2048 + r * 64 + jb * 16; }
  else { const int qb = task & 15; head = (task >> 4) & 3; b = task >> 6; qrow0 = ML + b * 256 + qb * 16; }
  const int n = lane & 15, kg = lane >> 4;
  const bf16_t* qp = PS + (size_t)(qrow0 + n) * 2304 + 256 + head * 64 + kg * 8;
  const bf16x8 q0 = *(const bf16x8*)qp, q1 = *(const bf16x8*)(qp + 32);
  const int rs = LAT ? min(max(r - 4, 0), 24) : 0;
  const int clo = LAT ? (jb == 0 ? 0 : jb == 1 ? 8 : jb == 2 ? 24 : 32) : 0;
  const int keyX = 8 * (n >> 2) + (n & 3);
  f32x4 s[NG][2];
#pragma unroll
  for (int gb = 0; gb < NG; gb += 4) {
    bf16x8 kf[4][4];
#pragma unroll
    for (int g4 = 0; g4 < 4; ++g4) {
      const int gi = gb + g4;
      int tk0;
      if (LAT && gi < 8) tk0 = (rs + gi) * 64 + clo; else tk0 = 2048 + (gi - (LAT ? 8 : 0)) * 32;
      const bf16_t* kp = KT + ((size_t)(b * 4 + head) * 2304 + tk0 + keyX) * 64 + kg * 8;
      kf[g4][0] = *(const bf16x8*)kp; kf[g4][1] = *(const bf16x8*)(kp + 32);
      kf[g4][2] = *(const bf16x8*)(kp + 4 * 64); kf[g4][3] = *(const bf16x8*)(kp + 4 * 64 + 32);
    }
    __builtin_amdgcn_sched_barrier(0);
#pragma unroll
    for (int g4 = 0; g4 < 4; ++g4) {
      const int gi = gb + g4;
      f32x4 z = {0.f, 0.f, 0.f, 0.f};
      s[gi][0] = __builtin_amdgcn_mfma_f32_16x16x32_bf16(kf[g4][0], q0, z, 0, 0, 0);
      s[gi][0] = __builtin_amdgcn_mfma_f32_16x16x32_bf16(kf[g4][1], q1, s[gi][0], 0, 0, 0);
      s[gi][1] = __builtin_amdgcn_mfma_f32_16x16x32_bf16(kf[g4][2], q0, z, 0, 0, 0);
      s[gi][1] = __builtin_amdgcn_mfma_f32_16x16x32_bf16(kf[g4][3], q1, s[gi][1], 0, 0, 0);
    }
    __builtin_amdgcn_sched_barrier(0);
  }
  float mx = -3.0e38f;
  const int jq = jb * 16 + n; const int cs = min(max(jq - 8, 0), 48);
#pragma unroll
  for (int gi = 0; gi < NG; ++gi)
#pragma unroll
    for (int blk = 0; blk < 2; ++blk)
#pragma unroll
      for (int i = 0; i < 4; ++i) {
        float v = s[gi][blk][i] * 0.125f;
        if (LAT && gi < 8) {
          const int kc = clo + 8 * kg + blk * 4 + i;
          const bool ok = (kc >= cs) && (kc < cs + 16);
          const int dr = rs + gi - r + 7; const int dc = min(max(kc - jq + 15, 0), 30);
          const float bias = rpb_lds[(head * 15 + dr) * 31 + dc];
          v = ok ? v + bias : -1.0e30f;
        }
        s[gi][blk][i] = v; mx = fmaxf(mx, v);
      }
  mx = fmaxf(mx, shx(mx, 16, lane)); mx = fmaxf(mx, shx(mx, 32, lane));
  float sum = 0.f;
#pragma unroll
  for (int gi = 0; gi < NG; ++gi)
#pragma unroll
    for (int blk = 0; blk < 2; ++blk)
#pragma unroll
      for (int i = 0; i < 4; ++i) { const float e = __expf(s[gi][blk][i] - mx); s[gi][blk][i] = e; sum += e; }
  sum += shx(sum, 16, lane); sum += shx(sum, 32, lane);
  f32x4 o[4];
#pragma unroll
  for (int db = 0; db < 4; ++db) o[db] = (f32x4){0.f, 0.f, 0.f, 0.f};
  const bf16_t* vbase = VT + ((size_t)(b * 4 + head) * 288 + kg) * 512 + n * 8;
#pragma unroll
  for (int gb = 0; gb < NG; gb += 2) {
    bf16x8 vf[2][4];
#pragma unroll
    for (int g4 = 0; g4 < 2; ++g4) {
      const int gi = gb + g4;
      int tok0;
      if (LAT && gi < 8) tok0 = (rs + gi) * 64 + clo; else tok0 = 2048 + (gi - (LAT ? 8 : 0)) * 32;
#pragma unroll
      for (int db = 0; db < 4; ++db) vf[g4][db] = *(const bf16x8*)(vbase + (size_t)(tok0 >> 3) * 512 + db * 128);
    }
    __builtin_amdgcn_sched_barrier(0);
#pragma unroll
    for (int g4 = 0; g4 < 2; ++g4) {
      const int gi = gb + g4;
      const u32x4 pk = pack8(s[gi][0], s[gi][1]);
      bf16x8 pf; __builtin_memcpy(&pf, &pk, 16);
#pragma unroll
      for (int db = 0; db < 4; ++db) o[db] = __builtin_amdgcn_mfma_f32_16x16x32_bf16(vf[g4][db], pf, o[db], 0, 0, 0);
    }
    __builtin_amdgcn_sched_barrier(0);
  }
  const float inv = 1.f / sum;
  bf16_t* op = Y4 + (size_t)(qrow0 + n) * 1024 + 256 + head * 64 + kg * 4;
#pragma unroll
  for (int db = 0; db < 4; ++db) {
    u32x2 w; w[0] = cvt_pk_bf16(o[db][0] * inv, o[db][1] * inv); w[1] = cvt_pk_bf16(o[db][2] * inv, o[db][3] * inv);
    *(u32x2*)(op + db * 16) = w;
  }
}

__device__ __forceinline__ void conv_task(const P& p, int l, int task) {
  const bf16_t* PS = (const bf16_t*)(p.ws + OFF_PS);
  bf16_t* Y4 = (bf16_t*)(p.ws + OFF_Y4);
  const int idx = task * 512 + otid();
  const int row = idx >> 5, c0 = (idx & 31) * 8;
  int pos, len; if (row < ML) { pos = row & 2047; len = 2048; } else { pos = (row - ML) & 255; len = 256; }
  const bf16_t* base = PS + (size_t)row * 2304;
  float z[3][8];
#pragma unroll
  for (int d = 0; d < 3; ++d) {
    const int pp = pos + d - 1;
    if (pp >= 0 && pp < len) {
      const u32x4 cv = *(const u32x4*)(base + (d - 1) * 2304 + 5 * 256 + c0), xv = *(const u32x4*)(base + (d - 1) * 2304 + 6 * 256 + c0);
#pragma unroll
      for (int i = 0; i < 4; ++i) { z[d][2 * i] = bflo(cv[i]) * bflo(xv[i]); z[d][2 * i + 1] = bfhi(cv[i]) * bfhi(xv[i]); }
    } else {
#pragma unroll
      for (int i = 0; i < 8; ++i) z[d][i] = 0.f;
    }
  }
  const u32x4 bv = *(const u32x4*)(base + 4 * 256 + c0);
  const float* w = p.conv_w + (size_t)l * 3 * 256 + c0;
  float y[8];
#pragma unroll
  for (int i = 0; i < 8; ++i) y[i] = w[i] * z[0][i] + w[256 + i] * z[1][i] + w[512 + i] * z[2][i];
  u32x4 o;
#pragma unroll
  for (int i = 0; i < 4; ++i) o[i] = cvt_pk_bf16(bflo(bv[i]) * y[2 * i], bfhi(bv[i]) * y[2 * i + 1]);
  *(u32x4*)(Y4 + (size_t)row * 1024 + 512 + c0) = o;
}

__device__ void sgu_task(const P& p, int l, int task, float* lds) {
  const int tid = otid();
  const bf16_t* PS = (const bf16_t*)(p.ws + OFF_PS);
  bf16_t* Y4 = (bf16_t*)(p.ws + OFF_Y4);
  const bf16_t* W16 = (const bf16_t*)(p.ws + OFF_SGUWT);
  const int chunk = task >> 2, g = task & 3;
  bf16_t* vnT = (bf16_t*)lds;
  constexpr int VS = 136;
  {
    const int s = tid >> 2, q = tid & 3;
    const bf16_t* vr = PS + (size_t)(chunk * 128 + s) * 2304 + 8 * 256;
    float sm = 0.f, sq = 0.f;
#pragma unroll
    for (int i = 0; i < 8; ++i) {
      const u32x4 v = *(const u32x4*)(vr + q * 64 + i * 8);
#pragma unroll
      for (int k = 0; k < 4; ++k) { const float a = bflo(v[k]), b = bfhi(v[k]); sm += a + b; sq += a * a + b * b; }
    }
    { const int ln = tid & 63; sm += shx(sm, 1, ln); sm += shx(sm, 2, ln); sq += shx(sq, 1, ln); sq += shx(sq, 2, ln); }
    const float mu = sm * (1.f / 256.f); const float var = fmaxf(sq * (1.f / 256.f) - mu * mu, 0.f); const float rstd = rsqrtf(var + 1e-6f);
    const int cb = g * 64 + q * 16;
    const float* lg = p.ln_g + l * 256 + cb; const float* lb = p.ln_b + l * 256 + cb;
#pragma unroll
    for (int i = 0; i < 2; ++i) {
      const u32x4 v = *(const u32x4*)(vr + cb + i * 8);
#pragma unroll
      for (int k = 0; k < 4; ++k) {
        const int cc = i * 8 + 2 * k;
        const unsigned pk = cvt_pk_bf16((bflo(v[k]) - mu) * rstd * lg[cc] + lb[cc], (bfhi(v[k]) - mu) * rstd * lg[cc + 1] + lb[cc + 1]);
        vnT[(q * 16 + cc) * VS + s] = (bf16_t)(pk & 0xffffu);
        vnT[(q * 16 + cc + 1) * VS + s] = (bf16_t)(pk >> 16);
      }
    }
  }
  __syncthreads();
  const int lane = tid & 63, w = tid >> 6, n = lane & 15, kg = lane >> 4;
  const int t = w * 16 + n;
  const bf16_t* wp = W16 + ((size_t)(g * 128 + t)) * 128 + kg * 8;
  bf16x8 wf[4];
#pragma unroll
  for (int ks = 0; ks < 4; ++ks) wf[ks] = *(const bf16x8*)(wp + ks * 32);
  f32x4 acc[4];
#pragma unroll
  for (int cb = 0; cb < 4; ++cb) {
    acc[cb] = (f32x4){0.f, 0.f, 0.f, 0.f};
#pragma unroll
    for (int ks = 0; ks < 4; ++ks) {
      const bf16x8 vf = *(const bf16x8*)(vnT + (cb * 16 + n) * VS + ks * 32 + kg * 8);
      acc[cb] = __builtin_amdgcn_mfma_f32_16x16x32_bf16(vf, wf[ks], acc[cb], 0, 0, 0);
    }
  }
  const int row = chunk * 128 + t;
  const float bs = p.sgu_b[((size_t)l * 4 + g) * 128 + t];
#pragma unroll
  for (int cb = 0; cb < 4; ++cb) {
    const int c = g * 64 + cb * 16 + kg * 4;
    const u32x2 uv = *(const u32x2*)(PS + (size_t)row * 2304 + 7 * 256 + c);
    u32x2 o; o[0] = cvt_pk_bf16(bflo(uv[0]) * (acc[cb][0] + bs), bfhi(uv[0]) * (acc[cb][1] + bs)); o[1] = cvt_pk_bf16(bflo(uv[1]) * (acc[cb][2] + bs), bfhi(uv[1]) * (acc[cb][3] + bs));
    *(u32x2*)(Y4 + (size_t)row * 1024 + 768 + c) = o;
  }
  __syncthreads();
}

__device__ void carry_phase(const P& p, int l) {
  const int gt = blockIdx.x * 512 + otid();
  if (gt >= 16 * 8 * 2 * 64) return;
  const int pp = gt & 63, d = (gt >> 6) & 1, b = (gt >> 7) & 7, g = gt >> 10;
  const float* S = (const float*)(p.ws + OFF_S) + (size_t)g * NCHUNK * 256 + d * 128 + 2 * pp;
  bf16_t* XU = (bf16_t*)(p.ws + OFF_XU) + (size_t)g * XUR * XUK + 512 + d * 128 + 2 * pp;
  const int li = ((l * 2 + d) * 16 + g);
  const float dt = expf(p.log_dt[li]);
  const cpx aT = s5_apow<false>(p.lam_re[li * 64 + pp], p.lam_im[li * 64 + pp], dt, (float)TCH);
  cpx st = {0.f, 0.f};
  for (int i0 = 0; i0 < 72; i0 += 8) {
    float sre[8], sim[8]; int rows[8];
#pragma unroll
    for (int k = 0; k < 8; ++k) {
      const int i = i0 + k; int row;
      if (i < 8) row = 512 + b * 8 + (d == 0 ? i : 7 - i); else row = b * 64 + (d == 0 ? (i - 8) : 63 - (i - 8));
      rows[k] = row; const float2 v = *(const float2*)(S + (size_t)row * 256); sre[k] = v.x; sim[k] = v.y;
    }
#pragma unroll
    for (int k = 0; k < 8; ++k) {
      *(unsigned*)(XU + (size_t)rows[k] * XUK) = cvt_pk_bf16(st.re, st.im);
      const cpx ns = cmul(aT, st); st.re = ns.re + sre[k]; st.im = ns.im + sim[k];
    }
  }
}

constexpr int PH_PER_LAYER = 11;
constexpr int N_PHASES = 1 + NDEPTH * PH_PER_LAYER + 1;

__global__ void __launch_bounds__(512, 2) mk_forward(P p_arg) {
  extern __shared__ __attribute__((aligned(16))) unsigned char shm[];
  LAS unsigned char* lds = (LAS unsigned char*)shm;
  float* ldsf = (float*)shm;
  unsigned char* ws0 = p_arg.ws;
  volatile LAS unsigned* xbw = (volatile LAS unsigned*)(lds + 131072);
  if (threadIdx.x == 0) { xbw[0] = 0u; xbw[1] = 0u; xbw[2] = 0u; xbw[3] = 0u; }
  __syncthreads();
  const XcdBarrier xb = xcd_barrier_post((unsigned*)(ws0 + OFF_BAR), xbw);
  if (p_arg.ph_lo < 0) cg::this_grid().sync();

  for (int ph = p_arg.ph_lo; ph < p_arg.ph_hi; ++ph) {
    int nrep = 1;
#if DBL_MASK
    { const int spx = (ph == 0) ? 11 : (ph == N_PHASES - 1) ? 13 : (ph - 1) % PH_PER_LAYER; if ((DBL_MASK >> spx) & 1) nrep = 2; }
#endif
    for (int rep = 0; rep < nrep; ++rep) {
    if (rep) xcd_barrier(xb);
    int G_ = gridDim.x, wg_ = blockIdx.x; asm volatile("" : "+s"(G_), "+s"(wg_));
    const int G = G_, wg = wg_;
    unsigned char* ws = ws0; asm volatile("" : "+s"(ws));
    P p = p_arg; p.ws = ws;
    float* H = (float*)(ws + OFF_H);
    const float* MOD = (const float*)(ws + OFF_MOD);
    if (ph == 0) {
      for (int t = wg; t < 192; t += G) mod_task(p, t, ldsf);
      for (int t = (wg + G - (192 % G)) % G; t < NT_WIN + NT_BR; t += G) prep_task(p, 0, t < NT_WIN ? t : PT_WBR0 + (t - NT_WIN), ldsf);
    } else if (ph == N_PHASES - 1) {
      final_rows(p);
#if TSEL
      xcd_barrier(xb);
      if (wg == 0) { const unsigned long long* ts = (const unsigned long long*)(ws + OFF_BAR + 14336); const unsigned long long v = ts[TSEL - 1]; const int N = (int)(TSEL == 3 ? v * 1000 : v / 10);
        for (int i = otid(); i < N && i < 300000; i += 512) p.out[(size_t)i * 16] += 0.125f; }
#endif
    } else {
      const int l = (ph - 1) / PH_PER_LAYER, sp = (ph - 1) % PH_PER_LAYER;
      const bool last = (l == NDEPTH - 1);
      const float* hL = l == 0 ? p.x : H; const float* hC = l == 0 ? p.ctx : H + (size_t)ML * 1024;
      const float* modl = MOD + (size_t)l * 9 * 6144;
      const int nMrows = last ? 64 : 72;
      switch (sp) {
#if PHMASK & 1
        case 0: {
          for (int t = wg; t < PT_NG1; t += G) prep_task(p, l, PT_G10 + t, ldsf);
          norm_rows(p, hL, hC, p.norm_g + (size_t)(l * 2 + 0) * 1024, modl, 0, MT, l > 0 ? MOD + ((size_t)(l - 1) * 9 + 8) * 6144 + 5 * 1024 : nullptr);
        } break;
#endif
#if PHMASK & 2
        case 1: {
          G1Sched S{(const char*)(ws + OFF_A), (const char*)(ws + OFF_WIN), G, wg, last ? 1 : 0};
          EpiG1 E{(bf16_t*)(ws + OFF_PS), (bf16_t*)(ws + OFF_XU), (bf16_t*)(ws + OFF_VT), (bf16_t*)(ws + OFF_KT)};
          gemm_phase(lds, 1024, 1024, S, E, (TSEL && TPHASE == 1 && wg == 0) ? (unsigned long long*)(ws + OFF_BAR + 14336) : nullptr);
        } break;
#endif
#if PHMASK & 4
        case 2: {
          {
            S5Sched S{(const char*)(ws + OFF_XU), (const char*)(ws + OFF_W1), (size_t)256 * 512 * 2, 0, 3, 1, 8, G, wg};
            EpiS1 E{(float*)(ws + OFF_S)};
            gemm_phase(lds, XUK, 512, S, E);
          }
          __syncthreads();
          const int tid2 = otid(), lane2 = tid2 & 63, wid2 = tid2 >> 6;
          for (int i = tid2; i < 4 * 15 * 31; i += 512) ldsf[i] = p.rpb[(size_t)l * 4 * 15 * 31 + i];
          __syncthreads();
          const int nwaves = G * 8, gw = wg * 8 + wid2;
#if TSEL
          unsigned long long* tsl = (unsigned long long*)(ws + OFF_BAR + 14336); const unsigned long long tq0 = __builtin_amdgcn_s_memrealtime();
#endif
          for (int t = gw; t < 4096; t += nwaves) attn_task<true>(p, t, l, ldsf, lane2);
          if (!last) for (int t = nwaves - 1 - gw; t < 512; t += nwaves) attn_task<false>(p, t, l, ldsf, lane2);
#if TSEL
          __syncthreads(); const unsigned long long tq1 = __builtin_amdgcn_s_memrealtime();
#endif
        } break;
#endif
#if PHMASK & 8
        case 3: {
          carry_phase(p, l);
          const int nconv = (last ? ML : MT) * 32 / 512;
          int st, sd; if (filler_range(wg, G, 32, st, sd)) for (int t = st; t < nconv; t += sd) conv_task(p, l, t);
        } break;
#endif
#if PHMASK & 16
        case 4: {
          S5Sched S{(const char*)(ws + OFF_XU), (const char*)(ws + OFF_W2), (size_t)512 * 768 * 2, (size_t)256 * 768 * 2, last ? 2 : 3, 2, 12, G, wg};
          EpiS2 E{(bf16_t*)(ws + OFF_YG), last ? 512 : NCHUNK};
          gemm_phase(lds, XUK, 768, S, E);
          const int nsgu = (last ? 128 : 144) * 4;
          { int st, sd; if (filler_range(wg, G, 96, st, sd)) { __syncthreads(); for (int t = st; t < nsgu / 2; t += sd) sgu_task(p, l, t, ldsf); } }
        } break;
#endif
#if PHMASK & 32
        case 5: {
          RectSched S{(const char*)(ws + OFF_YG), (const char*)(ws + OFF_WGLU), (size_t)256 * 256 * 2, 0, nMrows, 1, 4, G, wg};
          EpiGLU E{(const bf16_t*)(ws + OFF_YG), p.glu_b + l * 256, (bf16_t*)(ws + OFF_Y4)};
          gemm_phase(lds, 256, 256, S, E);
          const int nsgu = (last ? 128 : 144) * 4;
          { int st, sd; if (filler_range(wg, G, 72, st, sd)) { __syncthreads(); for (int t = nsgu / 2 + st; t < nsgu; t += sd) sgu_task(p, l, t, ldsf); } }
        } break;
#endif
#if PHMASK & 64
        case 6: {
          MergeSched S{(const char*)(ws + OFF_A), (const char*)(ws + OFF_Y4), (const char*)(ws + OFF_WIN), (const char*)(ws + OFF_WBR), last ? 0 : 128, G, wg};
          EpiMerge E{ws + OFF_GS + (size_t)wg * 65536, (bf16_t*)(ws + OFF_MIXTMP + (size_t)wg * 131072), (bf16_t*)(ws + OFF_MIX), (bf16_t*)(ws + OFF_GP)};
          gemm_phase(lds, 1024, 1024, S, E, (TSEL && TPHASE == 6 && wg == 0) ? (unsigned long long*)(ws + OFF_BAR + 14336) : nullptr);
          { int st, sd; if (filler_range(wg, G, last ? 0 : 128, st, sd)) for (int t = st; t < PT_NMID; t += sd) prep_task(p, l, PT_FF0 + t, ldsf); }
        } break;
#endif
#if PHMASK & 128
        case 7: {
          WoutSched S{(const char*)(ws + OFF_MIX), (const char*)(ws + OFF_GP), (const char*)(ws + OFF_WOUT), last ? 0 : 256, G, wg};
          EpiRes E{hL, hC, H, modl, 2, (float*)(ws + OFF_PART)};
          gemm_phase(lds, 1024, 1024, S, E);
        } break;
#endif
#if PHMASK & 256
        case 8: {
          norm_rows(p, H, l == 0 ? p.ctx : H + (size_t)ML * 1024, p.norm_g + (size_t)(l * 2 + 1) * 1024, modl, 3, last ? ML : MT, modl + (size_t)8 * 6144 + 2 * 1024);
          if (!last) for (int t = wg; t < NT_BR; t += G) prep_task(p, l + 1, PT_WBR0 + t, ldsf);
        } break;
#endif
#if PHMASK & 512
        case 9: {
          RectSched S{(const char*)(ws + OFF_A), (const char*)(ws + OFF_WFF1), (size_t)256 * 1024 * 2, (size_t)256 * 1024 * 2, nMrows, 16, 16, G, wg};
          EpiFF1 E{(bf16_t*)(ws + OFF_FFH)};
          gemm_phase(lds, 1024, 1024, S, E, (TSEL && TPHASE == 9 && wg == 0) ? (unsigned long long*)(ws + OFF_BAR + 14336) : nullptr);
          if (!last) { int st, sd; if (filler_range(wg, G, 128, st, sd)) for (int t = st; t < NT_WIN; t += sd) prep_task(p, l + 1, t, ldsf); }
        } break;
#endif
#if PHMASK & 1024
        case 10: {
          SplitSched S{(const char*)(ws + OFF_FFH), (const char*)(ws + OFF_WFF2), (const char*)(ws + OFF_FFH) + (size_t)64 * 256 * 4096 * 2, (size_t)256 * 4096 * 2, (size_t)256 * 4096 * 2, (size_t)256 * 4096 * 2, 64, 8, 256, last ? 0 : 256, G, wg};
          EpiRes E{H, H + (size_t)ML * 1024, H, modl, 5, (float*)(ws + OFF_PART)};
          gemm_phase(lds, 4096, 4096, S, E);
        } break;
#endif
      }
    }
    }
    if (ph + 1 < p_arg.ph_hi) { xcd_barrier(xb);
#if (DBL_MASK >> 12) & 1
      xcd_barrier(xb);
#endif
    }
  }
}

extern "C" void kernel_launch(void* const* d_in, const int* in_sizes, int n_in, void* d_out, int out_size, void* d_ws, size_t ws_size, hipStream_t stream) {
  constexpr size_t kDynLds = 131072 + 16;
  static int grid_blocks = 0;
  if (!grid_blocks) {
    (void)hipFuncSetAttribute((const void*)mk_forward, hipFuncAttributeMaxDynamicSharedMemorySize, (int)kDynLds);
    int dev = 0, cus = 0, per_cu = 0;
    (void)hipGetDevice(&dev);
    (void)hipDeviceGetAttribute(&cus, hipDeviceAttributeMultiprocessorCount, dev);
    (void)hipOccupancyMaxActiveBlocksPerMultiprocessor(&per_cu, mk_forward, 512, kDynLds);
    if (per_cu < 1) per_cu = 1;
    grid_blocks = cus;
  }
  P p{};
  const float** pp = (const float**)&p;
  for (int i = 0; i < 29; ++i) pp[i] = (const float*)d_in[i];
  p.out = (float*)d_out; p.ws = (unsigned char*)d_ws;
  (void)hipMemsetAsync((unsigned char*)d_ws + OFF_BAR, 0, 16384, stream);
#if MULTI_LAUNCH
  for (int ph = 0; ph < N_PHASES; ++ph) {
    p.ph_lo = ph; p.ph_hi = ph + 1;
    hipLaunchKernelGGL(mk_forward, dim3(grid_blocks), dim3(512), kDynLds, stream, p);
  }
#else
  p.ph_lo = 0; p.ph_hi = N_PHASES;
  void* args[] = {&p};
  (void)hipLaunchCooperativeKernel((void*)mk_forward, dim3(grid_blocks), dim3(512), args, kDynLds, stream);
#endif
}
```

```cpp
#include <hip/hip_runtime.h>
#include <hip/hip_cooperative_groups.h>
namespace cg = cooperative_groups;

#define LAS __attribute__((address_space(3)))
typedef unsigned short bf16_t;
typedef short bf16x8 __attribute__((ext_vector_type(8)));
typedef float f32x4 __attribute__((ext_vector_type(4)));
typedef unsigned u32x4 __attribute__((ext_vector_type(4)));
typedef unsigned u32x2 __attribute__((ext_vector_type(2)));

#ifndef PHMASK
#define PHMASK 0x7ff
#endif
#ifndef DBL_MASK
#define DBL_MASK 0
#endif
#ifndef TSEL
#define TSEL 0
#endif
#ifndef TPHASE
#define TPHASE 6
#endif
#ifndef MULTI_LAUNCH
#define MULTI_LAUNCH 0
#endif

constexpr int DM = 1024, NB = 8, SEQL = 2048, NDEPTH = 4, CTXL = 256, DFF = 4096, INW = 6400;
constexpr int ML = NB * SEQL;
constexpr int MC = NB * CTXL;
constexpr int MT = ML + MC;
constexpr int TCH = 32;
constexpr int NCHUNK = MT / TCH;
constexpr int XUR = 768;
constexpr int XUK = 768;

constexpr size_t OFF_H = 0;
constexpr size_t OFF_A = OFF_H + (size_t)MT * DM * 4;
constexpr size_t OFF_MIX = OFF_A + (size_t)MT * DM * 2;
constexpr size_t OFF_R1 = OFF_MIX + (size_t)MT * DM * 2;
constexpr size_t OFF_PS = OFF_R1;
constexpr size_t OFF_Y4 = OFF_PS + (size_t)MT * 2304 * 2;
constexpr size_t OFF_VT = OFF_Y4 + (size_t)MT * DM * 2;
constexpr size_t OFF_XU = OFF_VT + (size_t)NB * 4 * 64 * 2304 * 2;
constexpr size_t OFF_S = OFF_XU + (size_t)16 * XUR * XUK * 2;
constexpr size_t OFF_YG = OFF_S + (size_t)16 * NCHUNK * 256 * 4;
constexpr size_t OFF_R1END = OFF_YG + (size_t)MT * 256 * 2;
constexpr size_t OFF_FFH = OFF_R1;
constexpr size_t OFF_MIXTMP = OFF_PS;
constexpr size_t OFF_KT = OFF_YG;
constexpr size_t OFF_GS = OFF_VT;
constexpr size_t OFF_WIN = OFF_R1END;
constexpr size_t OFF_WFF1 = OFF_WIN + (size_t)INW * DM * 2;
constexpr size_t OFF_WFF2 = OFF_WFF1 + (size_t)DFF * DM * 2;
constexpr size_t OFF_WOUT = OFF_WFF2 + (size_t)DFF * DM * 2;
constexpr size_t OFF_WBR = OFF_WOUT + (size_t)DM * DM * 2;
constexpr size_t OFF_WGLU = OFF_WBR + (size_t)DM * DM * 2;
constexpr size_t OFF_W1 = OFF_WGLU + (size_t)256 * 256 * 2;
constexpr size_t OFF_W2 = OFF_W1 + (size_t)16 * 256 * 512 * 2;
constexpr size_t OFF_SGUWT = OFF_W2 + (size_t)16 * 512 * 768 * 2;
constexpr size_t OFF_MOD = OFF_SGUWT + (size_t)4 * 128 * 128 * 4;
constexpr size_t OFF_BAR = OFF_MOD + (size_t)NDEPTH * 9 * 6144 * 4;
constexpr size_t OFF_PART = OFF_BAR + 16384;
constexpr size_t OFF_END = OFF_PART + (size_t)8 * MC * DM * 4;
constexpr size_t OFF_KTAB = OFF_END;
static_assert(OFF_KTAB + (size_t)16 * 2 * 32 * 256 * 4 <= 453000000ull, "KTAB");
constexpr size_t OFF_GP = OFF_PS + (size_t)256 * 262144;
static_assert(OFF_GP + (size_t)MC * 4096 * 2 <= OFF_Y4, "GP alias");
static_assert((size_t)MT * DFF * 2 <= OFF_R1END - OFF_R1, "FFH alias");
static_assert((size_t)256 * 262144 <= (size_t)MT * 2304 * 2, "MIXTMP alias");
static_assert((size_t)256 * 131072 <= OFF_R1END - OFF_VT, "GS alias");
static_assert(OFF_END < 452000000ull, "workspace");

struct P {
  const float *x, *c, *ctx, *c_ctx, *ada_w, *ada_b, *norm_g, *final_g, *w_in, *w_branch, *w_out,
      *lam_re, *lam_im, *log_dt, *b_re, *b_im, *c_re, *c_im, *s5_d, *glu_w, *glu_b, *rpb, *conv_w,
      *ln_g, *ln_b, *sgu_w, *sgu_b, *w_ff1, *w_ff2;
  float* out;
  unsigned char* ws;
  int ph_lo, ph_hi;
};

__device__ __forceinline__ int otid() { int t = threadIdx.x; asm volatile("" : "+v"(t)); return t; }
__device__ __forceinline__ float bf2f(bf16_t b) { return __uint_as_float(((unsigned)b) << 16); }
__device__ __forceinline__ float bflo(unsigned w) { return __uint_as_float(w << 16); }
__device__ __forceinline__ float bfhi(unsigned w) { return __uint_as_float(w & 0xffff0000u); }
__device__ __forceinline__ unsigned cvt_pk_bf16(float lo, float hi) { unsigned r; asm volatile("v_cvt_pk_bf16_f32 %0, %1, %2" : "=v"(r) : "v"(lo), "v"(hi)); return r; }
__device__ __forceinline__ float sigm(float x) { return 1.f / (1.f + __expf(-x)); }
__device__ __forceinline__ float gelu_tanh(float x) { return x * sigm(1.5957691216057308f * (x + 0.044715f * x * x * x)); }
__device__ __forceinline__ u32x4 pack8(f32x4 a, f32x4 b) { u32x4 r; r[0] = cvt_pk_bf16(a[0], a[1]); r[1] = cvt_pk_bf16(a[2], a[3]); r[2] = cvt_pk_bf16(b[0], b[1]); r[3] = cvt_pk_bf16(b[2], b[3]); return r; }
__device__ __forceinline__ float shx(float v, int o, int lane) { return __int_as_float(__builtin_amdgcn_ds_bpermute((lane ^ o) << 2, __float_as_int(v))); }
__device__ __forceinline__ float wave_sum(float v, int lane) {
#pragma unroll
  for (int o = 32; o >= 1; o >>= 1) v += shx(v, o, lane);
  return v;
}


#define XB_TMO      128
#define XB_XCNT(j)  (256  + 64 * (j))
#define XB_XSUB(j)  (1280 + 64 * (j))
#define XB_XGEN(j)  (2304 + 64 * (j))
#define XB_TOP      3328
#define XB_TOPGEN   3392
#define XCD_BAR_WORDS 3456
#define XB_SPIN_CAP (1u << 22)
__device__ __forceinline__ unsigned xb_ld(unsigned* p)              { return __hip_atomic_load(p, __ATOMIC_RELAXED, __HIP_MEMORY_SCOPE_AGENT); }
__device__ __forceinline__ unsigned xb_add(unsigned* p, unsigned v) { return __hip_atomic_fetch_add(p, v, __ATOMIC_RELAXED, __HIP_MEMORY_SCOPE_AGENT); }
__device__ __forceinline__ unsigned xb_xcc_id() { return (unsigned)__builtin_amdgcn_s_getreg((3 << 11) | 20) & 0xFu; }
#define XB_SPIN(cond, bar) do { unsigned _sp = 0; while (cond) { __builtin_amdgcn_s_sleep(1); \
    if ((++_sp & 255u) == 0u) { if (xb_ld(&(bar)[XB_TMO])) break; if (_sp > XB_SPIN_CAP) { atomicAdd(&(bar)[XB_TMO], 1u); break; } } } } while (0)
struct XcdBarrier { unsigned* bar; unsigned x; volatile LAS unsigned* st; };
__device__ __forceinline__ XcdBarrier xcd_barrier_post(unsigned* bar, volatile LAS unsigned* st) {
  XcdBarrier b; b.bar = bar; b.x = xb_xcc_id(); b.st = st;
  if (threadIdx.x == 0) (void)xb_add(&bar[XB_XCNT(b.x)], 1u);
  return b;
}
__device__ __forceinline__ void xcd_barrier_complete(unsigned* bar, unsigned x, unsigned& nloc, unsigned& nx) {
  const unsigned G = gridDim.x * gridDim.y * gridDim.z;
  unsigned sum, cnt, mine, sp = 0u;
  for (;;) {
    sum = 0u; cnt = 0u; mine = 0u;
#pragma unroll
    for (unsigned j = 0; j < 16; ++j) { const unsigned c = xb_ld(&bar[XB_XCNT(j)]); sum += c; cnt += (c > 0u) ? 1u : 0u; mine = (j == x) ? c : mine; }
    if (sum == G) break;
    __builtin_amdgcn_s_sleep(1);
    if ((++sp & 255u) == 0u) { if (xb_ld(&bar[XB_TMO])) break; if (sp > XB_SPIN_CAP) { atomicAdd(&bar[XB_TMO], 1u); break; } }
  }
  nloc = mine > 0u ? mine : 1u; nx = cnt > 0u ? cnt : 1u;
}
__device__ __forceinline__ void xcd_barrier(const XcdBarrier& b) {
  asm volatile("s_waitcnt vmcnt(0)" ::: "memory");
  __syncthreads();
  if (threadIdx.x == 0) {
    unsigned* bar = b.bar;
    __builtin_amdgcn_s_waitcnt(0);
    unsigned nloc = b.st[0], nx = b.st[1];
    if (nloc == 0u) { xcd_barrier_complete(bar, b.x, nloc, nx); b.st[0] = nloc; b.st[1] = nx; }
    const unsigned old = xb_add(&bar[XB_XSUB(b.x)], 1u);
    const unsigned gen = old / nloc;
    if (old + 1u == (gen + 1u) * nloc) {
      __builtin_amdgcn_fence(__ATOMIC_RELEASE, "agent");
      asm volatile("s_waitcnt vmcnt(0)" ::: "memory");
      const unsigned og = xb_add(&bar[XB_TOP], 1u);
      const unsigned tg = og / nx;
      if (og + 1u == (tg + 1u) * nx) xb_add(&bar[XB_TOPGEN], 1u);
      else XB_SPIN(xb_ld(&bar[XB_TOPGEN]) == tg, bar);
      __builtin_amdgcn_fence(__ATOMIC_ACQUIRE, "agent");
      xb_add(&bar[XB_XGEN(b.x)], 1u);
      asm volatile("s_waitcnt vmcnt(0)" ::: "memory");
    } else {
      XB_SPIN(xb_ld(&bar[XB_XGEN(b.x)]) == gen, bar);
      __builtin_amdgcn_fence(__ATOMIC_ACQUIRE, "agent");
      asm volatile("s_waitcnt vmcnt(0)" ::: "memory");
    }
  }
  __syncthreads();
}

constexpr int BM = 256, BK = 64, HALF = 128, HTB = HALF * BK * 2, NXCD = 8, WGM = 8;
__device__ __forceinline__ int lds_byte(int r, int c) { const int st = (r >> 4) * 2 + (c >> 5), rr = r & 15, cc = c & 31, ob = rr * 64 + cc * 2; return st * 1024 + (ob ^ (((ob >> 9) & 1) << 5)); }
__device__ __forceinline__ void stage_rc(int b, int& R, int& C) { const int st = b / 1024, sb = b % 1024, swz = sb ^ (((sb >> 9) & 1) << 5); R = (st >> 1) * 16 + swz / 64; C = (st & 1) * 32 + (swz % 64) / 2; }
__device__ __forceinline__ int perm32(int rho) { const int n = rho >> 4, i = rho & 15; return 8 * (i >> 2) + 4 * n + (i & 3); }

struct Unit { const char* A; const char* B; int nt, pm, pn, kind; };

__device__ __forceinline__ void rect_map(int L, int nM, int nN, int& pm, int& pn) {
  const int nwg = nM * nN; int wgid = L;
  { const int q = nwg / NXCD, r = nwg % NXCD, xcd = wgid % NXCD, off = wgid / NXCD; wgid = (xcd < r ? xcd * (q + 1) : r * (q + 1) + (xcd - r) * q) + off; }
  const int nig = WGM * nN, gid = wgid / nig, fm = gid * WGM, gsz = (nM - fm) < WGM ? (nM - fm) : WGM;
  pm = fm + ((wgid % nig) % gsz); pn = (wgid % nig) / gsz;
}

template <class Sched, class Epi>
__device__ __forceinline__ void gemm_phase(LAS unsigned char* lds, const int lda, const int ldb, const Sched& S, const Epi& E, unsigned long long* tslot = nullptr) {
#if TSEL
  const unsigned long long tg0 = __builtin_amdgcn_s_memrealtime();
#endif
  int tid_ = threadIdx.x; asm volatile("" : "+v"(tid_));
  const int tid = tid_, wid = __builtin_amdgcn_readfirstlane(tid >> 6), lane = tid & 63, wr = wid >> 2, wc = wid & 3, fr = lane & 15, fq = lane >> 4;
  unsigned voffA[2], voffB[2];
#pragma unroll
  for (int i = 0; i < 2; ++i) { int R, C; stage_rc(tid * 16 + i * 8192, R, C); const int Rb = (R & ~31) + perm32(R & 31);
    voffA[i] = (unsigned)(R * lda + C) * 2u; voffB[i] = (unsigned)(Rb * ldb + C) * 2u; }
  const size_t kstep = (size_t)(BK * 2);
  const size_t hstepA = (size_t)HALF * lda * 2, hstepB = (size_t)HALF * ldb * 2;
  const unsigned ldsw = (unsigned)wid * 1024u;
  const int aoff = lds_byte(wr * 64 + fr, fq * 8), boff = lds_byte(wc * 32 + fr, fq * 8);
#define PG8_SA(b, h) (((b) * 2 + (h)) * HTB)
#define PG8_SB(b, h) ((4 + (b) * 2 + (h)) * HTB)
#define PG8_STAGE(bufoff, gbase, voff) do { _Pragma("unroll") for (int _i = 0; _i < 2; ++_i) \
    __builtin_amdgcn_global_load_lds((const unsigned*)((const char*)(gbase) + (voff)[_i]), (LAS unsigned*)(lds + (bufoff) + ldsw + _i * 8192), 16, 0, 0); } while (0)
#define PG8_LDA(dst, b, h) do { _Pragma("unroll") for (int m = 0; m < 4; ++m) _Pragma("unroll") for (int k = 0; k < 2; ++k) dst[m][k] = *(const LAS bf16x8*)(lds + PG8_SA(b, h) + aoff + m * 2048 + k * 1024); } while (0)
#define PG8_LDB(dst, b, h) do { _Pragma("unroll") for (int n = 0; n < 2; ++n) _Pragma("unroll") for (int k = 0; k < 2; ++k) dst[n][k] = *(const LAS bf16x8*)(lds + PG8_SB(b, h) + boff + n * 2048 + k * 1024); } while (0)
#define PG8_MMA(ai, bj, At, Bt) do { __builtin_amdgcn_s_setprio(1); _Pragma("unroll") for (int m = 0; m < 4; ++m) _Pragma("unroll") for (int n = 0; n < 2; ++n) _Pragma("unroll") for (int k = 0; k < 2; ++k) \
    acc[ai][bj][m][n] = __builtin_amdgcn_mfma_f32_16x16x32_bf16(Bt[n][k], At[m][k], acc[ai][bj][m][n], 0, 0, 0); __builtin_amdgcn_s_setprio(0); } while (0)
#define PG8_WAIT_V(n) asm volatile("s_waitcnt vmcnt(" #n ")" ::: "memory")
#define PG8_WAIT_L(n) asm volatile("s_waitcnt lgkmcnt(" #n ")" ::: "memory")
#define PG8_BAR __builtin_amdgcn_s_barrier()
#define PG8_SCHED __builtin_amdgcn_sched_barrier(0)
  Unit cur, nxt; int ui = 0;
  if (!S.next(0, cur)) return;
  f32x4 acc[2][2][4][2];
#pragma unroll
  for (int a = 0; a < 2; ++a)
#pragma unroll
    for (int b = 0; b < 2; ++b)
#pragma unroll
      for (int m = 0; m < 4; ++m)
#pragma unroll
        for (int n = 0; n < 2; ++n) acc[a][b][m][n] = (f32x4){0.f, 0.f, 0.f, 0.f};
  bf16x8 At[4][2], B0[2][2], B1[2][2];
  const char* cA = cur.A; const char* cB = cur.B;
  PG8_STAGE(PG8_SB(0, 0), cB, voffB); PG8_STAGE(PG8_SA(0, 0), cA, voffA); PG8_STAGE(PG8_SB(0, 1), cB + hstepB, voffB); PG8_STAGE(PG8_SA(0, 1), cA + hstepA, voffA);
  if (wr == 1) PG8_BAR;
  PG8_WAIT_V(4); PG8_BAR;
  PG8_STAGE(PG8_SB(1, 0), cB + kstep, voffB); PG8_STAGE(PG8_SA(1, 0), cA + kstep, voffA); PG8_STAGE(PG8_SB(1, 1), cB + hstepB + kstep, voffB);
  PG8_WAIT_V(6); PG8_BAR;
  for (;;) {
    const bool has_next = S.next(ui + 1, nxt);
    const char* nA = has_next ? nxt.A : cA; const char* nB = has_next ? nxt.B : cB;
    const int nt = cur.nt;
#if TSEL
    const unsigned long long tk0 = __builtin_amdgcn_s_memrealtime();
#endif
    for (int t = 0; t < nt; t += 2) {
      const bool last = (t == nt - 2);
      const char* a1 = cA + (size_t)(t + 1) * kstep;
      const char* a2 = last ? nA : cA + (size_t)(t + 2) * kstep; const char* b2 = last ? nB : cB + (size_t)(t + 2) * kstep;
      const char* a3 = a2 + kstep; const char* b3 = b2 + kstep;
      PG8_LDB(B0, 0, 0); PG8_SCHED; PG8_LDA(At, 0, 0); PG8_STAGE(PG8_SA(1, 1), a1 + hstepA, voffA);
      PG8_WAIT_L(8); PG8_BAR; PG8_WAIT_L(0); PG8_MMA(0, 0, At, B0); PG8_BAR; PG8_SCHED;
      PG8_LDB(B1, 0, 1); PG8_STAGE(PG8_SB(0, 0), b2, voffB);
      PG8_BAR; PG8_WAIT_L(0); PG8_MMA(0, 1, At, B1); PG8_BAR;
      PG8_LDA(At, 0, 1); PG8_STAGE(PG8_SA(0, 0), a2, voffA);
      PG8_BAR; PG8_WAIT_L(0); PG8_MMA(1, 0, At, B0); PG8_BAR; PG8_SCHED;
      PG8_STAGE(PG8_SB(0, 1), b2 + hstepB, voffB);
      PG8_WAIT_V(6); PG8_BAR; PG8_MMA(1, 1, At, B1); PG8_BAR;
      PG8_LDB(B0, 1, 0); PG8_SCHED; PG8_LDA(At, 1, 0); PG8_STAGE(PG8_SA(0, 1), a2 + hstepA, voffA);
      PG8_WAIT_L(8); PG8_BAR; PG8_WAIT_L(0); PG8_MMA(0, 0, At, B0); PG8_BAR; PG8_SCHED;
      PG8_LDB(B1, 1, 1); PG8_STAGE(PG8_SB(1, 0), b3, voffB);
      PG8_BAR; PG8_WAIT_L(0); PG8_MMA(0, 1, At, B1); PG8_BAR;
      PG8_LDA(At, 1, 1); PG8_STAGE(PG8_SA(1, 0), a3, voffA);
      PG8_BAR; PG8_WAIT_L(0); PG8_MMA(1, 0, At, B0); PG8_BAR; PG8_SCHED;
      PG8_STAGE(PG8_SB(1, 1), b3 + hstepB, voffB);
      PG8_WAIT_V(6); PG8_BAR; PG8_MMA(1, 1, At, B1); PG8_BAR;
    }
#if TSEL
    const unsigned long long te0 = __builtin_amdgcn_s_memrealtime();
    if (tslot && tid == 0) tslot[3 + (cur.kind & 1)] += te0 - tk0;
#endif
    { const int t2 = otid(); E(acc, cur, wr, wc, t2 & 15, (t2 & 63) >> 4); }
#if TSEL
    if (tslot && tid == 0) { asm volatile("s_waitcnt vmcnt(0)" ::: "memory"); tslot[0] += __builtin_amdgcn_s_memrealtime() - te0; tslot[2] += 1; }
#endif
    if (!has_next) break;
#pragma unroll
    for (int a = 0; a < 2; ++a)
#pragma unroll
      for (int b = 0; b < 2; ++b)
#pragma unroll
        for (int m = 0; m < 4; ++m)
#pragma unroll
          for (int n = 0; n < 2; ++n) acc[a][b][m][n] = (f32x4){0.f, 0.f, 0.f, 0.f};
    cur = nxt; cA = nA; cB = nB; ++ui;
  }
  PG8_WAIT_V(0);
  if (wr == 0) PG8_BAR;
  PG8_BAR;
#if TSEL
  if (tslot && tid == 0) tslot[1] += __builtin_amdgcn_s_memrealtime() - tg0;
#endif
#undef PG8_SA
#undef PG8_SB
#undef PG8_STAGE
#undef PG8_LDA
#undef PG8_LDB
#undef PG8_MMA
#undef PG8_WAIT_V
#undef PG8_WAIT_L
#undef PG8_BAR
#undef PG8_SCHED
}

typedef f32x4 Acc[2][2][4][2];
#define EPI_ROWS(u, wr, fr) \
  _Pragma("unroll") for (int ai = 0; ai < 2; ++ai) _Pragma("unroll") for (int m = 0; m < 4; ++m)
#define EPI_ROW(u, wr, fr) ((u).pm * 256 + ai * 128 + (wr) * 64 + m * 16 + (fr))
#define EPI_COL(wc, fq) (bj * 128 + (wc) * 32 + (fq) * 8)

__device__ __forceinline__ int bsel_of_tile(int pm) { return pm < 64 ? (pm >> 3) : 8; }

struct RectSched {
  const char* A; const char* B; size_t a_tile, b_tile; int nM, nN, nt, G, c;
  __device__ __forceinline__ bool next(int i, Unit& u) const {
    const int L = i * G + c; if (L >= nM * nN) return false;
    int pm, pn; rect_map(L, nM, nN, pm, pn);
    u.pm = pm; u.pn = pn; u.kind = 0; u.nt = nt; u.A = A + (size_t)pm * a_tile; u.B = B + (size_t)pn * b_tile; return true;
  }
};
struct G1Sched {
  const char* A; const char* B; int G, c, last;
  __device__ __forceinline__ bool next(int i, Unit& u) const {
    const int L = i * G + c; const int nl = 64 * 9, ncx = last ? 24 : 72;
    if (L >= nl + ncx) return false;
    int pm, pn;
    if (L < nl) rect_map(L, 64, 9, pm, pn);
    else { const int q = L - nl; if (last) { pm = 64 + q / 3; const int s = q % 3; pn = s == 0 ? 0 : (s + 1); } else { pm = 64 + q / 9; pn = q % 9; } }
    u.pm = pm; u.pn = pn; u.kind = 0; u.nt = 16; u.A = A + (size_t)pm * (256 * 1024 * 2); u.B = B + (size_t)pn * (256 * 1024 * 2); return true;
  }
};
struct S5Sched {
  const char* A; const char* B; size_t b_group, b_tile; int nMs, nN, nt, G, c;
  __device__ __forceinline__ bool next(int i, Unit& u) const {
    const int L = i * G + c; if (L >= 16 * nMs * nN) return false;
    const int g = L / (nMs * nN), r = L % (nMs * nN), pm = r / nN, pn = r % nN;
    u.pm = pm; u.pn = pn; u.kind = g; u.nt = nt;
    u.A = A + ((size_t)g * XUR + (size_t)pm * 256) * XUK * 2; u.B = B + (size_t)g * b_group + (size_t)pn * b_tile; return true;
  }
};
struct MergeSched {
  const char* Abuf; const char* Y4; const char* Win; const char* Wbr; int ncx, G, c;
  __device__ __forceinline__ bool next(int i, Unit& u) const {
    const int nlat = (256 - c + G - 1) / G;
    int pm, pd, k, j;
    if (i < 8 * nlat) { const int su = (i >> 3) * G + c; j = i & 7; k = j >> 1; const int x = su & 7, sl = su >> 3; pd = sl & 3; pm = x * 8 + (sl >> 2); u.kind = j; }
    else { const int i2 = i - 8 * nlat; const int q = (i2 >> 1) * G + c; if (q >= ncx) return false; j = i2 & 1; const int x = q & 7, sl = q >> 3; k = sl & 3; pd = sl >> 2; pm = 64 + x; u.kind = 8 + 2 * k + j; }
    u.pm = pm; u.pn = pd;
    if (!(j & 1)) { u.nt = 16; u.A = Abuf + (size_t)pm * (256 * 1024 * 2); u.B = Win + (size_t)(2304 + k * 1024 + pd * 256) * (1024 * 2); }
    else { u.nt = 4; u.A = Y4 + (size_t)pm * (256 * 1024 * 2) + (size_t)k * 512; u.B = Wbr + (size_t)(pd * 256) * (1024 * 2) + (size_t)k * 512; }
    return true;
  }
};
struct WoutSched {
  const char* MIXb; const char* GPb; const char* B; int ncx, G, c;
  __device__ __forceinline__ bool next(int i, Unit& u) const {
    const int L = i * G + c;
    if (L < 256) { int pm, pn; rect_map(L, 64, 4, pm, pn); u.pm = pm; u.pn = pn; u.kind = 0; u.nt = 16; u.A = MIXb + (size_t)pm * (256 * 1024 * 2); u.B = B + (size_t)pn * (256 * 1024 * 2); return true; }
    const int q = L - 256; if (q >= ncx) return false;
    const int ks = q & 7, pn = (q >> 3) & 3, pmc = q >> 5;
    u.pm = 64 + pmc; u.pn = pn; u.kind = 1 + ks; u.nt = 8;
    u.A = GPb + ((size_t)(ks >> 1) * MC + (size_t)pmc * 256) * (1024 * 2) + (size_t)(ks & 1) * 1024; u.B = B + (size_t)pn * (256 * 1024 * 2) + (size_t)(ks & 1) * 1024; return true;
  }
};
struct SplitSched {
  const char* A; const char* B; const char* Ac; size_t a_tile, b_tile, ac_tile; int nt, nts, nlat, ncx, G, c;
  __device__ __forceinline__ bool next(int i, Unit& u) const {
    const int L = i * G + c;
    if (L < nlat) { int pm, pn; rect_map(L, 64, 4, pm, pn); u.pm = pm; u.pn = pn; u.kind = 0; u.nt = nt; u.A = A + (size_t)pm * a_tile; u.B = B + (size_t)pn * b_tile; return true; }
    const int q = L - nlat; if (q >= ncx) return false;
    const int ks = q & 7, pn = (q >> 3) & 3, pmc = q >> 5;
    u.pm = 64 + pmc; u.pn = pn; u.kind = 1 + ks; u.nt = nts;
    u.A = Ac + (size_t)pmc * ac_tile + (size_t)ks * nts * 128; u.B = B + (size_t)pn * b_tile + (size_t)ks * nts * 128; return true;
  }
};

struct EpiG1 {
  bf16_t* PS; bf16_t* XU; bf16_t* VT; bf16_t* KT;
  __device__ __forceinline__ void operator()(const Acc& acc, const Unit& u, int wr, int wc, int fr, int fq) const {
    if (u.pn == 3) {
      const int voff = (wc >> 1) * (288 * 512) + ((wc & 1) * 32 + fq * 8) * 8;
      EPI_ROWS(u, wr, fr) {
        const int row = EPI_ROW(u, wr, fr);
        int b, tok; if (row < ML) { b = row >> 11; tok = row & 2047; } else { const int r2 = row - ML; b = r2 >> 8; tok = 2048 + (r2 & 255); }
        bf16_t* rb = VT + ((size_t)(b * 4) * 288 + (tok >> 3)) * 512 + (tok & 7) + voff;
#pragma unroll
        for (int bj = 0; bj < 2; ++bj) {
          const u32x4 pk = pack8(acc[ai][bj][m][0], acc[ai][bj][m][1]);
          bf16_t* base = rb + bj * (2 * 288 * 512);
#pragma unroll
          for (int i = 0; i < 4; ++i) { base[(2 * i) * 8] = (bf16_t)(pk[i] & 0xffffu); base[(2 * i + 1) * 8] = (bf16_t)(pk[i] >> 16); }
        }
      }
      return;
    }
    EPI_ROWS(u, wr, fr) {
      const int row = EPI_ROW(u, wr, fr);
#pragma unroll
      for (int bj = 0; bj < 2; ++bj) {
        const int c = EPI_COL(wc, fq);
        const u32x4 pk = pack8(acc[ai][bj][m][0], acc[ai][bj][m][1]);
        if (u.pn == 0) {
          const int g = c >> 4, h0 = c & 15;
          *(u32x4*)(XU + ((size_t)(g * XUR + (row >> 5)) * XUK + (row & 31) * 16 + h0)) = pk;
        } else if (u.pn == 2) {
          int b, tok; if (row < ML) { b = row >> 11; tok = row & 2047; } else { const int r2 = row - ML; b = r2 >> 8; tok = 2048 + (r2 & 255); }
          *(u32x4*)(KT + (((size_t)(b * 4 + (c >> 6)) * 2304 + tok) * 64 + (c & 63))) = pk;
        } else {
          *(u32x4*)(PS + (size_t)row * 2304 + u.pn * 256 + c) = pk;
        }
      }
    }
  }
};
struct EpiS1 {
  float* S;
  __device__ __forceinline__ void operator()(const Acc& acc, const Unit& u, int wr, int wc, int fr, int fq) const {
    EPI_ROWS(u, wr, fr) {
      const int row = EPI_ROW(u, wr, fr);
      if (row < NCHUNK) {
#pragma unroll
        for (int bj = 0; bj < 2; ++bj) {
          const int c = EPI_COL(wc, fq);
          float* dst = S + ((size_t)u.kind * NCHUNK + row) * 256 + c;
          *(f32x4*)dst = acc[ai][bj][m][0]; *(f32x4*)(dst + 4) = acc[ai][bj][m][1];
        }
      }
    }
  }
};
struct EpiS2 {
  bf16_t* YG; int rowlim;
  __device__ __forceinline__ void operator()(const Acc& acc, const Unit& u, int wr, int wc, int fr, int fq) const {
    EPI_ROWS(u, wr, fr) {
      const int row = EPI_ROW(u, wr, fr);
      if (row < rowlim) {
#pragma unroll
        for (int bj = 0; bj < 2; ++bj) {
          const int col = u.pn * 256 + EPI_COL(wc, fq);
          const int t = col >> 4, h0 = col & 15;
          f32x4 a = acc[ai][bj][m][0], b = acc[ai][bj][m][1];
#pragma unroll
          for (int i = 0; i < 4; ++i) { a[i] = gelu_tanh(a[i]); b[i] = gelu_tanh(b[i]); }
          *(u32x4*)(YG + ((size_t)(row * TCH + t)) * 256 + u.kind * 16 + h0) = pack8(a, b);
        }
      }
    }
  }
};
struct EpiGLU {
  const bf16_t* YG; const float* bias; bf16_t* Y4;
  __device__ __forceinline__ void operator()(const Acc& acc, const Unit& u, int wr, int wc, int fr, int fq) const {
    EPI_ROWS(u, wr, fr) {
      const int row = EPI_ROW(u, wr, fr);
#pragma unroll
      for (int bj = 0; bj < 2; ++bj) {
        const int c = EPI_COL(wc, fq);
        const u32x4 gv = *(const u32x4*)(YG + (size_t)row * 256 + c);
        const f32x4 b0 = *(const f32x4*)(bias + c), b1 = *(const f32x4*)(bias + c + 4);
        f32x4 a = acc[ai][bj][m][0] + b0, b = acc[ai][bj][m][1] + b1;
        a[0] = bflo(gv[0]) * sigm(a[0]); a[1] = bfhi(gv[0]) * sigm(a[1]); a[2] = bflo(gv[1]) * sigm(a[2]); a[3] = bfhi(gv[1]) * sigm(a[3]);
        b[0] = bflo(gv[2]) * sigm(b[0]); b[1] = bfhi(gv[2]) * sigm(b[1]); b[2] = bflo(gv[3]) * sigm(b[2]); b[3] = bfhi(gv[3]) * sigm(b[3]);
        *(u32x4*)(Y4 + (size_t)row * 1024 + c) = pack8(a, b);
      }
    }
  }
};
struct EpiMerge {
  unsigned char* GS; bf16_t* TMP; bf16_t* MIX; bf16_t* GP;
  __device__ __forceinline__ void operator()(const Acc& acc, const Unit& u, int wr, int wc, int fr, int fq) const {
    const int tid = otid(); const int j = u.kind, k = j >> 1;
    EPI_ROWS(u, wr, fr) {
#pragma unroll
      for (int bj = 0; bj < 2; ++bj) {
        const int e = (ai * 4 + m) * 2 + bj;
        unsigned char* gs = GS + ((size_t)e * 512 + tid) * 8;
        bf16_t* tp = TMP + ((size_t)e * 512 + tid) * 8;
        if (!(j & 1)) {
          const f32x4 a = acc[ai][bj][m][0], b = acc[ai][bj][m][1];
          u32x2 q;
          q[0] = (unsigned)(sigm(a[0]) * 255.f + 0.5f) | ((unsigned)(sigm(a[1]) * 255.f + 0.5f) << 8) | ((unsigned)(sigm(a[2]) * 255.f + 0.5f) << 16) | ((unsigned)(sigm(a[3]) * 255.f + 0.5f) << 24);
          q[1] = (unsigned)(sigm(b[0]) * 255.f + 0.5f) | ((unsigned)(sigm(b[1]) * 255.f + 0.5f) << 8) | ((unsigned)(sigm(b[2]) * 255.f + 0.5f) << 16) | ((unsigned)(sigm(b[3]) * 255.f + 0.5f) << 24);
          *(u32x2*)gs = q;
        } else {
          const u32x2 q = *(const u32x2*)gs;
          f32x4 a = acc[ai][bj][m][0], b = acc[ai][bj][m][1];
          const float sc = 1.f / 255.f;
#pragma unroll
          for (int i = 0; i < 4; ++i) { a[i] *= (float)((q[0] >> (8 * i)) & 255u) * sc; b[i] *= (float)((q[1] >> (8 * i)) & 255u) * sc; }
          if (j >= 8) {
            const int row = EPI_ROW(u, wr, fr) - ML; const int c = u.pn * 256 + EPI_COL(wc, fq);
            *(u32x4*)(GP + ((size_t)(k - 4) * MC + row) * 1024 + c) = pack8(a, b);
          } else {
            if (k > 0) { const u32x4 t = *(const u32x4*)tp; a[0] += bflo(t[0]); a[1] += bfhi(t[0]); a[2] += bflo(t[1]); a[3] += bfhi(t[1]); b[0] += bflo(t[2]); b[1] += bfhi(t[2]); b[2] += bflo(t[3]); b[3] += bfhi(t[3]); }
            if (k < 3) *(u32x4*)tp = pack8(a, b);
            else { const int row = EPI_ROW(u, wr, fr); const int c = u.pn * 256 + EPI_COL(wc, fq); *(u32x4*)(MIX + (size_t)row * 1024 + c) = pack8(a, b); }
          }
        }
      }
    }
  }
};
struct EpiRes {
  const float* hL; const float* hC; float* H; const float* modbase; int modidx; float* PART;
  __device__ __forceinline__ void operator()(const Acc& acc, const Unit& u, int wr, int wc, int fr, int fq) const {
    if (u.kind) {
      bf16_t* pb = (bf16_t*)PART + (size_t)(u.kind - 1) * MC * 1024;
      EPI_ROWS(u, wr, fr) {
        const int row = EPI_ROW(u, wr, fr) - ML;
#pragma unroll
        for (int bj = 0; bj < 2; ++bj) {
          const int c = u.pn * 256 + EPI_COL(wc, fq);
          *(u32x4*)(pb + (size_t)row * 1024 + c) = pack8(acc[ai][bj][m][0], acc[ai][bj][m][1]);
        }
      }
      return;
    }
    const float* mv = modbase + (size_t)bsel_of_tile(u.pm) * 6144 + modidx * 1024;
    EPI_ROWS(u, wr, fr) {
      const int row = EPI_ROW(u, wr, fr);
      const float* hs = row < ML ? hL + (size_t)row * 1024 : hC + (size_t)(row - ML) * 1024;
#pragma unroll
      for (int bj = 0; bj < 2; ++bj) {
        const int c = u.pn * 256 + EPI_COL(wc, fq);
        const f32x4 h0 = *(const f32x4*)(hs + c), h1 = *(const f32x4*)(hs + c + 4);
        const f32x4 m0 = *(const f32x4*)(mv + c), m1 = *(const f32x4*)(mv + c + 4);
        float* hd = H + (size_t)row * 1024 + c;
        *(f32x4*)hd = h0 + m0 * acc[ai][bj][m][0]; *(f32x4*)(hd + 4) = h1 + m1 * acc[ai][bj][m][1];
      }
    }
  }
};
struct EpiFF1 {
  bf16_t* FFH;
  __device__ __forceinline__ void operator()(const Acc& acc, const Unit& u, int wr, int wc, int fr, int fq) const {
    EPI_ROWS(u, wr, fr) {
      const int row = EPI_ROW(u, wr, fr);
#pragma unroll
      for (int bj = 0; bj < 2; ++bj) {
        const int c = u.pn * 256 + EPI_COL(wc, fq);
        f32x4 a = acc[ai][bj][m][0], b = acc[ai][bj][m][1];
#pragma unroll
        for (int i = 0; i < 4; ++i) { a[i] = fmaxf(a[i], 0.f); a[i] *= a[i]; b[i] = fmaxf(b[i], 0.f); b[i] *= b[i]; }
        *(u32x4*)(FFH + (size_t)row * 4096 + c) = pack8(a, b);
      }
    }
  }
};

__device__ void mod_task(const P& p, int task, float* lds) {
  const int tid = otid();
  float* sc = lds;
  float* red = lds + 9 * 1024;
  for (int i = tid; i < 9 * 1024; i += 512) { const float v = i < 8192 ? p.c[i] : p.c_ctx[i - 8192]; sc[i] = v * sigm(v); }
  __syncthreads();
  const int l = task / 48, jb = task % 48, jl = tid & 127, ks = tid >> 7, j = jb * 128 + jl;
  float a[9];
#pragma unroll
  for (int s = 0; s < 9; ++s) a[s] = 0.f;
  const float* w = p.ada_w + (size_t)l * 1024 * 6144 + j;
#pragma unroll 8
  for (int k = ks * 256; k < ks * 256 + 256; ++k) {
    const float wv = w[(size_t)k * 6144];
#pragma unroll
    for (int s = 0; s < 9; ++s) a[s] += sc[s * 1024 + k] * wv;
  }
#pragma unroll
  for (int s = 0; s < 9; ++s) red[(ks * 9 + s) * 128 + jl] = a[s];
  __syncthreads();
  float* MOD = (float*)(p.ws + OFF_MOD);
  for (int i = tid; i < 9 * 128; i += 512) {
    const int s = i >> 7, jj = i & 127;
    const float v = red[(0 * 9 + s) * 128 + jj] + red[(1 * 9 + s) * 128 + jj] + red[(2 * 9 + s) * 128 + jj] + red[(3 * 9 + s) * 128 + jj];
    MOD[((size_t)l * 9 + s) * 6144 + jb * 128 + jj] = v + p.ada_b[l * 6144 + jb * 128 + jj];
  }
  __syncthreads();
}

__device__ void tr_tile(const float* src, int lds_, bf16_t* dst, int ldd, float* tile  ) {
  const int tid = otid();
#pragma unroll
  for (int ps = 0; ps < 2; ++ps) {
    const int k = (tid >> 4) + ps * 32, n4 = (tid & 15) * 4;
    const f32x4 v = *(const f32x4*)(src + (size_t)k * lds_ + n4);
    tile[k * 65 + n4] = v[0]; tile[k * 65 + n4 + 1] = v[1]; tile[k * 65 + n4 + 2] = v[2]; tile[k * 65 + n4 + 3] = v[3];
  }
  __syncthreads();
  {
    const int n = tid >> 3, k8 = (tid & 7) * 8;
    u32x4 o;
#pragma unroll
    for (int i = 0; i < 4; ++i) o[i] = cvt_pk_bf16(tile[(k8 + 2 * i) * 65 + n], tile[(k8 + 2 * i + 1) * 65 + n]);
    *(u32x4*)(dst + (size_t)n * ldd + k8) = o;
  }
  __syncthreads();
}

struct cpx { float re, im; };
__device__ __forceinline__ cpx cmul(cpx a, cpx b) { return {a.re * b.re - a.im * b.im, a.re * b.im + a.im * b.re}; }
template <bool FAST>
__device__ __forceinline__ cpx s5_apow(float lre, float lim, float dt, float e) {
  const float zr = lre * dt * e, zi = lim * dt * e;
  if (FAST) { const float mg = __expf(zr); return {mg * __cosf(zi), mg * __sinf(zi)}; }
  const float mg = expf(zr); float sn, cs; sincosf(zi, &sn, &cs); return {mg * cs, mg * sn};
}
template <bool FAST>
__device__ __forceinline__ cpx s5_coef(float lre, float lim, float dt) {
  const cpx a = s5_apow<FAST>(lre, lim, dt, 1.f); const float nr = a.re - 1.f, ni = a.im, den = lre * lre + lim * lim;
  return {(nr * lre + ni * lim) / den, (ni * lre - nr * lim) / den};
}

constexpr int NT_WIN = 1600, NT_FF1 = 1024, NT_FF2 = 1024, NT_OUT = 256, NT_BR = 256, NT_GLU = 16;
constexpr int NT_TR = NT_WIN + NT_FF1 + NT_FF2 + NT_OUT + NT_BR + NT_GLU;
constexpr int NT_TOEP = 512, NT_W2S = 256, NT_W1 = 128, NT_SGUW = 16;
constexpr int NT_PREP = NT_TR + NT_TOEP + NT_W2S + NT_W1 + NT_SGUW;

__device__ void prep_task(const P& p, int l, int task, float* lds) {
  const int tid = otid();
  unsigned char* ws = p.ws;
  if (task < NT_TR) {
    const float* src; bf16_t* dst; int N, ldd, tk, tn;
    int t = task;
    if (t < NT_WIN) { src = p.w_in + (size_t)l * 1024 * 6400; N = 6400; dst = (bf16_t*)(ws + OFF_WIN); ldd = 1024; tk = t / 100; tn = t % 100; }
    else if ((t -= NT_WIN) < NT_FF1) { src = p.w_ff1 + (size_t)l * 1024 * 4096; N = 4096; dst = (bf16_t*)(ws + OFF_WFF1); ldd = 1024; tk = t / 64; tn = t % 64; }
    else if ((t -= NT_FF1) < NT_FF2) { src = p.w_ff2 + (size_t)l * 4096 * 1024; N = 1024; dst = (bf16_t*)(ws + OFF_WFF2); ldd = 4096; tk = t / 16; tn = t % 16; }
    else if ((t -= NT_FF2) < NT_OUT) { src = p.w_out + (size_t)l * 1024 * 1024; N = 1024; dst = (bf16_t*)(ws + OFF_WOUT); ldd = 1024; tk = t / 16; tn = t % 16; }
    else if ((t -= NT_OUT) < NT_BR) { const int k = t >> 6; t &= 63; src = p.w_branch + ((size_t)l * 4 + k) * 256 * 1024; N = 1024; dst = (bf16_t*)(ws + OFF_WBR) + k * 256; ldd = 1024; tk = t / 16; tn = t % 16; }
    else { t -= NT_BR; src = p.glu_w + (size_t)l * 256 * 256; N = 256; dst = (bf16_t*)(ws + OFF_WGLU); ldd = 256; tk = t / 4; tn = t % 4; }
    tr_tile(src + (size_t)tk * 64 * N + tn * 64, N, dst + (size_t)tn * 64 * ldd + tk * 64, ldd, lds);
    return;
  }
  task -= NT_TR;
  bf16_t* W2 = (bf16_t*)(ws + OFF_W2);
  bf16_t* W1 = (bf16_t*)(ws + OFF_W1);
  if (task < NT_TOEP) {
    const int g = task >> 5, lag = task & 31;
    cpx* E = (cpx*)lds;
    float* sC = lds + 256;
    float* sB = sC + 4096;
    if (tid < 128) {
      const int d = tid >> 6, pp = tid & 63; const int li = ((l * 2 + d) * 16 + g);
      const float dt = expf(p.log_dt[li]); const float lre = p.lam_re[li * 64 + pp], lim = p.lam_im[li * 64 + pp];
      E[tid] = cmul(s5_apow<true>(lre, lim, dt, (float)lag), s5_coef<false>(lre, lim, dt));
    }
    for (int i = tid; i < 4096; i += 512) {
      const int d = i >> 11, ri = (i >> 10) & 1, r = i & 1023; const int li = ((l * 2 + d) * 16 + g);
      sC[i] = (ri ? p.c_im : p.c_re)[(size_t)li * 1024 + r];
      sB[i] = (ri ? p.b_im : p.b_re)[(size_t)li * 1024 + r];
    }
    __syncthreads();
    if (tid < 256) {
      const int hp = tid >> 4, h = tid & 15;
      float kv[2];
#pragma unroll
      for (int d = 0; d < 2; ++d) {
        const float* cre = sC + d * 2048 + hp * 64; const float* cim = cre + 1024;
        const float* bre = sB + d * 2048 + h; const float* bim = bre + 1024;
        float s = 0.f;
#pragma unroll 8
        for (int pp = 0; pp < 64; ++pp) {
          const cpx bb = cmul(E[d * 64 + pp], (cpx){bre[pp * 16], bim[pp * 16]});
          s += cre[pp] * bb.re - cim[pp] * bb.im;
        }
        kv[d] = s;
      }
      float* KT_ = (float*)(ws + OFF_KTAB);
      KT_[((size_t)(g * 2 + 0) * 32 + lag) * 256 + tid] = kv[0];
      KT_[((size_t)(g * 2 + 1) * 32 + lag) * 256 + tid] = kv[1];
    }
    __syncthreads();
    return;
  }
  task -= NT_TOEP;
  if (task < NT_W2S) {
    for (int it = 0; it < 8; ++it) {
      const int idx = (task * 8 + it) * 512 + tid;
      const int pp = idx & 63, d = (idx >> 6) & 1, hp = (idx >> 7) & 15, t = (idx >> 11) & 31, g = idx >> 16;
      const int li = ((l * 2 + d) * 16 + g);
      const float dt = expf(p.log_dt[li]); const float lre = p.lam_re[li * 64 + pp], lim = p.lam_im[li * 64 + pp];
      const cpx ap = s5_apow<true>(lre, lim, dt, d == 0 ? (float)(t + 1) : (float)(TCH - t));
      const cpx cc = {p.c_re[((size_t)li * 16 + hp) * 64 + pp], p.c_im[((size_t)li * 16 + hp) * 64 + pp]};
      const cpx v = cmul(cc, ap);
      *(unsigned*)(W2 + ((size_t)g * 512 + t * 16 + hp) * 768 + 512 + d * 128 + 2 * pp) = cvt_pk_bf16(v.re, -v.im);
    }
    return;
  }
  task -= NT_W2S;
  if (task < NT_W1) {
    const int idx = task * 512 + tid;
    const int j = idx & 31, pp = (idx >> 5) & 63, d = (idx >> 11) & 1, g = idx >> 12;
    const int li = ((l * 2 + d) * 16 + g);
    const float dt = expf(p.log_dt[li]); const float lre = p.lam_re[li * 64 + pp], lim = p.lam_im[li * 64 + pp];
    const cpx e = cmul(s5_apow<true>(lre, lim, dt, d == 0 ? (float)(TCH - 1 - j) : (float)j), s5_coef<false>(lre, lim, dt));
    const float* bre = p.b_re + ((size_t)li * 64 + pp) * 16; const float* bim = p.b_im + ((size_t)li * 64 + pp) * 16;
    bf16_t* r0 = W1 + ((size_t)g * 256 + d * 128 + 2 * pp) * 512 + j * 16;
    bf16_t* r1 = r0 + 512;
#pragma unroll
    for (int h = 0; h < 16; h += 2) {
      const cpx v0 = cmul(e, (cpx){bre[h], bim[h]}), v1 = cmul(e, (cpx){bre[h + 1], bim[h + 1]});
      *(unsigned*)(r0 + h) = cvt_pk_bf16(v0.re, v1.re); *(unsigned*)(r1 + h) = cvt_pk_bf16(v0.im, v1.im);
    }
    return;
  }
  task -= NT_W1;
  {
    bf16_t* W16 = (bf16_t*)(ws + OFF_SGUWT);
    for (int it = 0; it < 4; ++it) {
      const int idx = ((task * 4 + it) * 512 + tid) * 2;
      const float* sp = p.sgu_w + (size_t)l * 65536 + idx;
      *(unsigned*)(W16 + idx) = cvt_pk_bf16(sp[0], sp[1]);
    }
  }
}


__device__ __forceinline__ bool filler_range(int wg, int G, int first, int& start, int& stride) {
  if (G > first) { if (wg < first) return false; start = wg - first; stride = G - first; return true; }
  start = wg; stride = G; return true;
}
constexpr int PT_WIN0 = 0, PT_FF0 = NT_WIN, PT_WBR0 = NT_WIN + NT_FF1 + NT_FF2 + NT_OUT, PT_G10 = PT_WBR0 + NT_BR;
constexpr int PT_NMID = NT_FF1 + NT_FF2 + NT_OUT, PT_NG1 = NT_PREP - PT_G10;

constexpr int NT_ASM = 256;
__device__ void w2_assemble_task(const P& p, int l, int task) {
  const float* KT_ = (const float*)(p.ws + OFF_KTAB);
  bf16_t* W2 = (bf16_t*)(p.ws + OFF_W2);
  const int tid = otid();
#pragma unroll
  for (int it = 0; it < 4; ++it) {
    const int idx = (task * 4 + it) * 512 + tid;
    const int hh = (idx & 1) * 8, j = (idx >> 1) & 31, row = (idx >> 6) & 511, g = idx >> 15;
    const int t = row >> 4, hp = row & 15;
    f32x4 a = {0.f, 0.f, 0.f, 0.f}, b = {0.f, 0.f, 0.f, 0.f};
    if (j <= t) { const float* k0 = KT_ + ((size_t)(g * 2 + 0) * 32 + (t - j)) * 256 + hp * 16 + hh; a += *(const f32x4*)k0; b += *(const f32x4*)(k0 + 4); }
    if (j >= t) { const float* k1 = KT_ + ((size_t)(g * 2 + 1) * 32 + (j - t)) * 256 + hp * 16 + hh; a += *(const f32x4*)k1; b += *(const f32x4*)(k1 + 4); }
    if (j == t && (hp >> 3) == (hh >> 3)) { const float dv = p.s5_d[l * 256 + g * 16 + hp]; const int e = hp & 7; if (e < 4) a[e] += dv; else b[e - 4] += dv; }
    *(u32x4*)(W2 + ((size_t)g * 512 + row) * 768 + j * 16 + hh) = pack8(a, b);
  }
}

__device__ void norm_rows(const P& p, const float* hL, const float* hC, const float* gvec, const float* modbase, int shift_idx, int nrows, const float* resmod  ) {
  const int tid = otid(); const int lane = tid & 63, wid = tid >> 6;
  bf16_t* A = (bf16_t*)(p.ws + OFF_A);
  const int stride = gridDim.x * 8;
  int row = blockIdx.x * 8 + wid;
  for (; row + 3 * stride < ML; row += 4 * stride) {
    f32x4 v[4][4]; float rstd[4];
#pragma unroll
    for (int r = 0; r < 4; ++r)
#pragma unroll
      for (int i = 0; i < 4; ++i) v[r][i] = *(const f32x4*)(hL + (size_t)(row + r * stride) * 1024 + i * 256 + lane * 4);
#pragma unroll
    for (int r = 0; r < 4; ++r) {
      float ss = 0.f;
#pragma unroll
      for (int i = 0; i < 4; ++i) ss += v[r][i][0] * v[r][i][0] + v[r][i][1] * v[r][i][1] + v[r][i][2] * v[r][i][2] + v[r][i][3] * v[r][i][3];
      ss = wave_sum(ss, lane);
      rstd[r] = rsqrtf(ss * (1.f / 1024.f) + 1e-6f);
    }
#pragma unroll
    for (int i = 0; i < 4; ++i) {
      const int c = i * 256 + lane * 4;
      const f32x4 g = *(const f32x4*)(gvec + c);
#pragma unroll
      for (int r = 0; r < 4; ++r) {
        const int rr = row + r * stride;
        const float* sh = modbase + (size_t)(rr >> 11) * 6144 + shift_idx * 1024;
        const f32x4 s1 = *(const f32x4*)(sh + 1024 + c), s0 = *(const f32x4*)(sh + c);
        f32x4 y;
#pragma unroll
        for (int q = 0; q < 4; ++q) y[q] = (v[r][i][q] * rstd[r] * g[q]) * (1.f + s1[q]) + s0[q];
        u32x2 o; o[0] = cvt_pk_bf16(y[0], y[1]); o[1] = cvt_pk_bf16(y[2], y[3]);
        *(u32x2*)(A + (size_t)rr * 1024 + c) = o;
      }
    }
  }
  for (; row < nrows; row += stride) {
    const float* h = row < ML ? hL + (size_t)row * 1024 : hC + (size_t)(row - ML) * 1024;
    const int bsel = row < ML ? (row >> 11) : 8;
    const float* sh = modbase + (size_t)bsel * 6144 + shift_idx * 1024; const float* sc = sh + 1024;
    f32x4 v[4]; float ss = 0.f;
#pragma unroll
    for (int i = 0; i < 4; ++i) v[i] = *(const f32x4*)(h + i * 256 + lane * 4);
    if (resmod && row >= ML) {
      const bf16_t* pr = (const bf16_t*)(p.ws + OFF_PART) + (size_t)(row - ML) * 1024;
      float* hw = (float*)(p.ws + OFF_H) + (size_t)row * 1024;
#pragma unroll
      for (int i = 0; i < 4; ++i) {
        const int c = i * 256 + lane * 4;
        f32x4 sm = {0.f, 0.f, 0.f, 0.f};
#pragma unroll
        for (int sl = 0; sl < 8; ++sl) { const u32x2 w = *(const u32x2*)(pr + (size_t)sl * MC * 1024 + c); sm[0] += bflo(w[0]); sm[1] += bfhi(w[0]); sm[2] += bflo(w[1]); sm[3] += bfhi(w[1]); }
        v[i] += *(const f32x4*)(resmod + c) * sm;
        *(f32x4*)(hw + c) = v[i];
      }
    }
#pragma unroll
    for (int i = 0; i < 4; ++i) ss += v[i][0] * v[i][0] + v[i][1] * v[i][1] + v[i][2] * v[i][2] + v[i][3] * v[i][3];
    ss = wave_sum(ss, lane);
    const float rstd = rsqrtf(ss * (1.f / 1024.f) + 1e-6f);
#pragma unroll
    for (int i = 0; i < 4; ++i) {
      const int c = i * 256 + lane * 4;
      const f32x4 g = *(const f32x4*)(gvec + c), s1 = *(const f32x4*)(sc + c), s0 = *(const f32x4*)(sh + c);
      f32x4 y;
#pragma unroll
      for (int q = 0; q < 4; ++q) y[q] = (v[i][q] * rstd * g[q]) * (1.f + s1[q]) + s0[q];
      u32x2 o; o[0] = cvt_pk_bf16(y[0], y[1]); o[1] = cvt_pk_bf16(y[2], y[3]);
      *(u32x2*)(A + (size_t)row * 1024 + c) = o;
    }
  }
}

__device__ void final_rows(const P& p) {
  const int tid = otid(); const int lane = tid & 63, wid = tid >> 6;
  const float* H = (const float*)(p.ws + OFF_H);
  const int stride = gridDim.x * 8;
  for (int row = blockIdx.x * 8 + wid; row < ML; row += 4 * stride) {
    f32x4 v[4][4];
#pragma unroll
    for (int r = 0; r < 4; ++r)
#pragma unroll
      for (int i = 0; i < 4; ++i) { const int rr = row + r * stride; v[r][i] = rr < ML ? *(const f32x4*)(H + (size_t)rr * 1024 + i * 256 + lane * 4) : (f32x4){0.f, 0.f, 0.f, 0.f}; }
#pragma unroll
    for (int r = 0; r < 4; ++r) {
      const int rr = row + r * stride;
      float ss = 0.f;
#pragma unroll
      for (int i = 0; i < 4; ++i) ss += v[r][i][0] * v[r][i][0] + v[r][i][1] * v[r][i][1] + v[r][i][2] * v[r][i][2] + v[r][i][3] * v[r][i][3];
      ss = wave_sum(ss, lane);
      const float rstd = rsqrtf(ss * (1.f / 1024.f) + 1e-6f);
      if (rr < ML) {
#pragma unroll
        for (int i = 0; i < 4; ++i) {
          const int c = i * 256 + lane * 4;
          const f32x4 g = *(const f32x4*)(p.final_g + c);
          f32x4 y;
#pragma unroll
          for (int q = 0; q < 4; ++q) y[q] = v[r][i][q] * rstd * g[q];
          *(f32x4*)(p.out + (size_t)rr * 1024 + c) = y;
        }
      }
    }
  }
}

template <bool LAT>
__device__ __forceinline__ void attn_task(const P& p, int task, int l, const float* rpb_lds, int lane) {
  constexpr int NG = LAT ? 16 : 8;
  const bf16_t* PS = (const bf16_t*)(p.ws + OFF_PS);
  const bf16_t* VT = (const bf16_t*)(p.ws + OFF_VT);
  const bf16_t* KT = (const bf16_t*)(p.ws + OFF_KT);
  bf16_t* Y4 = (bf16_t*)(p.ws + OFF_Y4);
  int b, head, r = 0, jb = 0, qrow0;
  if (LAT) { jb = task & 3; r = (task >> 2) & 31; head = (task >> 7) & 3; b = task >> 9; qrow0 = b * 2048 + r * 64 + jb * 16; }
  else { const int qb = task & 15; head = (task >> 4) & 3; b = task >> 6; qrow0 = ML + b * 256 + qb * 16; }
  const int n = lane & 15, kg = lane >> 4;
  const bf16_t* qp = PS + (size_t)(qrow0 + n) * 2304 + 256 + head * 64 + kg * 8;
  const bf16x8 q0 = *(const bf16x8*)qp, q1 = *(const bf16x8*)(qp + 32);
  const int rs = LAT ? min(max(r - 4, 0), 24) : 0;
  const int clo = LAT ? (jb == 0 ? 0 : jb == 1 ? 8 : jb == 2 ? 24 : 32) : 0;
  const int keyX = 8 * (n >> 2) + (n & 3);
  f32x4 s[NG][2];
#pragma unroll
  for (int gb = 0; gb < NG; gb += 4) {
    bf16x8 kf[4][4];
#pragma unroll
    for (int g4 = 0; g4 < 4; ++g4) {
      const int gi = gb + g4;
      int tk0;
      if (LAT && gi < 8) tk0 = (rs + gi) * 64 + clo; else tk0 = 2048 + (gi - (LAT ? 8 : 0)) * 32;
      const bf16_t* kp = KT + ((size_t)(b * 4 + head) * 2304 + tk0 + keyX) * 64 + kg * 8;
      kf[g4][0] = *(const bf16x8*)kp; kf[g4][1] = *(const bf16x8*)(kp + 32);
      kf[g4][2] = *(const bf16x8*)(kp + 4 * 64); kf[g4][3] = *(const bf16x8*)(kp + 4 * 64 + 32);
    }
    __builtin_amdgcn_sched_barrier(0);
#pragma unroll
    for (int g4 = 0; g4 < 4; ++g4) {
      const int gi = gb + g4;
      f32x4 z = {0.f, 0.f, 0.f, 0.f};
      s[gi][0] = __builtin_amdgcn_mfma_f32_16x16x32_bf16(kf[g4][0], q0, z, 0, 0, 0);
      s[gi][0] = __builtin_amdgcn_mfma_f32_16x16x32_bf16(kf[g4][1], q1, s[gi][0], 0, 0, 0);
      s[gi][1] = __builtin_amdgcn_mfma_f32_16x16x32_bf16(kf[g4][2], q0, z, 0, 0, 0);
      s[gi][1] = __builtin_amdgcn_mfma_f32_16x16x32_bf16(kf[g4][3], q1, s[gi][1], 0, 0, 0);
    }
    __builtin_amdgcn_sched_barrier(0);
  }
  float mx = -3.0e38f;
  const int jq = jb * 16 + n; const int cs = min(max(jq - 8, 0), 48);
#pragma unroll
  for (int gi = 0; gi < NG; ++gi)
#pragma unroll
    for (int blk = 0; blk < 2; ++blk)
#pragma unroll
      for (int i = 0; i < 4; ++i) {
        float v = s[gi][blk][i] * 0.125f;
        if (LAT && gi < 8) {
          const int kc = clo + 8 * kg + blk * 4 + i;
          const bool ok = (kc >= cs) && (kc < cs + 16);
          const int dr = rs + gi - r + 7; const int dc = min(max(kc - jq + 15, 0), 30);
          const float bias = rpb_lds[(head * 15 + dr) * 31 + dc];
          v = ok ? v + bias : -1.0e30f;
        }
        s[gi][blk][i] = v; mx = fmaxf(mx, v);
      }
  mx = fmaxf(mx, shx(mx, 16, lane)); mx = fmaxf(mx, shx(mx, 32, lane));
  float sum = 0.f;
#pragma unroll
  for (int gi = 0; gi < NG; ++gi)
#pragma unroll
    for (int blk = 0; blk < 2; ++blk)
#pragma unroll
      for (int i = 0; i < 4; ++i) { const float e = __expf(s[gi][blk][i] - mx); s[gi][blk][i] = e; sum += e; }
  sum += shx(sum, 16, lane); sum += shx(sum, 32, lane);
  f32x4 o[4];
#pragma unroll
  for (int db = 0; db < 4; ++db) o[db] = (f32x4){0.f, 0.f, 0.f, 0.f};
  const bf16_t* vbase = VT + ((size_t)(b * 4 + head) * 288 + kg) * 512 + n * 8;
#pragma unroll
  for (int gb = 0; gb < NG; gb += 2) {
    bf16x8 vf[2][4];
#pragma unroll
    for (int g4 = 0; g4 < 2; ++g4) {
      const int gi = gb + g4;
      int tok0;
      if (LAT && gi < 8) tok0 = (rs + gi) * 64 + clo; else tok0 = 2048 + (gi - (LAT ? 8 : 0)) * 32;
#pragma unroll
      for (int db = 0; db < 4; ++db) vf[g4][db] = *(const bf16x8*)(vbase + (size_t)(tok0 >> 3) * 512 + db * 128);
    }
    __builtin_amdgcn_sched_barrier(0);
#pragma unroll
    for (int g4 = 0; g4 < 2; ++g4) {
      const int gi = gb + g4;
      const u32x4 pk = pack8(s[gi][0], s[gi][1]);
      bf16x8 pf; __builtin_memcpy(&pf, &pk, 16);
#pragma unroll
      for (int db = 0; db < 4; ++db) o[db] = __builtin_amdgcn_mfma_f32_16x16x32_bf16(vf[g4][db], pf, o[db], 0, 0, 0);
    }
    __builtin_amdgcn_sched_barrier(0);
  }
  const float inv = 1.f / sum;
  bf16_t* op = Y4 + (size_t)(qrow0 + n) * 1024 + 256 + head * 64 + kg * 4;
#pragma unroll
  for (int db = 0; db < 4; ++db) {
    u32x2 w; w[0] = cvt_pk_bf16(o[db][0] * inv, o[db][1] * inv); w[1] = cvt_pk_bf16(o[db][2] * inv, o[db][3] * inv);
    *(u32x2*)(op + db * 16) = w;
  }
}

__device__ __forceinline__ void conv_task(const P& p, int l, int task) {
  const bf16_t* PS = (const bf16_t*)(p.ws + OFF_PS);
  bf16_t* Y4 = (bf16_t*)(p.ws + OFF_Y4);
  const int idx = task * 512 + otid();
  const int row = idx >> 5, c0 = (idx & 31) * 8;
  int pos, len; if (row < ML) { pos = row & 2047; len = 2048; } else { pos = (row - ML) & 255; len = 256; }
  const bf16_t* base = PS + (size_t)row * 2304;
  float z[3][8];
#pragma unroll
  for (int d = 0; d < 3; ++d) {
    const int pp = pos + d - 1;
    if (pp >= 0 && pp < len) {
      const u32x4 cv = *(const u32x4*)(base + (d - 1) * 2304 + 5 * 256 + c0), xv = *(const u32x4*)(base + (d - 1) * 2304 + 6 * 256 + c0);
#pragma unroll
      for (int i = 0; i < 4; ++i) { z[d][2 * i] = bflo(cv[i]) * bflo(xv[i]); z[d][2 * i + 1] = bfhi(cv[i]) * bfhi(xv[i]); }
    } else {
#pragma unroll
      for (int i = 0; i < 8; ++i) z[d][i] = 0.f;
    }
  }
  const u32x4 bv = *(const u32x4*)(base + 4 * 256 + c0);
  const float* w = p.conv_w + (size_t)l * 3 * 256 + c0;
  float y[8];
#pragma unroll
  for (int i = 0; i < 8; ++i) y[i] = w[i] * z[0][i] + w[256 + i] * z[1][i] + w[512 + i] * z[2][i];
  u32x4 o;
#pragma unroll
  for (int i = 0; i < 4; ++i) o[i] = cvt_pk_bf16(bflo(bv[i]) * y[2 * i], bfhi(bv[i]) * y[2 * i + 1]);
  *(u32x4*)(Y4 + (size_t)row * 1024 + 512 + c0) = o;
}

__device__ void sgu_task(const P& p, int l, int task, float* lds) {
  const int tid = otid();
  const bf16_t* PS = (const bf16_t*)(p.ws + OFF_PS);
  bf16_t* Y4 = (bf16_t*)(p.ws + OFF_Y4);
  const bf16_t* W16 = (const bf16_t*)(p.ws + OFF_SGUWT);
  const int chunk = task >> 2, g = task & 3;
  bf16_t* vnT = (bf16_t*)lds;
  constexpr int VS = 136;
  {
    const int s = tid >> 2, q = tid & 3;
    const bf16_t* vr = PS + (size_t)(chunk * 128 + s) * 2304 + 8 * 256;
    float sm = 0.f, sq = 0.f;
#pragma unroll
    for (int i = 0; i < 8; ++i) {
      const u32x4 v = *(const u32x4*)(vr + q * 64 + i * 8);
#pragma unroll
      for (int k = 0; k < 4; ++k) { const float a = bflo(v[k]), b = bfhi(v[k]); sm += a + b; sq += a * a + b * b; }
    }
    { const int ln = tid & 63; sm += shx(sm, 1, ln); sm += shx(sm, 2, ln); sq += shx(sq, 1, ln); sq += shx(sq, 2, ln); }
    const float mu = sm * (1.f / 256.f); const float var = fmaxf(sq * (1.f / 256.f) - mu * mu, 0.f); const float rstd = rsqrtf(var + 1e-6f);
    const int cb = g * 64 + q * 16;
    const float* lg = p.ln_g + l * 256 + cb; const float* lb = p.ln_b + l * 256 + cb;
#pragma unroll
    for (int i = 0; i < 2; ++i) {
      const u32x4 v = *(const u32x4*)(vr + cb + i * 8);
#pragma unroll
      for (int k = 0; k < 4; ++k) {
        const int cc = i * 8 + 2 * k;
        const unsigned pk = cvt_pk_bf16((bflo(v[k]) - mu) * rstd * lg[cc] + lb[cc], (bfhi(v[k]) - mu) * rstd * lg[cc + 1] + lb[cc + 1]);
        vnT[(q * 16 + cc) * VS + s] = (bf16_t)(pk & 0xffffu);
        vnT[(q * 16 + cc + 1) * VS + s] = (bf16_t)(pk >> 16);
      }
    }
  }
  __syncthreads();
  const int lane = tid & 63, w = tid >> 6, n = lane & 15, kg = lane >> 4;
  const int t = w * 16 + n;
  const bf16_t* wp = W16 + ((size_t)(g * 128 + t)) * 128 + kg * 8;
  bf16x8 wf[4];
#pragma unroll
  for (int ks = 0; ks < 4; ++ks) wf[ks] = *(const bf16x8*)(wp + ks * 32);
  f32x4 acc[4];
#pragma unroll
  for (int cb = 0; cb < 4; ++cb) {
    acc[cb] = (f32x4){0.f, 0.f, 0.f, 0.f};
#pragma unroll
    for (int ks = 0; ks < 4; ++ks) {
      const bf16x8 vf = *(const bf16x8*)(vnT + (cb * 16 + n) * VS + ks * 32 + kg * 8);
      acc[cb] = __builtin_amdgcn_mfma_f32_16x16x32_bf16(vf, wf[ks], acc[cb], 0, 0, 0);
    }
  }
  const int row = chunk * 128 + t;
  const float bs = p.sgu_b[((size_t)l * 4 + g) * 128 + t];
#pragma unroll
  for (int cb = 0; cb < 4; ++cb) {
    const int c = g * 64 + cb * 16 + kg * 4;
    const u32x2 uv = *(const u32x2*)(PS + (size_t)row * 2304 + 7 * 256 + c);
    u32x2 o; o[0] = cvt_pk_bf16(bflo(uv[0]) * (acc[cb][0] + bs), bfhi(uv[0]) * (acc[cb][1] + bs)); o[1] = cvt_pk_bf16(bflo(uv[1]) * (acc[cb][2] + bs), bfhi(uv[1]) * (acc[cb][3] + bs));
    *(u32x2*)(Y4 + (size_t)row * 1024 + 768 + c) = o;
  }
  __syncthreads();
}

__device__ void carry_phase(const P& p, int l) {
  const int gt = blockIdx.x * 512 + otid();
  if (gt >= 16 * 8 * 2 * 64) return;
  const int pp = gt & 63, d = (gt >> 6) & 1, b = (gt >> 7) & 7, g = gt >> 10;
  const float* S = (const float*)(p.ws + OFF_S) + (size_t)g * NCHUNK * 256 + d * 128 + 2 * pp;
  bf16_t* XU = (bf16_t*)(p.ws + OFF_XU) + (size_t)g * XUR * XUK + 512 + d * 128 + 2 * pp;
  const int li = ((l * 2 + d) * 16 + g);
  const float dt = expf(p.log_dt[li]);
  const cpx aT = s5_apow<false>(p.lam_re[li * 64 + pp], p.lam_im[li * 64 + pp], dt, (float)TCH);
  cpx st = {0.f, 0.f};
  for (int i0 = 0; i0 < 72; i0 += 8) {
    float sre[8], sim[8]; int rows[8];
#pragma unroll
    for (int k = 0; k < 8; ++k) {
      const int i = i0 + k; int row;
      if (i < 8) row = 512 + b * 8 + (d == 0 ? i : 7 - i); else row = b * 64 + (d == 0 ? (i - 8) : 63 - (i - 8));
      rows[k] = row; const float2 v = *(const float2*)(S + (size_t)row * 256); sre[k] = v.x; sim[k] = v.y;
    }
#pragma unroll
    for (int k = 0; k < 8; ++k) {
      *(unsigned*)(XU + (size_t)rows[k] * XUK) = cvt_pk_bf16(st.re, st.im);
      const cpx ns = cmul(aT, st); st.re = ns.re + sre[k]; st.im = ns.im + sim[k];
    }
  }
}

constexpr int PH_PER_LAYER = 11;
constexpr int N_PHASES = 1 + NDEPTH * PH_PER_LAYER + 1;

__global__ void __launch_bounds__(512, 2) mk_forward(P p_arg) {
  extern __shared__ __attribute__((aligned(16))) unsigned char shm[];
  LAS unsigned char* lds = (LAS unsigned char*)shm;
  float* ldsf = (float*)shm;
  unsigned char* ws0 = p_arg.ws;
  volatile LAS unsigned* xbw = (volatile LAS unsigned*)(lds + 131072);
  if (threadIdx.x == 0) { xbw[0] = 0u; xbw[1] = 0u; xbw[2] = 0u; xbw[3] = 0u; }
  __syncthreads();
  const XcdBarrier xb = xcd_barrier_post((unsigned*)(ws0 + OFF_BAR), xbw);
  if (p_arg.ph_lo < 0) cg::this_grid().sync();

  for (int ph = p_arg.ph_lo; ph < p_arg.ph_hi; ++ph) {
    int nrep = 1;
#if DBL_MASK
    { const int spx = (ph == 0) ? 11 : (ph == N_PHASES - 1) ? 13 : (ph - 1) % PH_PER_LAYER; if ((DBL_MASK >> spx) & 1) nrep = 2; }
#endif
    for (int rep = 0; rep < nrep; ++rep) {
    if (rep) xcd_barrier(xb);
    int G_ = gridDim.x, wg_ = blockIdx.x; asm volatile("" : "+s"(G_), "+s"(wg_));
    const int G = G_, wg = wg_;
    unsigned char* ws = ws0; asm volatile("" : "+s"(ws));
    P p = p_arg; p.ws = ws;
    float* H = (float*)(ws + OFF_H);
    const float* MOD = (const float*)(ws + OFF_MOD);
    if (ph == 0) {
      for (int t = wg; t < 192; t += G) mod_task(p, t, ldsf);
      for (int t = (wg + G - (192 % G)) % G; t < NT_WIN + NT_BR; t += G) prep_task(p, 0, t < NT_WIN ? t : PT_WBR0 + (t - NT_WIN), ldsf);
    } else if (ph == N_PHASES - 1) {
      final_rows(p);
#if TSEL
      xcd_barrier(xb);
      if (wg == 0) { const unsigned long long* ts = (const unsigned long long*)(ws + OFF_BAR + 14336); const unsigned long long v = ts[TSEL - 1]; const int N = (int)(TSEL == 3 ? v * 1000 : v / 10);
        for (int i = otid(); i < N && i < 300000; i += 512) p.out[(size_t)i * 16] += 0.125f; }
#endif
    } else {
      const int l = (ph - 1) / PH_PER_LAYER, sp = (ph - 1) % PH_PER_LAYER;
      const bool last = (l == NDEPTH - 1);
      const float* hL = l == 0 ? p.x : H; const float* hC = l == 0 ? p.ctx : H + (size_t)ML * 1024;
      const float* modl = MOD + (size_t)l * 9 * 6144;
      const int nMrows = last ? 64 : 72;
      switch (sp) {
#if PHMASK & 1
        case 0: {
          for (int t = wg; t < PT_NG1; t += G) prep_task(p, l, PT_G10 + t, ldsf);
          norm_rows(p, hL, hC, p.norm_g + (size_t)(l * 2 + 0) * 1024, modl, 0, MT, l > 0 ? MOD + ((size_t)(l - 1) * 9 + 8) * 6144 + 5 * 1024 : nullptr);
        } break;
#endif
#if PHMASK & 2
        case 1: {
          G1Sched S{(const char*)(ws + OFF_A), (const char*)(ws + OFF_WIN), G, wg, last ? 1 : 0};
          EpiG1 E{(bf16_t*)(ws + OFF_PS), (bf16_t*)(ws + OFF_XU), (bf16_t*)(ws + OFF_VT), (bf16_t*)(ws + OFF_KT)};
          gemm_phase(lds, 1024, 1024, S, E, (TSEL && TPHASE == 1 && wg == 0) ? (unsigned long long*)(ws + OFF_BAR + 14336) : nullptr);
          { int st, sd; if (filler_range(wg, G, 136, st, sd)) for (int t = st; t < NT_ASM; t += sd) w2_assemble_task(p, l, t); }
        } break;
#endif
#if PHMASK & 4
        case 2: {
          {
            S5Sched S{(const char*)(ws + OFF_XU), (const char*)(ws + OFF_W1), (size_t)256 * 512 * 2, 0, 3, 1, 8, G, wg};
            EpiS1 E{(float*)(ws + OFF_S)};
            gemm_phase(lds, XUK, 512, S, E);
          }
          __syncthreads();
          const int tid2 = otid(), lane2 = tid2 & 63, wid2 = tid2 >> 6;
          for (int i = tid2; i < 4 * 15 * 31; i += 512) ldsf[i] = p.rpb[(size_t)l * 4 * 15 * 31 + i];
          __syncthreads();
          const int nwaves = G * 8, gw = wg * 8 + wid2;
#if TSEL
          unsigned long long* tsl = (unsigned long long*)(ws + OFF_BAR + 14336); const unsigned long long tq0 = __builtin_amdgcn_s_memrealtime();
#endif
          for (int t = gw; t < 4096; t += nwaves) attn_task<true>(p, t, l, ldsf, lane2);
          if (!last) for (int t = nwaves - 1 - gw; t < 512; t += nwaves) attn_task<false>(p, t, l, ldsf, lane2);
#if TSEL
          __syncthreads(); const unsigned long long tq1 = __builtin_amdgcn_s_memrealtime();
#endif
        } break;
#endif
#if PHMASK & 8
        case 3: {
          carry_phase(p, l);
          const int nconv = (last ? ML : MT) * 32 / 512;
          int st, sd; if (filler_range(wg, G, 32, st, sd)) for (int t = st; t < nconv; t += sd) conv_task(p, l, t);
        } break;
#endif
#if PHMASK & 16
        case 4: {
          S5Sched S{(const char*)(ws + OFF_XU), (const char*)(ws + OFF_W2), (size_t)512 * 768 * 2, (size_t)256 * 768 * 2, last ? 2 : 3, 2, 12, G, wg};
          EpiS2 E{(bf16_t*)(ws + OFF_YG), last ? 512 : NCHUNK};
          gemm_phase(lds, XUK, 768, S, E);
          const int nsgu = (last ? 128 : 144) * 4;
          { int st, sd; if (filler_range(wg, G, 96, st, sd)) { __syncthreads(); for (int t = st; t < nsgu / 2; t += sd) sgu_task(p, l, t, ldsf); } }
        } break;
#endif
#if PHMASK & 32
        case 5: {
          RectSched S{(const char*)(ws + OFF_YG), (const char*)(ws + OFF_WGLU), (size_t)256 * 256 * 2, 0, nMrows, 1, 4, G, wg};
          EpiGLU E{(const bf16_t*)(ws + OFF_YG), p.glu_b + l * 256, (bf16_t*)(ws + OFF_Y4)};
          gemm_phase(lds, 256, 256, S, E);
          const int nsgu = (last ? 128 : 144) * 4;
          { int st, sd; if (filler_range(wg, G, 72, st, sd)) { __syncthreads(); for (int t = nsgu / 2 + st; t < nsgu; t += sd) sgu_task(p, l, t, ldsf); } }
        } break;
#endif
#if PHMASK & 64
        case 6: {
          MergeSched S{(const char*)(ws + OFF_A), (const char*)(ws + OFF_Y4), (const char*)(ws + OFF_WIN), (const char*)(ws + OFF_WBR), last ? 0 : 128, G, wg};
          EpiMerge E{ws + OFF_GS + (size_t)wg * 65536, (bf16_t*)(ws + OFF_MIXTMP + (size_t)wg * 131072), (bf16_t*)(ws + OFF_MIX), (bf16_t*)(ws + OFF_GP)};
          gemm_phase(lds, 1024, 1024, S, E, (TSEL && TPHASE == 6 && wg == 0) ? (unsigned long long*)(ws + OFF_BAR + 14336) : nullptr);
          { int st, sd; if (filler_range(wg, G, last ? 0 : 128, st, sd)) for (int t = st; t < PT_NMID; t += sd) prep_task(p, l, PT_FF0 + t, ldsf); }
        } break;
#endif
#if PHMASK & 128
        case 7: {
          WoutSched S{(const char*)(ws + OFF_MIX), (const char*)(ws + OFF_GP), (const char*)(ws + OFF_WOUT), last ? 0 : 256, G, wg};
          EpiRes E{hL, hC, H, modl, 2, (float*)(ws + OFF_PART)};
          gemm_phase(lds, 1024, 1024, S, E);
        } break;
#endif
#if PHMASK & 256
        case 8: {
          norm_rows(p, H, l == 0 ? p.ctx : H + (size_t)ML * 1024, p.norm_g + (size_t)(l * 2 + 1) * 1024, modl, 3, last ? ML : MT, modl + (size_t)8 * 6144 + 2 * 1024);
          if (!last) for (int t = wg; t < NT_BR; t += G) prep_task(p, l + 1, PT_WBR0 + t, ldsf);
        } break;
#endif
#if PHMASK & 512
        case 9: {
          RectSched S{(const char*)(ws + OFF_A), (const char*)(ws + OFF_WFF1), (size_t)256 * 1024 * 2, (size_t)256 * 1024 * 2, nMrows, 16, 16, G, wg};
          EpiFF1 E{(bf16_t*)(ws + OFF_FFH)};
          gemm_phase(lds, 1024, 1024, S, E, (TSEL && TPHASE == 9 && wg == 0) ? (unsigned long long*)(ws + OFF_BAR + 14336) : nullptr);
          if (!last) { int st, sd; if (filler_range(wg, G, 128, st, sd)) for (int t = st; t < NT_WIN; t += sd) prep_task(p, l + 1, t, ldsf); }
        } break;
#endif
#if PHMASK & 1024
        case 10: {
          SplitSched S{(const char*)(ws + OFF_FFH), (const char*)(ws + OFF_WFF2), (const char*)(ws + OFF_FFH) + (size_t)64 * 256 * 4096 * 2, (size_t)256 * 4096 * 2, (size_t)256 * 4096 * 2, (size_t)256 * 4096 * 2, 64, 8, 256, last ? 0 : 256, G, wg};
          EpiRes E{H, H + (size_t)ML * 1024, H, modl, 5, (float*)(ws + OFF_PART)};
          gemm_phase(lds, 4096, 4096, S, E);
        } break;
#endif
      }
    }
    }
    if (ph + 1 < p_arg.ph_hi) { xcd_barrier(xb);
#if (DBL_MASK >> 12) & 1
      xcd_barrier(xb);
#endif
    }
  }
}

extern "C" void kernel_launch(void* const* d_in, const int* in_sizes, int n_in, void* d_out, int out_size, void* d_ws, size_t ws_size, hipStream_t stream) {
  constexpr size_t kDynLds = 131072 + 16;
  static int grid_blocks = 0;
  if (!grid_blocks) {
    (void)hipFuncSetAttribute((const void*)mk_forward, hipFuncAttributeMaxDynamicSharedMemorySize, (int)kDynLds);
    int dev = 0, cus = 0, per_cu = 0;
    (void)hipGetDevice(&dev);
    (void)hipDeviceGetAttribute(&cus, hipDeviceAttributeMultiprocessorCount, dev);
    (void)hipOccupancyMaxActiveBlocksPerMultiprocessor(&per_cu, mk_forward, 512, kDynLds);
    if (per_cu < 1) per_cu = 1;
    grid_blocks = cus;
  }
  P p{};
  const float** pp = (const float**)&p;
  for (int i = 0; i < 29; ++i) pp[i] = (const float*)d_in[i];
  p.out = (float*)d_out; p.ws = (unsigned char*)d_ws;
  (void)hipMemsetAsync((unsigned char*)d_ws + OFF_BAR, 0, 16384, stream);
#if MULTI_LAUNCH
  for (int ph = 0; ph < N_PHASES; ++ph) {
    p.ph_lo = ph; p.ph_hi = ph + 1;
    hipLaunchKernelGGL(mk_forward, dim3(grid_blocks), dim3(512), kDynLds, stream, p);
  }
#else
  p.ph_lo = 0; p.ph_hi = N_PHASES;
  void* args[] = {&p};
  (void)hipLaunchCooperativeKernel((void*)mk_forward, dim3(grid_blocks), dim3(512), args, kDynLds, stream);
#endif
}
```

```cpp
#include <hip/hip_runtime.h>
#include <hip/hip_cooperative_groups.h>
namespace cg = cooperative_groups;

#define LAS __attribute__((address_space(3)))
typedef unsigned short bf16_t;
typedef short bf16x8 __attribute__((ext_vector_type(8)));
typedef float f32x4 __attribute__((ext_vector_type(4)));
typedef unsigned u32x4 __attribute__((ext_vector_type(4)));
typedef unsigned u32x2 __attribute__((ext_vector_type(2)));

#ifndef PHMASK
#define PHMASK 0x7ff
#endif
#ifndef DBL_MASK
#define DBL_MASK 0
#endif
#ifndef TSEL
#define TSEL 0
#endif
#ifndef TPHASE
#define TPHASE 6
#endif
#ifndef MULTI_LAUNCH
#define MULTI_LAUNCH 0
#endif

constexpr int DM = 1024, NB = 8, SEQL = 2048, NDEPTH = 4, CTXL = 256, DFF = 4096, INW = 6400;
constexpr int ML = NB * SEQL;
constexpr int MC = NB * CTXL;
constexpr int MT = ML + MC;
constexpr int TCH = 32;
constexpr int NCHUNK = MT / TCH;
constexpr int XUR = 768;
constexpr int XUK = 768;

constexpr size_t OFF_H = 0;
constexpr size_t OFF_A = OFF_H + (size_t)MT * DM * 4;
constexpr size_t OFF_MIX = OFF_A + (size_t)MT * DM * 2;
constexpr size_t OFF_R1 = OFF_MIX + (size_t)MT * DM * 2;
constexpr size_t OFF_PS = OFF_R1;
constexpr size_t OFF_Y4 = OFF_PS + (size_t)MT * 2304 * 2;
constexpr size_t OFF_VT = OFF_Y4 + (size_t)MT * DM * 2;
constexpr size_t OFF_XU = OFF_VT + (size_t)NB * 4 * 64 * 2304 * 2;
constexpr size_t OFF_S = OFF_XU + (size_t)16 * XUR * XUK * 2;
constexpr size_t OFF_YG = OFF_S + (size_t)16 * NCHUNK * 256 * 4;
constexpr size_t OFF_R1END = OFF_YG + (size_t)MT * 256 * 2;
constexpr size_t OFF_FFH = OFF_R1;
constexpr size_t OFF_MIXTMP = OFF_PS;
constexpr size_t OFF_KT = OFF_YG;
constexpr size_t OFF_GS = OFF_VT;
constexpr size_t OFF_WIN = OFF_R1END;
constexpr size_t OFF_WFF1 = OFF_WIN + (size_t)INW * DM * 2;
constexpr size_t OFF_WFF2 = OFF_WFF1 + (size_t)DFF * DM * 2;
constexpr size_t OFF_WOUT = OFF_WFF2 + (size_t)DFF * DM * 2;
constexpr size_t OFF_WBR = OFF_WOUT + (size_t)DM * DM * 2;
constexpr size_t OFF_WGLU = OFF_WBR + (size_t)DM * DM * 2;
constexpr size_t OFF_W1 = OFF_WGLU + (size_t)256 * 256 * 2;
constexpr size_t OFF_W2 = OFF_W1 + (size_t)16 * 256 * 512 * 2;
constexpr size_t OFF_SGUWT = OFF_W2 + (size_t)16 * 512 * 768 * 2;
constexpr size_t OFF_MOD = OFF_SGUWT + (size_t)4 * 128 * 128 * 4;
constexpr size_t OFF_BAR = OFF_MOD + (size_t)NDEPTH * 9 * 6144 * 4;
constexpr size_t OFF_PART = OFF_BAR + 16384;
constexpr size_t OFF_END = OFF_PART + (size_t)8 * MC * DM * 4;
constexpr size_t OFF_KTAB = OFF_END;
static_assert(OFF_KTAB + (size_t)16 * 2 * 32 * 256 * 4 <= 453000000ull, "KTAB");
constexpr size_t OFF_GP = OFF_PS + (size_t)256 * 262144;
static_assert(OFF_GP + (size_t)MC * 4096 * 2 <= OFF_Y4, "GP alias");
static_assert((size_t)MT * DFF * 2 <= OFF_R1END - OFF_R1, "FFH alias");
static_assert((size_t)256 * 262144 <= (size_t)MT * 2304 * 2, "MIXTMP alias");
static_assert((size_t)256 * 131072 <= OFF_R1END - OFF_VT, "GS alias");
static_assert(OFF_END < 452000000ull, "workspace");

struct P {
  const float *x, *c, *ctx, *c_ctx, *ada_w, *ada_b, *norm_g, *final_g, *w_in, *w_branch, *w_out,
      *lam_re, *lam_im, *log_dt, *b_re, *b_im, *c_re, *c_im, *s5_d, *glu_w, *glu_b, *rpb, *conv_w,
      *ln_g, *ln_b, *sgu_w, *sgu_b, *w_ff1, *w_ff2;
  float* out;
  unsigned char* ws;
  int ph_lo, ph_hi;
};

__device__ __forceinline__ int otid() { int t = threadIdx.x; asm volatile("" : "+v"(t)); return t; }
__device__ __forceinline__ float bf2f(bf16_t b) { return __uint_as_float(((unsigned)b) << 16); }
__device__ __forceinline__ float bflo(unsigned w) { return __uint_as_float(w << 16); }
__device__ __forceinline__ float bfhi(unsigned w) { return __uint_as_float(w & 0xffff0000u); }
__device__ __forceinline__ unsigned cvt_pk_bf16(float lo, float hi) { unsigned r; asm volatile("v_cvt_pk_bf16_f32 %0, %1, %2" : "=v"(r) : "v"(lo), "v"(hi)); return r; }
__device__ __forceinline__ float sigm(float x) { return 1.f / (1.f + __expf(-x)); }
__device__ __forceinline__ float gelu_tanh(float x) { return x * sigm(1.5957691216057308f * (x + 0.044715f * x * x * x)); }
__device__ __forceinline__ u32x4 pack8(f32x4 a, f32x4 b) { u32x4 r; r[0] = cvt_pk_bf16(a[0], a[1]); r[1] = cvt_pk_bf16(a[2], a[3]); r[2] = cvt_pk_bf16(b[0], b[1]); r[3] = cvt_pk_bf16(b[2], b[3]); return r; }
__device__ __forceinline__ float shx(float v, int o, int lane) { return __int_as_float(__builtin_amdgcn_ds_bpermute((lane ^ o) << 2, __float_as_int(v))); }
__device__ __forceinline__ float wave_sum(float v, int lane) {
#pragma unroll
  for (int o = 32; o >= 1; o >>= 1) v += shx(v, o, lane);
  return v;
}


#define XB_TMO      128
#define XB_XCNT(j)  (256  + 64 * (j))
#define XB_XSUB(j)  (1280 + 64 * (j))
#define XB_XGEN(j)  (2304 + 64 * (j))
#define XB_TOP      3328
#define XB_TOPGEN   3392
#define XCD_BAR_WORDS 3456
#define XB_SPIN_CAP (1u << 22)
__device__ __forceinline__ unsigned xb_ld(unsigned* p)              { return __hip_atomic_load(p, __ATOMIC_RELAXED, __HIP_MEMORY_SCOPE_AGENT); }
__device__ __forceinline__ unsigned xb_add(unsigned* p, unsigned v) { return __hip_atomic_fetch_add(p, v, __ATOMIC_RELAXED, __HIP_MEMORY_SCOPE_AGENT); }
__device__ __forceinline__ unsigned xb_xcc_id() { return (unsigned)__builtin_amdgcn_s_getreg((3 << 11) | 20) & 0xFu; }
#define XB_SPIN(cond, bar) do { unsigned _sp = 0; while (cond) { __builtin_amdgcn_s_sleep(1); \
    if ((++_sp & 255u) == 0u) { if (xb_ld(&(bar)[XB_TMO])) break; if (_sp > XB_SPIN_CAP) { atomicAdd(&(bar)[XB_TMO], 1u); break; } } } } while (0)
struct XcdBarrier { unsigned* bar; unsigned x; volatile LAS unsigned* st; };
__device__ __forceinline__ XcdBarrier xcd_barrier_post(unsigned* bar, volatile LAS unsigned* st) {
  XcdBarrier b; b.bar = bar; b.x = xb_xcc_id(); b.st = st;
  if (threadIdx.x == 0) (void)xb_add(&bar[XB_XCNT(b.x)], 1u);
  return b;
}
__device__ __forceinline__ void xcd_barrier_complete(unsigned* bar, unsigned x, unsigned& nloc, unsigned& nx) {
  const unsigned G = gridDim.x * gridDim.y * gridDim.z;
  unsigned sum, cnt, mine, sp = 0u;
  for (;;) {
    sum = 0u; cnt = 0u; mine = 0u;
#pragma unroll
    for (unsigned j = 0; j < 16; ++j) { const unsigned c = xb_ld(&bar[XB_XCNT(j)]); sum += c; cnt += (c > 0u) ? 1u : 0u; mine = (j == x) ? c : mine; }
    if (sum == G) break;
    __builtin_amdgcn_s_sleep(1);
    if ((++sp & 255u) == 0u) { if (xb_ld(&bar[XB_TMO])) break; if (sp > XB_SPIN_CAP) { atomicAdd(&bar[XB_TMO], 1u); break; } }
  }
  nloc = mine > 0u ? mine : 1u; nx = cnt > 0u ? cnt : 1u;
}
__device__ __forceinline__ void xcd_barrier(const XcdBarrier& b) {
  asm volatile("s_waitcnt vmcnt(0)" ::: "memory");
  __syncthreads();
  if (threadIdx.x == 0) {
    unsigned* bar = b.bar;
    __builtin_amdgcn_s_waitcnt(0);
    unsigned nloc = b.st[0], nx = b.st[1];
    if (nloc == 0u) { xcd_barrier_complete(bar, b.x, nloc, nx); b.st[0] = nloc; b.st[1] = nx; }
    const unsigned old = xb_add(&bar[XB_XSUB(b.x)], 1u);
    const unsigned gen = old / nloc;
    if (old + 1u == (gen + 1u) * nloc) {
      __builtin_amdgcn_fence(__ATOMIC_RELEASE, "agent");
      asm volatile("s_waitcnt vmcnt(0)" ::: "memory");
      const unsigned og = xb_add(&bar[XB_TOP], 1u);
      const unsigned tg = og / nx;
      if (og + 1u == (tg + 1u) * nx) xb_add(&bar[XB_TOPGEN], 1u);
      else XB_SPIN(xb_ld(&bar[XB_TOPGEN]) == tg, bar);
      __builtin_amdgcn_fence(__ATOMIC_ACQUIRE, "agent");
      xb_add(&bar[XB_XGEN(b.x)], 1u);
      asm volatile("s_waitcnt vmcnt(0)" ::: "memory");
    } else {
      XB_SPIN(xb_ld(&bar[XB_XGEN(b.x)]) == gen, bar);
      __builtin_amdgcn_fence(__ATOMIC_ACQUIRE, "agent");
      asm volatile("s_waitcnt vmcnt(0)" ::: "memory");
    }
  }
  __syncthreads();
}

constexpr int BM = 256, BK = 64, HALF = 128, HTB = HALF * BK * 2, NXCD = 8, WGM = 8;
__device__ __forceinline__ int lds_byte(int r, int c) { const int st = (r >> 4) * 2 + (c >> 5), rr = r & 15, cc = c & 31, ob = rr * 64 + cc * 2; return st * 1024 + (ob ^ (((ob >> 9) & 1) << 5)); }
__device__ __forceinline__ void stage_rc(int b, int& R, int& C) { const int st = b / 1024, sb = b % 1024, swz = sb ^ (((sb >> 9) & 1) << 5); R = (st >> 1) * 16 + swz / 64; C = (st & 1) * 32 + (swz % 64) / 2; }
__device__ __forceinline__ int perm32(int rho) { const int n = rho >> 4, i = rho & 15; return 8 * (i >> 2) + 4 * n + (i & 3); }

struct Unit { const char* A; const char* B; int nt, pm, pn, kind; };

__device__ __forceinline__ void rect_map(int L, int nM, int nN, int& pm, int& pn) {
  const int nwg = nM * nN; int wgid = L;
  { const int q = nwg / NXCD, r = nwg % NXCD, xcd = wgid % NXCD, off = wgid / NXCD; wgid = (xcd < r ? xcd * (q + 1) : r * (q + 1) + (xcd - r) * q) + off; }
  const int nig = WGM * nN, gid = wgid / nig, fm = gid * WGM, gsz = (nM - fm) < WGM ? (nM - fm) : WGM;
  pm = fm + ((wgid % nig) % gsz); pn = (wgid % nig) / gsz;
}

template <class Sched, class Epi>
__device__ __forceinline__ void gemm_phase(LAS unsigned char* lds, const int lda, const int ldb, const Sched& S, const Epi& E, unsigned long long* tslot = nullptr) {
#if TSEL
  const unsigned long long tg0 = __builtin_amdgcn_s_memrealtime();
#endif
  int tid_ = threadIdx.x; asm volatile("" : "+v"(tid_));
  const int tid = tid_, wid = __builtin_amdgcn_readfirstlane(tid >> 6), lane = tid & 63, wr = wid >> 2, wc = wid & 3, fr = lane & 15, fq = lane >> 4;
  unsigned voffA[2], voffB[2];
#pragma unroll
  for (int i = 0; i < 2; ++i) { int R, C; stage_rc(tid * 16 + i * 8192, R, C); const int Rb = (R & ~31) + perm32(R & 31);
    voffA[i] = (unsigned)(R * lda + C) * 2u; voffB[i] = (unsigned)(Rb * ldb + C) * 2u; }
  const size_t kstep = (size_t)(BK * 2);
  const size_t hstepA = (size_t)HALF * lda * 2, hstepB = (size_t)HALF * ldb * 2;
  const unsigned ldsw = (unsigned)wid * 1024u;
  const int aoff = lds_byte(wr * 64 + fr, fq * 8), boff = lds_byte(wc * 32 + fr, fq * 8);
#define PG8_SA(b, h) (((b) * 2 + (h)) * HTB)
#define PG8_SB(b, h) ((4 + (b) * 2 + (h)) * HTB)
#define PG8_STAGE(bufoff, gbase, voff) do { _Pragma("unroll") for (int _i = 0; _i < 2; ++_i) \
    __builtin_amdgcn_global_load_lds((const unsigned*)((const char*)(gbase) + (voff)[_i]), (LAS unsigned*)(lds + (bufoff) + ldsw + _i * 8192), 16, 0, 0); } while (0)
#define PG8_LDA(dst, b, h) do { _Pragma("unroll") for (int m = 0; m < 4; ++m) _Pragma("unroll") for (int k = 0; k < 2; ++k) dst[m][k] = *(const LAS bf16x8*)(lds + PG8_SA(b, h) + aoff + m * 2048 + k * 1024); } while (0)
#define PG8_LDB(dst, b, h) do { _Pragma("unroll") for (int n = 0; n < 2; ++n) _Pragma("unroll") for (int k = 0; k < 2; ++k) dst[n][k] = *(const LAS bf16x8*)(lds + PG8_SB(b, h) + boff + n * 2048 + k * 1024); } while (0)
#define PG8_MMA(ai, bj, At, Bt) do { __builtin_amdgcn_s_setprio(1); _Pragma("unroll") for (int m = 0; m < 4; ++m) _Pragma("unroll") for (int n = 0; n < 2; ++n) _Pragma("unroll") for (int k = 0; k < 2; ++k) \
    acc[ai][bj][m][n] = __builtin_amdgcn_mfma_f32_16x16x32_bf16(Bt[n][k], At[m][k], acc[ai][bj][m][n], 0, 0, 0); __builtin_amdgcn_s_setprio(0); } while (0)
#define PG8_WAIT_V(n) asm volatile("s_waitcnt vmcnt(" #n ")" ::: "memory")
#define PG8_WAIT_L(n) asm volatile("s_waitcnt lgkmcnt(" #n ")" ::: "memory")
#define PG8_BAR __builtin_amdgcn_s_barrier()
#define PG8_SCHED __builtin_amdgcn_sched_barrier(0)
  Unit cur, nxt; int ui = 0;
  if (!S.next(0, cur)) return;
  f32x4 acc[2][2][4][2];
#pragma unroll
  for (int a = 0; a < 2; ++a)
#pragma unroll
    for (int b = 0; b < 2; ++b)
#pragma unroll
      for (int m = 0; m < 4; ++m)
#pragma unroll
        for (int n = 0; n < 2; ++n) acc[a][b][m][n] = (f32x4){0.f, 0.f, 0.f, 0.f};
  bf16x8 At[4][2], B0[2][2], B1[2][2];
  const char* cA = cur.A; const char* cB = cur.B;
  PG8_STAGE(PG8_SB(0, 0), cB, voffB); PG8_STAGE(PG8_SA(0, 0), cA, voffA); PG8_STAGE(PG8_SB(0, 1), cB + hstepB, voffB); PG8_STAGE(PG8_SA(0, 1), cA + hstepA, voffA);
  if (wr == 1) PG8_BAR;
  PG8_WAIT_V(4); PG8_BAR;
  PG8_STAGE(PG8_SB(1, 0), cB + kstep, voffB); PG8_STAGE(PG8_SA(1, 0), cA + kstep, voffA); PG8_STAGE(PG8_SB(1, 1), cB + hstepB + kstep, voffB);
  PG8_WAIT_V(6); PG8_BAR;
  for (;;) {
    const bool has_next = S.next(ui + 1, nxt);
    const char* nA = has_next ? nxt.A : cA; const char* nB = has_next ? nxt.B : cB;
    const int nt = cur.nt;
#if TSEL
    const unsigned long long tk0 = __builtin_amdgcn_s_memrealtime();
#endif
    for (int t = 0; t < nt; t += 2) {
      const bool last = (t == nt - 2);
      const char* a1 = cA + (size_t)(t + 1) * kstep;
      const char* a2 = last ? nA : cA + (size_t)(t + 2) * kstep; const char* b2 = last ? nB : cB + (size_t)(t + 2) * kstep;
      const char* a3 = a2 + kstep; const char* b3 = b2 + kstep;
      PG8_LDB(B0, 0, 0); PG8_SCHED; PG8_LDA(At, 0, 0); PG8_STAGE(PG8_SA(1, 1), a1 + hstepA, voffA);
      PG8_WAIT_L(8); PG8_BAR; PG8_WAIT_L(0); PG8_MMA(0, 0, At, B0); PG8_BAR; PG8_SCHED;
      PG8_LDB(B1, 0, 1); PG8_STAGE(PG8_SB(0, 0), b2, voffB);
      PG8_BAR; PG8_WAIT_L(0); PG8_MMA(0, 1, At, B1); PG8_BAR;
      PG8_LDA(At, 0, 1); PG8_STAGE(PG8_SA(0, 0), a2, voffA);
      PG8_BAR; PG8_WAIT_L(0); PG8_MMA(1, 0, At, B0); PG8_BAR; PG8_SCHED;
      PG8_STAGE(PG8_SB(0, 1), b2 + hstepB, voffB);
      PG8_WAIT_V(6); PG8_BAR; PG8_MMA(1, 1, At, B1); PG8_BAR;
      PG8_LDB(B0, 1, 0); PG8_SCHED; PG8_LDA(At, 1, 0); PG8_STAGE(PG8_SA(0, 1), a2 + hstepA, voffA);
      PG8_WAIT_L(8); PG8_BAR; PG8_WAIT_L(0); PG8_MMA(0, 0, At, B0); PG8_BAR; PG8_SCHED;
      PG8_LDB(B1, 1, 1); PG8_STAGE(PG8_SB(1, 0), b3, voffB);
      PG8_BAR; PG8_WAIT_L(0); PG8_MMA(0, 1, At, B1); PG8_BAR;
      PG8_LDA(At, 1, 1); PG8_STAGE(PG8_SA(1, 0), a3, voffA);
      PG8_BAR; PG8_WAIT_L(0); PG8_MMA(1, 0, At, B0); PG8_BAR; PG8_SCHED;
      PG8_STAGE(PG8_SB(1, 1), b3 + hstepB, voffB);
      PG8_WAIT_V(6); PG8_BAR; PG8_MMA(1, 1, At, B1); PG8_BAR;
    }
#if TSEL
    const unsigned long long te0 = __builtin_amdgcn_s_memrealtime();
    if (tslot && tid == 0) tslot[3 + (cur.kind & 1)] += te0 - tk0;
#endif
    { const int t2 = otid(); E(acc, cur, wr, wc, t2 & 15, (t2 & 63) >> 4); }
#if TSEL
    if (tslot && tid == 0) { asm volatile("s_waitcnt vmcnt(0)" ::: "memory"); tslot[0] += __builtin_amdgcn_s_memrealtime() - te0; tslot[2] += 1; }
#endif
    if (!has_next) break;
#pragma unroll
    for (int a = 0; a < 2; ++a)
#pragma unroll
      for (int b = 0; b < 2; ++b)
#pragma unroll
        for (int m = 0; m < 4; ++m)
#pragma unroll
          for (int n = 0; n < 2; ++n) acc[a][b][m][n] = (f32x4){0.f, 0.f, 0.f, 0.f};
    cur = nxt; cA = nA; cB = nB; ++ui;
  }
  PG8_WAIT_V(0);
  if (wr == 0) PG8_BAR;
  PG8_BAR;
#if TSEL
  if (tslot && tid == 0) tslot[1] += __builtin_amdgcn_s_memrealtime() - tg0;
#endif
#undef PG8_SA
#undef PG8_SB
#undef PG8_STAGE
#undef PG8_LDA
#undef PG8_LDB
#undef PG8_MMA
#undef PG8_WAIT_V
#undef PG8_WAIT_L
#undef PG8_BAR
#undef PG8_SCHED
}

typedef f32x4 Acc[2][2][4][2];
#define EPI_ROWS(u, wr, fr) \
  _Pragma("unroll") for (int ai = 0; ai < 2; ++ai) _Pragma("unroll") for (int m = 0; m < 4; ++m)
#define EPI_ROW(u, wr, fr) ((u).pm * 256 + ai * 128 + (wr) * 64 + m * 16 + (fr))
#define EPI_COL(wc, fq) (bj * 128 + (wc) * 32 + (fq) * 8)

__device__ __forceinline__ int bsel_of_tile(int pm) { return pm < 64 ? (pm >> 3) : 8; }

struct RectSched {
  const char* A; const char* B; size_t a_tile, b_tile; int nM, nN, nt, G, c;
  __device__ __forceinline__ bool next(int i, Unit& u) const {
    const int L = i * G + c; if (L >= nM * nN) return false;
    int pm, pn; rect_map(L, nM, nN, pm, pn);
    u.pm = pm; u.pn = pn; u.kind = 0; u.nt = nt; u.A = A + (size_t)pm * a_tile; u.B = B + (size_t)pn * b_tile; return true;
  }
};
struct G1Sched {
  const char* A; const char* B; int G, c, last;
  __device__ __forceinline__ bool next(int i, Unit& u) const {
    const int L = i * G + c; const int nl = 64 * 9, ncx = last ? 24 : 72;
    if (L >= nl + ncx) return false;
    int pm, pn;
    if (L < nl) rect_map(L, 64, 9, pm, pn);
    else { const int q = L - nl; if (last) { pm = 64 + q / 3; const int s = q % 3; pn = s == 0 ? 0 : (s + 1); } else { pm = 64 + q / 9; pn = q % 9; } }
    u.pm = pm; u.pn = pn; u.kind = 0; u.nt = 16; u.A = A + (size_t)pm * (256 * 1024 * 2); u.B = B + (size_t)pn * (256 * 1024 * 2); return true;
  }
};
struct S5Sched {
  const char* A; const char* B; size_t b_group, b_tile; int nMs, nN, nt, G, c;
  __device__ __forceinline__ bool next(int i, Unit& u) const {
    const int L = i * G + c; if (L >= 16 * nMs * nN) return false;
    const int g = L / (nMs * nN), r = L % (nMs * nN), pm = r / nN, pn = r % nN;
    u.pm = pm; u.pn = pn; u.kind = g; u.nt = nt;
    u.A = A + ((size_t)g * XUR + (size_t)pm * 256) * XUK * 2; u.B = B + (size_t)g * b_group + (size_t)pn * b_tile; return true;
  }
};
struct MergeSched {
  const char* Abuf; const char* Y4; const char* Win; const char* Wbr; int ncx, G, c;
  __device__ __forceinline__ bool next(int i, Unit& u) const {
    const int nlat = (256 - c + G - 1) / G;
    int pm, pd, k, j;
    if (i < 8 * nlat) { const int su = (i >> 3) * G + c; j = i & 7; k = j >> 1; const int x = su & 7, sl = su >> 3; pd = sl & 3; pm = x * 8 + (sl >> 2); u.kind = j; }
    else { const int i2 = i - 8 * nlat; const int q = (i2 >> 1) * G + c; if (q >= ncx) return false; j = i2 & 1; const int x = q & 7, sl = q >> 3; k = sl & 3; pd = sl >> 2; pm = 64 + x; u.kind = 8 + 2 * k + j; }
    u.pm = pm; u.pn = pd;
    if (!(j & 1)) { u.nt = 16; u.A = Abuf + (size_t)pm * (256 * 1024 * 2); u.B = Win + (size_t)(2304 + k * 1024 + pd * 256) * (1024 * 2); }
    else { u.nt = 4; u.A = Y4 + (size_t)pm * (256 * 1024 * 2) + (size_t)k * 512; u.B = Wbr + (size_t)(pd * 256) * (1024 * 2) + (size_t)k * 512; }
    return true;
  }
};
struct WoutSched {
  const char* MIXb; const char* GPb; const char* B; int ncx, G, c;
  __device__ __forceinline__ bool next(int i, Unit& u) const {
    const int L = i * G + c;
    if (L < 256) { int pm, pn; rect_map(L, 64, 4, pm, pn); u.pm = pm; u.pn = pn; u.kind = 0; u.nt = 16; u.A = MIXb + (size_t)pm * (256 * 1024 * 2); u.B = B + (size_t)pn * (256 * 1024 * 2); return true; }
    const int q = L - 256; if (q >= ncx) return false;
    const int ks = q & 7, pn = (q >> 3) & 3, pmc = q >> 5;
    u.pm = 64 + pmc; u.pn = pn; u.kind = 1 + ks; u.nt = 8;
    u.A = GPb + ((size_t)(ks >> 1) * MC + (size_t)pmc * 256) * (1024 * 2) + (size_t)(ks & 1) * 1024; u.B = B + (size_t)pn * (256 * 1024 * 2) + (size_t)(ks & 1) * 1024; return true;
  }
};
struct SplitSched {
  const char* A; const char* B; const char* Ac; size_t a_tile, b_tile, ac_tile; int nt, nts, nlat, ncx, G, c;
  __device__ __forceinline__ bool next(int i, Unit& u) const {
    const int L = i * G + c;
    if (L < nlat) { int pm, pn; rect_map(L, 64, 4, pm, pn); u.pm = pm; u.pn = pn; u.kind = 0; u.nt = nt; u.A = A + (size_t)pm * a_tile; u.B = B + (size_t)pn * b_tile; return true; }
    const int q = L - nlat; if (q >= ncx) return false;
    const int ks = q & 7, pn = (q >> 3) & 3, pmc = q >> 5;
    u.pm = 64 + pmc; u.pn = pn; u.kind = 1 + ks; u.nt = nts;
    u.A = Ac + (size_t)pmc * ac_tile + (size_t)ks * nts * 128; u.B = B + (size_t)pn * b_tile + (size_t)ks * nts * 128; return true;
  }
};

struct EpiG1 {
  bf16_t* PS; bf16_t* XU; bf16_t* VT; bf16_t* KT;
  __device__ __forceinline__ void operator()(const Acc& acc, const Unit& u, int wr, int wc, int fr, int fq) const {
    if (u.pn == 3) {
      const int voff = (wc >> 1) * (288 * 512) + ((wc & 1) * 32 + fq * 8) * 8;
      EPI_ROWS(u, wr, fr) {
        const int row = EPI_ROW(u, wr, fr);
        int b, tok; if (row < ML) { b = row >> 11; tok = row & 2047; } else { const int r2 = row - ML; b = r2 >> 8; tok = 2048 + (r2 & 255); }
        bf16_t* rb = VT + ((size_t)(b * 4) * 288 + (tok >> 3)) * 512 + (tok & 7) + voff;
#pragma unroll
        for (int bj = 0; bj < 2; ++bj) {
          const u32x4 pk = pack8(acc[ai][bj][m][0], acc[ai][bj][m][1]);
          bf16_t* base = rb + bj * (2 * 288 * 512);
#pragma unroll
          for (int i = 0; i < 4; ++i) { base[(2 * i) * 8] = (bf16_t)(pk[i] & 0xffffu); base[(2 * i + 1) * 8] = (bf16_t)(pk[i] >> 16); }
        }
      }
      return;
    }
    EPI_ROWS(u, wr, fr) {
      const int row = EPI_ROW(u, wr, fr);
#pragma unroll
      for (int bj = 0; bj < 2; ++bj) {
        const int c = EPI_COL(wc, fq);
        const u32x4 pk = pack8(acc[ai][bj][m][0], acc[ai][bj][m][1]);
        if (u.pn == 0) {
          const int g = c >> 4, h0 = c & 15;
          *(u32x4*)(XU + ((size_t)(g * XUR + (row >> 5)) * XUK + (row & 31) * 16 + h0)) = pk;
        } else if (u.pn == 2) {
          int b, tok; if (row < ML) { b = row >> 11; tok = row & 2047; } else { const int r2 = row - ML; b = r2 >> 8; tok = 2048 + (r2 & 255); }
          *(u32x4*)(KT + (((size_t)(b * 4 + (c >> 6)) * 2304 + tok) * 64 + (c & 63))) = pk;
        } else {
          *(u32x4*)(PS + (size_t)row * 2304 + u.pn * 256 + c) = pk;
        }
      }
    }
  }
};
struct EpiS1 {
  float* S;
  __device__ __forceinline__ void operator()(const Acc& acc, const Unit& u, int wr, int wc, int fr, int fq) const {
    EPI_ROWS(u, wr, fr) {
      const int row = EPI_ROW(u, wr, fr);
      if (row < NCHUNK) {
#pragma unroll
        for (int bj = 0; bj < 2; ++bj) {
          const int c = EPI_COL(wc, fq);
          float* dst = S + ((size_t)u.kind * NCHUNK + row) * 256 + c;
          *(f32x4*)dst = acc[ai][bj][m][0]; *(f32x4*)(dst + 4) = acc[ai][bj][m][1];
        }
      }
    }
  }
};
struct EpiS2 {
  bf16_t* YG; int rowlim;
  __device__ __forceinline__ void operator()(const Acc& acc, const Unit& u, int wr, int wc, int fr, int fq) const {
    EPI_ROWS(u, wr, fr) {
      const int row = EPI_ROW(u, wr, fr);
      if (row < rowlim) {
#pragma unroll
        for (int bj = 0; bj < 2; ++bj) {
          const int col = u.pn * 256 + EPI_COL(wc, fq);
          const int t = col >> 4, h0 = col & 15;
          f32x4 a = acc[ai][bj][m][0], b = acc[ai][bj][m][1];
#pragma unroll
          for (int i = 0; i < 4; ++i) { a[i] = gelu_tanh(a[i]); b[i] = gelu_tanh(b[i]); }
          *(u32x4*)(YG + ((size_t)(row * TCH + t)) * 256 + u.kind * 16 + h0) = pack8(a, b);
        }
      }
    }
  }
};
struct EpiGLU {
  const bf16_t* YG; const float* bias; bf16_t* Y4;
  __device__ __forceinline__ void operator()(const Acc& acc, const Unit& u, int wr, int wc, int fr, int fq) const {
    EPI_ROWS(u, wr, fr) {
      const int row = EPI_ROW(u, wr, fr);
#pragma unroll
      for (int bj = 0; bj < 2; ++bj) {
        const int c = EPI_COL(wc, fq);
        const u32x4 gv = *(const u32x4*)(YG + (size_t)row * 256 + c);
        const f32x4 b0 = *(const f32x4*)(bias + c), b1 = *(const f32x4*)(bias + c + 4);
        f32x4 a = acc[ai][bj][m][0] + b0, b = acc[ai][bj][m][1] + b1;
        a[0] = bflo(gv[0]) * sigm(a[0]); a[1] = bfhi(gv[0]) * sigm(a[1]); a[2] = bflo(gv[1]) * sigm(a[2]); a[3] = bfhi(gv[1]) * sigm(a[3]);
        b[0] = bflo(gv[2]) * sigm(b[0]); b[1] = bfhi(gv[2]) * sigm(b[1]); b[2] = bflo(gv[3]) * sigm(b[2]); b[3] = bfhi(gv[3]) * sigm(b[3]);
        *(u32x4*)(Y4 + (size_t)row * 1024 + c) = pack8(a, b);
      }
    }
  }
};
struct EpiMerge {
  unsigned char* GS; bf16_t* TMP; bf16_t* MIX; bf16_t* GP;
  __device__ __forceinline__ void operator()(const Acc& acc, const Unit& u, int wr, int wc, int fr, int fq) const {
    const int tid = otid(); const int j = u.kind, k = j >> 1;
    EPI_ROWS(u, wr, fr) {
#pragma unroll
      for (int bj = 0; bj < 2; ++bj) {
        const int e = (ai * 4 + m) * 2 + bj;
        unsigned char* gs = GS + ((size_t)e * 512 + tid) * 8;
        bf16_t* tp = TMP + ((size_t)e * 512 + tid) * 8;
        if (!(j & 1)) {
          const f32x4 a = acc[ai][bj][m][0], b = acc[ai][bj][m][1];
          u32x2 q;
          q[0] = (unsigned)(sigm(a[0]) * 255.f + 0.5f) | ((unsigned)(sigm(a[1]) * 255.f + 0.5f) << 8) | ((unsigned)(sigm(a[2]) * 255.f + 0.5f) << 16) | ((unsigned)(sigm(a[3]) * 255.f + 0.5f) << 24);
          q[1] = (unsigned)(sigm(b[0]) * 255.f + 0.5f) | ((unsigned)(sigm(b[1]) * 255.f + 0.5f) << 8) | ((unsigned)(sigm(b[2]) * 255.f + 0.5f) << 16) | ((unsigned)(sigm(b[3]) * 255.f + 0.5f) << 24);
          *(u32x2*)gs = q;
        } else {
          const u32x2 q = *(const u32x2*)gs;
          f32x4 a = acc[ai][bj][m][0], b = acc[ai][bj][m][1];
          const float sc = 1.f / 255.f;
#pragma unroll
          for (int i = 0; i < 4; ++i) { a[i] *= (float)((q[0] >> (8 * i)) & 255u) * sc; b[i] *= (float)((q[1] >> (8 * i)) & 255u) * sc; }
          if (j >= 8) {
            const int row = EPI_ROW(u, wr, fr) - ML; const int c = u.pn * 256 + EPI_COL(wc, fq);
            *(u32x4*)(GP + ((size_t)(k - 4) * MC + row) * 1024 + c) = pack8(a, b);
          } else {
            if (k > 0) { const u32x4 t = *(const u32x4*)tp; a[0] += bflo(t[0]); a[1] += bfhi(t[0]); a[2] += bflo(t[1]); a[3] += bfhi(t[1]); b[0] += bflo(t[2]); b[1] += bfhi(t[2]); b[2] += bflo(t[3]); b[3] += bfhi(t[3]); }
            if (k < 3) *(u32x4*)tp = pack8(a, b);
            else { const int row = EPI_ROW(u, wr, fr); const int c = u.pn * 256 + EPI_COL(wc, fq); *(u32x4*)(MIX + (size_t)row * 1024 + c) = pack8(a, b); }
          }
        }
      }
    }
  }
};
struct EpiRes {
  const float* hL; const float* hC; float* H; const float* modbase; int modidx; float* PART;
  __device__ __forceinline__ void operator()(const Acc& acc, const Unit& u, int wr, int wc, int fr, int fq) const {
    if (u.kind) {
      bf16_t* pb = (bf16_t*)PART + (size_t)(u.kind - 1) * MC * 1024;
      EPI_ROWS(u, wr, fr) {
        const int row = EPI_ROW(u, wr, fr) - ML;
#pragma unroll
        for (int bj = 0; bj < 2; ++bj) {
          const int c = u.pn * 256 + EPI_COL(wc, fq);
          *(u32x4*)(pb + (size_t)row * 1024 + c) = pack8(acc[ai][bj][m][0], acc[ai][bj][m][1]);
        }
      }
      return;
    }
    const float* mv = modbase + (size_t)bsel_of_tile(u.pm) * 6144 + modidx * 1024;
    EPI_ROWS(u, wr, fr) {
      const int row = EPI_ROW(u, wr, fr);
      const float* hs = row < ML ? hL + (size_t)row * 1024 : hC + (size_t)(row - ML) * 1024;
#pragma unroll
      for (int bj = 0; bj < 2; ++bj) {
        const int c = u.pn * 256 + EPI_COL(wc, fq);
        const f32x4 h0 = *(const f32x4*)(hs + c), h1 = *(const f32x4*)(hs + c + 4);
        const f32x4 m0 = *(const f32x4*)(mv + c), m1 = *(const f32x4*)(mv + c + 4);
        float* hd = H + (size_t)row * 1024 + c;
        *(f32x4*)hd = h0 + m0 * acc[ai][bj][m][0]; *(f32x4*)(hd + 4) = h1 + m1 * acc[ai][bj][m][1];
      }
    }
  }
};
struct EpiFF1 {
  bf16_t* FFH;
  __device__ __forceinline__ void operator()(const Acc& acc, const Unit& u, int wr, int wc, int fr, int fq) const {
    EPI_ROWS(u, wr, fr) {
      const int row = EPI_ROW(u, wr, fr);
#pragma unroll
      for (int bj = 0; bj < 2; ++bj) {
        const int c = u.pn * 256 + EPI_COL(wc, fq);
        f32x4 a = acc[ai][bj][m][0], b = acc[ai][bj][m][1];
#pragma unroll
        for (int i = 0; i < 4; ++i) { a[i] = fmaxf(a[i], 0.f); a[i] *= a[i]; b[i] = fmaxf(b[i], 0.f); b[i] *= b[i]; }
        *(u32x4*)(FFH + (size_t)row * 4096 + c) = pack8(a, b);
      }
    }
  }
};

__device__ void mod_task(const P& p, int task, float* lds) {
  const int tid = otid();
  float* sc = lds;
  float* red = lds + 9 * 1024;
  for (int i = tid; i < 9 * 1024; i += 512) { const float v = i < 8192 ? p.c[i] : p.c_ctx[i - 8192]; sc[i] = v * sigm(v); }
  __syncthreads();
  const int l = task / 48, jb = task % 48, jl = tid & 127, ks = tid >> 7, j = jb * 128 + jl;
  float a[9];
#pragma unroll
  for (int s = 0; s < 9; ++s) a[s] = 0.f;
  const float* w = p.ada_w + (size_t)l * 1024 * 6144 + j;
#pragma unroll 8
  for (int k = ks * 256; k < ks * 256 + 256; ++k) {
    const float wv = w[(size_t)k * 6144];
#pragma unroll
    for (int s = 0; s < 9; ++s) a[s] += sc[s * 1024 + k] * wv;
  }
#pragma unroll
  for (int s = 0; s < 9; ++s) red[(ks * 9 + s) * 128 + jl] = a[s];
  __syncthreads();
  float* MOD = (float*)(p.ws + OFF_MOD);
  for (int i = tid; i < 9 * 128; i += 512) {
    const int s = i >> 7, jj = i & 127;
    const float v = red[(0 * 9 + s) * 128 + jj] + red[(1 * 9 + s) * 128 + jj] + red[(2 * 9 + s) * 128 + jj] + red[(3 * 9 + s) * 128 + jj];
    MOD[((size_t)l * 9 + s) * 6144 + jb * 128 + jj] = v + p.ada_b[l * 6144 + jb * 128 + jj];
  }
  __syncthreads();
}

__device__ void tr_tile(const float* src, int lds_, bf16_t* dst, int ldd, float* tile  ) {
  const int tid = otid();
#pragma unroll
  for (int ps = 0; ps < 2; ++ps) {
    const int k = (tid >> 4) + ps * 32, n4 = (tid & 15) * 4;
    const f32x4 v = *(const f32x4*)(src + (size_t)k * lds_ + n4);
    tile[k * 65 + n4] = v[0]; tile[k * 65 + n4 + 1] = v[1]; tile[k * 65 + n4 + 2] = v[2]; tile[k * 65 + n4 + 3] = v[3];
  }
  __syncthreads();
  {
    const int n = tid >> 3, k8 = (tid & 7) * 8;
    u32x4 o;
#pragma unroll
    for (int i = 0; i < 4; ++i) o[i] = cvt_pk_bf16(tile[(k8 + 2 * i) * 65 + n], tile[(k8 + 2 * i + 1) * 65 + n]);
    *(u32x4*)(dst + (size_t)n * ldd + k8) = o;
  }
  __syncthreads();
}

struct cpx { float re, im; };
__device__ __forceinline__ cpx cmul(cpx a, cpx b) { return {a.re * b.re - a.im * b.im, a.re * b.im + a.im * b.re}; }
template <bool FAST>
__device__ __forceinline__ cpx s5_apow(float lre, float lim, float dt, float e) {
  const float zr = lre * dt * e, zi = lim * dt * e;
  if (FAST) { const float mg = __expf(zr); return {mg * __cosf(zi), mg * __sinf(zi)}; }
  const float mg = expf(zr); float sn, cs; sincosf(zi, &sn, &cs); return {mg * cs, mg * sn};
}
template <bool FAST>
__device__ __forceinline__ cpx s5_coef(float lre, float lim, float dt) {
  const cpx a = s5_apow<FAST>(lre, lim, dt, 1.f); const float nr = a.re - 1.f, ni = a.im, den = lre * lre + lim * lim;
  return {(nr * lre + ni * lim) / den, (ni * lre - nr * lim) / den};
}

constexpr int NT_WIN = 1600, NT_FF1 = 1024, NT_FF2 = 1024, NT_OUT = 256, NT_BR = 256, NT_GLU = 16;
constexpr int NT_TR = NT_WIN + NT_FF1 + NT_FF2 + NT_OUT + NT_BR + NT_GLU;
constexpr int NT_TOEP = 512, NT_W2S = 256, NT_W1 = 128, NT_SGUW = 16;
constexpr int NT_PREP = NT_TR + NT_TOEP + NT_W2S + NT_W1 + NT_SGUW;

struct TrDesc { const float* src; bf16_t* dst; int lds_, ldd; };
__device__ __forceinline__ TrDesc tr_desc(const P& p, int l, int task) {
  unsigned char* ws = p.ws;
  const float* src; bf16_t* dst; int N, ldd, tk, tn;
  int t = task;
  if (t < NT_WIN) { src = p.w_in + (size_t)l * 1024 * 6400; N = 6400; dst = (bf16_t*)(ws + OFF_WIN); ldd = 1024; tk = t / 100; tn = t % 100; }
  else if ((t -= NT_WIN) < NT_FF1) { src = p.w_ff1 + (size_t)l * 1024 * 4096; N = 4096; dst = (bf16_t*)(ws + OFF_WFF1); ldd = 1024; tk = t / 64; tn = t % 64; }
  else if ((t -= NT_FF1) < NT_FF2) { src = p.w_ff2 + (size_t)l * 4096 * 1024; N = 1024; dst = (bf16_t*)(ws + OFF_WFF2); ldd = 4096; tk = t / 16; tn = t % 16; }
  else if ((t -= NT_FF2) < NT_OUT) { src = p.w_out + (size_t)l * 1024 * 1024; N = 1024; dst = (bf16_t*)(ws + OFF_WOUT); ldd = 1024; tk = t / 16; tn = t % 16; }
  else if ((t -= NT_OUT) < NT_BR) { const int k = t >> 6; t &= 63; src = p.w_branch + ((size_t)l * 4 + k) * 256 * 1024; N = 1024; dst = (bf16_t*)(ws + OFF_WBR) + k * 256; ldd = 1024; tk = t / 16; tn = t % 16; }
  else { t -= NT_BR; src = p.glu_w + (size_t)l * 256 * 256; N = 256; dst = (bf16_t*)(ws + OFF_WGLU); ldd = 256; tk = t / 4; tn = t % 4; }
  return {src + (size_t)tk * 64 * N + tn * 64, dst + (size_t)tn * 64 * ldd + tk * 64, N, ldd};
}
__device__ void tr_loop(const P& p, int l, int tbase, int t0, int t1, int td, float* tile  ) {
  if (t0 >= t1) return;
  const int tid = otid();
  const int k0 = tid >> 4, n4 = (tid & 15) * 4, n = tid >> 3, k8 = (tid & 7) * 8;
  TrDesc d = tr_desc(p, l, tbase + t0);
  f32x4 v0 = *(const f32x4*)(d.src + (size_t)k0 * d.lds_ + n4), v1 = *(const f32x4*)(d.src + (size_t)(k0 + 32) * d.lds_ + n4);
  for (int t = t0; t < t1; t += td) {
    tile[k0 * 65 + n4] = v0[0]; tile[k0 * 65 + n4 + 1] = v0[1]; tile[k0 * 65 + n4 + 2] = v0[2]; tile[k0 * 65 + n4 + 3] = v0[3];
    tile[(k0 + 32) * 65 + n4] = v1[0]; tile[(k0 + 32) * 65 + n4 + 1] = v1[1]; tile[(k0 + 32) * 65 + n4 + 2] = v1[2]; tile[(k0 + 32) * 65 + n4 + 3] = v1[3];
    __syncthreads();
    bf16_t* dcur = d.dst; const int lcur = d.ldd;
    if (t + td < t1) { d = tr_desc(p, l, tbase + t + td); v0 = *(const f32x4*)(d.src + (size_t)k0 * d.lds_ + n4); v1 = *(const f32x4*)(d.src + (size_t)(k0 + 32) * d.lds_ + n4); }
    u32x4 o;
#pragma unroll
    for (int i = 0; i < 4; ++i) o[i] = cvt_pk_bf16(tile[(k8 + 2 * i) * 65 + n], tile[(k8 + 2 * i + 1) * 65 + n]);
    *(u32x4*)(dcur + (size_t)n * lcur + k8) = o;
    __syncthreads();
  }
}

__device__ void prep_task(const P& p, int l, int task, float* lds) {
  const int tid = otid();
  unsigned char* ws = p.ws;
  if (task < NT_TR) {
    const float* src; bf16_t* dst; int N, ldd, tk, tn;
    int t = task;
    if (t < NT_WIN) { src = p.w_in + (size_t)l * 1024 * 6400; N = 6400; dst = (bf16_t*)(ws + OFF_WIN); ldd = 1024; tk = t / 100; tn = t % 100; }
    else if ((t -= NT_WIN) < NT_FF1) { src = p.w_ff1 + (size_t)l * 1024 * 4096; N = 4096; dst = (bf16_t*)(ws + OFF_WFF1); ldd = 1024; tk = t / 64; tn = t % 64; }
    else if ((t -= NT_FF1) < NT_FF2) { src = p.w_ff2 + (size_t)l * 4096 * 1024; N = 1024; dst = (bf16_t*)(ws + OFF_WFF2); ldd = 4096; tk = t / 16; tn = t % 16; }
    else if ((t -= NT_FF2) < NT_OUT) { src = p.w_out + (size_t)l * 1024 * 1024; N = 1024; dst = (bf16_t*)(ws + OFF_WOUT); ldd = 1024; tk = t / 16; tn = t % 16; }
    else if ((t -= NT_OUT) < NT_BR) { const int k = t >> 6; t &= 63; src = p.w_branch + ((size_t)l * 4 + k) * 256 * 1024; N = 1024; dst = (bf16_t*)(ws + OFF_WBR) + k * 256; ldd = 1024; tk = t / 16; tn = t % 16; }
    else { t -= NT_BR; src = p.glu_w + (size_t)l * 256 * 256; N = 256; dst = (bf16_t*)(ws + OFF_WGLU); ldd = 256; tk = t / 4; tn = t % 4; }
    tr_tile(src + (size_t)tk * 64 * N + tn * 64, N, dst + (size_t)tn * 64 * ldd + tk * 64, ldd, lds);
    return;
  }
  task -= NT_TR;
  bf16_t* W2 = (bf16_t*)(ws + OFF_W2);
  bf16_t* W1 = (bf16_t*)(ws + OFF_W1);
  if (task < NT_TOEP) {
    const int g = task >> 5, lag = task & 31;
    cpx* E = (cpx*)lds;
    float* sC = lds + 256;
    float* sB = sC + 4096;
    if (tid < 128) {
      const int d = tid >> 6, pp = tid & 63; const int li = ((l * 2 + d) * 16 + g);
      const float dt = expf(p.log_dt[li]); const float lre = p.lam_re[li * 64 + pp], lim = p.lam_im[li * 64 + pp];
      E[tid] = cmul(s5_apow<true>(lre, lim, dt, (float)lag), s5_coef<false>(lre, lim, dt));
    }
    for (int i = tid; i < 4096; i += 512) {
      const int d = i >> 11, ri = (i >> 10) & 1, r = i & 1023; const int li = ((l * 2 + d) * 16 + g);
      sC[i] = (ri ? p.c_im : p.c_re)[(size_t)li * 1024 + r];
      sB[i] = (ri ? p.b_im : p.b_re)[(size_t)li * 1024 + r];
    }
    __syncthreads();
    if (tid < 256) {
      const int hp = tid >> 4, h = tid & 15;
      float kv[2];
#pragma unroll
      for (int d = 0; d < 2; ++d) {
        const float* cre = sC + d * 2048 + hp * 64; const float* cim = cre + 1024;
        const float* bre = sB + d * 2048 + h; const float* bim = bre + 1024;
        float s = 0.f;
#pragma unroll 8
        for (int pp = 0; pp < 64; ++pp) {
          const cpx bb = cmul(E[d * 64 + pp], (cpx){bre[pp * 16], bim[pp * 16]});
          s += cre[pp] * bb.re - cim[pp] * bb.im;
        }
        kv[d] = s;
      }
      float* KT_ = (float*)(ws + OFF_KTAB);
      KT_[((size_t)(g * 2 + 0) * 32 + lag) * 256 + tid] = kv[0];
      KT_[((size_t)(g * 2 + 1) * 32 + lag) * 256 + tid] = kv[1];
    }
    __syncthreads();
    return;
  }
  task -= NT_TOEP;
  if (task < NT_W2S) {
    for (int it = 0; it < 8; ++it) {
      const int idx = (task * 8 + it) * 512 + tid;
      const int pp = idx & 63, d = (idx >> 6) & 1, hp = (idx >> 7) & 15, t = (idx >> 11) & 31, g = idx >> 16;
      const int li = ((l * 2 + d) * 16 + g);
      const float dt = expf(p.log_dt[li]); const float lre = p.lam_re[li * 64 + pp], lim = p.lam_im[li * 64 + pp];
      const cpx ap = s5_apow<true>(lre, lim, dt, d == 0 ? (float)(t + 1) : (float)(TCH - t));
      const cpx cc = {p.c_re[((size_t)li * 16 + hp) * 64 + pp], p.c_im[((size_t)li * 16 + hp) * 64 + pp]};
      const cpx v = cmul(cc, ap);
      *(unsigned*)(W2 + ((size_t)g * 512 + t * 16 + hp) * 768 + 512 + d * 128 + 2 * pp) = cvt_pk_bf16(v.re, -v.im);
    }
    return;
  }
  task -= NT_W2S;
  if (task < NT_W1) {
    const int idx = task * 512 + tid;
    const int j = idx & 31, pp = (idx >> 5) & 63, d = (idx >> 11) & 1, g = idx >> 12;
    const int li = ((l * 2 + d) * 16 + g);
    const float dt = expf(p.log_dt[li]); const float lre = p.lam_re[li * 64 + pp], lim = p.lam_im[li * 64 + pp];
    const cpx e = cmul(s5_apow<true>(lre, lim, dt, d == 0 ? (float)(TCH - 1 - j) : (float)j), s5_coef<false>(lre, lim, dt));
    const float* bre = p.b_re + ((size_t)li * 64 + pp) * 16; const float* bim = p.b_im + ((size_t)li * 64 + pp) * 16;
    bf16_t* r0 = W1 + ((size_t)g * 256 + d * 128 + 2 * pp) * 512 + j * 16;
    bf16_t* r1 = r0 + 512;
#pragma unroll
    for (int h = 0; h < 16; h += 2) {
      const cpx v0 = cmul(e, (cpx){bre[h], bim[h]}), v1 = cmul(e, (cpx){bre[h + 1], bim[h + 1]});
      *(unsigned*)(r0 + h) = cvt_pk_bf16(v0.re, v1.re); *(unsigned*)(r1 + h) = cvt_pk_bf16(v0.im, v1.im);
    }
    return;
  }
  task -= NT_W1;
  {
    bf16_t* W16 = (bf16_t*)(ws + OFF_SGUWT);
    for (int it = 0; it < 4; ++it) {
      const int idx = ((task * 4 + it) * 512 + tid) * 2;
      const float* sp = p.sgu_w + (size_t)l * 65536 + idx;
      *(unsigned*)(W16 + idx) = cvt_pk_bf16(sp[0], sp[1]);
    }
  }
}


__device__ __forceinline__ bool filler_range(int wg, int G, int first, int& start, int& stride) {
  if (G > first) { if (wg < first) return false; start = wg - first; stride = G - first; return true; }
  start = wg; stride = G; return true;
}
constexpr int PT_WIN0 = 0, PT_FF0 = NT_WIN, PT_WBR0 = NT_WIN + NT_FF1 + NT_FF2 + NT_OUT, PT_G10 = PT_WBR0 + NT_BR;
constexpr int PT_NMID = NT_FF1 + NT_FF2 + NT_OUT, PT_NG1 = NT_PREP - PT_G10;

constexpr int NT_ASM = 256;
__device__ void w2_assemble_task(const P& p, int l, int task) {
  const float* KT_ = (const float*)(p.ws + OFF_KTAB);
  bf16_t* W2 = (bf16_t*)(p.ws + OFF_W2);
  const int tid = otid();
#pragma unroll
  for (int it = 0; it < 4; ++it) {
    const int idx = (task * 4 + it) * 512 + tid;
    const int hh = (idx & 1) * 8, j = (idx >> 1) & 31, row = (idx >> 6) & 511, g = idx >> 15;
    const int t = row >> 4, hp = row & 15;
    f32x4 a = {0.f, 0.f, 0.f, 0.f}, b = {0.f, 0.f, 0.f, 0.f};
    if (j <= t) { const float* k0 = KT_ + ((size_t)(g * 2 + 0) * 32 + (t - j)) * 256 + hp * 16 + hh; a += *(const f32x4*)k0; b += *(const f32x4*)(k0 + 4); }
    if (j >= t) { const float* k1 = KT_ + ((size_t)(g * 2 + 1) * 32 + (j - t)) * 256 + hp * 16 + hh; a += *(const f32x4*)k1; b += *(const f32x4*)(k1 + 4); }
    if (j == t && (hp >> 3) == (hh >> 3)) { const float dv = p.s5_d[l * 256 + g * 16 + hp]; const int e = hp & 7; if (e < 4) a[e] += dv; else b[e - 4] += dv; }
    *(u32x4*)(W2 + ((size_t)g * 512 + row) * 768 + j * 16 + hh) = pack8(a, b);
  }
}

__device__ void norm_rows(const P& p, const float* hL, const float* hC, const float* gvec, const float* modbase, int shift_idx, int nrows, const float* resmod  ) {
  const int tid = otid(); const int lane = tid & 63, wid = tid >> 6;
  bf16_t* A = (bf16_t*)(p.ws + OFF_A);
  const int stride = gridDim.x * 8;
  int row = blockIdx.x * 8 + wid;
  for (; row + 3 * stride < ML; row += 4 * stride) {
    f32x4 v[4][4]; float rstd[4];
#pragma unroll
    for (int r = 0; r < 4; ++r)
#pragma unroll
      for (int i = 0; i < 4; ++i) v[r][i] = *(const f32x4*)(hL + (size_t)(row + r * stride) * 1024 + i * 256 + lane * 4);
#pragma unroll
    for (int r = 0; r < 4; ++r) {
      float ss = 0.f;
#pragma unroll
      for (int i = 0; i < 4; ++i) ss += v[r][i][0] * v[r][i][0] + v[r][i][1] * v[r][i][1] + v[r][i][2] * v[r][i][2] + v[r][i][3] * v[r][i][3];
      ss = wave_sum(ss, lane);
      rstd[r] = rsqrtf(ss * (1.f / 1024.f) + 1e-6f);
    }
#pragma unroll
    for (int i = 0; i < 4; ++i) {
      const int c = i * 256 + lane * 4;
      const f32x4 g = *(const f32x4*)(gvec + c);
#pragma unroll
      for (int r = 0; r < 4; ++r) {
        const int rr = row + r * stride;
        const float* sh = modbase + (size_t)(rr >> 11) * 6144 + shift_idx * 1024;
        const f32x4 s1 = *(const f32x4*)(sh + 1024 + c), s0 = *(const f32x4*)(sh + c);
        f32x4 y;
#pragma unroll
        for (int q = 0; q < 4; ++q) y[q] = (v[r][i][q] * rstd[r] * g[q]) * (1.f + s1[q]) + s0[q];
        u32x2 o; o[0] = cvt_pk_bf16(y[0], y[1]); o[1] = cvt_pk_bf16(y[2], y[3]);
        *(u32x2*)(A + (size_t)rr * 1024 + c) = o;
      }
    }
  }
  for (; row < nrows; row += stride) {
    const float* h = row < ML ? hL + (size_t)row * 1024 : hC + (size_t)(row - ML) * 1024;
    const int bsel = row < ML ? (row >> 11) : 8;
    const float* sh = modbase + (size_t)bsel * 6144 + shift_idx * 1024; const float* sc = sh + 1024;
    f32x4 v[4]; float ss = 0.f;
#pragma unroll
    for (int i = 0; i < 4; ++i) v[i] = *(const f32x4*)(h + i * 256 + lane * 4);
    if (resmod && row >= ML) {
      const bf16_t* pr = (const bf16_t*)(p.ws + OFF_PART) + (size_t)(row - ML) * 1024;
      float* hw = (float*)(p.ws + OFF_H) + (size_t)row * 1024;
#pragma unroll
      for (int i = 0; i < 4; ++i) {
        const int c = i * 256 + lane * 4;
        f32x4 sm = {0.f, 0.f, 0.f, 0.f};
#pragma unroll
        for (int sl = 0; sl < 8; ++sl) { const u32x2 w = *(const u32x2*)(pr + (size_t)sl * MC * 1024 + c); sm[0] += bflo(w[0]); sm[1] += bfhi(w[0]); sm[2] += bflo(w[1]); sm[3] += bfhi(w[1]); }
        v[i] += *(const f32x4*)(resmod + c) * sm;
        *(f32x4*)(hw + c) = v[i];
      }
    }
#pragma unroll
    for (int i = 0; i < 4; ++i) ss += v[i][0] * v[i][0] + v[i][1] * v[i][1] + v[i][2] * v[i][2] + v[i][3] * v[i][3];
    ss = wave_sum(ss, lane);
    const float rstd = rsqrtf(ss * (1.f / 1024.f) + 1e-6f);
#pragma unroll
    for (int i = 0; i < 4; ++i) {
      const int c = i * 256 + lane * 4;
      const f32x4 g = *(const f32x4*)(gvec + c), s1 = *(const f32x4*)(sc + c), s0 = *(const f32x4*)(sh + c);
      f32x4 y;
#pragma unroll
      for (int q = 0; q < 4; ++q) y[q] = (v[i][q] * rstd * g[q]) * (1.f + s1[q]) + s0[q];
      u32x2 o; o[0] = cvt_pk_bf16(y[0], y[1]); o[1] = cvt_pk_bf16(y[2], y[3]);
      *(u32x2*)(A + (size_t)row * 1024 + c) = o;
    }
  }
}

__device__ void final_rows(const P& p) {
  const int tid = otid(); const int lane = tid & 63, wid = tid >> 6;
  const float* H = (const float*)(p.ws + OFF_H);
  const int stride = gridDim.x * 8;
  for (int row = blockIdx.x * 8 + wid; row < ML; row += 4 * stride) {
    f32x4 v[4][4];
#pragma unroll
    for (int r = 0; r < 4; ++r)
#pragma unroll
      for (int i = 0; i < 4; ++i) { const int rr = row + r * stride; v[r][i] = rr < ML ? *(const f32x4*)(H + (size_t)rr * 1024 + i * 256 + lane * 4) : (f32x4){0.f, 0.f, 0.f, 0.f}; }
#pragma unroll
    for (int r = 0; r < 4; ++r) {
      const int rr = row + r * stride;
      float ss = 0.f;
#pragma unroll
      for (int i = 0; i < 4; ++i) ss += v[r][i][0] * v[r][i][0] + v[r][i][1] * v[r][i][1] + v[r][i][2] * v[r][i][2] + v[r][i][3] * v[r][i][3];
      ss = wave_sum(ss, lane);
      const float rstd = rsqrtf(ss * (1.f / 1024.f) + 1e-6f);
      if (rr < ML) {
#pragma unroll
        for (int i = 0; i < 4; ++i) {
          const int c = i * 256 + lane * 4;
          const f32x4 g = *(const f32x4*)(p.final_g + c);
          f32x4 y;
#pragma unroll
          for (int q = 0; q < 4; ++q) y[q] = v[r][i][q] * rstd * g[q];
          *(f32x4*)(p.out + (size_t)rr * 1024 + c) = y;
        }
      }
    }
  }
}

template <bool LAT>
__device__ __forceinline__ void attn_task(const P& p, int task, int l, const float* rpb_lds, int lane) {
  constexpr int NG = LAT ? 16 : 8;
  const bf16_t* PS = (const bf16_t*)(p.ws + OFF_PS);
  const bf16_t* VT = (const bf16_t*)(p.ws + OFF_VT);
  const bf16_t* KT = (const bf16_t*)(p.ws + OFF_KT);
  bf16_t* Y4 = (bf16_t*)(p.ws + OFF_Y4);
  int b, head, r = 0, jb = 0, qrow0;
  if (LAT) { jb = task & 3; r = (task >> 2) & 31; head = (task >> 7) & 3; b = task >> 9; qrow0 = b * 2048 + r * 64 + jb * 16; }
  else { const int qb = task & 15; head = (task >> 4) & 3; b = task >> 6; qrow0 = ML + b * 256 + qb * 16; }
  const int n = lane & 15, kg = lane >> 4;
  const bf16_t* qp = PS + (size_t)(qrow0 + n) * 2304 + 256 + head * 64 + kg * 8;
  const bf16x8 q0 = *(const bf16x8*)qp, q1 = *(const bf16x8*)(qp + 32);
  const int rs = LAT ? min(max(r - 4, 0), 24) : 0;
  const int clo = LAT ? (jb == 0 ? 0 : jb == 1 ? 8 : jb == 2 ? 24 : 32) : 0;
  const int keyX = 8 * (n >> 2) + (n & 3);
  f32x4 s[NG][2];
#pragma unroll
  for (int gb = 0; gb < NG; gb += 4) {
    bf16x8 kf[4][4];
#pragma unroll
    for (int g4 = 0; g4 < 4; ++g4) {
      const int gi = gb + g4;
      int tk0;
      if (LAT && gi < 8) tk0 = (rs + gi) * 64 + clo; else tk0 = 2048 + (gi - (LAT ? 8 : 0)) * 32;
      const bf16_t* kp = KT + ((size_t)(b * 4 + head) * 2304 + tk0 + keyX) * 64 + kg * 8;
      kf[g4][0] = *(const bf16x8*)kp; kf[g4][1] = *(const bf16x8*)(kp + 32);
      kf[g4][2] = *(const bf16x8*)(kp + 4 * 64); kf[g4][3] = *(const bf16x8*)(kp + 4 * 64 + 32);
    }
    __builtin_amdgcn_sched_barrier(0);
#pragma unroll
    for (int g4 = 0; g4 < 4; ++g4) {
      const int gi = gb + g4;
      f32x4 z = {0.f, 0.f, 0.f, 0.f};
      s[gi][0] = __builtin_amdgcn_mfma_f32_16x16x32_bf16(kf[g4][0], q0, z, 0, 0, 0);
      s[gi][0] = __builtin_amdgcn_mfma_f32_16x16x32_bf16(kf[g4][1], q1, s[gi][0], 0, 0, 0);
      s[gi][1] = __builtin_amdgcn_mfma_f32_16x16x32_bf16(kf[g4][2], q0, z, 0, 0, 0);
      s[gi][1] = __builtin_amdgcn_mfma_f32_16x16x32_bf16(kf[g4][3], q1, s[gi][1], 0, 0, 0);
    }
    __builtin_amdgcn_sched_barrier(0);
  }
  float mx = -3.0e38f;
  const int jq = jb * 16 + n; const int cs = min(max(jq - 8, 0), 48);
#pragma unroll
  for (int gi = 0; gi < NG; ++gi)
#pragma unroll
    for (int blk = 0; blk < 2; ++blk)
#pragma unroll
      for (int i = 0; i < 4; ++i) {
        float v = s[gi][blk][i] * 0.125f;
        if (LAT && gi < 8) {
          const int kc = clo + 8 * kg + blk * 4 + i;
          const bool ok = (kc >= cs) && (kc < cs + 16);
          const int dr = rs + gi - r + 7; const int dc = min(max(kc - jq + 15, 0), 30);
          const float bias = rpb_lds[(head * 15 + dr) * 31 + dc];
          v = ok ? v + bias : -1.0e30f;
        }
        s[gi][blk][i] = v; mx = fmaxf(mx, v);
      }
  mx = fmaxf(mx, shx(mx, 16, lane)); mx = fmaxf(mx, shx(mx, 32, lane));
  float sum = 0.f;
#pragma unroll
  for (int gi = 0; gi < NG; ++gi)
#pragma unroll
    for (int blk = 0; blk < 2; ++blk)
#pragma unroll
      for (int i = 0; i < 4; ++i) { const float e = __expf(s[gi][blk][i] - mx); s[gi][blk][i] = e; sum += e; }
  sum += shx(sum, 16, lane); sum += shx(sum, 32, lane);
  f32x4 o[4];
#pragma unroll
  for (int db = 0; db < 4; ++db) o[db] = (f32x4){0.f, 0.f, 0.f, 0.f};
  const bf16_t* vbase = VT + ((size_t)(b * 4 + head) * 288 + kg) * 512 + n * 8;
#pragma unroll
  for (int gb = 0; gb < NG; gb += 2) {
    bf16x8 vf[2][4];
#pragma unroll
    for (int g4 = 0; g4 < 2; ++g4) {
      const int gi = gb + g4;
      int tok0;
      if (LAT && gi < 8) tok0 = (rs + gi) * 64 + clo; else tok0 = 2048 + (gi - (LAT ? 8 : 0)) * 32;
#pragma unroll
      for (int db = 0; db < 4; ++db) vf[g4][db] = *(const bf16x8*)(vbase + (size_t)(tok0 >> 3) * 512 + db * 128);
    }
    __builtin_amdgcn_sched_barrier(0);
#pragma unroll
    for (int g4 = 0; g4 < 2; ++g4) {
      const int gi = gb + g4;
      const u32x4 pk = pack8(s[gi][0], s[gi][1]);
      bf16x8 pf; __builtin_memcpy(&pf, &pk, 16);
#pragma unroll
      for (int db = 0; db < 4; ++db) o[db] = __builtin_amdgcn_mfma_f32_16x16x32_bf16(vf[g4][db], pf, o[db], 0, 0, 0);
    }
    __builtin_amdgcn_sched_barrier(0);
  }
  const float inv = 1.f / sum;
  bf16_t* op = Y4 + (size_t)(qrow0 + n) * 1024 + 256 + head * 64 + kg * 4;
#pragma unroll
  for (int db = 0; db < 4; ++db) {
    u32x2 w; w[0] = cvt_pk_bf16(o[db][0] * inv, o[db][1] * inv); w[1] = cvt_pk_bf16(o[db][2] * inv, o[db][3] * inv);
    *(u32x2*)(op + db * 16) = w;
  }
}

__device__ __forceinline__ void conv_task(const P& p, int l, int task) {
  const bf16_t* PS = (const bf16_t*)(p.ws + OFF_PS);
  bf16_t* Y4 = (bf16_t*)(p.ws + OFF_Y4);
  const int idx = task * 512 + otid();
  const int row = idx >> 5, c0 = (idx & 31) * 8;
  int pos, len; if (row < ML) { pos = row & 2047; len = 2048; } else { pos = (row - ML) & 255; len = 256; }
  const bf16_t* base = PS + (size_t)row * 2304;
  float z[3][8];
#pragma unroll
  for (int d = 0; d < 3; ++d) {
    const int pp = pos + d - 1;
    if (pp >= 0 && pp < len) {
      const u32x4 cv = *(const u32x4*)(base + (d - 1) * 2304 + 5 * 256 + c0), xv = *(const u32x4*)(base + (d - 1) * 2304 + 6 * 256 + c0);
#pragma unroll
      for (int i = 0; i < 4; ++i) { z[d][2 * i] = bflo(cv[i]) * bflo(xv[i]); z[d][2 * i + 1] = bfhi(cv[i]) * bfhi(xv[i]); }
    } else {
#pragma unroll
      for (int i = 0; i < 8; ++i) z[d][i] = 0.f;
    }
  }
  const u32x4 bv = *(const u32x4*)(base + 4 * 256 + c0);
  const float* w = p.conv_w + (size_t)l * 3 * 256 + c0;
  float y[8];
#pragma unroll
  for (int i = 0; i < 8; ++i) y[i] = w[i] * z[0][i] + w[256 + i] * z[1][i] + w[512 + i] * z[2][i];
  u32x4 o;
#pragma unroll
  for (int i = 0; i < 4; ++i) o[i] = cvt_pk_bf16(bflo(bv[i]) * y[2 * i], bfhi(bv[i]) * y[2 * i + 1]);
  *(u32x4*)(Y4 + (size_t)row * 1024 + 512 + c0) = o;
}

__device__ void sgu_task(const P& p, int l, int task, float* lds) {
  const int tid = otid();
  const bf16_t* PS = (const bf16_t*)(p.ws + OFF_PS);
  bf16_t* Y4 = (bf16_t*)(p.ws + OFF_Y4);
  const bf16_t* W16 = (const bf16_t*)(p.ws + OFF_SGUWT);
  const int chunk = task >> 2, g = task & 3;
  bf16_t* vnT = (bf16_t*)lds;
  constexpr int VS = 136;
  {
    const int s = tid >> 2, q = tid & 3;
    const bf16_t* vr = PS + (size_t)(chunk * 128 + s) * 2304 + 8 * 256;
    float sm = 0.f, sq = 0.f;
#pragma unroll
    for (int i = 0; i < 8; ++i) {
      const u32x4 v = *(const u32x4*)(vr + q * 64 + i * 8);
#pragma unroll
      for (int k = 0; k < 4; ++k) { const float a = bflo(v[k]), b = bfhi(v[k]); sm += a + b; sq += a * a + b * b; }
    }
    { const int ln = tid & 63; sm += shx(sm, 1, ln); sm += shx(sm, 2, ln); sq += shx(sq, 1, ln); sq += shx(sq, 2, ln); }
    const float mu = sm * (1.f / 256.f); const float var = fmaxf(sq * (1.f / 256.f) - mu * mu, 0.f); const float rstd = rsqrtf(var + 1e-6f);
    const int cb = g * 64 + q * 16;
    const float* lg = p.ln_g + l * 256 + cb; const float* lb = p.ln_b + l * 256 + cb;
#pragma unroll
    for (int i = 0; i < 2; ++i) {
      const u32x4 v = *(const u32x4*)(vr + cb + i * 8);
#pragma unroll
      for (int k = 0; k < 4; ++k) {
        const int cc = i * 8 + 2 * k;
        const unsigned pk = cvt_pk_bf16((bflo(v[k]) - mu) * rstd * lg[cc] + lb[cc], (bfhi(v[k]) - mu) * rstd * lg[cc + 1] + lb[cc + 1]);
        vnT[(q * 16 + cc) * VS + s] = (bf16_t)(pk & 0xffffu);
        vnT[(q * 16 + cc + 1) * VS + s] = (bf16_t)(pk >> 16);
      }
    }
  }
  __syncthreads();
  const int lane = tid & 63, w = tid >> 6, n = lane & 15, kg = lane >> 4;
  const int t = w * 16 + n;
  const bf16_t* wp = W16 + ((size_t)(g * 128 + t)) * 128 + kg * 8;
  bf16x8 wf[4];
#pragma unroll
  for (int ks = 0; ks < 4; ++ks) wf[ks] = *(const bf16x8*)(wp + ks * 32);
  f32x4 acc[4];
#pragma unroll
  for (int cb = 0; cb < 4; ++cb) {
    acc[cb] = (f32x4){0.f, 0.f, 0.f, 0.f};
#pragma unroll
    for (int ks = 0; ks < 4; ++ks) {
      const bf16x8 vf = *(const bf16x8*)(vnT + (cb * 16 + n) * VS + ks * 32 + kg * 8);
      acc[cb] = __builtin_amdgcn_mfma_f32_16x16x32_bf16(vf, wf[ks], acc[cb], 0, 0, 0);
    }
  }
  const int row = chunk * 128 + t;
  const float bs = p.sgu_b[((size_t)l * 4 + g) * 128 + t];
#pragma unroll
  for (int cb = 0; cb < 4; ++cb) {
    const int c = g * 64 + cb * 16 + kg * 4;
    const u32x2 uv = *(const u32x2*)(PS + (size_t)row * 2304 + 7 * 256 + c);
    u32x2 o; o[0] = cvt_pk_bf16(bflo(uv[0]) * (acc[cb][0] + bs), bfhi(uv[0]) * (acc[cb][1] + bs)); o[1] = cvt_pk_bf16(bflo(uv[1]) * (acc[cb][2] + bs), bfhi(uv[1]) * (acc[cb][3] + bs));
    *(u32x2*)(Y4 + (size_t)row * 1024 + 768 + c) = o;
  }
  __syncthreads();
}

__device__ void carry_phase(const P& p, int l) {
  const int gt = blockIdx.x * 512 + otid();
  if (gt >= 16 * 8 * 2 * 64) return;
  const int pp = gt & 63, d = (gt >> 6) & 1, b = (gt >> 7) & 7, g = gt >> 10;
  const float* S = (const float*)(p.ws + OFF_S) + (size_t)g * NCHUNK * 256 + d * 128 + 2 * pp;
  bf16_t* XU = (bf16_t*)(p.ws + OFF_XU) + (size_t)g * XUR * XUK + 512 + d * 128 + 2 * pp;
  const int li = ((l * 2 + d) * 16 + g);
  const float dt = expf(p.log_dt[li]);
  const cpx aT = s5_apow<false>(p.lam_re[li * 64 + pp], p.lam_im[li * 64 + pp], dt, (float)TCH);
  cpx st = {0.f, 0.f};
  for (int i0 = 0; i0 < 72; i0 += 8) {
    float sre[8], sim[8]; int rows[8];
#pragma unroll
    for (int k = 0; k < 8; ++k) {
      const int i = i0 + k; int row;
      if (i < 8) row = 512 + b * 8 + (d == 0 ? i : 7 - i); else row = b * 64 + (d == 0 ? (i - 8) : 63 - (i - 8));
      rows[k] = row; const float2 v = *(const float2*)(S + (size_t)row * 256); sre[k] = v.x; sim[k] = v.y;
    }
#pragma unroll
    for (int k = 0; k < 8; ++k) {
      *(unsigned*)(XU + (size_t)rows[k] * XUK) = cvt_pk_bf16(st.re, st.im);
      const cpx ns = cmul(aT, st); st.re = ns.re + sre[k]; st.im = ns.im + sim[k];
    }
  }
}

constexpr int PH_PER_LAYER = 11;
constexpr int N_PHASES = 1 + NDEPTH * PH_PER_LAYER + 1;

__global__ void __launch_bounds__(512, 2) mk_forward(P p_arg) {
  extern __shared__ __attribute__((aligned(16))) unsigned char shm[];
  LAS unsigned char* lds = (LAS unsigned char*)shm;
  float* ldsf = (float*)shm;
  unsigned char* ws0 = p_arg.ws;
  volatile LAS unsigned* xbw = (volatile LAS unsigned*)(lds + 131072);
  if (threadIdx.x == 0) { xbw[0] = 0u; xbw[1] = 0u; xbw[2] = 0u; xbw[3] = 0u; }
  __syncthreads();
  const XcdBarrier xb = xcd_barrier_post((unsigned*)(ws0 + OFF_BAR), xbw);
  if (p_arg.ph_lo < 0) cg::this_grid().sync();

  for (int ph = p_arg.ph_lo; ph < p_arg.ph_hi; ++ph) {
    int nrep = 1;
#if DBL_MASK
    { const int spx = (ph == 0) ? 11 : (ph == N_PHASES - 1) ? 13 : (ph - 1) % PH_PER_LAYER; if ((DBL_MASK >> spx) & 1) nrep = 2; }
#endif
    for (int rep = 0; rep < nrep; ++rep) {
    if (rep) xcd_barrier(xb);
    int G_ = gridDim.x, wg_ = blockIdx.x; asm volatile("" : "+s"(G_), "+s"(wg_));
    const int G = G_, wg = wg_;
    unsigned char* ws = ws0; asm volatile("" : "+s"(ws));
    P p = p_arg; p.ws = ws;
    float* H = (float*)(ws + OFF_H);
    const float* MOD = (const float*)(ws + OFF_MOD);
    if (ph == 0) {
      for (int t = wg; t < 192; t += G) mod_task(p, t, ldsf);
      { const int t0 = (wg + G - (192 % G)) % G;
        tr_loop(p, 0, 0, t0, NT_WIN, G, ldsf);
        const int r = (NT_WIN - t0 + G - 1) / G; tr_loop(p, 0, PT_WBR0, t0 + r * G - NT_WIN, NT_BR, G, ldsf); }
    } else if (ph == N_PHASES - 1) {
      final_rows(p);
#if TSEL
      xcd_barrier(xb);
      if (wg == 0) { const unsigned long long* ts = (const unsigned long long*)(ws + OFF_BAR + 14336); const unsigned long long v = ts[TSEL - 1]; const int N = (int)(TSEL == 3 ? v * 1000 : v / 10);
        for (int i = otid(); i < N && i < 300000; i += 512) p.out[(size_t)i * 16] += 0.125f; }
#endif
    } else {
      const int l = (ph - 1) / PH_PER_LAYER, sp = (ph - 1) % PH_PER_LAYER;
      const bool last = (l == NDEPTH - 1);
      const float* hL = l == 0 ? p.x : H; const float* hC = l == 0 ? p.ctx : H + (size_t)ML * 1024;
      const float* modl = MOD + (size_t)l * 9 * 6144;
      const int nMrows = last ? 64 : 72;
      switch (sp) {
#if PHMASK & 1
        case 0: {
          for (int t = wg; t < PT_NG1; t += G) prep_task(p, l, PT_G10 + t, ldsf);
          norm_rows(p, hL, hC, p.norm_g + (size_t)(l * 2 + 0) * 1024, modl, 0, MT, l > 0 ? MOD + ((size_t)(l - 1) * 9 + 8) * 6144 + 5 * 1024 : nullptr);
        } break;
#endif
#if PHMASK & 2
        case 1: {
          G1Sched S{(const char*)(ws + OFF_A), (const char*)(ws + OFF_WIN), G, wg, last ? 1 : 0};
          EpiG1 E{(bf16_t*)(ws + OFF_PS), (bf16_t*)(ws + OFF_XU), (bf16_t*)(ws + OFF_VT), (bf16_t*)(ws + OFF_KT)};
          gemm_phase(lds, 1024, 1024, S, E, (TSEL && TPHASE == 1 && wg == 0) ? (unsigned long long*)(ws + OFF_BAR + 14336) : nullptr);
          { int st, sd; if (filler_range(wg, G, 136, st, sd)) for (int t = st; t < NT_ASM; t += sd) w2_assemble_task(p, l, t); }
        } break;
#endif
#if PHMASK & 4
        case 2: {
          {
            S5Sched S{(const char*)(ws + OFF_XU), (const char*)(ws + OFF_W1), (size_t)256 * 512 * 2, 0, 3, 1, 8, G, wg};
            EpiS1 E{(float*)(ws + OFF_S)};
            gemm_phase(lds, XUK, 512, S, E);
          }
          __syncthreads();
          const int tid2 = otid(), lane2 = tid2 & 63, wid2 = tid2 >> 6;
          for (int i = tid2; i < 4 * 15 * 31; i += 512) ldsf[i] = p.rpb[(size_t)l * 4 * 15 * 31 + i];
          __syncthreads();
          const int nwaves = G * 8, gw = wg * 8 + wid2;
#if TSEL
          unsigned long long* tsl = (unsigned long long*)(ws + OFF_BAR + 14336); const unsigned long long tq0 = __builtin_amdgcn_s_memrealtime();
#endif
          for (int t = gw; t < 4096; t += nwaves) attn_task<true>(p, t, l, ldsf, lane2);
          if (!last) for (int t = nwaves - 1 - gw; t < 512; t += nwaves) attn_task<false>(p, t, l, ldsf, lane2);
#if TSEL
          __syncthreads(); const unsigned long long tq1 = __builtin_amdgcn_s_memrealtime();
#endif
        } break;
#endif
#if PHMASK & 8
        case 3: {
          carry_phase(p, l);
          const int nconv = (last ? ML : MT) * 32 / 512;
          int st, sd; if (filler_range(wg, G, 32, st, sd)) for (int t = st; t < nconv; t += sd) conv_task(p, l, t);
        } break;
#endif
#if PHMASK & 16
        case 4: {
          S5Sched S{(const char*)(ws + OFF_XU), (const char*)(ws + OFF_W2), (size_t)512 * 768 * 2, (size_t)256 * 768 * 2, last ? 2 : 3, 2, 12, G, wg};
          EpiS2 E{(bf16_t*)(ws + OFF_YG), last ? 512 : NCHUNK};
          gemm_phase(lds, XUK, 768, S, E);
          const int nsgu = (last ? 128 : 144) * 4;
          { int st, sd; if (filler_range(wg, G, 96, st, sd)) { __syncthreads(); for (int t = st; t < nsgu / 2; t += sd) sgu_task(p, l, t, ldsf); } }
        } break;
#endif
#if PHMASK & 32
        case 5: {
          RectSched S{(const char*)(ws + OFF_YG), (const char*)(ws + OFF_WGLU), (size_t)256 * 256 * 2, 0, nMrows, 1, 4, G, wg};
          EpiGLU E{(const bf16_t*)(ws + OFF_YG), p.glu_b + l * 256, (bf16_t*)(ws + OFF_Y4)};
          gemm_phase(lds, 256, 256, S, E);
          const int nsgu = (last ? 128 : 144) * 4;
          { int st, sd; if (filler_range(wg, G, 72, st, sd)) { __syncthreads(); for (int t = nsgu / 2 + st; t < nsgu; t += sd) sgu_task(p, l, t, ldsf); } }
        } break;
#endif
#if PHMASK & 64
        case 6: {
          MergeSched S{(const char*)(ws + OFF_A), (const char*)(ws + OFF_Y4), (const char*)(ws + OFF_WIN), (const char*)(ws + OFF_WBR), last ? 0 : 128, G, wg};
          EpiMerge E{ws + OFF_GS + (size_t)wg * 65536, (bf16_t*)(ws + OFF_MIXTMP + (size_t)wg * 131072), (bf16_t*)(ws + OFF_MIX), (bf16_t*)(ws + OFF_GP)};
          gemm_phase(lds, 1024, 1024, S, E, (TSEL && TPHASE == 6 && wg == 0) ? (unsigned long long*)(ws + OFF_BAR + 14336) : nullptr);
          { int st, sd; if (filler_range(wg, G, last ? 0 : 128, st, sd)) tr_loop(p, l, PT_FF0, st, PT_NMID, sd, ldsf); }
        } break;
#endif
#if PHMASK & 128
        case 7: {
          WoutSched S{(const char*)(ws + OFF_MIX), (const char*)(ws + OFF_GP), (const char*)(ws + OFF_WOUT), last ? 0 : 256, G, wg};
          EpiRes E{hL, hC, H, modl, 2, (float*)(ws + OFF_PART)};
          gemm_phase(lds, 1024, 1024, S, E);
        } break;
#endif
#if PHMASK & 256
        case 8: {
          norm_rows(p, H, l == 0 ? p.ctx : H + (size_t)ML * 1024, p.norm_g + (size_t)(l * 2 + 1) * 1024, modl, 3, last ? ML : MT, modl + (size_t)8 * 6144 + 2 * 1024);
          if (!last) for (int t = wg; t < NT_BR; t += G) prep_task(p, l + 1, PT_WBR0 + t, ldsf);
        } break;
#endif
#if PHMASK & 512
        case 9: {
          RectSched S{(const char*)(ws + OFF_A), (const char*)(ws + OFF_WFF1), (size_t)256 * 1024 * 2, (size_t)256 * 1024 * 2, nMrows, 16, 16, G, wg};
          EpiFF1 E{(bf16_t*)(ws + OFF_FFH)};
          gemm_phase(lds, 1024, 1024, S, E, (TSEL && TPHASE == 9 && wg == 0) ? (unsigned long long*)(ws + OFF_BAR + 14336) : nullptr);
          if (!last) { int st, sd; if (filler_range(wg, G, 128, st, sd)) tr_loop(p, l + 1, 0, st, NT_WIN, sd, ldsf); }
        } break;
#endif
#if PHMASK & 1024
        case 10: {
          SplitSched S{(const char*)(ws + OFF_FFH), (const char*)(ws + OFF_WFF2), (const char*)(ws + OFF_FFH) + (size_t)64 * 256 * 4096 * 2, (size_t)256 * 4096 * 2, (size_t)256 * 4096 * 2, (size_t)256 * 4096 * 2, 64, 8, 256, last ? 0 : 256, G, wg};
          EpiRes E{H, H + (size_t)ML * 1024, H, modl, 5, (float*)(ws + OFF_PART)};
          gemm_phase(lds, 4096, 4096, S, E);
        } break;
#endif
      }
    }
    }
    if (ph + 1 < p_arg.ph_hi) { xcd_barrier(xb);
#if (DBL_MASK >> 12) & 1
      xcd_barrier(xb);
#endif
    }
  }
}

extern "C" void kernel_launch(void* const* d_in, const int* in_sizes, int n_in, void* d_out, int out_size, void* d_ws, size_t ws_size, hipStream_t stream) {
  constexpr size_t kDynLds = 131072 + 16;
  static int grid_blocks = 0;
  if (!grid_blocks) {
    (void)hipFuncSetAttribute((const void*)mk_forward, hipFuncAttributeMaxDynamicSharedMemorySize, (int)kDynLds);
    int dev = 0, cus = 0, per_cu = 0;
    (void)hipGetDevice(&dev);
    (void)hipDeviceGetAttribute(&cus, hipDeviceAttributeMultiprocessorCount, dev);
    (void)hipOccupancyMaxActiveBlocksPerMultiprocessor(&per_cu, mk_forward, 512, kDynLds);
    if (per_cu < 1) per_cu = 1;
    grid_blocks = cus;
  }
  P p{};
  const float** pp = (const float**)&p;
  for (int i = 0; i < 29; ++i) pp[i] = (const float*)d_in[i];
  p.out = (float*)d_out; p.ws = (unsigned char*)d_ws;
  (void)hipMemsetAsync((unsigned char*)d_ws + OFF_BAR, 0, 16384, stream);
#if MULTI_LAUNCH
  for (int ph = 0; ph < N_PHASES; ++ph) {
    p.ph_lo = ph; p.ph_hi = ph + 1;
    hipLaunchKernelGGL(mk_forward, dim3(grid_blocks), dim3(512), kDynLds, stream, p);
  }
#else
  p.ph_lo = 0; p.ph_hi = N_PHASES;
  void* args[] = {&p};
  (void)hipLaunchCooperativeKernel((void*)mk_forward, dim3(grid_blocks), dim3(512), args, kDynLds, stream);
#endif
}
```

```cpp
#include <hip/hip_runtime.h>
#include <hip/hip_cooperative_groups.h>
namespace cg = cooperative_groups;

#define LAS __attribute__((address_space(3)))
typedef unsigned short bf16_t;
typedef short bf16x8 __attribute__((ext_vector_type(8)));
typedef float f32x4 __attribute__((ext_vector_type(4)));
typedef unsigned u32x4 __attribute__((ext_vector_type(4)));
typedef unsigned u32x2 __attribute__((ext_vector_type(2)));

#ifndef PHMASK
#define PHMASK 0x7ff
#endif
#ifndef DBL_MASK
#define DBL_MASK 0
#endif
#ifndef TSEL
#define TSEL 0
#endif
#ifndef TPHASE
#define TPHASE 6
#endif
#ifndef MULTI_LAUNCH
#define MULTI_LAUNCH 0
#endif

constexpr int DM = 1024, NB = 8, SEQL = 2048, NDEPTH = 4, CTXL = 256, DFF = 4096, INW = 6400;
constexpr int ML = NB * SEQL;
constexpr int MC = NB * CTXL;
constexpr int MT = ML + MC;
constexpr int TCH = 32;
constexpr int NCHUNK = MT / TCH;
constexpr int XUR = 768;
constexpr int XUK = 768;

constexpr size_t OFF_H = 0;
constexpr size_t OFF_A = OFF_H + (size_t)MT * DM * 4;
constexpr size_t OFF_MIX = OFF_A + (size_t)MT * DM * 2;
constexpr size_t OFF_R1 = OFF_MIX + (size_t)MT * DM * 2;
constexpr size_t OFF_PS = OFF_R1;
constexpr size_t OFF_Y4 = OFF_PS + (size_t)MT * 2304 * 2;
constexpr size_t OFF_VT = OFF_Y4 + (size_t)MT * DM * 2;
constexpr size_t OFF_XU = OFF_VT + (size_t)NB * 4 * 64 * 2304 * 2;
constexpr size_t OFF_S = OFF_XU + (size_t)16 * XUR * XUK * 2;
constexpr size_t OFF_YG = OFF_S + (size_t)16 * NCHUNK * 256 * 4;
constexpr size_t OFF_R1END = OFF_YG + (size_t)MT * 256 * 2;
constexpr size_t OFF_FFH = OFF_R1;
constexpr size_t OFF_MIXTMP = OFF_PS;
constexpr size_t OFF_KT = OFF_YG;
constexpr size_t OFF_GS = OFF_VT;
constexpr size_t OFF_WIN = OFF_R1END;
constexpr size_t OFF_WFF1 = OFF_WIN + (size_t)INW * DM * 2;
constexpr size_t OFF_WFF2 = OFF_WFF1 + (size_t)DFF * DM * 2;
constexpr size_t OFF_WOUT = OFF_WFF2 + (size_t)DFF * DM * 2;
constexpr size_t OFF_WBR = OFF_WOUT + (size_t)DM * DM * 2;
constexpr size_t OFF_WGLU = OFF_WBR + (size_t)DM * DM * 2;
constexpr size_t OFF_W1 = OFF_WGLU + (size_t)256 * 256 * 2;
constexpr size_t OFF_W2 = OFF_W1 + (size_t)16 * 256 * 512 * 2;
constexpr size_t OFF_SGUWT = OFF_W2 + (size_t)16 * 512 * 768 * 2;
constexpr size_t OFF_MOD = OFF_SGUWT + (size_t)4 * 128 * 128 * 4;
constexpr size_t OFF_BAR = OFF_MOD + (size_t)NDEPTH * 9 * 6144 * 4;
constexpr size_t OFF_PART = OFF_BAR + 16384;
constexpr size_t OFF_END = OFF_PART + (size_t)8 * MC * DM * 4;
constexpr size_t OFF_KTAB = OFF_END;
static_assert(OFF_KTAB + (size_t)16 * 2 * 32 * 256 * 4 <= 453000000ull, "KTAB");
constexpr size_t OFF_GP = OFF_PS + (size_t)256 * 262144;
static_assert(OFF_GP + (size_t)MC * 4096 * 2 <= OFF_Y4, "GP alias");
static_assert((size_t)MT * DFF * 2 <= OFF_R1END - OFF_R1, "FFH alias");
static_assert((size_t)256 * 262144 <= (size_t)MT * 2304 * 2, "MIXTMP alias");
static_assert((size_t)256 * 131072 <= OFF_R1END - OFF_VT, "GS alias");
static_assert(OFF_END < 452000000ull, "workspace");

struct P {
  const float *x, *c, *ctx, *c_ctx, *ada_w, *ada_b, *norm_g, *final_g, *w_in, *w_branch, *w_out,
      *lam_re, *lam_im, *log_dt, *b_re, *b_im, *c_re, *c_im, *s5_d, *glu_w, *glu_b, *rpb, *conv_w,
      *ln_g, *ln_b, *sgu_w, *sgu_b, *w_ff1, *w_ff2;
  float* out;
  unsigned char* ws;
  int ph_lo, ph_hi;
};

__device__ __forceinline__ int otid() { int t = threadIdx.x; asm volatile("" : "+v"(t)); return t; }
__device__ __forceinline__ float bf2f(bf16_t b) { return __uint_as_float(((unsigned)b) << 16); }
__device__ __forceinline__ float bflo(unsigned w) { return __uint_as_float(w << 16); }
__device__ __forceinline__ float bfhi(unsigned w) { return __uint_as_float(w & 0xffff0000u); }
__device__ __forceinline__ unsigned cvt_pk_bf16(float lo, float hi) { unsigned r; asm volatile("v_cvt_pk_bf16_f32 %0, %1, %2" : "=v"(r) : "v"(lo), "v"(hi)); return r; }
__device__ __forceinline__ float sigm(float x) { return 1.f / (1.f + __expf(-x)); }
__device__ __forceinline__ float gelu_tanh(float x) { return x * sigm(1.5957691216057308f * (x + 0.044715f * x * x * x)); }
__device__ __forceinline__ u32x4 pack8(f32x4 a, f32x4 b) { u32x4 r; r[0] = cvt_pk_bf16(a[0], a[1]); r[1] = cvt_pk_bf16(a[2], a[3]); r[2] = cvt_pk_bf16(b[0], b[1]); r[3] = cvt_pk_bf16(b[2], b[3]); return r; }
__device__ __forceinline__ float shx(float v, int o, int lane) { return __int_as_float(__builtin_amdgcn_ds_bpermute((lane ^ o) << 2, __float_as_int(v))); }
__device__ __forceinline__ float wave_sum(float v, int lane) {
#pragma unroll
  for (int o = 32; o >= 1; o >>= 1) v += shx(v, o, lane);
  return v;
}


#define XB_TMO      128
#define XB_XCNT(j)  (256  + 64 * (j))
#define XB_XSUB(j)  (1280 + 64 * (j))
#define XB_XGEN(j)  (2304 + 64 * (j))
#define XB_TOP      3328
#define XB_TOPGEN   3392
#define XCD_BAR_WORDS 3456
#define XB_SPIN_CAP (1u << 22)
__device__ __forceinline__ unsigned xb_ld(unsigned* p)              { return __hip_atomic_load(p, __ATOMIC_RELAXED, __HIP_MEMORY_SCOPE_AGENT); }
__device__ __forceinline__ unsigned xb_add(unsigned* p, unsigned v) { return __hip_atomic_fetch_add(p, v, __ATOMIC_RELAXED, __HIP_MEMORY_SCOPE_AGENT); }
__device__ __forceinline__ unsigned xb_xcc_id() { return (unsigned)__builtin_amdgcn_s_getreg((3 << 11) | 20) & 0xFu; }
#define XB_SPIN(cond, bar) do { unsigned _sp = 0; while (cond) { __builtin_amdgcn_s_sleep(1); \
    if ((++_sp & 255u) == 0u) { if (xb_ld(&(bar)[XB_TMO])) break; if (_sp > XB_SPIN_CAP) { atomicAdd(&(bar)[XB_TMO], 1u); break; } } } } while (0)
struct XcdBarrier { unsigned* bar; unsigned x; volatile LAS unsigned* st; };
__device__ __forceinline__ XcdBarrier xcd_barrier_post(unsigned* bar, volatile LAS unsigned* st) {
  XcdBarrier b; b.bar = bar; b.x = xb_xcc_id(); b.st = st;
  if (threadIdx.x == 0) (void)xb_add(&bar[XB_XCNT(b.x)], 1u);
  return b;
}
__device__ __forceinline__ void xcd_barrier_complete(unsigned* bar, unsigned x, unsigned& nloc, unsigned& nx) {
  const unsigned G = gridDim.x * gridDim.y * gridDim.z;
  unsigned sum, cnt, mine, sp = 0u;
  for (;;) {
    sum = 0u; cnt = 0u; mine = 0u;
#pragma unroll
    for (unsigned j = 0; j < 16; ++j) { const unsigned c = xb_ld(&bar[XB_XCNT(j)]); sum += c; cnt += (c > 0u) ? 1u : 0u; mine = (j == x) ? c : mine; }
    if (sum == G) break;
    __builtin_amdgcn_s_sleep(1);
    if ((++sp & 255u) == 0u) { if (xb_ld(&bar[XB_TMO])) break; if (sp > XB_SPIN_CAP) { atomicAdd(&bar[XB_TMO], 1u); break; } }
  }
  nloc = mine > 0u ? mine : 1u; nx = cnt > 0u ? cnt : 1u;
}
__device__ __forceinline__ void xcd_barrier(const XcdBarrier& b) {
  asm volatile("s_waitcnt vmcnt(0)" ::: "memory");
  __syncthreads();
  if (threadIdx.x == 0) {
    unsigned* bar = b.bar;
    __builtin_amdgcn_s_waitcnt(0);
    unsigned nloc = b.st[0], nx = b.st[1];
    if (nloc == 0u) { xcd_barrier_complete(bar, b.x, nloc, nx); b.st[0] = nloc; b.st[1] = nx; }
    const unsigned old = xb_add(&bar[XB_XSUB(b.x)], 1u);
    const unsigned gen = old / nloc;
    if (old + 1u == (gen + 1u) * nloc) {
      __builtin_amdgcn_fence(__ATOMIC_RELEASE, "agent");
      asm volatile("s_waitcnt vmcnt(0)" ::: "memory");
      const unsigned og = xb_add(&bar[XB_TOP], 1u);
      const unsigned tg = og / nx;
      if (og + 1u == (tg + 1u) * nx) xb_add(&bar[XB_TOPGEN], 1u);
      else XB_SPIN(xb_ld(&bar[XB_TOPGEN]) == tg, bar);
      __builtin_amdgcn_fence(__ATOMIC_ACQUIRE, "agent");
      xb_add(&bar[XB_XGEN(b.x)], 1u);
      asm volatile("s_waitcnt vmcnt(0)" ::: "memory");
    } else {
      XB_SPIN(xb_ld(&bar[XB_XGEN(b.x)]) == gen, bar);
      __builtin_amdgcn_fence(__ATOMIC_ACQUIRE, "agent");
      asm volatile("s_waitcnt vmcnt(0)" ::: "memory");
    }
  }
  __syncthreads();
}

constexpr int BM = 256, BK = 64, HALF = 128, HTB = HALF * BK * 2, NXCD = 8, WGM = 8;
__device__ __forceinline__ int lds_byte(int r, int c) { const int st = (r >> 4) * 2 + (c >> 5), rr = r & 15, cc = c & 31, ob = rr * 64 + cc * 2; return st * 1024 + (ob ^ (((ob >> 9) & 1) << 5)); }
__device__ __forceinline__ void stage_rc(int b, int& R, int& C) { const int st = b / 1024, sb = b % 1024, swz = sb ^ (((sb >> 9) & 1) << 5); R = (st >> 1) * 16 + swz / 64; C = (st & 1) * 32 + (swz % 64) / 2; }
__device__ __forceinline__ int perm32(int rho) { const int n = rho >> 4, i = rho & 15; return 8 * (i >> 2) + 4 * n + (i & 3); }

struct Unit { const char* A; const char* B; int nt, pm, pn, kind; };

__device__ __forceinline__ void rect_map(int L, int nM, int nN, int& pm, int& pn) {
  const int nwg = nM * nN; int wgid = L;
  { const int q = nwg / NXCD, r = nwg % NXCD, xcd = wgid % NXCD, off = wgid / NXCD; wgid = (xcd < r ? xcd * (q + 1) : r * (q + 1) + (xcd - r) * q) + off; }
  const int nig = WGM * nN, gid = wgid / nig, fm = gid * WGM, gsz = (nM - fm) < WGM ? (nM - fm) : WGM;
  pm = fm + ((wgid % nig) % gsz); pn = (wgid % nig) / gsz;
}

template <class Sched, class Epi>
__device__ __forceinline__ void gemm_phase(LAS unsigned char* lds, const int lda, const int ldb, const Sched& S, const Epi& E, unsigned long long* tslot = nullptr) {
#if TSEL
  const unsigned long long tg0 = __builtin_amdgcn_s_memrealtime();
#endif
  int tid_ = threadIdx.x; asm volatile("" : "+v"(tid_));
  const int tid = tid_, wid = __builtin_amdgcn_readfirstlane(tid >> 6), lane = tid & 63, wr = wid >> 2, wc = wid & 3, fr = lane & 15, fq = lane >> 4;
  unsigned voffA[2], voffB[2];
#pragma unroll
  for (int i = 0; i < 2; ++i) { int R, C; stage_rc(tid * 16 + i * 8192, R, C); const int Rb = (R & ~31) + perm32(R & 31);
    voffA[i] = (unsigned)(R * lda + C) * 2u; voffB[i] = (unsigned)(Rb * ldb + C) * 2u; }
  const size_t kstep = (size_t)(BK * 2);
  const size_t hstepA = (size_t)HALF * lda * 2, hstepB = (size_t)HALF * ldb * 2;
  const unsigned ldsw = (unsigned)wid * 1024u;
  const int aoff = lds_byte(wr * 64 + fr, fq * 8), boff = lds_byte(wc * 32 + fr, fq * 8);
#define PG8_SA(b, h) (((b) * 2 + (h)) * HTB)
#define PG8_SB(b, h) ((4 + (b) * 2 + (h)) * HTB)
#define PG8_STAGE(bufoff, gbase, voff) do { _Pragma("unroll") for (int _i = 0; _i < 2; ++_i) \
    __builtin_amdgcn_global_load_lds((const unsigned*)((const char*)(gbase) + (voff)[_i]), (LAS unsigned*)(lds + (bufoff) + ldsw + _i * 8192), 16, 0, 0); } while (0)
#define PG8_LDA(dst, b, h) do { _Pragma("unroll") for (int m = 0; m < 4; ++m) _Pragma("unroll") for (int k = 0; k < 2; ++k) dst[m][k] = *(const LAS bf16x8*)(lds + PG8_SA(b, h) + aoff + m * 2048 + k * 1024); } while (0)
#define PG8_LDB(dst, b, h) do { _Pragma("unroll") for (int n = 0; n < 2; ++n) _Pragma("unroll") for (int k = 0; k < 2; ++k) dst[n][k] = *(const LAS bf16x8*)(lds + PG8_SB(b, h) + boff + n * 2048 + k * 1024); } while (0)
#define PG8_MMA(ai, bj, At, Bt) do { __builtin_amdgcn_s_setprio(1); _Pragma("unroll") for (int m = 0; m < 4; ++m) _Pragma("unroll") for (int n = 0; n < 2; ++n) _Pragma("unroll") for (int k = 0; k < 2; ++k) \
    acc[ai][bj][m][n] = __builtin_amdgcn_mfma_f32_16x16x32_bf16(Bt[n][k], At[m][k], acc[ai][bj][m][n], 0, 0, 0); __builtin_amdgcn_s_setprio(0); } while (0)
#define PG8_WAIT_V(n) asm volatile("s_waitcnt vmcnt(" #n ")" ::: "memory")
#define PG8_WAIT_L(n) asm volatile("s_waitcnt lgkmcnt(" #n ")" ::: "memory")
#define PG8_BAR __builtin_amdgcn_s_barrier()
#define PG8_SCHED __builtin_amdgcn_sched_barrier(0)
  Unit cur, nxt; int ui = 0;
  if (!S.next(0, cur)) return;
  f32x4 acc[2][2][4][2];
#pragma unroll
  for (int a = 0; a < 2; ++a)
#pragma unroll
    for (int b = 0; b < 2; ++b)
#pragma unroll
      for (int m = 0; m < 4; ++m)
#pragma unroll
        for (int n = 0; n < 2; ++n) acc[a][b][m][n] = (f32x4){0.f, 0.f, 0.f, 0.f};
  bf16x8 At[4][2], B0[2][2], B1[2][2];
  const char* cA = cur.A; const char* cB = cur.B;
  PG8_STAGE(PG8_SB(0, 0), cB, voffB); PG8_STAGE(PG8_SA(0, 0), cA, voffA); PG8_STAGE(PG8_SB(0, 1), cB + hstepB, voffB); PG8_STAGE(PG8_SA(0, 1), cA + hstepA, voffA);
  if (wr == 1) PG8_BAR;
  PG8_WAIT_V(4); PG8_BAR;
  PG8_STAGE(PG8_SB(1, 0), cB + kstep, voffB); PG8_STAGE(PG8_SA(1, 0), cA + kstep, voffA); PG8_STAGE(PG8_SB(1, 1), cB + hstepB + kstep, voffB);
  PG8_WAIT_V(6); PG8_BAR;
  for (;;) {
    const bool has_next = S.next(ui + 1, nxt);
    const char* nA = has_next ? nxt.A : cA; const char* nB = has_next ? nxt.B : cB;
    const int nt = cur.nt;
#if TSEL
    const unsigned long long tk0 = __builtin_amdgcn_s_memrealtime();
#endif
    for (int t = 0; t < nt; t += 2) {
      const bool last = (t == nt - 2);
      const char* a1 = cA + (size_t)(t + 1) * kstep;
      const char* a2 = last ? nA : cA + (size_t)(t + 2) * kstep; const char* b2 = last ? nB : cB + (size_t)(t + 2) * kstep;
      const char* a3 = a2 + kstep; const char* b3 = b2 + kstep;
      PG8_LDB(B0, 0, 0); PG8_SCHED; PG8_LDA(At, 0, 0); PG8_STAGE(PG8_SA(1, 1), a1 + hstepA, voffA);
      PG8_WAIT_L(8); PG8_BAR; PG8_WAIT_L(0); PG8_MMA(0, 0, At, B0); PG8_BAR; PG8_SCHED;
      PG8_LDB(B1, 0, 1); PG8_STAGE(PG8_SB(0, 0), b2, voffB);
      PG8_BAR; PG8_WAIT_L(0); PG8_MMA(0, 1, At, B1); PG8_BAR;
      PG8_LDA(At, 0, 1); PG8_STAGE(PG8_SA(0, 0), a2, voffA);
      PG8_BAR; PG8_WAIT_L(0); PG8_MMA(1, 0, At, B0); PG8_BAR; PG8_SCHED;
      PG8_STAGE(PG8_SB(0, 1), b2 + hstepB, voffB);
      PG8_WAIT_V(6); PG8_BAR; PG8_MMA(1, 1, At, B1); PG8_BAR;
      PG8_LDB(B0, 1, 0); PG8_SCHED; PG8_LDA(At, 1, 0); PG8_STAGE(PG8_SA(0, 1), a2 + hstepA, voffA);
      PG8_WAIT_L(8); PG8_BAR; PG8_WAIT_L(0); PG8_MMA(0, 0, At, B0); PG8_BAR; PG8_SCHED;
      PG8_LDB(B1, 1, 1); PG8_STAGE(PG8_SB(1, 0), b3, voffB);
      PG8_BAR; PG8_WAIT_L(0); PG8_MMA(0, 1, At, B1); PG8_BAR;
      PG8_LDA(At, 1, 1); PG8_STAGE(PG8_SA(1, 0), a3, voffA);
      PG8_BAR; PG8_WAIT_L(0); PG8_MMA(1, 0, At, B0); PG8_BAR; PG8_SCHED;
      PG8_STAGE(PG8_SB(1, 1), b3 + hstepB, voffB);
      PG8_WAIT_V(6); PG8_BAR; PG8_MMA(1, 1, At, B1); PG8_BAR;
    }
#if TSEL
    const unsigned long long te0 = __builtin_amdgcn_s_memrealtime();
    if (tslot && tid == 0) tslot[3 + (cur.kind & 1)] += te0 - tk0;
#endif
    { const int t2 = otid(); E(acc, cur, wr, wc, t2 & 15, (t2 & 63) >> 4); }
#if TSEL
    if (tslot && tid == 0) { asm volatile("s_waitcnt vmcnt(0)" ::: "memory"); tslot[0] += __builtin_amdgcn_s_memrealtime() - te0; tslot[2] += 1; }
#endif
    if (!has_next) break;
#pragma unroll
    for (int a = 0; a < 2; ++a)
#pragma unroll
      for (int b = 0; b < 2; ++b)
#pragma unroll
        for (int m = 0; m < 4; ++m)
#pragma unroll
          for (int n = 0; n < 2; ++n) acc[a][b][m][n] = (f32x4){0.f, 0.f, 0.f, 0.f};
    cur = nxt; cA = nA; cB = nB; ++ui;
  }
  PG8_WAIT_V(0);
  if (wr == 0) PG8_BAR;
  PG8_BAR;
#if TSEL
  if (tslot && tid == 0) tslot[1] += __builtin_amdgcn_s_memrealtime() - tg0;
#endif
#undef PG8_SA
#undef PG8_SB
#undef PG8_STAGE
#undef PG8_LDA
#undef PG8_LDB
#undef PG8_MMA
#undef PG8_WAIT_V
#undef PG8_WAIT_L
#undef PG8_BAR
#undef PG8_SCHED
}

typedef f32x4 Acc[2][2][4][2];
#define EPI_ROWS(u, wr, fr) \
  _Pragma("unroll") for (int ai = 0; ai < 2; ++ai) _Pragma("unroll") for (int m = 0; m < 4; ++m)
#define EPI_ROW(u, wr, fr) ((u).pm * 256 + ai * 128 + (wr) * 64 + m * 16 + (fr))
#define EPI_COL(wc, fq) (bj * 128 + (wc) * 32 + (fq) * 8)

__device__ __forceinline__ int bsel_of_tile(int pm) { return pm < 64 ? (pm >> 3) : 8; }

struct RectSched {
  const char* A; const char* B; size_t a_tile, b_tile; int nM, nN, nt, G, c;
  __device__ __forceinline__ bool next(int i, Unit& u) const {
    const int L = i * G + c; if (L >= nM * nN) return false;
    int pm, pn; rect_map(L, nM, nN, pm, pn);
    u.pm = pm; u.pn = pn; u.kind = 0; u.nt = nt; u.A = A + (size_t)pm * a_tile; u.B = B + (size_t)pn * b_tile; return true;
  }
};
struct G1Sched {
  const char* A; const char* B; int G, c, last;
  __device__ __forceinline__ bool next(int i, Unit& u) const {
    const int L = i * G + c; const int nl = 64 * 9, ncx = last ? 24 : 72;
    if (L >= nl + ncx) return false;
    int pm, pn;
    if (L < nl) rect_map(L, 64, 9, pm, pn);
    else { const int q = L - nl; if (last) { pm = 64 + q / 3; const int s = q % 3; pn = s == 0 ? 0 : (s + 1); } else { pm = 64 + q / 9; pn = q % 9; } }
    u.pm = pm; u.pn = pn; u.kind = 0; u.nt = 16; u.A = A + (size_t)pm * (256 * 1024 * 2); u.B = B + (size_t)pn * (256 * 1024 * 2); return true;
  }
};
struct S5Sched {
  const char* A; const char* B; size_t b_group, b_tile; int nMs, nN, nt, G, c;
  __device__ __forceinline__ bool next(int i, Unit& u) const {
    const int L = i * G + c; if (L >= 16 * nMs * nN) return false;
    const int g = L / (nMs * nN), r = L % (nMs * nN), pm = r / nN, pn = r % nN;
    u.pm = pm; u.pn = pn; u.kind = g; u.nt = nt;
    u.A = A + ((size_t)g * XUR + (size_t)pm * 256) * XUK * 2; u.B = B + (size_t)g * b_group + (size_t)pn * b_tile; return true;
  }
};
struct MergeSched {
  const char* Abuf; const char* Y4; const char* Win; const char* Wbr; int ncx, G, c;
  __device__ __forceinline__ bool next(int i, Unit& u) const {
    const int nlat = (256 - c + G - 1) / G;
    int pm, pd, k, j;
    if (i < 8 * nlat) { const int su = (i >> 3) * G + c; j = i & 7; k = j >> 1; const int x = su & 7, sl = su >> 3; pd = sl & 3; pm = x * 8 + (sl >> 2); u.kind = j; }
    else { const int i2 = i - 8 * nlat; const int q = (i2 >> 1) * G + c; if (q >= ncx) return false; j = i2 & 1; const int x = q & 7, sl = q >> 3; k = sl & 3; pd = sl >> 2; pm = 64 + x; u.kind = 8 + 2 * k + j; }
    u.pm = pm; u.pn = pd;
    if (!(j & 1)) { u.nt = 16; u.A = Abuf + (size_t)pm * (256 * 1024 * 2); u.B = Win + (size_t)(2304 + k * 1024 + pd * 256) * (1024 * 2); }
    else { u.nt = 4; u.A = Y4 + (size_t)pm * (256 * 1024 * 2) + (size_t)k * 512; u.B = Wbr + (size_t)(pd * 256) * (1024 * 2) + (size_t)k * 512; }
    return true;
  }
};
struct WoutSched {
  const char* MIXb; const char* GPb; const char* B; int ncx, G, c;
  __device__ __forceinline__ bool next(int i, Unit& u) const {
    const int L = i * G + c;
    if (L < 256) { int pm, pn; rect_map(L, 64, 4, pm, pn); u.pm = pm; u.pn = pn; u.kind = 0; u.nt = 16; u.A = MIXb + (size_t)pm * (256 * 1024 * 2); u.B = B + (size_t)pn * (256 * 1024 * 2); return true; }
    const int q = L - 256; if (q >= ncx) return false;
    const int ks = q & 7, pn = (q >> 3) & 3, pmc = q >> 5;
    u.pm = 64 + pmc; u.pn = pn; u.kind = 1 + ks; u.nt = 8;
    u.A = GPb + ((size_t)(ks >> 1) * MC + (size_t)pmc * 256) * (1024 * 2) + (size_t)(ks & 1) * 1024; u.B = B + (size_t)pn * (256 * 1024 * 2) + (size_t)(ks & 1) * 1024; return true;
  }
};
struct SplitSched {
  const char* A; const char* B; const char* Ac; size_t a_tile, b_tile, ac_tile; int nt, nts, nlat, ncx, G, c;
  __device__ __forceinline__ bool next(int i, Unit& u) const {
    const int L = i * G + c;
    if (L < nlat) { int pm, pn; rect_map(L, 64, 4, pm, pn); u.pm = pm; u.pn = pn; u.kind = 0; u.nt = nt; u.A = A + (size_t)pm * a_tile; u.B = B + (size_t)pn * b_tile; return true; }
    const int q = L - nlat; if (q >= ncx) return false;
    const int ks = q & 7, pn = (q >> 3) & 3, pmc = q >> 5;
    u.pm = 64 + pmc; u.pn = pn; u.kind = 1 + ks; u.nt = nts;
    u.A = Ac + (size_t)pmc * ac_tile + (size_t)ks * nts * 128; u.B = B + (size_t)pn * b_tile + (size_t)ks * nts * 128; return true;
  }
};

struct EpiG1 {
  bf16_t* PS; bf16_t* XU; bf16_t* VT; bf16_t* KT;
  __device__ __forceinline__ void operator()(const Acc& acc, const Unit& u, int wr, int wc, int fr, int fq) const {
    if (u.pn == 3) {
      const int voff = (wc >> 1) * (288 * 512) + ((wc & 1) * 32 + fq * 8) * 8;
      EPI_ROWS(u, wr, fr) {
        const int row = EPI_ROW(u, wr, fr);
        int b, tok; if (row < ML) { b = row >> 11; tok = row & 2047; } else { const int r2 = row - ML; b = r2 >> 8; tok = 2048 + (r2 & 255); }
        bf16_t* rb = VT + ((size_t)(b * 4) * 288 + (tok >> 3)) * 512 + (tok & 7) + voff;
#pragma unroll
        for (int bj = 0; bj < 2; ++bj) {
          const u32x4 pk = pack8(acc[ai][bj][m][0], acc[ai][bj][m][1]);
          bf16_t* base = rb + bj * (2 * 288 * 512);
#pragma unroll
          for (int i = 0; i < 4; ++i) { base[(2 * i) * 8] = (bf16_t)(pk[i] & 0xffffu); base[(2 * i + 1) * 8] = (bf16_t)(pk[i] >> 16); }
        }
      }
      return;
    }
    EPI_ROWS(u, wr, fr) {
      const int row = EPI_ROW(u, wr, fr);
#pragma unroll
      for (int bj = 0; bj < 2; ++bj) {
        const int c = EPI_COL(wc, fq);
        const u32x4 pk = pack8(acc[ai][bj][m][0], acc[ai][bj][m][1]);
        if (u.pn == 0) {
          const int g = c >> 4, h0 = c & 15;
          *(u32x4*)(XU + ((size_t)(g * XUR + (row >> 5)) * XUK + (row & 31) * 16 + h0)) = pk;
        } else if (u.pn == 2) {
          int b, tok; if (row < ML) { b = row >> 11; tok = row & 2047; } else { const int r2 = row - ML; b = r2 >> 8; tok = 2048 + (r2 & 255); }
          *(u32x4*)(KT + (((size_t)(b * 4 + (c >> 6)) * 2304 + tok) * 64 + (c & 63))) = pk;
        } else {
          *(u32x4*)(PS + (size_t)row * 2304 + u.pn * 256 + c) = pk;
        }
      }
    }
  }
};
struct EpiS1 {
  float* S;
  __device__ __forceinline__ void operator()(const Acc& acc, const Unit& u, int wr, int wc, int fr, int fq) const {
    EPI_ROWS(u, wr, fr) {
      const int row = EPI_ROW(u, wr, fr);
      if (row < NCHUNK) {
#pragma unroll
        for (int bj = 0; bj < 2; ++bj) {
          const int c = EPI_COL(wc, fq);
          float* dst = S + ((size_t)u.kind * NCHUNK + row) * 256 + c;
          *(f32x4*)dst = acc[ai][bj][m][0]; *(f32x4*)(dst + 4) = acc[ai][bj][m][1];
        }
      }
    }
  }
};
struct EpiS2 {
  bf16_t* YG; int rowlim;
  __device__ __forceinline__ void operator()(const Acc& acc, const Unit& u, int wr, int wc, int fr, int fq) const {
    EPI_ROWS(u, wr, fr) {
      const int row = EPI_ROW(u, wr, fr);
      if (row < rowlim) {
#pragma unroll
        for (int bj = 0; bj < 2; ++bj) {
          const int col = u.pn * 256 + EPI_COL(wc, fq);
          const int t = col >> 4, h0 = col & 15;
          f32x4 a = acc[ai][bj][m][0], b = acc[ai][bj][m][1];
#pragma unroll
          for (int i = 0; i < 4; ++i) { a[i] = gelu_tanh(a[i]); b[i] = gelu_tanh(b[i]); }
          *(u32x4*)(YG + ((size_t)(row * TCH + t)) * 256 + u.kind * 16 + h0) = pack8(a, b);
        }
      }
    }
  }
};
struct EpiGLU {
  const bf16_t* YG; const float* bias; bf16_t* Y4;
  __device__ __forceinline__ void operator()(const Acc& acc, const Unit& u, int wr, int wc, int fr, int fq) const {
    EPI_ROWS(u, wr, fr) {
      const int row = EPI_ROW(u, wr, fr);
#pragma unroll
      for (int bj = 0; bj < 2; ++bj) {
        const int c = EPI_COL(wc, fq);
        const u32x4 gv = *(const u32x4*)(YG + (size_t)row * 256 + c);
        const f32x4 b0 = *(const f32x4*)(bias + c), b1 = *(const f32x4*)(bias + c + 4);
        f32x4 a = acc[ai][bj][m][0] + b0, b = acc[ai][bj][m][1] + b1;
        a[0] = bflo(gv[0]) * sigm(a[0]); a[1] = bfhi(gv[0]) * sigm(a[1]); a[2] = bflo(gv[1]) * sigm(a[2]); a[3] = bfhi(gv[1]) * sigm(a[3]);
        b[0] = bflo(gv[2]) * sigm(b[0]); b[1] = bfhi(gv[2]) * sigm(b[1]); b[2] = bflo(gv[3]) * sigm(b[2]); b[3] = bfhi(gv[3]) * sigm(b[3]);
        *(u32x4*)(Y4 + (size_t)row * 1024 + c) = pack8(a, b);
      }
    }
  }
};
struct EpiMerge {
  unsigned char* GS; bf16_t* TMP; bf16_t* MIX; bf16_t* GP;
  __device__ __forceinline__ void operator()(const Acc& acc, const Unit& u, int wr, int wc, int fr, int fq) const {
    const int tid = otid(); const int j = u.kind, k = j >> 1;
    EPI_ROWS(u, wr, fr) {
#pragma unroll
      for (int bj = 0; bj < 2; ++bj) {
        const int e = (ai * 4 + m) * 2 + bj;
        unsigned char* gs = GS + ((size_t)e * 512 + tid) * 8;
        bf16_t* tp = TMP + ((size_t)e * 512 + tid) * 8;
        if (!(j & 1)) {
          const f32x4 a = acc[ai][bj][m][0], b = acc[ai][bj][m][1];
          u32x2 q;
          q[0] = (unsigned)(sigm(a[0]) * 255.f + 0.5f) | ((unsigned)(sigm(a[1]) * 255.f + 0.5f) << 8) | ((unsigned)(sigm(a[2]) * 255.f + 0.5f) << 16) | ((unsigned)(sigm(a[3]) * 255.f + 0.5f) << 24);
          q[1] = (unsigned)(sigm(b[0]) * 255.f + 0.5f) | ((unsigned)(sigm(b[1]) * 255.f + 0.5f) << 8) | ((unsigned)(sigm(b[2]) * 255.f + 0.5f) << 16) | ((unsigned)(sigm(b[3]) * 255.f + 0.5f) << 24);
          *(u32x2*)gs = q;
        } else {
          const u32x2 q = *(const u32x2*)gs;
          f32x4 a = acc[ai][bj][m][0], b = acc[ai][bj][m][1];
          const float sc = 1.f / 255.f;
#pragma unroll
          for (int i = 0; i < 4; ++i) { a[i] *= (float)((q[0] >> (8 * i)) & 255u) * sc; b[i] *= (float)((q[1] >> (8 * i)) & 255u) * sc; }
          if (j >= 8) {
            const int row = EPI_ROW(u, wr, fr) - ML; const int c = u.pn * 256 + EPI_COL(wc, fq);
            *(u32x4*)(GP + ((size_t)(k - 4) * MC + row) * 1024 + c) = pack8(a, b);
          } else {
            if (k > 0) { const u32x4 t = *(const u32x4*)tp; a[0] += bflo(t[0]); a[1] += bfhi(t[0]); a[2] += bflo(t[1]); a[3] += bfhi(t[1]); b[0] += bflo(t[2]); b[1] += bfhi(t[2]); b[2] += bflo(t[3]); b[3] += bfhi(t[3]); }
            if (k < 3) *(u32x4*)tp = pack8(a, b);
            else { const int row = EPI_ROW(u, wr, fr); const int c = u.pn * 256 + EPI_COL(wc, fq); *(u32x4*)(MIX + (size_t)row * 1024 + c) = pack8(a, b); }
          }
        }
      }
    }
  }
};
struct EpiRes {
  const float* hL; const float* hC; float* H; const float* modbase; int modidx; float* PART;
  __device__ __forceinline__ void operator()(const Acc& acc, const Unit& u, int wr, int wc, int fr, int fq) const {
    if (u.kind) {
      bf16_t* pb = (bf16_t*)PART + (size_t)(u.kind - 1) * MC * 1024;
      EPI_ROWS(u, wr, fr) {
        const int row = EPI_ROW(u, wr, fr) - ML;
#pragma unroll
        for (int bj = 0; bj < 2; ++bj) {
          const int c = u.pn * 256 + EPI_COL(wc, fq);
          *(u32x4*)(pb + (size_t)row * 1024 + c) = pack8(acc[ai][bj][m][0], acc[ai][bj][m][1]);
        }
      }
      return;
    }
    const float* mv = modbase + (size_t)bsel_of_tile(u.pm) * 6144 + modidx * 1024;
    EPI_ROWS(u, wr, fr) {
      const int row = EPI_ROW(u, wr, fr);
      const float* hs = row < ML ? hL + (size_t)row * 1024 : hC + (size_t)(row - ML) * 1024;
#pragma unroll
      for (int bj = 0; bj < 2; ++bj) {
        const int c = u.pn * 256 + EPI_COL(wc, fq);
        const f32x4 h0 = *(const f32x4*)(hs + c), h1 = *(const f32x4*)(hs + c + 4);
        const f32x4 m0 = *(const f32x4*)(mv + c), m1 = *(const f32x4*)(mv + c + 4);
        float* hd = H + (size_t)row * 1024 + c;
        *(f32x4*)hd = h0 + m0 * acc[ai][bj][m][0]; *(f32x4*)(hd + 4) = h1 + m1 * acc[ai][bj][m][1];
      }
    }
  }
};
struct EpiFF1 {
  bf16_t* FFH;
  __device__ __forceinline__ void operator()(const Acc& acc, const Unit& u, int wr, int wc, int fr, int fq) const {
    EPI_ROWS(u, wr, fr) {
      const int row = EPI_ROW(u, wr, fr);
#pragma unroll
      for (int bj = 0; bj < 2; ++bj) {
        const int c = u.pn * 256 + EPI_COL(wc, fq);
        f32x4 a = acc[ai][bj][m][0], b = acc[ai][bj][m][1];
#pragma unroll
        for (int i = 0; i < 4; ++i) { a[i] = fmaxf(a[i], 0.f); a[i] *= a[i]; b[i] = fmaxf(b[i], 0.f); b[i] *= b[i]; }
        *(u32x4*)(FFH + (size_t)row * 4096 + c) = pack8(a, b);
      }
    }
  }
};

__device__ void mod_task(const P& p, int task, float* lds) {
  const int tid = otid();
  float* sc = lds;
  float* red = lds + 9 * 1024;
  for (int i = tid; i < 9 * 1024; i += 512) { const float v = i < 8192 ? p.c[i] : p.c_ctx[i - 8192]; sc[i] = v * sigm(v); }
  __syncthreads();
  const int l = task / 48, jb = task % 48, jl = tid & 127, ks = tid >> 7, j = jb * 128 + jl;
  float a[9];
#pragma unroll
  for (int s = 0; s < 9; ++s) a[s] = 0.f;
  const float* w = p.ada_w + (size_t)l * 1024 * 6144 + j;
#pragma unroll 8
  for (int k = ks * 256; k < ks * 256 + 256; ++k) {
    const float wv = w[(size_t)k * 6144];
#pragma unroll
    for (int s = 0; s < 9; ++s) a[s] += sc[s * 1024 + k] * wv;
  }
#pragma unroll
  for (int s = 0; s < 9; ++s) red[(ks * 9 + s) * 128 + jl] = a[s];
  __syncthreads();
  float* MOD = (float*)(p.ws + OFF_MOD);
  for (int i = tid; i < 9 * 128; i += 512) {
    const int s = i >> 7, jj = i & 127;
    const float v = red[(0 * 9 + s) * 128 + jj] + red[(1 * 9 + s) * 128 + jj] + red[(2 * 9 + s) * 128 + jj] + red[(3 * 9 + s) * 128 + jj];
    MOD[((size_t)l * 9 + s) * 6144 + jb * 128 + jj] = v + p.ada_b[l * 6144 + jb * 128 + jj];
  }
  __syncthreads();
}

__device__ void tr_tile(const float* src, int lds_, bf16_t* dst, int ldd, float* tile  ) {
  const int tid = otid();
#pragma unroll
  for (int ps = 0; ps < 2; ++ps) {
    const int k = (tid >> 4) + ps * 32, n4 = (tid & 15) * 4;
    const f32x4 v = *(const f32x4*)(src + (size_t)k * lds_ + n4);
    tile[k * 65 + n4] = v[0]; tile[k * 65 + n4 + 1] = v[1]; tile[k * 65 + n4 + 2] = v[2]; tile[k * 65 + n4 + 3] = v[3];
  }
  __syncthreads();
  {
    const int n = tid >> 3, k8 = (tid & 7) * 8;
    u32x4 o;
#pragma unroll
    for (int i = 0; i < 4; ++i) o[i] = cvt_pk_bf16(tile[(k8 + 2 * i) * 65 + n], tile[(k8 + 2 * i + 1) * 65 + n]);
    *(u32x4*)(dst + (size_t)n * ldd + k8) = o;
  }
  __syncthreads();
}

struct cpx { float re, im; };
__device__ __forceinline__ cpx cmul(cpx a, cpx b) { return {a.re * b.re - a.im * b.im, a.re * b.im + a.im * b.re}; }
template <bool FAST>
__device__ __forceinline__ cpx s5_apow(float lre, float lim, float dt, float e) {
  const float zr = lre * dt * e, zi = lim * dt * e;
  if (FAST) { const float mg = __expf(zr); return {mg * __cosf(zi), mg * __sinf(zi)}; }
  const float mg = expf(zr); float sn, cs; sincosf(zi, &sn, &cs); return {mg * cs, mg * sn};
}
template <bool FAST>
__device__ __forceinline__ cpx s5_coef(float lre, float lim, float dt) {
  const cpx a = s5_apow<FAST>(lre, lim, dt, 1.f); const float nr = a.re - 1.f, ni = a.im, den = lre * lre + lim * lim;
  return {(nr * lre + ni * lim) / den, (ni * lre - nr * lim) / den};
}

constexpr int NT_WIN = 1600, NT_FF1 = 1024, NT_FF2 = 1024, NT_OUT = 256, NT_BR = 256, NT_GLU = 16;
constexpr int NT_TR = NT_WIN + NT_FF1 + NT_FF2 + NT_OUT + NT_BR + NT_GLU;
constexpr int NT_TOEP = 512, NT_W2S = 256, NT_W1 = 128, NT_SGUW = 16;
constexpr int NT_PREP = NT_TR + NT_TOEP + NT_W2S + NT_W1 + NT_SGUW;

struct TrDesc { const float* src; bf16_t* dst; int lds_, ldd; };
__device__ __forceinline__ TrDesc tr_desc(const P& p, int l, int task) {
  unsigned char* ws = p.ws;
  const float* src; bf16_t* dst; int N, ldd, tk, tn;
  int t = task;
  if (t < NT_WIN) { src = p.w_in + (size_t)l * 1024 * 6400; N = 6400; dst = (bf16_t*)(ws + OFF_WIN); ldd = 1024; tk = t / 100; tn = t % 100; }
  else if ((t -= NT_WIN) < NT_FF1) { src = p.w_ff1 + (size_t)l * 1024 * 4096; N = 4096; dst = (bf16_t*)(ws + OFF_WFF1); ldd = 1024; tk = t / 64; tn = t % 64; }
  else if ((t -= NT_FF1) < NT_FF2) { src = p.w_ff2 + (size_t)l * 4096 * 1024; N = 1024; dst = (bf16_t*)(ws + OFF_WFF2); ldd = 4096; tk = t / 16; tn = t % 16; }
  else if ((t -= NT_FF2) < NT_OUT) { src = p.w_out + (size_t)l * 1024 * 1024; N = 1024; dst = (bf16_t*)(ws + OFF_WOUT); ldd = 1024; tk = t / 16; tn = t % 16; }
  else if ((t -= NT_OUT) < NT_BR) { const int k = t >> 6; t &= 63; src = p.w_branch + ((size_t)l * 4 + k) * 256 * 1024; N = 1024; dst = (bf16_t*)(ws + OFF_WBR) + k * 256; ldd = 1024; tk = t / 16; tn = t % 16; }
  else { t -= NT_BR; src = p.glu_w + (size_t)l * 256 * 256; N = 256; dst = (bf16_t*)(ws + OFF_WGLU); ldd = 256; tk = t / 4; tn = t % 4; }
  return {src + (size_t)tk * 64 * N + tn * 64, dst + (size_t)tn * 64 * ldd + tk * 64, N, ldd};
}
__device__ void tr_loop(const P& p, int l, int tbase, int t0, int t1, int td, float* tile  ) {
  if (t0 >= t1) return;
  const int tid = otid();
  const int k0 = tid >> 4, n4 = (tid & 15) * 4, n = tid >> 3, k8 = (tid & 7) * 8;
  TrDesc d = tr_desc(p, l, tbase + t0);
  f32x4 v0 = *(const f32x4*)(d.src + (size_t)k0 * d.lds_ + n4), v1 = *(const f32x4*)(d.src + (size_t)(k0 + 32) * d.lds_ + n4);
  for (int t = t0; t < t1; t += td) {
    tile[k0 * 65 + n4] = v0[0]; tile[k0 * 65 + n4 + 1] = v0[1]; tile[k0 * 65 + n4 + 2] = v0[2]; tile[k0 * 65 + n4 + 3] = v0[3];
    tile[(k0 + 32) * 65 + n4] = v1[0]; tile[(k0 + 32) * 65 + n4 + 1] = v1[1]; tile[(k0 + 32) * 65 + n4 + 2] = v1[2]; tile[(k0 + 32) * 65 + n4 + 3] = v1[3];
    __syncthreads();
    bf16_t* dcur = d.dst; const int lcur = d.ldd;
    if (t + td < t1) { d = tr_desc(p, l, tbase + t + td); v0 = *(const f32x4*)(d.src + (size_t)k0 * d.lds_ + n4); v1 = *(const f32x4*)(d.src + (size_t)(k0 + 32) * d.lds_ + n4); }
    u32x4 o;
#pragma unroll
    for (int i = 0; i < 4; ++i) o[i] = cvt_pk_bf16(tile[(k8 + 2 * i) * 65 + n], tile[(k8 + 2 * i + 1) * 65 + n]);
    *(u32x4*)(dcur + (size_t)n * lcur + k8) = o;
    __syncthreads();
  }
}

__device__ void prep_task(const P& p, int l, int task, float* lds) {
  const int tid = otid();
  unsigned char* ws = p.ws;
  if (task < NT_TR) {
    const float* src; bf16_t* dst; int N, ldd, tk, tn;
    int t = task;
    if (t < NT_WIN) { src = p.w_in + (size_t)l * 1024 * 6400; N = 6400; dst = (bf16_t*)(ws + OFF_WIN); ldd = 1024; tk = t / 100; tn = t % 100; }
    else if ((t -= NT_WIN) < NT_FF1) { src = p.w_ff1 + (size_t)l * 1024 * 4096; N = 4096; dst = (bf16_t*)(ws + OFF_WFF1); ldd = 1024; tk = t / 64; tn = t % 64; }
    else if ((t -= NT_FF1) < NT_FF2) { src = p.w_ff2 + (size_t)l * 4096 * 1024; N = 1024; dst = (bf16_t*)(ws + OFF_WFF2); ldd = 4096; tk = t / 16; tn = t % 16; }
    else if ((t -= NT_FF2) < NT_OUT) { src = p.w_out + (size_t)l * 1024 * 1024; N = 1024; dst = (bf16_t*)(ws + OFF_WOUT); ldd = 1024; tk = t / 16; tn = t % 16; }
    else if ((t -= NT_OUT) < NT_BR) { const int k = t >> 6; t &= 63; src = p.w_branch + ((size_t)l * 4 + k) * 256 * 1024; N = 1024; dst = (bf16_t*)(ws + OFF_WBR) + k * 256; ldd = 1024; tk = t / 16; tn = t % 16; }
    else { t -= NT_BR; src = p.glu_w + (size_t)l * 256 * 256; N = 256; dst = (bf16_t*)(ws + OFF_WGLU); ldd = 256; tk = t / 4; tn = t % 4; }
    tr_tile(src + (size_t)tk * 64 * N + tn * 64, N, dst + (size_t)tn * 64 * ldd + tk * 64, ldd, lds);
    return;
  }
  task -= NT_TR;
  bf16_t* W2 = (bf16_t*)(ws + OFF_W2);
  bf16_t* W1 = (bf16_t*)(ws + OFF_W1);
  if (task < NT_TOEP) {
    const int g = task >> 5, lag = task & 31;
    cpx* E = (cpx*)lds;
    float* sC = lds + 256;
    float* sB = sC + 4096;
    if (tid < 128) {
      const int d = tid >> 6, pp = tid & 63; const int li = ((l * 2 + d) * 16 + g);
      const float dt = expf(p.log_dt[li]); const float lre = p.lam_re[li * 64 + pp], lim = p.lam_im[li * 64 + pp];
      E[tid] = cmul(s5_apow<true>(lre, lim, dt, (float)lag), s5_coef<false>(lre, lim, dt));
    }
    for (int i = tid; i < 4096; i += 512) {
      const int d = i >> 11, ri = (i >> 10) & 1, r = i & 1023; const int li = ((l * 2 + d) * 16 + g);
      sC[i] = (ri ? p.c_im : p.c_re)[(size_t)li * 1024 + r];
      sB[i] = (ri ? p.b_im : p.b_re)[(size_t)li * 1024 + r];
    }
    __syncthreads();
    if (tid < 256) {
      const int hp = tid >> 4, h = tid & 15;
      float kv[2];
#pragma unroll
      for (int d = 0; d < 2; ++d) {
        const float* cre = sC + d * 2048 + hp * 64; const float* cim = cre + 1024;
        const float* bre = sB + d * 2048 + h; const float* bim = bre + 1024;
        float s = 0.f;
#pragma unroll 8
        for (int pp = 0; pp < 64; ++pp) {
          const cpx bb = cmul(E[d * 64 + pp], (cpx){bre[pp * 16], bim[pp * 16]});
          s += cre[pp] * bb.re - cim[pp] * bb.im;
        }
        kv[d] = s;
      }
      float* KT_ = (float*)(ws + OFF_KTAB);
      KT_[((size_t)(g * 2 + 0) * 32 + lag) * 256 + tid] = kv[0];
      KT_[((size_t)(g * 2 + 1) * 32 + lag) * 256 + tid] = kv[1];
    }
    __syncthreads();
    return;
  }
  task -= NT_TOEP;
  if (task < NT_W2S) {
    for (int it = 0; it < 8; ++it) {
      const int idx = (task * 8 + it) * 512 + tid;
      const int pp = idx & 63, d = (idx >> 6) & 1, hp = (idx >> 7) & 15, t = (idx >> 11) & 31, g = idx >> 16;
      const int li = ((l * 2 + d) * 16 + g);
      const float dt = expf(p.log_dt[li]); const float lre = p.lam_re[li * 64 + pp], lim = p.lam_im[li * 64 + pp];
      const cpx ap = s5_apow<true>(lre, lim, dt, d == 0 ? (float)(t + 1) : (float)(TCH - t));
      const cpx cc = {p.c_re[((size_t)li * 16 + hp) * 64 + pp], p.c_im[((size_t)li * 16 + hp) * 64 + pp]};
      const cpx v = cmul(cc, ap);
      *(unsigned*)(W2 + ((size_t)g * 512 + t * 16 + hp) * 768 + 512 + d * 128 + 2 * pp) = cvt_pk_bf16(v.re, -v.im);
    }
    return;
  }
  task -= NT_W2S;
  if (task < NT_W1) {
    const int idx = task * 512 + tid;
    const int j = idx & 31, pp = (idx >> 5) & 63, d = (idx >> 11) & 1, g = idx >> 12;
    const int li = ((l * 2 + d) * 16 + g);
    const float dt = expf(p.log_dt[li]); const float lre = p.lam_re[li * 64 + pp], lim = p.lam_im[li * 64 + pp];
    const cpx e = cmul(s5_apow<true>(lre, lim, dt, d == 0 ? (float)(TCH - 1 - j) : (float)j), s5_coef<false>(lre, lim, dt));
    const float* bre = p.b_re + ((size_t)li * 64 + pp) * 16; const float* bim = p.b_im + ((size_t)li * 64 + pp) * 16;
    bf16_t* r0 = W1 + ((size_t)g * 256 + d * 128 + 2 * pp) * 512 + j * 16;
    bf16_t* r1 = r0 + 512;
#pragma unroll
    for (int h = 0; h < 16; h += 2) {
      const cpx v0 = cmul(e, (cpx){bre[h], bim[h]}), v1 = cmul(e, (cpx){bre[h + 1], bim[h + 1]});
      *(unsigned*)(r0 + h) = cvt_pk_bf16(v0.re, v1.re); *(unsigned*)(r1 + h) = cvt_pk_bf16(v0.im, v1.im);
    }
    return;
  }
  task -= NT_W1;
  {
    bf16_t* W16 = (bf16_t*)(ws + OFF_SGUWT);
    for (int it = 0; it < 4; ++it) {
      const int idx = ((task * 4 + it) * 512 + tid) * 2;
      const float* sp = p.sgu_w + (size_t)l * 65536 + idx;
      *(unsigned*)(W16 + idx) = cvt_pk_bf16(sp[0], sp[1]);
    }
  }
}


__device__ __forceinline__ bool filler_range(int wg, int G, int first, int& start, int& stride) {
  if (G > first) { if (wg < first) return false; start = wg - first; stride = G - first; return true; }
  start = wg; stride = G; return true;
}
constexpr int PT_WIN0 = 0, PT_FF0 = NT_WIN, PT_WBR0 = NT_WIN + NT_FF1 + NT_FF2 + NT_OUT, PT_G10 = PT_WBR0 + NT_BR;
constexpr int PT_NMID = NT_FF1 + NT_FF2 + NT_OUT, PT_NG1 = NT_PREP - PT_G10;

constexpr int NT_ASM = 256;
__device__ void w2_assemble_task(const P& p, int l, int task) {
  const float* KT_ = (const float*)(p.ws + OFF_KTAB);
  bf16_t* W2 = (bf16_t*)(p.ws + OFF_W2);
  const int tid = otid();
#pragma unroll
  for (int it = 0; it < 4; ++it) {
    const int idx = (task * 4 + it) * 512 + tid;
    const int hh = (idx & 1) * 8, j = (idx >> 1) & 31, row = (idx >> 6) & 511, g = idx >> 15;
    const int t = row >> 4, hp = row & 15;
    f32x4 a = {0.f, 0.f, 0.f, 0.f}, b = {0.f, 0.f, 0.f, 0.f};
    if (j <= t) { const float* k0 = KT_ + ((size_t)(g * 2 + 0) * 32 + (t - j)) * 256 + hp * 16 + hh; a += *(const f32x4*)k0; b += *(const f32x4*)(k0 + 4); }
    if (j >= t) { const float* k1 = KT_ + ((size_t)(g * 2 + 1) * 32 + (j - t)) * 256 + hp * 16 + hh; a += *(const f32x4*)k1; b += *(const f32x4*)(k1 + 4); }
    if (j == t && (hp >> 3) == (hh >> 3)) { const float dv = p.s5_d[l * 256 + g * 16 + hp]; const int e = hp & 7; if (e < 4) a[e] += dv; else b[e - 4] += dv; }
    *(u32x4*)(W2 + ((size_t)g * 512 + row) * 768 + j * 16 + hh) = pack8(a, b);
  }
}

__device__ void norm_rows(const P& p, const float* hL, const float* hC, const float* gvec, const float* modbase, int shift_idx, int nrows, const float* resmod  ) {
  const int tid = otid(); const int lane = tid & 63, wid = tid >> 6;
  bf16_t* A = (bf16_t*)(p.ws + OFF_A);
  const int stride = gridDim.x * 8;
  int row = blockIdx.x * 8 + wid;
  for (; row + 3 * stride < ML; row += 4 * stride) {
    f32x4 v[4][4]; float rstd[4];
#pragma unroll
    for (int r = 0; r < 4; ++r)
#pragma unroll
      for (int i = 0; i < 4; ++i) v[r][i] = *(const f32x4*)(hL + (size_t)(row + r * stride) * 1024 + i * 256 + lane * 4);
#pragma unroll
    for (int r = 0; r < 4; ++r) {
      float ss = 0.f;
#pragma unroll
      for (int i = 0; i < 4; ++i) ss += v[r][i][0] * v[r][i][0] + v[r][i][1] * v[r][i][1] + v[r][i][2] * v[r][i][2] + v[r][i][3] * v[r][i][3];
      ss = wave_sum(ss, lane);
      rstd[r] = rsqrtf(ss * (1.f / 1024.f) + 1e-6f);
    }
#pragma unroll
    for (int i = 0; i < 4; ++i) {
      const int c = i * 256 + lane * 4;
      const f32x4 g = *(const f32x4*)(gvec + c);
#pragma unroll
      for (int r = 0; r < 4; ++r) {
        const int rr = row + r * stride;
        const float* sh = modbase + (size_t)(rr >> 11) * 6144 + shift_idx * 1024;
        const f32x4 s1 = *(const f32x4*)(sh + 1024 + c), s0 = *(const f32x4*)(sh + c);
        f32x4 y;
#pragma unroll
        for (int q = 0; q < 4; ++q) y[q] = (v[r][i][q] * rstd[r] * g[q]) * (1.f + s1[q]) + s0[q];
        u32x2 o; o[0] = cvt_pk_bf16(y[0], y[1]); o[1] = cvt_pk_bf16(y[2], y[3]);
        *(u32x2*)(A + (size_t)rr * 1024 + c) = o;
      }
    }
  }
  for (; row < nrows; row += stride) {
    const float* h = row < ML ? hL + (size_t)row * 1024 : hC + (size_t)(row - ML) * 1024;
    const int bsel = row < ML ? (row >> 11) : 8;
    const float* sh = modbase + (size_t)bsel * 6144 + shift_idx * 1024; const float* sc = sh + 1024;
    f32x4 v[4]; float ss = 0.f;
#pragma unroll
    for (int i = 0; i < 4; ++i) v[i] = *(const f32x4*)(h + i * 256 + lane * 4);
    if (resmod && row >= ML) {
      const bf16_t* pr = (const bf16_t*)(p.ws + OFF_PART) + (size_t)(row - ML) * 1024;
      float* hw = (float*)(p.ws + OFF_H) + (size_t)row * 1024;
#pragma unroll
      for (int i = 0; i < 4; ++i) {
        const int c = i * 256 + lane * 4;
        f32x4 sm = {0.f, 0.f, 0.f, 0.f};
#pragma unroll
        for (int sl = 0; sl < 8; ++sl) { const u32x2 w = *(const u32x2*)(pr + (size_t)sl * MC * 1024 + c); sm[0] += bflo(w[0]); sm[1] += bfhi(w[0]); sm[2] += bflo(w[1]); sm[3] += bfhi(w[1]); }
        v[i] += *(const f32x4*)(resmod + c) * sm;
        *(f32x4*)(hw + c) = v[i];
      }
    }
#pragma unroll
    for (int i = 0; i < 4; ++i) ss += v[i][0] * v[i][0] + v[i][1] * v[i][1] + v[i][2] * v[i][2] + v[i][3] * v[i][3];
    ss = wave_sum(ss, lane);
    const float rstd = rsqrtf(ss * (1.f / 1024.f) + 1e-6f);
#pragma unroll
    for (int i = 0; i < 4; ++i) {
      const int c = i * 256 + lane * 4;
      const f32x4 g = *(const f32x4*)(gvec + c), s1 = *(const f32x4*)(sc + c), s0 = *(const f32x4*)(sh + c);
      f32x4 y;
#pragma unroll
      for (int q = 0; q < 4; ++q) y[q] = (v[i][q] * rstd * g[q]) * (1.f + s1[q]) + s0[q];
      u32x2 o; o[0] = cvt_pk_bf16(y[0], y[1]); o[1] = cvt_pk_bf16(y[2], y[3]);
      *(u32x2*)(A + (size_t)row * 1024 + c) = o;
    }
  }
}

__device__ void final_rows(const P& p) {
  const int tid = otid(); const int lane = tid & 63, wid = tid >> 6;
  const float* H = (const float*)(p.ws + OFF_H);
  const int stride = gridDim.x * 8;
  for (int row = blockIdx.x * 8 + wid; row < ML; row += 4 * stride) {
    f32x4 v[4][4];
#pragma unroll
    for (int r = 0; r < 4; ++r)
#pragma unroll
      for (int i = 0; i < 4; ++i) { const int rr = row + r * stride; v[r][i] = rr < ML ? *(const f32x4*)(H + (size_t)rr * 1024 + i * 256 + lane * 4) : (f32x4){0.f, 0.f, 0.f, 0.f}; }
#pragma unroll
    for (int r = 0; r < 4; ++r) {
      const int rr = row + r * stride;
      float ss = 0.f;
#pragma unroll
      for (int i = 0; i < 4; ++i) ss += v[r][i][0] * v[r][i][0] + v[r][i][1] * v[r][i][1] + v[r][i][2] * v[r][i][2] + v[r][i][3] * v[r][i][3];
      ss = wave_sum(ss, lane);
      const float rstd = rsqrtf(ss * (1.f / 1024.f) + 1e-6f);
      if (rr < ML) {
#pragma unroll
        for (int i = 0; i < 4; ++i) {
          const int c = i * 256 + lane * 4;
          const f32x4 g = *(const f32x4*)(p.final_g + c);
          f32x4 y;
#pragma unroll
          for (int q = 0; q < 4; ++q) y[q] = v[r][i][q] * rstd * g[q];
          *(f32x4*)(p.out + (size_t)rr * 1024 + c) = y;
        }
      }
    }
  }
}

template <bool LAT>
__device__ __forceinline__ void attn_task(const P& p, int task, int l, const float* rpb_lds, int lane) {
  constexpr int NG = LAT ? 16 : 8;
  task = __builtin_amdgcn_readfirstlane(task);
  const bf16_t* PS = (const bf16_t*)(p.ws + OFF_PS);
  const bf16_t* VT = (const bf16_t*)(p.ws + OFF_VT);
  const bf16_t* KT = (const bf16_t*)(p.ws + OFF_KT);
  bf16_t* Y4 = (bf16_t*)(p.ws + OFF_Y4);
  int b, head, r = 0, jb = 0, qrow0;
  if (LAT) { jb = task & 3; r = (task >> 2) & 31; head = (task >> 7) & 3; b = task >> 9; qrow0 = b * 2048 + r * 64 + jb * 16; }
  else { const int qb = task & 15; head = (task >> 4) & 3; b = task >> 6; qrow0 = ML + b * 256 + qb * 16; }
  const int n = lane & 15, kg = lane >> 4;
  const bf16_t* qp = PS + (size_t)(qrow0 + n) * 2304 + 256 + head * 64 + kg * 8;
  const bf16x8 q0 = *(const bf16x8*)qp, q1 = *(const bf16x8*)(qp + 32);
  const int rs = LAT ? min(max(r - 4, 0), 24) : 0;
  const int clo = LAT ? (jb == 0 ? 0 : jb == 1 ? 8 : jb == 2 ? 24 : 32) : 0;
  const int keyX = 8 * (n >> 2) + (n & 3);
  const char* kub = (const char*)(KT + (size_t)(b * 4 + head) * 2304 * 64);
  const char* vub = (const char*)(VT + (size_t)(b * 4 + head) * 288 * 512);
  const unsigned klo = (unsigned)(keyX * 64 + kg * 8) * 2u, vlo = (unsigned)(kg * 512 + n * 8) * 2u;
  const int jq = jb * 16 + n; const int cs = min(max(jq - 8, 0), 48);
  bf16x8 kf[2][2][4], vf[2][2][4];
#define ATT_TK0(gi) ((LAT && (gi) < 8) ? (rs + (gi)) * 64 + clo : 2048 + ((gi) - (LAT ? 8 : 0)) * 32)
#define ATT_LOADK(sl, gb) _Pragma("unroll") for (int g2 = 0; g2 < 2; ++g2) { const char* kp = kub + (size_t)ATT_TK0((gb) + g2) * 128; \
    kf[sl][g2][0] = *(const bf16x8*)(kp + klo); kf[sl][g2][1] = *(const bf16x8*)(kp + 64 + klo); kf[sl][g2][2] = *(const bf16x8*)(kp + 512 + klo); kf[sl][g2][3] = *(const bf16x8*)(kp + 576 + klo); }
#define ATT_LOADV(sl, gb) _Pragma("unroll") for (int g2 = 0; g2 < 2; ++g2) { const char* vp = vub + (size_t)(ATT_TK0((gb) + g2) >> 3) * 1024; \
    _Pragma("unroll") for (int db = 0; db < 4; ++db) vf[sl][g2][db] = *(const bf16x8*)(vp + db * 256 + vlo); }
#define ATT_BATCH(sl, gb) do { \
    f32x4 s[2][2]; \
    _Pragma("unroll") for (int g2 = 0; g2 < 2; ++g2) { f32x4 z = {0.f, 0.f, 0.f, 0.f}; \
      s[g2][0] = __builtin_amdgcn_mfma_f32_16x16x32_bf16(kf[sl][g2][0], q0, z, 0, 0, 0); s[g2][0] = __builtin_amdgcn_mfma_f32_16x16x32_bf16(kf[sl][g2][1], q1, s[g2][0], 0, 0, 0); \
      s[g2][1] = __builtin_amdgcn_mfma_f32_16x16x32_bf16(kf[sl][g2][2], q0, z, 0, 0, 0); s[g2][1] = __builtin_amdgcn_mfma_f32_16x16x32_bf16(kf[sl][g2][3], q1, s[g2][1], 0, 0, 0); } \
    __builtin_amdgcn_sched_barrier(0); \
    if ((gb) + 4 < NG) { ATT_LOADK(sl, (gb) + 4); } \
    __builtin_amdgcn_sched_barrier(0); \
    float bm = -3.0e38f; \
    if (LAT && (gb) < 8) { \
      _Pragma("unroll") for (int g2 = 0; g2 < 2; ++g2) { const float* brow = rpb_lds + (head * 15 + (rs + (gb) + g2 - r + 7)) * 31; \
        _Pragma("unroll") for (int blk = 0; blk < 2; ++blk) _Pragma("unroll") for (int i = 0; i < 4; ++i) { \
          const int kc = clo + 8 * kg + blk * 4 + i; const bool ok = (kc >= cs) && (kc < cs + 16); const int dc = min(max(kc - jq + 15, 0), 30); \
          const float v = ok ? s[g2][blk][i] * 0.125f + brow[dc] : -1.0e30f; s[g2][blk][i] = v; bm = fmaxf(bm, v); } } \
    } else { \
      _Pragma("unroll") for (int g2 = 0; g2 < 2; ++g2) _Pragma("unroll") for (int blk = 0; blk < 2; ++blk) _Pragma("unroll") for (int i = 0; i < 4; ++i) { \
        const float v = s[g2][blk][i] * 0.125f; s[g2][blk][i] = v; bm = fmaxf(bm, v); } \
    } \
    bm = fmaxf(bm, shx(bm, 16, lane)); bm = fmaxf(bm, shx(bm, 32, lane)); \
    const float mnew = fmaxf(mrun, bm); const float alpha = __expf(mrun - mnew); \
    float ps = 0.f; \
    _Pragma("unroll") for (int g2 = 0; g2 < 2; ++g2) _Pragma("unroll") for (int blk = 0; blk < 2; ++blk) _Pragma("unroll") for (int i = 0; i < 4; ++i) { \
      const float e = __expf(s[g2][blk][i] - mnew); s[g2][blk][i] = e; ps += e; } \
    sum = sum * alpha + ps; mrun = mnew; \
    _Pragma("unroll") for (int db = 0; db < 4; ++db) o[db] *= alpha; \
    _Pragma("unroll") for (int g2 = 0; g2 < 2; ++g2) { const u32x4 pk = pack8(s[g2][0], s[g2][1]); bf16x8 pf; __builtin_memcpy(&pf, &pk, 16); \
      _Pragma("unroll") for (int db = 0; db < 4; ++db) o[db] = __builtin_amdgcn_mfma_f32_16x16x32_bf16(vf[sl][g2][db], pf, o[db], 0, 0, 0); } \
    __builtin_amdgcn_sched_barrier(0); \
    if ((gb) + 4 < NG) { ATT_LOADV(sl, (gb) + 4); } \
    __builtin_amdgcn_sched_barrier(0); \
  } while (0)
  ATT_LOADK(0, 0); ATT_LOADV(0, 0); ATT_LOADK(1, 2); ATT_LOADV(1, 2);
  float mrun = -3.0e38f, sum = 0.f;
  f32x4 o[4];
#pragma unroll
  for (int db = 0; db < 4; ++db) o[db] = (f32x4){0.f, 0.f, 0.f, 0.f};
#pragma unroll 1
  for (int gq = 0; gq < NG; gq += 4) {
    ATT_BATCH(0, gq);
    ATT_BATCH(1, gq + 2);
  }
#undef ATT_TK0
#undef ATT_LOADK
#undef ATT_LOADV
#undef ATT_BATCH
  sum += shx(sum, 16, lane); sum += shx(sum, 32, lane);
  const float inv = 1.f / sum;
  bf16_t* op = Y4 + (size_t)(qrow0 + n) * 1024 + 256 + head * 64 + kg * 4;
#pragma unroll
  for (int db = 0; db < 4; ++db) {
    u32x2 w; w[0] = cvt_pk_bf16(o[db][0] * inv, o[db][1] * inv); w[1] = cvt_pk_bf16(o[db][2] * inv, o[db][3] * inv);
    *(u32x2*)(op + db * 16) = w;
  }
}

__device__ __forceinline__ void conv_task(const P& p, int l, int task) {
  const bf16_t* PS = (const bf16_t*)(p.ws + OFF_PS);
  bf16_t* Y4 = (bf16_t*)(p.ws + OFF_Y4);
  const int idx = task * 512 + otid();
  const int row = idx >> 5, c0 = (idx & 31) * 8;
  int pos, len; if (row < ML) { pos = row & 2047; len = 2048; } else { pos = (row - ML) & 255; len = 256; }
  const bf16_t* base = PS + (size_t)row * 2304;
  float z[3][8];
#pragma unroll
  for (int d = 0; d < 3; ++d) {
    const int pp = pos + d - 1;
    if (pp >= 0 && pp < len) {
      const u32x4 cv = *(const u32x4*)(base + (d - 1) * 2304 + 5 * 256 + c0), xv = *(const u32x4*)(base + (d - 1) * 2304 + 6 * 256 + c0);
#pragma unroll
      for (int i = 0; i < 4; ++i) { z[d][2 * i] = bflo(cv[i]) * bflo(xv[i]); z[d][2 * i + 1] = bfhi(cv[i]) * bfhi(xv[i]); }
    } else {
#pragma unroll
      for (int i = 0; i < 8; ++i) z[d][i] = 0.f;
    }
  }
  const u32x4 bv = *(const u32x4*)(base + 4 * 256 + c0);
  const float* w = p.conv_w + (size_t)l * 3 * 256 + c0;
  float y[8];
#pragma unroll
  for (int i = 0; i < 8; ++i) y[i] = w[i] * z[0][i] + w[256 + i] * z[1][i] + w[512 + i] * z[2][i];
  u32x4 o;
#pragma unroll
  for (int i = 0; i < 4; ++i) o[i] = cvt_pk_bf16(bflo(bv[i]) * y[2 * i], bfhi(bv[i]) * y[2 * i + 1]);
  *(u32x4*)(Y4 + (size_t)row * 1024 + 512 + c0) = o;
}

__device__ void sgu_task(const P& p, int l, int task, float* lds) {
  const int tid = otid();
  const bf16_t* PS = (const bf16_t*)(p.ws + OFF_PS);
  bf16_t* Y4 = (bf16_t*)(p.ws + OFF_Y4);
  const bf16_t* W16 = (const bf16_t*)(p.ws + OFF_SGUWT);
  const int chunk = task >> 2, g = task & 3;
  bf16_t* vnT = (bf16_t*)lds;
  constexpr int VS = 136;
  {
    const int s = tid >> 2, q = tid & 3;
    const bf16_t* vr = PS + (size_t)(chunk * 128 + s) * 2304 + 8 * 256;
    float sm = 0.f, sq = 0.f;
#pragma unroll
    for (int i = 0; i < 8; ++i) {
      const u32x4 v = *(const u32x4*)(vr + q * 64 + i * 8);
#pragma unroll
      for (int k = 0; k < 4; ++k) { const float a = bflo(v[k]), b = bfhi(v[k]); sm += a + b; sq += a * a + b * b; }
    }
    { const int ln = tid & 63; sm += shx(sm, 1, ln); sm += shx(sm, 2, ln); sq += shx(sq, 1, ln); sq += shx(sq, 2, ln); }
    const float mu = sm * (1.f / 256.f); const float var = fmaxf(sq * (1.f / 256.f) - mu * mu, 0.f); const float rstd = rsqrtf(var + 1e-6f);
    const int cb = g * 64 + q * 16;
    const float* lg = p.ln_g + l * 256 + cb; const float* lb = p.ln_b + l * 256 + cb;
#pragma unroll
    for (int i = 0; i < 2; ++i) {
      const u32x4 v = *(const u32x4*)(vr + cb + i * 8);
#pragma unroll
      for (int k = 0; k < 4; ++k) {
        const int cc = i * 8 + 2 * k;
        const unsigned pk = cvt_pk_bf16((bflo(v[k]) - mu) * rstd * lg[cc] + lb[cc], (bfhi(v[k]) - mu) * rstd * lg[cc + 1] + lb[cc + 1]);
        vnT[(q * 16 + cc) * VS + s] = (bf16_t)(pk & 0xffffu);
        vnT[(q * 16 + cc + 1) * VS + s] = (bf16_t)(pk >> 16);
      }
    }
  }
  __syncthreads();
  const int lane = tid & 63, w = tid >> 6, n = lane & 15, kg = lane >> 4;
  const int t = w * 16 + n;
  const bf16_t* wp = W16 + ((size_t)(g * 128 + t)) * 128 + kg * 8;
  bf16x8 wf[4];
#pragma unroll
  for (int ks = 0; ks < 4; ++ks) wf[ks] = *(const bf16x8*)(wp + ks * 32);
  f32x4 acc[4];
#pragma unroll
  for (int cb = 0; cb < 4; ++cb) {
    acc[cb] = (f32x4){0.f, 0.f, 0.f, 0.f};
#pragma unroll
    for (int ks = 0; ks < 4; ++ks) {
      const bf16x8 vf = *(const bf16x8*)(vnT + (cb * 16 + n) * VS + ks * 32 + kg * 8);
      acc[cb] = __builtin_amdgcn_mfma_f32_16x16x32_bf16(vf, wf[ks], acc[cb], 0, 0, 0);
    }
  }
  const int row = chunk * 128 + t;
  const float bs = p.sgu_b[((size_t)l * 4 + g) * 128 + t];
#pragma unroll
  for (int cb = 0; cb < 4; ++cb) {
    const int c = g * 64 + cb * 16 + kg * 4;
    const u32x2 uv = *(const u32x2*)(PS + (size_t)row * 2304 + 7 * 256 + c);
    u32x2 o; o[0] = cvt_pk_bf16(bflo(uv[0]) * (acc[cb][0] + bs), bfhi(uv[0]) * (acc[cb][1] + bs)); o[1] = cvt_pk_bf16(bflo(uv[1]) * (acc[cb][2] + bs), bfhi(uv[1]) * (acc[cb][3] + bs));
    *(u32x2*)(Y4 + (size_t)row * 1024 + 768 + c) = o;
  }
  __syncthreads();
}

__device__ void carry_phase(const P& p, int l) {
  const int gt = blockIdx.x * 512 + otid();
  if (gt >= 16 * 8 * 2 * 64) return;
  const int pp = gt & 63, d = (gt >> 6) & 1, b = (gt >> 7) & 7, g = gt >> 10;
  const float* S = (const float*)(p.ws + OFF_S) + (size_t)g * NCHUNK * 256 + d * 128 + 2 * pp;
  bf16_t* XU = (bf16_t*)(p.ws + OFF_XU) + (size_t)g * XUR * XUK + 512 + d * 128 + 2 * pp;
  const int li = ((l * 2 + d) * 16 + g);
  const float dt = expf(p.log_dt[li]);
  const cpx aT = s5_apow<false>(p.lam_re[li * 64 + pp], p.lam_im[li * 64 + pp], dt, (float)TCH);
  cpx st = {0.f, 0.f};
  for (int i0 = 0; i0 < 72; i0 += 8) {
    float sre[8], sim[8]; int rows[8];
#pragma unroll
    for (int k = 0; k < 8; ++k) {
      const int i = i0 + k; int row;
      if (i < 8) row = 512 + b * 8 + (d == 0 ? i : 7 - i); else row = b * 64 + (d == 0 ? (i - 8) : 63 - (i - 8));
      rows[k] = row; const float2 v = *(const float2*)(S + (size_t)row * 256); sre[k] = v.x; sim[k] = v.y;
    }
#pragma unroll
    for (int k = 0; k < 8; ++k) {
      *(unsigned*)(XU + (size_t)rows[k] * XUK) = cvt_pk_bf16(st.re, st.im);
      const cpx ns = cmul(aT, st); st.re = ns.re + sre[k]; st.im = ns.im + sim[k];
    }
  }
}

constexpr int PH_PER_LAYER = 11;
constexpr int N_PHASES = 1 + NDEPTH * PH_PER_LAYER + 1;

__global__ void __launch_bounds__(512, 2) mk_forward(P p_arg) {
  extern __shared__ __attribute__((aligned(16))) unsigned char shm[];
  LAS unsigned char* lds = (LAS unsigned char*)shm;
  float* ldsf = (float*)shm;
  unsigned char* ws0 = p_arg.ws;
  volatile LAS unsigned* xbw = (volatile LAS unsigned*)(lds + 131072);
  if (threadIdx.x == 0) { xbw[0] = 0u; xbw[1] = 0u; xbw[2] = 0u; xbw[3] = 0u; }
  __syncthreads();
  const XcdBarrier xb = xcd_barrier_post((unsigned*)(ws0 + OFF_BAR), xbw);
  if (p_arg.ph_lo < 0) cg::this_grid().sync();

  for (int ph = p_arg.ph_lo; ph < p_arg.ph_hi; ++ph) {
    int nrep = 1;
#if DBL_MASK
    { const int spx = (ph == 0) ? 11 : (ph == N_PHASES - 1) ? 13 : (ph - 1) % PH_PER_LAYER; if ((DBL_MASK >> spx) & 1) nrep = 2; }
#endif
    for (int rep = 0; rep < nrep; ++rep) {
    if (rep) xcd_barrier(xb);
    int G_ = gridDim.x, wg_ = blockIdx.x; asm volatile("" : "+s"(G_), "+s"(wg_));
    const int G = G_, wg = wg_;
    unsigned char* ws = ws0; asm volatile("" : "+s"(ws));
    P p = p_arg; p.ws = ws;
    float* H = (float*)(ws + OFF_H);
    const float* MOD = (const float*)(ws + OFF_MOD);
    if (ph == 0) {
      for (int t = wg; t < 192; t += G) mod_task(p, t, ldsf);
      { const int t0 = (wg + G - (192 % G)) % G;
        tr_loop(p, 0, 0, t0, NT_WIN, G, ldsf);
        const int r = (NT_WIN - t0 + G - 1) / G; tr_loop(p, 0, PT_WBR0, t0 + r * G - NT_WIN, NT_BR, G, ldsf); }
    } else if (ph == N_PHASES - 1) {
      final_rows(p);
#if TSEL
      xcd_barrier(xb);
      if (wg == 0) { const unsigned long long* ts = (const unsigned long long*)(ws + OFF_BAR + 14336); const unsigned long long v = ts[TSEL - 1]; const int N = (int)(TSEL == 3 ? v * 1000 : v / 10);
        for (int i = otid(); i < N && i < 300000; i += 512) p.out[(size_t)i * 16] += 0.125f; }
#endif
    } else {
      const int l = (ph - 1) / PH_PER_LAYER, sp = (ph - 1) % PH_PER_LAYER;
      const bool last = (l == NDEPTH - 1);
      const float* hL = l == 0 ? p.x : H; const float* hC = l == 0 ? p.ctx : H + (size_t)ML * 1024;
      const float* modl = MOD + (size_t)l * 9 * 6144;
      const int nMrows = last ? 64 : 72;
      switch (sp) {
#if PHMASK & 1
        case 0: {
          for (int t = wg; t < PT_NG1; t += G) prep_task(p, l, PT_G10 + t, ldsf);
          norm_rows(p, hL, hC, p.norm_g + (size_t)(l * 2 + 0) * 1024, modl, 0, MT, l > 0 ? MOD + ((size_t)(l - 1) * 9 + 8) * 6144 + 5 * 1024 : nullptr);
        } break;
#endif
#if PHMASK & 2
        case 1: {
          G1Sched S{(const char*)(ws + OFF_A), (const char*)(ws + OFF_WIN), G, wg, last ? 1 : 0};
          EpiG1 E{(bf16_t*)(ws + OFF_PS), (bf16_t*)(ws + OFF_XU), (bf16_t*)(ws + OFF_VT), (bf16_t*)(ws + OFF_KT)};
          gemm_phase(lds, 1024, 1024, S, E, (TSEL && TPHASE == 1 && wg == 0) ? (unsigned long long*)(ws + OFF_BAR + 14336) : nullptr);
          { int st, sd; if (filler_range(wg, G, 136, st, sd)) for (int t = st; t < NT_ASM; t += sd) w2_assemble_task(p, l, t); }
        } break;
#endif
#if PHMASK & 4
        case 2: {
          {
            S5Sched S{(const char*)(ws + OFF_XU), (const char*)(ws + OFF_W1), (size_t)256 * 512 * 2, 0, 3, 1, 8, G, wg};
            EpiS1 E{(float*)(ws + OFF_S)};
            gemm_phase(lds, XUK, 512, S, E);
          }
          __syncthreads();
          const int tid2 = otid(), lane2 = tid2 & 63, wid2 = tid2 >> 6;
          for (int i = tid2; i < 4 * 15 * 31; i += 512) ldsf[i] = p.rpb[(size_t)l * 4 * 15 * 31 + i];
          __syncthreads();
          const int nwaves = G * 8, gw = wg * 8 + wid2;
#if TSEL
          unsigned long long* tsl = (unsigned long long*)(ws + OFF_BAR + 14336); const unsigned long long tq0 = __builtin_amdgcn_s_memrealtime();
#endif
          for (int t = gw; t < 4096; t += nwaves) attn_task<true>(p, t, l, ldsf, lane2);
          if (!last) for (int t = nwaves - 1 - gw; t < 512; t += nwaves) attn_task<false>(p, t, l, ldsf, lane2);
#if TSEL
          __syncthreads(); const unsigned long long tq1 = __builtin_amdgcn_s_memrealtime();
#endif
        } break;
#endif
#if PHMASK & 8
        case 3: {
          carry_phase(p, l);
          const int nconv = (last ? ML : MT) * 32 / 512;
          int st, sd; if (filler_range(wg, G, 32, st, sd)) for (int t = st; t < nconv; t += sd) conv_task(p, l, t);
        } break;
#endif
#if PHMASK & 16
        case 4: {
          S5Sched S{(const char*)(ws + OFF_XU), (const char*)(ws + OFF_W2), (size_t)512 * 768 * 2, (size_t)256 * 768 * 2, last ? 2 : 3, 2, 12, G, wg};
          EpiS2 E{(bf16_t*)(ws + OFF_YG), last ? 512 : NCHUNK};
          gemm_phase(lds, XUK, 768, S, E);
          const int nsgu = (last ? 128 : 144) * 4;
          { int st, sd; if (filler_range(wg, G, 96, st, sd)) { __syncthreads(); for (int t = st; t < nsgu / 2; t += sd) sgu_task(p, l, t, ldsf); } }
        } break;
#endif
#if PHMASK & 32
        case 5: {
          RectSched S{(const char*)(ws + OFF_YG), (const char*)(ws + OFF_WGLU), (size_t)256 * 256 * 2, 0, nMrows, 1, 4, G, wg};
          EpiGLU E{(const bf16_t*)(ws + OFF_YG), p.glu_b + l * 256, (bf16_t*)(ws + OFF_Y4)};
          gemm_phase(lds, 256, 256, S, E);
          const int nsgu = (last ? 128 : 144) * 4;
          { int st, sd; if (filler_range(wg, G, 72, st, sd)) { __syncthreads(); for (int t = nsgu / 2 + st; t < nsgu; t += sd) sgu_task(p, l, t, ldsf); } }
        } break;
#endif
#if PHMASK & 64
        case 6: {
          MergeSched S{(const char*)(ws + OFF_A), (const char*)(ws + OFF_Y4), (const char*)(ws + OFF_WIN), (const char*)(ws + OFF_WBR), last ? 0 : 128, G, wg};
          EpiMerge E{ws + OFF_GS + (size_t)wg * 65536, (bf16_t*)(ws + OFF_MIXTMP + (size_t)wg * 131072), (bf16_t*)(ws + OFF_MIX), (bf16_t*)(ws + OFF_GP)};
          gemm_phase(lds, 1024, 1024, S, E, (TSEL && TPHASE == 6 && wg == 0) ? (unsigned long long*)(ws + OFF_BAR + 14336) : nullptr);
          { int st, sd; if (filler_range(wg, G, last ? 0 : 128, st, sd)) tr_loop(p, l, PT_FF0, st, PT_NMID, sd, ldsf); }
        } break;
#endif
#if PHMASK & 128
        case 7: {
          WoutSched S{(const char*)(ws + OFF_MIX), (const char*)(ws + OFF_GP), (const char*)(ws + OFF_WOUT), last ? 0 : 256, G, wg};
          EpiRes E{hL, hC, H, modl, 2, (float*)(ws + OFF_PART)};
          gemm_phase(lds, 1024, 1024, S, E);
        } break;
#endif
#if PHMASK & 256
        case 8: {
          norm_rows(p, H, l == 0 ? p.ctx : H + (size_t)ML * 1024, p.norm_g + (size_t)(l * 2 + 1) * 1024, modl, 3, last ? ML : MT, modl + (size_t)8 * 6144 + 2 * 1024);
          if (!last) for (int t = wg; t < NT_BR; t += G) prep_task(p, l + 1, PT_WBR0 + t, ldsf);
        } break;
#endif
#if PHMASK & 512
        case 9: {
          RectSched S{(const char*)(ws + OFF_A), (const char*)(ws + OFF_WFF1), (size_t)256 * 1024 * 2, (size_t)256 * 1024 * 2, nMrows, 16, 16, G, wg};
          EpiFF1 E{(bf16_t*)(ws + OFF_FFH)};
          gemm_phase(lds, 1024, 1024, S, E, (TSEL && TPHASE == 9 && wg == 0) ? (unsigned long long*)(ws + OFF_BAR + 14336) : nullptr);
          if (!last) { int st, sd; if (filler_range(wg, G, 128, st, sd)) tr_loop(p, l + 1, 0, st, NT_WIN, sd, ldsf); }
        } break;
#endif
#if PHMASK & 1024
        case 10: {
          SplitSched S{(const char*)(ws + OFF_FFH), (const char*)(ws + OFF_WFF2), (const char*)(ws + OFF_FFH) + (size_t)64 * 256 * 4096 * 2, (size_t)256 * 4096 * 2, (size_t)256 * 4096 * 2, (size_t)256 * 4096 * 2, 64, 8, 256, last ? 0 : 256, G, wg};
          EpiRes E{H, H + (size_t)ML * 1024, H, modl, 5, (float*)(ws + OFF_PART)};
          gemm_phase(lds, 4096, 4096, S, E);
        } break;
#endif
      }
    }
    }
    if (ph + 1 < p_arg.ph_hi) { xcd_barrier(xb);
#if (DBL_MASK >> 12) & 1
      xcd_barrier(xb);
#endif
    }
  }
}

extern "C" void kernel_launch(void* const* d_in, const int* in_sizes, int n_in, void* d_out, int out_size, void* d_ws, size_t ws_size, hipStream_t stream) {
  constexpr size_t kDynLds = 131072 + 16;
  static int grid_blocks = 0;
  if (!grid_blocks) {
    (void)hipFuncSetAttribute((const void*)mk_forward, hipFuncAttributeMaxDynamicSharedMemorySize, (int)kDynLds);
    int dev = 0, cus = 0, per_cu = 0;
    (void)hipGetDevice(&dev);
    (void)hipDeviceGetAttribute(&cus, hipDeviceAttributeMultiprocessorCount, dev);
    (void)hipOccupancyMaxActiveBlocksPerMultiprocessor(&per_cu, mk_forward, 512, kDynLds);
    if (per_cu < 1) per_cu = 1;
    grid_blocks = cus;
  }
  P p{};
  const float** pp = (const float**)&p;
  for (int i = 0; i < 29; ++i) pp[i] = (const float*)d_in[i];
  p.out = (float*)d_out; p.ws = (unsigned char*)d_ws;
  (void)hipMemsetAsync((unsigned char*)d_ws + OFF_BAR, 0, 16384, stream);
#if MULTI_LAUNCH
  for (int ph = 0; ph < N_PHASES; ++ph) {
    p.ph_lo = ph; p.ph_hi = ph + 1;
    hipLaunchKernelGGL(mk_forward, dim3(grid_blocks), dim3(512), kDynLds, stream, p);
  }
#else
  p.ph_lo = 0; p.ph_hi = N_PHASES;
  void* args[] = {&p};
  (void)hipLaunchCooperativeKernel((void*)mk_forward, dim3(grid_blocks), dim3(512), args, kDynLds, stream);
#endif
}
```

```cpp
#include <hip/hip_runtime.h>
#include <hip/hip_cooperative_groups.h>
namespace cg = cooperative_groups;

#define LAS __attribute__((address_space(3)))
typedef unsigned short bf16_t;
typedef short bf16x8 __attribute__((ext_vector_type(8)));
typedef float f32x4 __attribute__((ext_vector_type(4)));
typedef unsigned u32x4 __attribute__((ext_vector_type(4)));
typedef unsigned u32x2 __attribute__((ext_vector_type(2)));

#ifndef PHMASK
#define PHMASK 0x7ff
#endif
#ifndef DBL_MASK
#define DBL_MASK 0
#endif
#ifndef TSEL
#define TSEL 0
#endif
#ifndef TPHASE
#define TPHASE 6
#endif
#ifndef MULTI_LAUNCH
#define MULTI_LAUNCH 0
#endif

constexpr int DM = 1024, NB = 8, SEQL = 2048, NDEPTH = 4, CTXL = 256, DFF = 4096, INW = 6400;
constexpr int ML = NB * SEQL;
constexpr int MC = NB * CTXL;
constexpr int MT = ML + MC;
constexpr int TCH = 32;
constexpr int NCHUNK = MT / TCH;
constexpr int XUR = 768;
constexpr int XUK = 768;

constexpr size_t OFF_H = 0;
constexpr size_t OFF_A = OFF_H + (size_t)MT * DM * 4;
constexpr size_t OFF_MIX = OFF_A + (size_t)MT * DM * 2;
constexpr size_t OFF_R1 = OFF_MIX + (size_t)MT * DM * 2;
constexpr size_t OFF_PS = OFF_R1;
constexpr size_t OFF_Y4 = OFF_PS + (size_t)MT * 2304 * 2;
constexpr size_t OFF_VT = OFF_Y4 + (size_t)MT * DM * 2;
constexpr size_t OFF_XU = OFF_VT + (size_t)NB * 4 * 64 * 2304 * 2;
constexpr size_t OFF_S = OFF_XU + (size_t)16 * XUR * XUK * 2;
constexpr size_t OFF_YG = OFF_S + (size_t)16 * NCHUNK * 256 * 4;
constexpr size_t OFF_R1END = OFF_YG + (size_t)MT * 256 * 2;
constexpr size_t OFF_FFH = OFF_R1;
constexpr size_t OFF_MIXTMP = OFF_PS;
constexpr size_t OFF_KT = OFF_YG;
constexpr size_t OFF_GS = OFF_VT;
constexpr size_t OFF_WIN = OFF_R1END;
constexpr size_t OFF_WFF1 = OFF_WIN + (size_t)INW * DM * 2;
constexpr size_t OFF_WFF2 = OFF_WFF1 + (size_t)DFF * DM * 2;
constexpr size_t OFF_WOUT = OFF_WFF2 + (size_t)DFF * DM * 2;
constexpr size_t OFF_WBR = OFF_WOUT + (size_t)DM * DM * 2;
constexpr size_t OFF_WGLU = OFF_WBR + (size_t)DM * DM * 2;
constexpr size_t OFF_W1 = OFF_WGLU + (size_t)256 * 256 * 2;
constexpr size_t OFF_W2 = OFF_W1 + (size_t)16 * 256 * 512 * 2;
constexpr size_t OFF_SGUWT = OFF_W2 + (size_t)16 * 512 * 768 * 2;
constexpr size_t OFF_MOD = OFF_SGUWT + (size_t)4 * 128 * 128 * 4;
constexpr size_t OFF_BAR = OFF_MOD + (size_t)NDEPTH * 9 * 6144 * 4;
constexpr size_t OFF_PART = OFF_BAR + 16384;
constexpr size_t OFF_END = OFF_PART + (size_t)8 * MC * DM * 4;
constexpr size_t OFF_KTAB = OFF_END;
static_assert(OFF_KTAB + (size_t)16 * 2 * 32 * 256 * 4 <= 453000000ull, "KTAB");
constexpr size_t OFF_GP = OFF_PS + (size_t)256 * 262144;
static_assert(OFF_GP + (size_t)MC * 4096 * 2 <= OFF_Y4, "GP alias");
static_assert((size_t)MT * DFF * 2 <= OFF_R1END - OFF_R1, "FFH alias");
static_assert((size_t)256 * 262144 <= (size_t)MT * 2304 * 2, "MIXTMP alias");
static_assert((size_t)256 * 131072 <= OFF_R1END - OFF_VT, "GS alias");
static_assert(OFF_END < 452000000ull, "workspace");

struct P {
  const float *x, *c, *ctx, *c_ctx, *ada_w, *ada_b, *norm_g, *final_g, *w_in, *w_branch, *w_out,
      *lam_re, *lam_im, *log_dt, *b_re, *b_im, *c_re, *c_im, *s5_d, *glu_w, *glu_b, *rpb, *conv_w,
      *ln_g, *ln_b, *sgu_w, *sgu_b, *w_ff1, *w_ff2;
  float* out;
  unsigned char* ws;
  int ph_lo, ph_hi;
};

__device__ __forceinline__ int otid() { int t = threadIdx.x; asm volatile("" : "+v"(t)); return t; }
__device__ __forceinline__ float bf2f(bf16_t b) { return __uint_as_float(((unsigned)b) << 16); }
__device__ __forceinline__ float bflo(unsigned w) { return __uint_as_float(w << 16); }
__device__ __forceinline__ float bfhi(unsigned w) { return __uint_as_float(w & 0xffff0000u); }
__device__ __forceinline__ unsigned cvt_pk_bf16(float lo, float hi) { unsigned r; asm volatile("v_cvt_pk_bf16_f32 %0, %1, %2" : "=v"(r) : "v"(lo), "v"(hi)); return r; }
__device__ __forceinline__ float sigm(float x) { return 1.f / (1.f + __expf(-x)); }
__device__ __forceinline__ float gelu_tanh(float x) { return x * sigm(1.5957691216057308f * (x + 0.044715f * x * x * x)); }
__device__ __forceinline__ u32x4 pack8(f32x4 a, f32x4 b) { u32x4 r; r[0] = cvt_pk_bf16(a[0], a[1]); r[1] = cvt_pk_bf16(a[2], a[3]); r[2] = cvt_pk_bf16(b[0], b[1]); r[3] = cvt_pk_bf16(b[2], b[3]); return r; }
__device__ __forceinline__ float shx(float v, int o, int lane) { return __int_as_float(__builtin_amdgcn_ds_bpermute((lane ^ o) << 2, __float_as_int(v))); }
__device__ __forceinline__ float wave_sum(float v, int lane) {
#pragma unroll
  for (int o = 32; o >= 1; o >>= 1) v += shx(v, o, lane);
  return v;
}


#define XB_TMO      128
#define XB_XCNT(j)  (256  + 64 * (j))
#define XB_XSUB(j)  (1280 + 64 * (j))
#define XB_XGEN(j)  (2304 + 64 * (j))
#define XB_TOP      3328
#define XB_TOPGEN   3392
#define XCD_BAR_WORDS 3456
#define XB_SPIN_CAP (1u << 22)
__device__ __forceinline__ unsigned xb_ld(unsigned* p)              { return __hip_atomic_load(p, __ATOMIC_RELAXED, __HIP_MEMORY_SCOPE_AGENT); }
__device__ __forceinline__ unsigned xb_add(unsigned* p, unsigned v) { return __hip_atomic_fetch_add(p, v, __ATOMIC_RELAXED, __HIP_MEMORY_SCOPE_AGENT); }
__device__ __forceinline__ unsigned xb_xcc_id() { return (unsigned)__builtin_amdgcn_s_getreg((3 << 11) | 20) & 0xFu; }
#define XB_SPIN(cond, bar) do { unsigned _sp = 0; while (cond) { __builtin_amdgcn_s_sleep(1); \
    if ((++_sp & 255u) == 0u) { if (xb_ld(&(bar)[XB_TMO])) break; if (_sp > XB_SPIN_CAP) { atomicAdd(&(bar)[XB_TMO], 1u); break; } } } } while (0)
struct XcdBarrier { unsigned* bar; unsigned x; volatile LAS unsigned* st; };
__device__ __forceinline__ XcdBarrier xcd_barrier_post(unsigned* bar, volatile LAS unsigned* st) {
  XcdBarrier b; b.bar = bar; b.x = xb_xcc_id(); b.st = st;
  if (threadIdx.x == 0) (void)xb_add(&bar[XB_XCNT(b.x)], 1u);
  return b;
}
__device__ __forceinline__ void xcd_barrier_complete(unsigned* bar, unsigned x, unsigned& nloc, unsigned& nx) {
  const unsigned G = gridDim.x * gridDim.y * gridDim.z;
  unsigned sum, cnt, mine, sp = 0u;
  for (;;) {
    sum = 0u; cnt = 0u; mine = 0u;
#pragma unroll
    for (unsigned j = 0; j < 16; ++j) { const unsigned c = xb_ld(&bar[XB_XCNT(j)]); sum += c; cnt += (c > 0u) ? 1u : 0u; mine = (j == x) ? c : mine; }
    if (sum == G) break;
    __builtin_amdgcn_s_sleep(1);
    if ((++sp & 255u) == 0u) { if (xb_ld(&bar[XB_TMO])) break; if (sp > XB_SPIN_CAP) { atomicAdd(&bar[XB_TMO], 1u); break; } }
  }
  nloc = mine > 0u ? mine : 1u; nx = cnt > 0u ? cnt : 1u;
}
__device__ __forceinline__ void xcd_barrier(const XcdBarrier& b) {
  asm volatile("s_waitcnt vmcnt(0)" ::: "memory");
  __syncthreads();
  if (threadIdx.x == 0) {
    unsigned* bar = b.bar;
    __builtin_amdgcn_s_waitcnt(0);
    unsigned nloc = b.st[0], nx = b.st[1];
    if (nloc == 0u) { xcd_barrier_complete(bar, b.x, nloc, nx); b.st[0] = nloc; b.st[1] = nx; }
    const unsigned old = xb_add(&bar[XB_XSUB(b.x)], 1u);
    const unsigned gen = old / nloc;
    if (old + 1u == (gen + 1u) * nloc) {
      __builtin_amdgcn_fence(__ATOMIC_RELEASE, "agent");
      asm volatile("s_waitcnt vmcnt(0)" ::: "memory");
      const unsigned og = xb_add(&bar[XB_TOP], 1u);
      const unsigned tg = og / nx;
      if (og + 1u == (tg + 1u) * nx) xb_add(&bar[XB_TOPGEN], 1u);
      else XB_SPIN(xb_ld(&bar[XB_TOPGEN]) == tg, bar);
      __builtin_amdgcn_fence(__ATOMIC_ACQUIRE, "agent");
      xb_add(&bar[XB_XGEN(b.x)], 1u);
      asm volatile("s_waitcnt vmcnt(0)" ::: "memory");
    } else {
      XB_SPIN(xb_ld(&bar[XB_XGEN(b.x)]) == gen, bar);
      __builtin_amdgcn_fence(__ATOMIC_ACQUIRE, "agent");
      asm volatile("s_waitcnt vmcnt(0)" ::: "memory");
    }
  }
  __syncthreads();
}

constexpr int BM = 256, BK = 64, HALF = 128, HTB = HALF * BK * 2, NXCD = 8, WGM = 8;
__device__ __forceinline__ int lds_byte(int r, int c) { const int st = (r >> 4) * 2 + (c >> 5), rr = r & 15, cc = c & 31, ob = rr * 64 + cc * 2; return st * 1024 + (ob ^ (((ob >> 9) & 1) << 5)); }
__device__ __forceinline__ void stage_rc(int b, int& R, int& C) { const int st = b / 1024, sb = b % 1024, swz = sb ^ (((sb >> 9) & 1) << 5); R = (st >> 1) * 16 + swz / 64; C = (st & 1) * 32 + (swz % 64) / 2; }
__device__ __forceinline__ int perm32(int rho) { const int n = rho >> 4, i = rho & 15; return 8 * (i >> 2) + 4 * n + (i & 3); }

struct Unit { const char* A; const char* B; int nt, pm, pn, kind; };

__device__ __forceinline__ void rect_map(int L, int nM, int nN, int& pm, int& pn) {
  const int nwg = nM * nN; int wgid = L;
  { const int q = nwg / NXCD, r = nwg % NXCD, xcd = wgid % NXCD, off = wgid / NXCD; wgid = (xcd < r ? xcd * (q + 1) : r * (q + 1) + (xcd - r) * q) + off; }
  const int nig = WGM * nN, gid = wgid / nig, fm = gid * WGM, gsz = (nM - fm) < WGM ? (nM - fm) : WGM;
  pm = fm + ((wgid % nig) % gsz); pn = (wgid % nig) / gsz;
}

template <class Sched, class Epi>
__device__ __forceinline__ void gemm_phase(LAS unsigned char* lds, const int lda, const int ldb, const Sched& S, const Epi& E, unsigned long long* tslot = nullptr) {
#if TSEL
  const unsigned long long tg0 = __builtin_amdgcn_s_memrealtime();
#endif
  int tid_ = threadIdx.x; asm volatile("" : "+v"(tid_));
  const int tid = tid_, wid = __builtin_amdgcn_readfirstlane(tid >> 6), lane = tid & 63, wr = wid >> 2, wc = wid & 3, fr = lane & 15, fq = lane >> 4;
  unsigned voffA[2], voffB[2];
#pragma unroll
  for (int i = 0; i < 2; ++i) { int R, C; stage_rc(tid * 16 + i * 8192, R, C); const int Rb = (R & ~31) + perm32(R & 31);
    voffA[i] = (unsigned)(R * lda + C) * 2u; voffB[i] = (unsigned)(Rb * ldb + C) * 2u; }
  const size_t kstep = (size_t)(BK * 2);
  const size_t hstepA = (size_t)HALF * lda * 2, hstepB = (size_t)HALF * ldb * 2;
  const unsigned ldsw = (unsigned)wid * 1024u;
  const int aoff = lds_byte(wr * 64 + fr, fq * 8), boff = lds_byte(wc * 32 + fr, fq * 8);
#define PG8_SA(b, h) (((b) * 2 + (h)) * HTB)
#define PG8_SB(b, h) ((4 + (b) * 2 + (h)) * HTB)
#define PG8_STAGE(bufoff, gbase, voff) do { _Pragma("unroll") for (int _i = 0; _i < 2; ++_i) \
    __builtin_amdgcn_global_load_lds((const unsigned*)((const char*)(gbase) + (voff)[_i]), (LAS unsigned*)(lds + (bufoff) + ldsw + _i * 8192), 16, 0, 0); } while (0)
#define PG8_LDA(dst, b, h) do { _Pragma("unroll") for (int m = 0; m < 4; ++m) _Pragma("unroll") for (int k = 0; k < 2; ++k) dst[m][k] = *(const LAS bf16x8*)(lds + PG8_SA(b, h) + aoff + m * 2048 + k * 1024); } while (0)
#define PG8_LDB(dst, b, h) do { _Pragma("unroll") for (int n = 0; n < 2; ++n) _Pragma("unroll") for (int k = 0; k < 2; ++k) dst[n][k] = *(const LAS bf16x8*)(lds + PG8_SB(b, h) + boff + n * 2048 + k * 1024); } while (0)
#define PG8_MMA(ai, bj, At, Bt) do { __builtin_amdgcn_s_setprio(1); _Pragma("unroll") for (int m = 0; m < 4; ++m) _Pragma("unroll") for (int n = 0; n < 2; ++n) _Pragma("unroll") for (int k = 0; k < 2; ++k) \
    acc[ai][bj][m][n] = __builtin_amdgcn_mfma_f32_16x16x32_bf16(Bt[n][k], At[m][k], acc[ai][bj][m][n], 0, 0, 0); __builtin_amdgcn_s_setprio(0); } while (0)
#define PG8_WAIT_V(n) asm volatile("s_waitcnt vmcnt(" #n ")" ::: "memory")
#define PG8_WAIT_L(n) asm volatile("s_waitcnt lgkmcnt(" #n ")" ::: "memory")
#define PG8_BAR __builtin_amdgcn_s_barrier()
#define PG8_SCHED __builtin_amdgcn_sched_barrier(0)
  Unit cur, nxt; int ui = 0;
  if (!S.next(0, cur)) return;
  f32x4 acc[2][2][4][2];
#pragma unroll
  for (int a = 0; a < 2; ++a)
#pragma unroll
    for (int b = 0; b < 2; ++b)
#pragma unroll
      for (int m = 0; m < 4; ++m)
#pragma unroll
        for (int n = 0; n < 2; ++n) acc[a][b][m][n] = (f32x4){0.f, 0.f, 0.f, 0.f};
  bf16x8 At[4][2], B0[2][2], B1[2][2];
  const char* cA = cur.A; const char* cB = cur.B;
  PG8_STAGE(PG8_SB(0, 0), cB, voffB); PG8_STAGE(PG8_SA(0, 0), cA, voffA); PG8_STAGE(PG8_SB(0, 1), cB + hstepB, voffB); PG8_STAGE(PG8_SA(0, 1), cA + hstepA, voffA);
  if (wr == 1) PG8_BAR;
  PG8_WAIT_V(4); PG8_BAR;
  PG8_STAGE(PG8_SB(1, 0), cB + kstep, voffB); PG8_STAGE(PG8_SA(1, 0), cA + kstep, voffA); PG8_STAGE(PG8_SB(1, 1), cB + hstepB + kstep, voffB);
  PG8_WAIT_V(6); PG8_BAR;
  for (;;) {
    const bool has_next = S.next(ui + 1, nxt);
    const char* nA = has_next ? nxt.A : cA; const char* nB = has_next ? nxt.B : cB;
    const int nt = cur.nt;
#if TSEL
    const unsigned long long tk0 = __builtin_amdgcn_s_memrealtime();
#endif
    for (int t = 0; t < nt; t += 2) {
      const bool last = (t == nt - 2);
      const char* a1 = cA + (size_t)(t + 1) * kstep;
      const char* a2 = last ? nA : cA + (size_t)(t + 2) * kstep; const char* b2 = last ? nB : cB + (size_t)(t + 2) * kstep;
      const char* a3 = a2 + kstep; const char* b3 = b2 + kstep;
      PG8_LDB(B0, 0, 0); PG8_SCHED; PG8_LDA(At, 0, 0); PG8_STAGE(PG8_SA(1, 1), a1 + hstepA, voffA);
      PG8_WAIT_L(8); PG8_BAR; PG8_WAIT_L(0); PG8_MMA(0, 0, At, B0); PG8_BAR; PG8_SCHED;
      PG8_LDB(B1, 0, 1); PG8_STAGE(PG8_SB(0, 0), b2, voffB);
      PG8_BAR; PG8_WAIT_L(0); PG8_MMA(0, 1, At, B1); PG8_BAR;
      PG8_LDA(At, 0, 1); PG8_STAGE(PG8_SA(0, 0), a2, voffA);
      PG8_BAR; PG8_WAIT_L(0); PG8_MMA(1, 0, At, B0); PG8_BAR; PG8_SCHED;
      PG8_STAGE(PG8_SB(0, 1), b2 + hstepB, voffB);
      PG8_WAIT_V(6); PG8_BAR; PG8_MMA(1, 1, At, B1); PG8_BAR;
      PG8_LDB(B0, 1, 0); PG8_SCHED; PG8_LDA(At, 1, 0); PG8_STAGE(PG8_SA(0, 1), a2 + hstepA, voffA);
      PG8_WAIT_L(8); PG8_BAR; PG8_WAIT_L(0); PG8_MMA(0, 0, At, B0); PG8_BAR; PG8_SCHED;
      PG8_LDB(B1, 1, 1); PG8_STAGE(PG8_SB(1, 0), b3, voffB);
      PG8_BAR; PG8_WAIT_L(0); PG8_MMA(0, 1, At, B1); PG8_BAR;
      PG8_LDA(At, 1, 1); PG8_STAGE(PG8_SA(1, 0), a3, voffA);
      PG8_BAR; PG8_WAIT_L(0); PG8_MMA(1, 0, At, B0); PG8_BAR; PG8_SCHED;
      PG8_STAGE(PG8_SB(1, 1), b3 + hstepB, voffB);
      PG8_WAIT_V(6); PG8_BAR; PG8_MMA(1, 1, At, B1); PG8_BAR;
    }
#if TSEL
    const unsigned long long te0 = __builtin_amdgcn_s_memrealtime();
    if (tslot && tid == 0) tslot[3 + (cur.kind & 1)] += te0 - tk0;
#endif
    { const int t2 = otid(); E(acc, cur, wr, wc, t2 & 15, (t2 & 63) >> 4); }
#if TSEL
    if (tslot && tid == 0) { asm volatile("s_waitcnt vmcnt(0)" ::: "memory"); tslot[0] += __builtin_amdgcn_s_memrealtime() - te0; tslot[2] += 1; }
#endif
    if (!has_next) break;
#pragma unroll
    for (int a = 0; a < 2; ++a)
#pragma unroll
      for (int b = 0; b < 2; ++b)
#pragma unroll
        for (int m = 0; m < 4; ++m)
#pragma unroll
          for (int n = 0; n < 2; ++n) acc[a][b][m][n] = (f32x4){0.f, 0.f, 0.f, 0.f};
    cur = nxt; cA = nA; cB = nB; ++ui;
  }
  PG8_WAIT_V(0);
  if (wr == 0) PG8_BAR;
  PG8_BAR;
#if TSEL
  if (tslot && tid == 0) tslot[1] += __builtin_amdgcn_s_memrealtime() - tg0;
#endif
#undef PG8_SA
#undef PG8_SB
#undef PG8_STAGE
#undef PG8_LDA
#undef PG8_LDB
#undef PG8_MMA
#undef PG8_WAIT_V
#undef PG8_WAIT_L
#undef PG8_BAR
#undef PG8_SCHED
}

typedef f32x4 Acc[2][2][4][2];
#define EPI_ROWS(u, wr, fr) \
  _Pragma("unroll") for (int ai = 0; ai < 2; ++ai) _Pragma("unroll") for (int m = 0; m < 4; ++m)
#define EPI_ROW(u, wr, fr) ((u).pm * 256 + ai * 128 + (wr) * 64 + m * 16 + (fr))
#define EPI_COL(wc, fq) (bj * 128 + (wc) * 32 + (fq) * 8)

__device__ __forceinline__ int bsel_of_tile(int pm) { return pm < 64 ? (pm >> 3) : 8; }

struct RectSched {
  const char* A; const char* B; size_t a_tile, b_tile; int nM, nN, nt, G, c;
  __device__ __forceinline__ bool next(int i, Unit& u) const {
    const int L = i * G + c; if (L >= nM * nN) return false;
    int pm, pn; rect_map(L, nM, nN, pm, pn);
    u.pm = pm; u.pn = pn; u.kind = 0; u.nt = nt; u.A = A + (size_t)pm * a_tile; u.B = B + (size_t)pn * b_tile; return true;
  }
};
struct G1Sched {
  const char* A; const char* B; int G, c, last;
  __device__ __forceinline__ bool next(int i, Unit& u) const {
    const int L = i * G + c; const int nl = 64 * 9, ncx = last ? 24 : 72;
    if (L >= nl + ncx) return false;
    int pm, pn;
    if (L < nl) rect_map(L, 64, 9, pm, pn);
    else { const int q = L - nl; if (last) { pm = 64 + q / 3; const int s = q % 3; pn = s == 0 ? 0 : (s + 1); } else { pm = 64 + q / 9; pn = q % 9; } }
    u.pm = pm; u.pn = pn; u.kind = 0; u.nt = 16; u.A = A + (size_t)pm * (256 * 1024 * 2); u.B = B + (size_t)pn * (256 * 1024 * 2); return true;
  }
};
struct S5Sched {
  const char* A; const char* B; size_t b_group, b_tile; int nMs, nN, nt, G, c;
  __device__ __forceinline__ bool next(int i, Unit& u) const {
    const int L = i * G + c; if (L >= 16 * nMs * nN) return false;
    const int g = L / (nMs * nN), r = L % (nMs * nN), pm = r / nN, pn = r % nN;
    u.pm = pm; u.pn = pn; u.kind = g; u.nt = nt;
    u.A = A + ((size_t)g * XUR + (size_t)pm * 256) * XUK * 2; u.B = B + (size_t)g * b_group + (size_t)pn * b_tile; return true;
  }
};
struct MergeSched {
  const char* Abuf; const char* Y4; const char* Win; const char* Wbr; int ncx, G, c;
  __device__ __forceinline__ bool next(int i, Unit& u) const {
    const int nlat = (256 - c + G - 1) / G;
    int pm, pd, k, j;
    if (i < 8 * nlat) { const int su = (i >> 3) * G + c; j = i & 7; k = j >> 1; const int x = su & 7, sl = su >> 3; pd = sl & 3; pm = x * 8 + (sl >> 2); u.kind = j; }
    else { const int i2 = i - 8 * nlat; const int q = (i2 >> 1) * G + c; if (q >= ncx) return false; j = i2 & 1; const int x = q & 7, sl = q >> 3; k = sl & 3; pd = sl >> 2; pm = 64 + x; u.kind = 8 + 2 * k + j; }
    u.pm = pm; u.pn = pd;
    if (!(j & 1)) { u.nt = 16; u.A = Abuf + (size_t)pm * (256 * 1024 * 2); u.B = Win + (size_t)(2304 + k * 1024 + pd * 256) * (1024 * 2); }
    else { u.nt = 4; u.A = Y4 + (size_t)pm * (256 * 1024 * 2) + (size_t)k * 512; u.B = Wbr + (size_t)(pd * 256) * (1024 * 2) + (size_t)k * 512; }
    return true;
  }
};
struct WoutSched {
  const char* MIXb; const char* GPb; const char* B; int ncx, G, c;
  __device__ __forceinline__ bool next(int i, Unit& u) const {
    const int L = i * G + c;
    if (L < 256) { int pm, pn; rect_map(L, 64, 4, pm, pn); u.pm = pm; u.pn = pn; u.kind = 0; u.nt = 16; u.A = MIXb + (size_t)pm * (256 * 1024 * 2); u.B = B + (size_t)pn * (256 * 1024 * 2); return true; }
    const int q = L - 256; if (q >= ncx) return false;
    const int ks = q & 7, pn = (q >> 3) & 3, pmc = q >> 5;
    u.pm = 64 + pmc; u.pn = pn; u.kind = 1 + ks; u.nt = 8;
    u.A = GPb + ((size_t)(ks >> 1) * MC + (size_t)pmc * 256) * (1024 * 2) + (size_t)(ks & 1) * 1024; u.B = B + (size_t)pn * (256 * 1024 * 2) + (size_t)(ks & 1) * 1024; return true;
  }
};
struct SplitSched {
  const char* A; const char* B; const char* Ac; size_t a_tile, b_tile, ac_tile; int nt, nts, nlat, ncx, G, c;
  __device__ __forceinline__ bool next(int i, Unit& u) const {
    const int L = i * G + c;
    if (L < nlat) { int pm, pn; rect_map(L, 64, 4, pm, pn); u.pm = pm; u.pn = pn; u.kind = 0; u.nt = nt; u.A = A + (size_t)pm * a_tile; u.B = B + (size_t)pn * b_tile; return true; }
    const int q = L - nlat; if (q >= ncx) return false;
    const int ks = q & 7, pn = (q >> 3) & 3, pmc = q >> 5;
    u.pm = 64 + pmc; u.pn = pn; u.kind = 1 + ks; u.nt = nts;
    u.A = Ac + (size_t)pmc * ac_tile + (size_t)ks * nts * 128; u.B = B + (size_t)pn * b_tile + (size_t)ks * nts * 128; return true;
  }
};

struct EpiG1 {
  bf16_t* PS; bf16_t* XU; bf16_t* VT; bf16_t* KT;
  __device__ __forceinline__ void operator()(const Acc& acc, const Unit& u, int wr, int wc, int fr, int fq) const {
    if (u.pn == 3) {
      const int voff = (wc >> 1) * (288 * 512) + ((wc & 1) * 32 + fq * 8) * 8;
      EPI_ROWS(u, wr, fr) {
        const int row = EPI_ROW(u, wr, fr);
        int b, tok; if (row < ML) { b = row >> 11; tok = row & 2047; } else { const int r2 = row - ML; b = r2 >> 8; tok = 2048 + (r2 & 255); }
        bf16_t* rb = VT + ((size_t)(b * 4) * 288 + (tok >> 3)) * 512 + (tok & 7) + voff;
#pragma unroll
        for (int bj = 0; bj < 2; ++bj) {
          const u32x4 pk = pack8(acc[ai][bj][m][0], acc[ai][bj][m][1]);
          bf16_t* base = rb + bj * (2 * 288 * 512);
#pragma unroll
          for (int i = 0; i < 4; ++i) { base[(2 * i) * 8] = (bf16_t)(pk[i] & 0xffffu); base[(2 * i + 1) * 8] = (bf16_t)(pk[i] >> 16); }
        }
      }
      return;
    }
    EPI_ROWS(u, wr, fr) {
      const int row = EPI_ROW(u, wr, fr);
#pragma unroll
      for (int bj = 0; bj < 2; ++bj) {
        const int c = EPI_COL(wc, fq);
        const u32x4 pk = pack8(acc[ai][bj][m][0], acc[ai][bj][m][1]);
        if (u.pn == 0) {
          const int g = c >> 4, h0 = c & 15;
          *(u32x4*)(XU + ((size_t)(g * XUR + (row >> 5)) * XUK + (row & 31) * 16 + h0)) = pk;
        } else if (u.pn == 2) {
          int b, tok; if (row < ML) { b = row >> 11; tok = row & 2047; } else { const int r2 = row - ML; b = r2 >> 8; tok = 2048 + (r2 & 255); }
          *(u32x4*)(KT + (((size_t)(b * 4 + (c >> 6)) * 2304 + tok) * 64 + (c & 63))) = pk;
        } else {
          *(u32x4*)(PS + (size_t)row * 2304 + u.pn * 256 + c) = pk;
        }
      }
    }
  }
};
struct EpiS1 {
  float* S;
  __device__ __forceinline__ void operator()(const Acc& acc, const Unit& u, int wr, int wc, int fr, int fq) const {
    EPI_ROWS(u, wr, fr) {
      const int row = EPI_ROW(u, wr, fr);
      if (row < NCHUNK) {
#pragma unroll
        for (int bj = 0; bj < 2; ++bj) {
          const int c = EPI_COL(wc, fq);
          float* dst = S + ((size_t)u.kind * NCHUNK + row) * 256 + c;
          *(f32x4*)dst = acc[ai][bj][m][0]; *(f32x4*)(dst + 4) = acc[ai][bj][m][1];
        }
      }
    }
  }
};
struct EpiS2 {
  bf16_t* YG; int rowlim;
  __device__ __forceinline__ void operator()(const Acc& acc, const Unit& u, int wr, int wc, int fr, int fq) const {
    EPI_ROWS(u, wr, fr) {
      const int row = EPI_ROW(u, wr, fr);
      if (row < rowlim) {
#pragma unroll
        for (int bj = 0; bj < 2; ++bj) {
          const int col = u.pn * 256 + EPI_COL(wc, fq);
          const int t = col >> 4, h0 = col & 15;
          f32x4 a = acc[ai][bj][m][0], b = acc[ai][bj][m][1];
#pragma unroll
          for (int i = 0; i < 4; ++i) { a[i] = gelu_tanh(a[i]); b[i] = gelu_tanh(b[i]); }
          *(u32x4*)(YG + ((size_t)(row * TCH + t)) * 256 + u.kind * 16 + h0) = pack8(a, b);
        }
      }
    }
  }
};
struct EpiGLU {
  const bf16_t* YG; const float* bias; bf16_t* Y4;
  __device__ __forceinline__ void operator()(const Acc& acc, const Unit& u, int wr, int wc, int fr, int fq) const {
    EPI_ROWS(u, wr, fr) {
      const int row = EPI_ROW(u, wr, fr);
#pragma unroll
      for (int bj = 0; bj < 2; ++bj) {
        const int c = EPI_COL(wc, fq);
        const u32x4 gv = *(const u32x4*)(YG + (size_t)row * 256 + c);
        const f32x4 b0 = *(const f32x4*)(bias + c), b1 = *(const f32x4*)(bias + c + 4);
        f32x4 a = acc[ai][bj][m][0] + b0, b = acc[ai][bj][m][1] + b1;
        a[0] = bflo(gv[0]) * sigm(a[0]); a[1] = bfhi(gv[0]) * sigm(a[1]); a[2] = bflo(gv[1]) * sigm(a[2]); a[3] = bfhi(gv[1]) * sigm(a[3]);
        b[0] = bflo(gv[2]) * sigm(b[0]); b[1] = bfhi(gv[2]) * sigm(b[1]); b[2] = bflo(gv[3]) * sigm(b[2]); b[3] = bfhi(gv[3]) * sigm(b[3]);
        *(u32x4*)(Y4 + (size_t)row * 1024 + c) = pack8(a, b);
      }
    }
  }
};
struct EpiMerge {
  unsigned char* GS; bf16_t* TMP; bf16_t* MIX; bf16_t* GP;
  __device__ __forceinline__ void operator()(const Acc& acc, const Unit& u, int wr, int wc, int fr, int fq) const {
    const int tid = otid(); const int j = u.kind, k = j >> 1;
    EPI_ROWS(u, wr, fr) {
#pragma unroll
      for (int bj = 0; bj < 2; ++bj) {
        const int e = (ai * 4 + m) * 2 + bj;
        unsigned char* gs = GS + ((size_t)e * 512 + tid) * 8;
        bf16_t* tp = TMP + ((size_t)e * 512 + tid) * 8;
        if (!(j & 1)) {
          const f32x4 a = acc[ai][bj][m][0], b = acc[ai][bj][m][1];
          u32x2 q;
          q[0] = (unsigned)(sigm(a[0]) * 255.f + 0.5f) | ((unsigned)(sigm(a[1]) * 255.f + 0.5f) << 8) | ((unsigned)(sigm(a[2]) * 255.f + 0.5f) << 16) | ((unsigned)(sigm(a[3]) * 255.f + 0.5f) << 24);
          q[1] = (unsigned)(sigm(b[0]) * 255.f + 0.5f) | ((unsigned)(sigm(b[1]) * 255.f + 0.5f) << 8) | ((unsigned)(sigm(b[2]) * 255.f + 0.5f) << 16) | ((unsigned)(sigm(b[3]) * 255.f + 0.5f) << 24);
          *(u32x2*)gs = q;
        } else {
          const u32x2 q = *(const u32x2*)gs;
          f32x4 a = acc[ai][bj][m][0], b = acc[ai][bj][m][1];
          const float sc = 1.f / 255.f;
#pragma unroll
          for (int i = 0; i < 4; ++i) { a[i] *= (float)((q[0] >> (8 * i)) & 255u) * sc; b[i] *= (float)((q[1] >> (8 * i)) & 255u) * sc; }
          if (j >= 8) {
            const int row = EPI_ROW(u, wr, fr) - ML; const int c = u.pn * 256 + EPI_COL(wc, fq);
            *(u32x4*)(GP + ((size_t)(k - 4) * MC + row) * 1024 + c) = pack8(a, b);
          } else {
            if (k > 0) { const u32x4 t = *(const u32x4*)tp; a[0] += bflo(t[0]); a[1] += bfhi(t[0]); a[2] += bflo(t[1]); a[3] += bfhi(t[1]); b[0] += bflo(t[2]); b[1] += bfhi(t[2]); b[2] += bflo(t[3]); b[3] += bfhi(t[3]); }
            if (k < 3) *(u32x4*)tp = pack8(a, b);
            else { const int row = EPI_ROW(u, wr, fr); const int c = u.pn * 256 + EPI_COL(wc, fq); *(u32x4*)(MIX + (size_t)row * 1024 + c) = pack8(a, b); }
          }
        }
      }
    }
  }
};
struct EpiRes {
  const float* hL; const float* hC; float* H; const float* modbase; int modidx; float* PART;
  __device__ __forceinline__ void operator()(const Acc& acc, const Unit& u, int wr, int wc, int fr, int fq) const {
    if (u.kind) {
      bf16_t* pb = (bf16_t*)PART + (size_t)(u.kind - 1) * MC * 1024;
      EPI_ROWS(u, wr, fr) {
        const int row = EPI_ROW(u, wr, fr) - ML;
#pragma unroll
        for (int bj = 0; bj < 2; ++bj) {
          const int c = u.pn * 256 + EPI_COL(wc, fq);
          *(u32x4*)(pb + (size_t)row * 1024 + c) = pack8(acc[ai][bj][m][0], acc[ai][bj][m][1]);
        }
      }
      return;
    }
    const float* mv = modbase + (size_t)bsel_of_tile(u.pm) * 6144 + modidx * 1024;
    EPI_ROWS(u, wr, fr) {
      const int row = EPI_ROW(u, wr, fr);
      const float* hs = row < ML ? hL + (size_t)row * 1024 : hC + (size_t)(row - ML) * 1024;
#pragma unroll
      for (int bj = 0; bj < 2; ++bj) {
        const int c = u.pn * 256 + EPI_COL(wc, fq);
        const f32x4 h0 = *(const f32x4*)(hs + c), h1 = *(const f32x4*)(hs + c + 4);
        const f32x4 m0 = *(const f32x4*)(mv + c), m1 = *(const f32x4*)(mv + c + 4);
        float* hd = H + (size_t)row * 1024 + c;
        *(f32x4*)hd = h0 + m0 * acc[ai][bj][m][0]; *(f32x4*)(hd + 4) = h1 + m1 * acc[ai][bj][m][1];
      }
    }
  }
};
struct EpiFF1 {
  bf16_t* FFH;
  __device__ __forceinline__ void operator()(const Acc& acc, const Unit& u, int wr, int wc, int fr, int fq) const {
    EPI_ROWS(u, wr, fr) {
      const int row = EPI_ROW(u, wr, fr);
#pragma unroll
      for (int bj = 0; bj < 2; ++bj) {
        const int c = u.pn * 256 + EPI_COL(wc, fq);
        f32x4 a = acc[ai][bj][m][0], b = acc[ai][bj][m][1];
#pragma unroll
        for (int i = 0; i < 4; ++i) { a[i] = fmaxf(a[i], 0.f); a[i] *= a[i]; b[i] = fmaxf(b[i], 0.f); b[i] *= b[i]; }
        *(u32x4*)(FFH + (size_t)row * 4096 + c) = pack8(a, b);
      }
    }
  }
};

__device__ void mod_task(const P& p, int task, float* lds) {
  const int tid = otid();
  float* sc = lds;
  float* red = lds + 9 * 1024;
  for (int i = tid; i < 9 * 1024; i += 512) { const float v = i < 8192 ? p.c[i] : p.c_ctx[i - 8192]; sc[i] = v * sigm(v); }
  __syncthreads();
  const int l = task / 48, jb = task % 48, jl = tid & 127, ks = tid >> 7, j = jb * 128 + jl;
  float a[9];
#pragma unroll
  for (int s = 0; s < 9; ++s) a[s] = 0.f;
  const float* w = p.ada_w + (size_t)l * 1024 * 6144 + j;
#pragma unroll 8
  for (int k = ks * 256; k < ks * 256 + 256; ++k) {
    const float wv = w[(size_t)k * 6144];
#pragma unroll
    for (int s = 0; s < 9; ++s) a[s] += sc[s * 1024 + k] * wv;
  }
#pragma unroll
  for (int s = 0; s < 9; ++s) red[(ks * 9 + s) * 128 + jl] = a[s];
  __syncthreads();
  float* MOD = (float*)(p.ws + OFF_MOD);
  for (int i = tid; i < 9 * 128; i += 512) {
    const int s = i >> 7, jj = i & 127;
    const float v = red[(0 * 9 + s) * 128 + jj] + red[(1 * 9 + s) * 128 + jj] + red[(2 * 9 + s) * 128 + jj] + red[(3 * 9 + s) * 128 + jj];
    MOD[((size_t)l * 9 + s) * 6144 + jb * 128 + jj] = v + p.ada_b[l * 6144 + jb * 128 + jj];
  }
  __syncthreads();
}

__device__ void tr_tile(const float* src, int lds_, bf16_t* dst, int ldd, float* tile  ) {
  const int tid = otid();
#pragma unroll
  for (int ps = 0; ps < 2; ++ps) {
    const int k = (tid >> 4) + ps * 32, n4 = (tid & 15) * 4;
    const f32x4 v = *(const f32x4*)(src + (size_t)k * lds_ + n4);
    tile[k * 65 + n4] = v[0]; tile[k * 65 + n4 + 1] = v[1]; tile[k * 65 + n4 + 2] = v[2]; tile[k * 65 + n4 + 3] = v[3];
  }
  __syncthreads();
  {
    const int n = tid >> 3, k8 = (tid & 7) * 8;
    u32x4 o;
#pragma unroll
    for (int i = 0; i < 4; ++i) o[i] = cvt_pk_bf16(tile[(k8 + 2 * i) * 65 + n], tile[(k8 + 2 * i + 1) * 65 + n]);
    *(u32x4*)(dst + (size_t)n * ldd + k8) = o;
  }
  __syncthreads();
}

struct cpx { float re, im; };
__device__ __forceinline__ cpx cmul(cpx a, cpx b) { return {a.re * b.re - a.im * b.im, a.re * b.im + a.im * b.re}; }
template <bool FAST>
__device__ __forceinline__ cpx s5_apow(float lre, float lim, float dt, float e) {
  const float zr = lre * dt * e, zi = lim * dt * e;
  if (FAST) { const float mg = __expf(zr); return {mg * __cosf(zi), mg * __sinf(zi)}; }
  const float mg = expf(zr); float sn, cs; sincosf(zi, &sn, &cs); return {mg * cs, mg * sn};
}
template <bool FAST>
__device__ __forceinline__ cpx s5_coef(float lre, float lim, float dt) {
  const cpx a = s5_apow<FAST>(lre, lim, dt, 1.f); const float nr = a.re - 1.f, ni = a.im, den = lre * lre + lim * lim;
  return {(nr * lre + ni * lim) / den, (ni * lre - nr * lim) / den};
}

constexpr int NT_WIN = 1600, NT_FF1 = 1024, NT_FF2 = 1024, NT_OUT = 256, NT_BR = 256, NT_GLU = 16;
constexpr int NT_TR = NT_WIN + NT_FF1 + NT_FF2 + NT_OUT + NT_BR + NT_GLU;
constexpr int NT_TOEP = 512, NT_W2S = 256, NT_W1 = 128, NT_SGUW = 16;
constexpr int NT_PREP = NT_TR + NT_TOEP + NT_W2S + NT_W1 + NT_SGUW;

struct TrDesc { const float* src; bf16_t* dst; int lds_, ldd; };
__device__ __forceinline__ TrDesc tr_desc(const P& p, int l, int task) {
  unsigned char* ws = p.ws;
  const float* src; bf16_t* dst; int N, ldd, tk, tn;
  int t = task;
  if (t < NT_WIN) { src = p.w_in + (size_t)l * 1024 * 6400; N = 6400; dst = (bf16_t*)(ws + OFF_WIN); ldd = 1024; tk = t / 100; tn = t % 100; }
  else if ((t -= NT_WIN) < NT_FF1) { src = p.w_ff1 + (size_t)l * 1024 * 4096; N = 4096; dst = (bf16_t*)(ws + OFF_WFF1); ldd = 1024; tk = t / 64; tn = t % 64; }
  else if ((t -= NT_FF1) < NT_FF2) { src = p.w_ff2 + (size_t)l * 4096 * 1024; N = 1024; dst = (bf16_t*)(ws + OFF_WFF2); ldd = 4096; tk = t / 16; tn = t % 16; }
  else if ((t -= NT_FF2) < NT_OUT) { src = p.w_out + (size_t)l * 1024 * 1024; N = 1024; dst = (bf16_t*)(ws + OFF_WOUT); ldd = 1024; tk = t / 16; tn = t % 16; }
  else if ((t -= NT_OUT) < NT_BR) { const int k = t >> 6; t &= 63; src = p.w_branch + ((size_t)l * 4 + k) * 256 * 1024; N = 1024; dst = (bf16_t*)(ws + OFF_WBR) + k * 256; ldd = 1024; tk = t / 16; tn = t % 16; }
  else { t -= NT_BR; src = p.glu_w + (size_t)l * 256 * 256; N = 256; dst = (bf16_t*)(ws + OFF_WGLU); ldd = 256; tk = t / 4; tn = t % 4; }
  return {src + (size_t)tk * 64 * N + tn * 64, dst + (size_t)tn * 64 * ldd + tk * 64, N, ldd};
}
__device__ void tr_loop(const P& p, int l, int tbase, int t0, int t1, int td, float* tile  ) {
  if (t0 >= t1) return;
  const int tid = otid();
  const int k0 = tid >> 4, n4 = (tid & 15) * 4, n = tid >> 3, k8 = (tid & 7) * 8;
  TrDesc d = tr_desc(p, l, tbase + t0);
  f32x4 v0 = *(const f32x4*)(d.src + (size_t)k0 * d.lds_ + n4), v1 = *(const f32x4*)(d.src + (size_t)(k0 + 32) * d.lds_ + n4);
  for (int t = t0; t < t1; t += td) {
    tile[k0 * 65 + n4] = v0[0]; tile[k0 * 65 + n4 + 1] = v0[1]; tile[k0 * 65 + n4 + 2] = v0[2]; tile[k0 * 65 + n4 + 3] = v0[3];
    tile[(k0 + 32) * 65 + n4] = v1[0]; tile[(k0 + 32) * 65 + n4 + 1] = v1[1]; tile[(k0 + 32) * 65 + n4 + 2] = v1[2]; tile[(k0 + 32) * 65 + n4 + 3] = v1[3];
    __syncthreads();
    bf16_t* dcur = d.dst; const int lcur = d.ldd;
    if (t + td < t1) { d = tr_desc(p, l, tbase + t + td); v0 = *(const f32x4*)(d.src + (size_t)k0 * d.lds_ + n4); v1 = *(const f32x4*)(d.src + (size_t)(k0 + 32) * d.lds_ + n4); }
    u32x4 o;
#pragma unroll
    for (int i = 0; i < 4; ++i) o[i] = cvt_pk_bf16(tile[(k8 + 2 * i) * 65 + n], tile[(k8 + 2 * i + 1) * 65 + n]);
    *(u32x4*)(dcur + (size_t)n * lcur + k8) = o;
    __syncthreads();
  }
}

__device__ void prep_task(const P& p, int l, int task, float* lds) {
  const int tid = otid();
  unsigned char* ws = p.ws;
  if (task < NT_TR) {
    const float* src; bf16_t* dst; int N, ldd, tk, tn;
    int t = task;
    if (t < NT_WIN) { src = p.w_in + (size_t)l * 1024 * 6400; N = 6400; dst = (bf16_t*)(ws + OFF_WIN); ldd = 1024; tk = t / 100; tn = t % 100; }
    else if ((t -= NT_WIN) < NT_FF1) { src = p.w_ff1 + (size_t)l * 1024 * 4096; N = 4096; dst = (bf16_t*)(ws + OFF_WFF1); ldd = 1024; tk = t / 64; tn = t % 64; }
    else if ((t -= NT_FF1) < NT_FF2) { src = p.w_ff2 + (size_t)l * 4096 * 1024; N = 1024; dst = (bf16_t*)(ws + OFF_WFF2); ldd = 4096; tk = t / 16; tn = t % 16; }
    else if ((t -= NT_FF2) < NT_OUT) { src = p.w_out + (size_t)l * 1024 * 1024; N = 1024; dst = (bf16_t*)(ws + OFF_WOUT); ldd = 1024; tk = t / 16; tn = t % 16; }
    else if ((t -= NT_OUT) < NT_BR) { const int k = t >> 6; t &= 63; src = p.w_branch + ((size_t)l * 4 + k) * 256 * 1024; N = 1024; dst = (bf16_t*)(ws + OFF_WBR) + k * 256; ldd = 1024; tk = t / 16; tn = t % 16; }
    else { t -= NT_BR; src = p.glu_w + (size_t)l * 256 * 256; N = 256; dst = (bf16_t*)(ws + OFF_WGLU); ldd = 256; tk = t / 4; tn = t % 4; }
    tr_tile(src + (size_t)tk * 64 * N + tn * 64, N, dst + (size_t)tn * 64 * ldd + tk * 64, ldd, lds);
    return;
  }
  task -= NT_TR;
  bf16_t* W2 = (bf16_t*)(ws + OFF_W2);
  bf16_t* W1 = (bf16_t*)(ws + OFF_W1);
  if (task < NT_TOEP) {
    const int g = task >> 5, lag = task & 31;
    cpx* E = (cpx*)lds;
    float* sC = lds + 256;
    float* sB = sC + 4096;
    if (tid < 128) {
      const int d = tid >> 6, pp = tid & 63; const int li = ((l * 2 + d) * 16 + g);
      const float dt = expf(p.log_dt[li]); const float lre = p.lam_re[li * 64 + pp], lim = p.lam_im[li * 64 + pp];
      E[tid] = cmul(s5_apow<true>(lre, lim, dt, (float)lag), s5_coef<false>(lre, lim, dt));
    }
    for (int i = tid; i < 4096; i += 512) {
      const int d = i >> 11, ri = (i >> 10) & 1, r = i & 1023; const int li = ((l * 2 + d) * 16 + g);
      sC[i] = (ri ? p.c_im : p.c_re)[(size_t)li * 1024 + r];
      sB[i] = (ri ? p.b_im : p.b_re)[(size_t)li * 1024 + r];
    }
    __syncthreads();
    if (tid < 256) {
      const int hp = tid >> 4, h = tid & 15;
      float kv[2];
#pragma unroll
      for (int d = 0; d < 2; ++d) {
        const float* cre = sC + d * 2048 + hp * 64; const float* cim = cre + 1024;
        const float* bre = sB + d * 2048 + h; const float* bim = bre + 1024;
        float s = 0.f;
#pragma unroll 8
        for (int pp = 0; pp < 64; ++pp) {
          const cpx bb = cmul(E[d * 64 + pp], (cpx){bre[pp * 16], bim[pp * 16]});
          s += cre[pp] * bb.re - cim[pp] * bb.im;
        }
        kv[d] = s;
      }
      float* KT_ = (float*)(ws + OFF_KTAB);
      KT_[((size_t)(g * 2 + 0) * 32 + lag) * 256 + tid] = kv[0];
      KT_[((size_t)(g * 2 + 1) * 32 + lag) * 256 + tid] = kv[1];
    }
    __syncthreads();
    return;
  }
  task -= NT_TOEP;
  if (task < NT_W2S) {
    for (int it = 0; it < 8; ++it) {
      const int idx = (task * 8 + it) * 512 + tid;
      const int pp = idx & 63, d = (idx >> 6) & 1, hp = (idx >> 7) & 15, t = (idx >> 11) & 31, g = idx >> 16;
      const int li = ((l * 2 + d) * 16 + g);
      const float dt = expf(p.log_dt[li]); const float lre = p.lam_re[li * 64 + pp], lim = p.lam_im[li * 64 + pp];
      const cpx ap = s5_apow<true>(lre, lim, dt, d == 0 ? (float)(t + 1) : (float)(TCH - t));
      const cpx cc = {p.c_re[((size_t)li * 16 + hp) * 64 + pp], p.c_im[((size_t)li * 16 + hp) * 64 + pp]};
      const cpx v = cmul(cc, ap);
      *(unsigned*)(W2 + ((size_t)g * 512 + t * 16 + hp) * 768 + 512 + d * 128 + 2 * pp) = cvt_pk_bf16(v.re, -v.im);
    }
    return;
  }
  task -= NT_W2S;
  if (task < NT_W1) {
    const int idx = task * 512 + tid;
    const int j = idx & 31, pp = (idx >> 5) & 63, d = (idx >> 11) & 1, g = idx >> 12;
    const int li = ((l * 2 + d) * 16 + g);
    const float dt = expf(p.log_dt[li]); const float lre = p.lam_re[li * 64 + pp], lim = p.lam_im[li * 64 + pp];
    const cpx e = cmul(s5_apow<true>(lre, lim, dt, d == 0 ? (float)(TCH - 1 - j) : (float)j), s5_coef<false>(lre, lim, dt));
    const float* bre = p.b_re + ((size_t)li * 64 + pp) * 16; const float* bim = p.b_im + ((size_t)li * 64 + pp) * 16;
    bf16_t* r0 = W1 + ((size_t)g * 256 + d * 128 + 2 * pp) * 512 + j * 16;
    bf16_t* r1 = r0 + 512;
#pragma unroll
    for (int h = 0; h < 16; h += 2) {
      const cpx v0 = cmul(e, (cpx){bre[h], bim[h]}), v1 = cmul(e, (cpx){bre[h + 1], bim[h + 1]});
      *(unsigned*)(r0 + h) = cvt_pk_bf16(v0.re, v1.re); *(unsigned*)(r1 + h) = cvt_pk_bf16(v0.im, v1.im);
    }
    return;
  }
  task -= NT_W1;
  {
    bf16_t* W16 = (bf16_t*)(ws + OFF_SGUWT);
    for (int it = 0; it < 4; ++it) {
      const int idx = ((task * 4 + it) * 512 + tid) * 2;
      const float* sp = p.sgu_w + (size_t)l * 65536 + idx;
      *(unsigned*)(W16 + idx) = cvt_pk_bf16(sp[0], sp[1]);
    }
  }
}


__device__ __forceinline__ bool filler_range(int wg, int G, int first, int& start, int& stride) {
  if (G > first) { if (wg < first) return false; start = wg - first; stride = G - first; return true; }
  start = wg; stride = G; return true;
}
constexpr int PT_WIN0 = 0, PT_FF0 = NT_WIN, PT_WBR0 = NT_WIN + NT_FF1 + NT_FF2 + NT_OUT, PT_G10 = PT_WBR0 + NT_BR;
constexpr int PT_NMID = NT_FF1 + NT_FF2 + NT_OUT, PT_NG1 = NT_PREP - PT_G10;

constexpr int NT_ASM = 256;
__device__ void w2_assemble_task(const P& p, int l, int task) {
  const float* KT_ = (const float*)(p.ws + OFF_KTAB);
  bf16_t* W2 = (bf16_t*)(p.ws + OFF_W2);
  const int tid = otid();
#pragma unroll
  for (int it = 0; it < 4; ++it) {
    const int idx = (task * 4 + it) * 512 + tid;
    const int hh = (idx & 1) * 8, j = (idx >> 1) & 31, row = (idx >> 6) & 511, g = idx >> 15;
    const int t = row >> 4, hp = row & 15;
    f32x4 a = {0.f, 0.f, 0.f, 0.f}, b = {0.f, 0.f, 0.f, 0.f};
    if (j <= t) { const float* k0 = KT_ + ((size_t)(g * 2 + 0) * 32 + (t - j)) * 256 + hp * 16 + hh; a += *(const f32x4*)k0; b += *(const f32x4*)(k0 + 4); }
    if (j >= t) { const float* k1 = KT_ + ((size_t)(g * 2 + 1) * 32 + (j - t)) * 256 + hp * 16 + hh; a += *(const f32x4*)k1; b += *(const f32x4*)(k1 + 4); }
    if (j == t && (hp >> 3) == (hh >> 3)) { const float dv = p.s5_d[l * 256 + g * 16 + hp]; const int e = hp & 7; if (e < 4) a[e] += dv; else b[e - 4] += dv; }
    *(u32x4*)(W2 + ((size_t)g * 512 + row) * 768 + j * 16 + hh) = pack8(a, b);
  }
}

__device__ void norm_rows(const P& p, const float* hL, const float* hC, const float* gvec, const float* modbase, int shift_idx, int nrows, const float* resmod  ) {
  const int tid = otid(); const int lane = tid & 63, wid = tid >> 6;
  bf16_t* A = (bf16_t*)(p.ws + OFF_A);
  const int stride = gridDim.x * 8;
  int row = blockIdx.x * 8 + wid;
  for (; row + 3 * stride < ML; row += 4 * stride) {
    f32x4 v[4][4]; float rstd[4];
#pragma unroll
    for (int r = 0; r < 4; ++r)
#pragma unroll
      for (int i = 0; i < 4; ++i) v[r][i] = *(const f32x4*)(hL + (size_t)(row + r * stride) * 1024 + i * 256 + lane * 4);
#pragma unroll
    for (int r = 0; r < 4; ++r) {
      float ss = 0.f;
#pragma unroll
      for (int i = 0; i < 4; ++i) ss += v[r][i][0] * v[r][i][0] + v[r][i][1] * v[r][i][1] + v[r][i][2] * v[r][i][2] + v[r][i][3] * v[r][i][3];
      ss = wave_sum(ss, lane);
      rstd[r] = rsqrtf(ss * (1.f / 1024.f) + 1e-6f);
    }
#pragma unroll
    for (int i = 0; i < 4; ++i) {
      const int c = i * 256 + lane * 4;
      const f32x4 g = *(const f32x4*)(gvec + c);
#pragma unroll
      for (int r = 0; r < 4; ++r) {
        const int rr = row + r * stride;
        const float* sh = modbase + (size_t)(rr >> 11) * 6144 + shift_idx * 1024;
        const f32x4 s1 = *(const f32x4*)(sh + 1024 + c), s0 = *(const f32x4*)(sh + c);
        f32x4 y;
#pragma unroll
        for (int q = 0; q < 4; ++q) y[q] = (v[r][i][q] * rstd[r] * g[q]) * (1.f + s1[q]) + s0[q];
        u32x2 o; o[0] = cvt_pk_bf16(y[0], y[1]); o[1] = cvt_pk_bf16(y[2], y[3]);
        *(u32x2*)(A + (size_t)rr * 1024 + c) = o;
      }
    }
  }
  for (; row < nrows; row += stride) {
    const float* h = row < ML ? hL + (size_t)row * 1024 : hC + (size_t)(row - ML) * 1024;
    const int bsel = row < ML ? (row >> 11) : 8;
    const float* sh = modbase + (size_t)bsel * 6144 + shift_idx * 1024; const float* sc = sh + 1024;
    f32x4 v[4]; float ss = 0.f;
#pragma unroll
    for (int i = 0; i < 4; ++i) v[i] = *(const f32x4*)(h + i * 256 + lane * 4);
    if (resmod && row >= ML) {
      const bf16_t* pr = (const bf16_t*)(p.ws + OFF_PART) + (size_t)(row - ML) * 1024;
      float* hw = (float*)(p.ws + OFF_H) + (size_t)row * 1024;
#pragma unroll
      for (int i = 0; i < 4; ++i) {
        const int c = i * 256 + lane * 4;
        f32x4 sm = {0.f, 0.f, 0.f, 0.f};
#pragma unroll
        for (int sl = 0; sl < 8; ++sl) { const u32x2 w = *(const u32x2*)(pr + (size_t)sl * MC * 1024 + c); sm[0] += bflo(w[0]); sm[1] += bfhi(w[0]); sm[2] += bflo(w[1]); sm[3] += bfhi(w[1]); }
        v[i] += *(const f32x4*)(resmod + c) * sm;
        *(f32x4*)(hw + c) = v[i];
      }
    }
#pragma unroll
    for (int i = 0; i < 4; ++i) ss += v[i][0] * v[i][0] + v[i][1] * v[i][1] + v[i][2] * v[i][2] + v[i][3] * v[i][3];
    ss = wave_sum(ss, lane);
    const float rstd = rsqrtf(ss * (1.f / 1024.f) + 1e-6f);
#pragma unroll
    for (int i = 0; i < 4; ++i) {
      const int c = i * 256 + lane * 4;
      const f32x4 g = *(const f32x4*)(gvec + c), s1 = *(const f32x4*)(sc + c), s0 = *(const f32x4*)(sh + c);
      f32x4 y;
#pragma unroll
      for (int q = 0; q < 4; ++q) y[q] = (v[i][q] * rstd * g[q]) * (1.f + s1[q]) + s0[q];
      u32x2 o; o[0] = cvt_pk_bf16(y[0], y[1]); o[1] = cvt_pk_bf16(y[2], y[3]);
      *(u32x2*)(A + (size_t)row * 1024 + c) = o;
    }
  }
}

__device__ void final_rows(const P& p) {
  const int tid = otid(); const int lane = tid & 63, wid = tid >> 6;
  const float* H = (const float*)(p.ws + OFF_H);
  const int stride = gridDim.x * 8;
  for (int row = blockIdx.x * 8 + wid; row < ML; row += 4 * stride) {
    f32x4 v[4][4];
#pragma unroll
    for (int r = 0; r < 4; ++r)
#pragma unroll
      for (int i = 0; i < 4; ++i) { const int rr = row + r * stride; v[r][i] = rr < ML ? *(const f32x4*)(H + (size_t)rr * 1024 + i * 256 + lane * 4) : (f32x4){0.f, 0.f, 0.f, 0.f}; }
#pragma unroll
    for (int r = 0; r < 4; ++r) {
      const int rr = row + r * stride;
      float ss = 0.f;
#pragma unroll
      for (int i = 0; i < 4; ++i) ss += v[r][i][0] * v[r][i][0] + v[r][i][1] * v[r][i][1] + v[r][i][2] * v[r][i][2] + v[r][i][3] * v[r][i][3];
      ss = wave_sum(ss, lane);
      const float rstd = rsqrtf(ss * (1.f / 1024.f) + 1e-6f);
      if (rr < ML) {
#pragma unroll
        for (int i = 0; i < 4; ++i) {
          const int c = i * 256 + lane * 4;
          const f32x4 g = *(const f32x4*)(p.final_g + c);
          f32x4 y;
#pragma unroll
          for (int q = 0; q < 4; ++q) y[q] = v[r][i][q] * rstd * g[q];
          *(f32x4*)(p.out + (size_t)rr * 1024 + c) = y;
        }
      }
    }
  }
}

template <bool LAT>
__device__ __forceinline__ void attn_task(const P& p, int task, int l, const float* rpb_lds, int lane) {
  constexpr int NG = LAT ? 16 : 8;
  task = __builtin_amdgcn_readfirstlane(task);
  const bf16_t* PS = (const bf16_t*)(p.ws + OFF_PS);
  const bf16_t* VT = (const bf16_t*)(p.ws + OFF_VT);
  const bf16_t* KT = (const bf16_t*)(p.ws + OFF_KT);
  bf16_t* Y4 = (bf16_t*)(p.ws + OFF_Y4);
  int b, head, r = 0, jb = 0, qrow0;
  if (LAT) { jb = task & 3; r = (task >> 2) & 31; head = (task >> 7) & 3; b = task >> 9; qrow0 = b * 2048 + r * 64 + jb * 16; }
  else { const int qb = task & 15; head = (task >> 4) & 3; b = task >> 6; qrow0 = ML + b * 256 + qb * 16; }
  const int n = lane & 15, kg = lane >> 4;
  const bf16_t* qp = PS + (size_t)(qrow0 + n) * 2304 + 256 + head * 64 + kg * 8;
  const bf16x8 q0 = *(const bf16x8*)qp, q1 = *(const bf16x8*)(qp + 32);
  const int rs = LAT ? min(max(r - 4, 0), 24) : 0;
  const int clo = LAT ? (jb == 0 ? 0 : jb == 1 ? 8 : jb == 2 ? 24 : 32) : 0;
  const int keyX = 8 * (n >> 2) + (n & 3);
  const char* kub = (const char*)(KT + (size_t)(b * 4 + head) * 2304 * 64);
  const char* vub = (const char*)(VT + (size_t)(b * 4 + head) * 288 * 512);
  const unsigned klo = (unsigned)(keyX * 64 + kg * 8) * 2u, vlo = (unsigned)(kg * 512 + n * 8) * 2u;
  const int jq = jb * 16 + n; const int cs = min(max(jq - 8, 0), 48);
  bf16x8 kf[2][2][4], vf[2][2][4];
#define ATT_TK0(gi) ((LAT && (gi) < 8) ? (rs + (gi)) * 64 + clo : 2048 + ((gi) - (LAT ? 8 : 0)) * 32)
#define ATT_LOADK(sl, gb) _Pragma("unroll") for (int g2 = 0; g2 < 2; ++g2) { const char* kp = kub + (size_t)ATT_TK0((gb) + g2) * 128; \
    kf[sl][g2][0] = *(const bf16x8*)(kp + klo); kf[sl][g2][1] = *(const bf16x8*)(kp + 64 + klo); kf[sl][g2][2] = *(const bf16x8*)(kp + 512 + klo); kf[sl][g2][3] = *(const bf16x8*)(kp + 576 + klo); }
#define ATT_LOADV(sl, gb) _Pragma("unroll") for (int g2 = 0; g2 < 2; ++g2) { const char* vp = vub + (size_t)(ATT_TK0((gb) + g2) >> 3) * 1024; \
    _Pragma("unroll") for (int db = 0; db < 4; ++db) vf[sl][g2][db] = *(const bf16x8*)(vp + db * 256 + vlo); }
#define ATT_BATCH(sl, gb) do { \
    f32x4 s[2][2]; \
    _Pragma("unroll") for (int g2 = 0; g2 < 2; ++g2) { f32x4 z = {0.f, 0.f, 0.f, 0.f}; \
      s[g2][0] = __builtin_amdgcn_mfma_f32_16x16x32_bf16(kf[sl][g2][0], q0, z, 0, 0, 0); s[g2][0] = __builtin_amdgcn_mfma_f32_16x16x32_bf16(kf[sl][g2][1], q1, s[g2][0], 0, 0, 0); \
      s[g2][1] = __builtin_amdgcn_mfma_f32_16x16x32_bf16(kf[sl][g2][2], q0, z, 0, 0, 0); s[g2][1] = __builtin_amdgcn_mfma_f32_16x16x32_bf16(kf[sl][g2][3], q1, s[g2][1], 0, 0, 0); } \
    if ((gb) + 4 < NG) { ATT_LOADK(sl, (gb) + 4); } \
    float bm = -3.0e38f; \
    if (LAT && (gb) < 8) { \
      _Pragma("unroll") for (int g2 = 0; g2 < 2; ++g2) { const float* brow = rpb_lds + (head * 15 + (rs + (gb) + g2 - r + 7)) * 31; \
        _Pragma("unroll") for (int blk = 0; blk < 2; ++blk) _Pragma("unroll") for (int i = 0; i < 4; ++i) { \
          const int kc = clo + 8 * kg + blk * 4 + i; const bool ok = (kc >= cs) && (kc < cs + 16); const int dc = min(max(kc - jq + 15, 0), 30); \
          const float v = ok ? s[g2][blk][i] * 0.125f + brow[dc] : -1.0e30f; s[g2][blk][i] = v; bm = fmaxf(bm, v); } } \
    } else { \
      _Pragma("unroll") for (int g2 = 0; g2 < 2; ++g2) _Pragma("unroll") for (int blk = 0; blk < 2; ++blk) _Pragma("unroll") for (int i = 0; i < 4; ++i) { \
        const float v = s[g2][blk][i] * 0.125f; s[g2][blk][i] = v; bm = fmaxf(bm, v); } \
    } \
    bm = fmaxf(bm, shx(bm, 16, lane)); bm = fmaxf(bm, shx(bm, 32, lane)); \
    const float mnew = fmaxf(mrun, bm); const float alpha = __expf(mrun - mnew); \
    float ps = 0.f; \
    _Pragma("unroll") for (int g2 = 0; g2 < 2; ++g2) _Pragma("unroll") for (int blk = 0; blk < 2; ++blk) _Pragma("unroll") for (int i = 0; i < 4; ++i) { \
      const float e = __expf(s[g2][blk][i] - mnew); s[g2][blk][i] = e; ps += e; } \
    sum = sum * alpha + ps; mrun = mnew; \
    _Pragma("unroll") for (int db = 0; db < 4; ++db) o[db] *= alpha; \
    _Pragma("unroll") for (int g2 = 0; g2 < 2; ++g2) { const u32x4 pk = pack8(s[g2][0], s[g2][1]); bf16x8 pf; __builtin_memcpy(&pf, &pk, 16); \
      _Pragma("unroll") for (int db = 0; db < 4; ++db) o[db] = __builtin_amdgcn_mfma_f32_16x16x32_bf16(vf[sl][g2][db], pf, o[db], 0, 0, 0); } \
    if ((gb) + 4 < NG) { ATT_LOADV(sl, (gb) + 4); } \
  } while (0)
  ATT_LOADK(0, 0); ATT_LOADV(0, 0); ATT_LOADK(1, 2); ATT_LOADV(1, 2);
  float mrun = -3.0e38f, sum = 0.f;
  f32x4 o[4];
#pragma unroll
  for (int db = 0; db < 4; ++db) o[db] = (f32x4){0.f, 0.f, 0.f, 0.f};
#pragma unroll 1
  for (int gq = 0; gq < NG; gq += 4) {
    ATT_BATCH(0, gq);
    ATT_BATCH(1, gq + 2);
  }
#undef ATT_TK0
#undef ATT_LOADK
#undef ATT_LOADV
#undef ATT_BATCH
  sum += shx(sum, 16, lane); sum += shx(sum, 32, lane);
  const float inv = 1.f / sum;
  bf16_t* op = Y4 + (size_t)(qrow0 + n) * 1024 + 256 + head * 64 + kg * 4;
#pragma unroll
  for (int db = 0; db < 4; ++db) {
    u32x2 w; w[0] = cvt_pk_bf16(o[db][0] * inv, o[db][1] * inv); w[1] = cvt_pk_bf16(o[db][2] * inv, o[db][3] * inv);
    *(u32x2*)(op + db * 16) = w;
  }
}

__device__ __forceinline__ void conv_task(const P& p, int l, int task) {
  const bf16_t* PS = (const bf16_t*)(p.ws + OFF_PS);
  bf16_t* Y4 = (bf16_t*)(p.ws + OFF_Y4);
  const int idx = task * 512 + otid();
  const int row = idx >> 5, c0 = (idx & 31) * 8;
  int pos, len; if (row < ML) { pos = row & 2047; len = 2048; } else { pos = (row - ML) & 255; len = 256; }
  const bf16_t* base = PS + (size_t)row * 2304;
  float z[3][8];
#pragma unroll
  for (int d = 0; d < 3; ++d) {
    const int pp = pos + d - 1;
    if (pp >= 0 && pp < len) {
      const u32x4 cv = *(const u32x4*)(base + (d - 1) * 2304 + 5 * 256 + c0), xv = *(const u32x4*)(base + (d - 1) * 2304 + 6 * 256 + c0);
#pragma unroll
      for (int i = 0; i < 4; ++i) { z[d][2 * i] = bflo(cv[i]) * bflo(xv[i]); z[d][2 * i + 1] = bfhi(cv[i]) * bfhi(xv[i]); }
    } else {
#pragma unroll
      for (int i = 0; i < 8; ++i) z[d][i] = 0.f;
    }
  }
  const u32x4 bv = *(const u32x4*)(base + 4 * 256 + c0);
  const float* w = p.conv_w + (size_t)l * 3 * 256 + c0;
  float y[8];
#pragma unroll
  for (int i = 0; i < 8; ++i) y[i] = w[i] * z[0][i] + w[256 + i] * z[1][i] + w[512 + i] * z[2][i];
  u32x4 o;
#pragma unroll
  for (int i = 0; i < 4; ++i) o[i] = cvt_pk_bf16(bflo(bv[i]) * y[2 * i], bfhi(bv[i]) * y[2 * i + 1]);
  *(u32x4*)(Y4 + (size_t)row * 1024 + 512 + c0) = o;
}

__device__ void sgu_task(const P& p, int l, int task, float* lds) {
  const int tid = otid();
  const bf16_t* PS = (const bf16_t*)(p.ws + OFF_PS);
  bf16_t* Y4 = (bf16_t*)(p.ws + OFF_Y4);
  const bf16_t* W16 = (const bf16_t*)(p.ws + OFF_SGUWT);
  const int chunk = task >> 2, g = task & 3;
  bf16_t* vnT = (bf16_t*)lds;
  constexpr int VS = 136;
  {
    const int s = tid >> 2, q = tid & 3;
    const bf16_t* vr = PS + (size_t)(chunk * 128 + s) * 2304 + 8 * 256;
    float sm = 0.f, sq = 0.f;
#pragma unroll
    for (int i = 0; i < 8; ++i) {
      const u32x4 v = *(const u32x4*)(vr + q * 64 + i * 8);
#pragma unroll
      for (int k = 0; k < 4; ++k) { const float a = bflo(v[k]), b = bfhi(v[k]); sm += a + b; sq += a * a + b * b; }
    }
    { const int ln = tid & 63; sm += shx(sm, 1, ln); sm += shx(sm, 2, ln); sq += shx(sq, 1, ln); sq += shx(sq, 2, ln); }
    const float mu = sm * (1.f / 256.f); const float var = fmaxf(sq * (1.f / 256.f) - mu * mu, 0.f); const float rstd = rsqrtf(var + 1e-6f);
    const int cb = g * 64 + q * 16;
    const float* lg = p.ln_g + l * 256 + cb; const float* lb = p.ln_b + l * 256 + cb;
#pragma unroll
    for (int i = 0; i < 2; ++i) {
      const u32x4 v = *(const u32x4*)(vr + cb + i * 8);
#pragma unroll
      for (int k = 0; k < 4; ++k) {
        const int cc = i * 8 + 2 * k;
        const unsigned pk = cvt_pk_bf16((bflo(v[k]) - mu) * rstd * lg[cc] + lb[cc], (bfhi(v[k]) - mu) * rstd * lg[cc + 1] + lb[cc + 1]);
        vnT[(q * 16 + cc) * VS + s] = (bf16_t)(pk & 0xffffu);
        vnT[(q * 16 + cc + 1) * VS + s] = (bf16_t)(pk >> 16);
      }
    }
  }
  __syncthreads();
  const int lane = tid & 63, w = tid >> 6, n = lane & 15, kg = lane >> 4;
  const int t = w * 16 + n;
  const bf16_t* wp = W16 + ((size_t)(g * 128 + t)) * 128 + kg * 8;
  bf16x8 wf[4];
#pragma unroll
  for (int ks = 0; ks < 4; ++ks) wf[ks] = *(const bf16x8*)(wp + ks * 32);
  f32x4 acc[4];
#pragma unroll
  for (int cb = 0; cb < 4; ++cb) {
    acc[cb] = (f32x4){0.f, 0.f, 0.f, 0.f};
#pragma unroll
    for (int ks = 0; ks < 4; ++ks) {
      const bf16x8 vf = *(const bf16x8*)(vnT + (cb * 16 + n) * VS + ks * 32 + kg * 8);
      acc[cb] = __builtin_amdgcn_mfma_f32_16x16x32_bf16(vf, wf[ks], acc[cb], 0, 0, 0);
    }
  }
  const int row = chunk * 128 + t;
  const float bs = p.sgu_b[((size_t)l * 4 + g) * 128 + t];
#pragma unroll
  for (int cb = 0; cb < 4; ++cb) {
    const int c = g * 64 + cb * 16 + kg * 4;
    const u32x2 uv = *(const u32x2*)(PS + (size_t)row * 2304 + 7 * 256 + c);
    u32x2 o; o[0] = cvt_pk_bf16(bflo(uv[0]) * (acc[cb][0] + bs), bfhi(uv[0]) * (acc[cb][1] + bs)); o[1] = cvt_pk_bf16(bflo(uv[1]) * (acc[cb][2] + bs), bfhi(uv[1]) * (acc[cb][3] + bs));
    *(u32x2*)(Y4 + (size_t)row * 1024 + 768 + c) = o;
  }
  __syncthreads();
}

__device__ void carry_phase(const P& p, int l) {
  const int gt = blockIdx.x * 512 + otid();
  if (gt >= 16 * 8 * 2 * 64) return;
  const int pp = gt & 63, d = (gt >> 6) & 1, b = (gt >> 7) & 7, g = gt >> 10;
  const float* S = (const float*)(p.ws + OFF_S) + (size_t)g * NCHUNK * 256 + d * 128 + 2 * pp;
  bf16_t* XU = (bf16_t*)(p.ws + OFF_XU) + (size_t)g * XUR * XUK + 512 + d * 128 + 2 * pp;
  const int li = ((l * 2 + d) * 16 + g);
  const float dt = expf(p.log_dt[li]);
  const cpx aT = s5_apow<false>(p.lam_re[li * 64 + pp], p.lam_im[li * 64 + pp], dt, (float)TCH);
  cpx st = {0.f, 0.f};
  for (int i0 = 0; i0 < 72; i0 += 8) {
    float sre[8], sim[8]; int rows[8];
#pragma unroll
    for (int k = 0; k < 8; ++k) {
      const int i = i0 + k; int row;
      if (i < 8) row = 512 + b * 8 + (d == 0 ? i : 7 - i); else row = b * 64 + (d == 0 ? (i - 8) : 63 - (i - 8));
      rows[k] = row; const float2 v = *(const float2*)(S + (size_t)row * 256); sre[k] = v.x; sim[k] = v.y;
    }
#pragma unroll
    for (int k = 0; k < 8; ++k) {
      *(unsigned*)(XU + (size_t)rows[k] * XUK) = cvt_pk_bf16(st.re, st.im);
      const cpx ns = cmul(aT, st); st.re = ns.re + sre[k]; st.im = ns.im + sim[k];
    }
  }
}

constexpr int PH_PER_LAYER = 11;
constexpr int N_PHASES = 1 + NDEPTH * PH_PER_LAYER + 1;

__global__ void __launch_bounds__(512, 2) mk_forward(P p_arg) {
  extern __shared__ __attribute__((aligned(16))) unsigned char shm[];
  LAS unsigned char* lds = (LAS unsigned char*)shm;
  float* ldsf = (float*)shm;
  unsigned char* ws0 = p_arg.ws;
  volatile LAS unsigned* xbw = (volatile LAS unsigned*)(lds + 131072);
  if (threadIdx.x == 0) { xbw[0] = 0u; xbw[1] = 0u; xbw[2] = 0u; xbw[3] = 0u; }
  __syncthreads();
  const XcdBarrier xb = xcd_barrier_post((unsigned*)(ws0 + OFF_BAR), xbw);
  if (p_arg.ph_lo < 0) cg::this_grid().sync();

  for (int ph = p_arg.ph_lo; ph < p_arg.ph_hi; ++ph) {
    int nrep = 1;
#if DBL_MASK
    { const int spx = (ph == 0) ? 11 : (ph == N_PHASES - 1) ? 13 : (ph - 1) % PH_PER_LAYER; if ((DBL_MASK >> spx) & 1) nrep = 2; }
#endif
    for (int rep = 0; rep < nrep; ++rep) {
    if (rep) xcd_barrier(xb);
    int G_ = gridDim.x, wg_ = blockIdx.x; asm volatile("" : "+s"(G_), "+s"(wg_));
    const int G = G_, wg = wg_;
    unsigned char* ws = ws0; asm volatile("" : "+s"(ws));
    P p = p_arg; p.ws = ws;
    float* H = (float*)(ws + OFF_H);
    const float* MOD = (const float*)(ws + OFF_MOD);
    if (ph == 0) {
      for (int t = wg; t < 192; t += G) mod_task(p, t, ldsf);
      { const int t0 = (wg + G - (192 % G)) % G;
        tr_loop(p, 0, 0, t0, NT_WIN, G, ldsf);
        const int r = (NT_WIN - t0 + G - 1) / G; tr_loop(p, 0, PT_WBR0, t0 + r * G - NT_WIN, NT_BR, G, ldsf); }
    } else if (ph == N_PHASES - 1) {
      final_rows(p);
#if TSEL
      xcd_barrier(xb);
      if (wg == 0) { const unsigned long long* ts = (const unsigned long long*)(ws + OFF_BAR + 14336); const unsigned long long v = ts[TSEL - 1]; const int N = (int)(TSEL == 3 ? v * 1000 : v / 10);
        for (int i = otid(); i < N && i < 300000; i += 512) p.out[(size_t)i * 16] += 0.125f; }
#endif
    } else {
      const int l = (ph - 1) / PH_PER_LAYER, sp = (ph - 1) % PH_PER_LAYER;
      const bool last = (l == NDEPTH - 1);
      const float* hL = l == 0 ? p.x : H; const float* hC = l == 0 ? p.ctx : H + (size_t)ML * 1024;
      const float* modl = MOD + (size_t)l * 9 * 6144;
      const int nMrows = last ? 64 : 72;
      switch (sp) {
#if PHMASK & 1
        case 0: {
          for (int t = wg; t < PT_NG1; t += G) prep_task(p, l, PT_G10 + t, ldsf);
          norm_rows(p, hL, hC, p.norm_g + (size_t)(l * 2 + 0) * 1024, modl, 0, MT, l > 0 ? MOD + ((size_t)(l - 1) * 9 + 8) * 6144 + 5 * 1024 : nullptr);
        } break;
#endif
#if PHMASK & 2
        case 1: {
          G1Sched S{(const char*)(ws + OFF_A), (const char*)(ws + OFF_WIN), G, wg, last ? 1 : 0};
          EpiG1 E{(bf16_t*)(ws + OFF_PS), (bf16_t*)(ws + OFF_XU), (bf16_t*)(ws + OFF_VT), (bf16_t*)(ws + OFF_KT)};
          gemm_phase(lds, 1024, 1024, S, E, (TSEL && TPHASE == 1 && wg == 0) ? (unsigned long long*)(ws + OFF_BAR + 14336) : nullptr);
          { int st, sd; if (filler_range(wg, G, 136, st, sd)) for (int t = st; t < NT_ASM; t += sd) w2_assemble_task(p, l, t); }
        } break;
#endif
#if PHMASK & 4
        case 2: {
          {
            S5Sched S{(const char*)(ws + OFF_XU), (const char*)(ws + OFF_W1), (size_t)256 * 512 * 2, 0, 3, 1, 8, G, wg};
            EpiS1 E{(float*)(ws + OFF_S)};
            gemm_phase(lds, XUK, 512, S, E);
          }
          __syncthreads();
          const int tid2 = otid(), lane2 = tid2 & 63, wid2 = tid2 >> 6;
          for (int i = tid2; i < 4 * 15 * 31; i += 512) ldsf[i] = p.rpb[(size_t)l * 4 * 15 * 31 + i];
          __syncthreads();
          const int nwaves = G * 8, gw = wg * 8 + wid2;
#if TSEL
          unsigned long long* tsl = (unsigned long long*)(ws + OFF_BAR + 14336); const unsigned long long tq0 = __builtin_amdgcn_s_memrealtime();
#endif
          for (int t = gw; t < 4096; t += nwaves) attn_task<true>(p, t, l, ldsf, lane2);
          if (!last) for (int t = nwaves - 1 - gw; t < 512; t += nwaves) attn_task<false>(p, t, l, ldsf, lane2);
#if TSEL
          __syncthreads(); const unsigned long long tq1 = __builtin_amdgcn_s_memrealtime();
#endif
        } break;
#endif
#if PHMASK & 8
        case 3: {
          carry_phase(p, l);
          const int nconv = (last ? ML : MT) * 32 / 512;
          int st, sd; if (filler_range(wg, G, 32, st, sd)) for (int t = st; t < nconv; t += sd) conv_task(p, l, t);
        } break;
#endif
#if PHMASK & 16
        case 4: {
          S5Sched S{(const char*)(ws + OFF_XU), (const char*)(ws + OFF_W2), (size_t)512 * 768 * 2, (size_t)256 * 768 * 2, last ? 2 : 3, 2, 12, G, wg};
          EpiS2 E{(bf16_t*)(ws + OFF_YG), last ? 512 : NCHUNK};
          gemm_phase(lds, XUK, 768, S, E);
          const int nsgu = (last ? 128 : 144) * 4;
          { int st, sd; if (filler_range(wg, G, 96, st, sd)) { __syncthreads(); for (int t = st; t < nsgu / 2; t += sd) sgu_task(p, l, t, ldsf); } }
        } break;
#endif
#if PHMASK & 32
        case 5: {
          RectSched S{(const char*)(ws + OFF_YG), (const char*)(ws + OFF_WGLU), (size_t)256 * 256 * 2, 0, nMrows, 1, 4, G, wg};
          EpiGLU E{(const bf16_t*)(ws + OFF_YG), p.glu_b + l * 256, (bf16_t*)(ws + OFF_Y4)};
          gemm_phase(lds, 256, 256, S, E);
          const int nsgu = (last ? 128 : 144) * 4;
          { int st, sd; if (filler_range(wg, G, 72, st, sd)) { __syncthreads(); for (int t = nsgu / 2 + st; t < nsgu; t += sd) sgu_task(p, l, t, ldsf); } }
        } break;
#endif
#if PHMASK & 64
        case 6: {
          MergeSched S{(const char*)(ws + OFF_A), (const char*)(ws + OFF_Y4), (const char*)(ws + OFF_WIN), (const char*)(ws + OFF_WBR), last ? 0 : 128, G, wg};
          EpiMerge E{ws + OFF_GS + (size_t)wg * 65536, (bf16_t*)(ws + OFF_MIXTMP + (size_t)wg * 131072), (bf16_t*)(ws + OFF_MIX), (bf16_t*)(ws + OFF_GP)};
          gemm_phase(lds, 1024, 1024, S, E, (TSEL && TPHASE == 6 && wg == 0) ? (unsigned long long*)(ws + OFF_BAR + 14336) : nullptr);
          { int st, sd; if (filler_range(wg, G, last ? 0 : 128, st, sd)) tr_loop(p, l, PT_FF0, st, PT_NMID, sd, ldsf); }
        } break;
#endif
#if PHMASK & 128
        case 7: {
          WoutSched S{(const char*)(ws + OFF_MIX), (const char*)(ws + OFF_GP), (const char*)(ws + OFF_WOUT), last ? 0 : 256, G, wg};
          EpiRes E{hL, hC, H, modl, 2, (float*)(ws + OFF_PART)};
          gemm_phase(lds, 1024, 1024, S, E);
        } break;
#endif
#if PHMASK & 256
        case 8: {
          norm_rows(p, H, l == 0 ? p.ctx : H + (size_t)ML * 1024, p.norm_g + (size_t)(l * 2 + 1) * 1024, modl, 3, last ? ML : MT, modl + (size_t)8 * 6144 + 2 * 1024);
          if (!last) for (int t = wg; t < NT_BR; t += G) prep_task(p, l + 1, PT_WBR0 + t, ldsf);
        } break;
#endif
#if PHMASK & 512
        case 9: {
          RectSched S{(const char*)(ws + OFF_A), (const char*)(ws + OFF_WFF1), (size_t)256 * 1024 * 2, (size_t)256 * 1024 * 2, nMrows, 16, 16, G, wg};
          EpiFF1 E{(bf16_t*)(ws + OFF_FFH)};
          gemm_phase(lds, 1024, 1024, S, E, (TSEL && TPHASE == 9 && wg == 0) ? (unsigned long long*)(ws + OFF_BAR + 14336) : nullptr);
          if (!last) { int st, sd; if (filler_range(wg, G, 128, st, sd)) tr_loop(p, l + 1, 0, st, NT_WIN, sd, ldsf); }
        } break;
#endif
#if PHMASK & 1024
        case 10: {
          SplitSched S{(const char*)(ws + OFF_FFH), (const char*)(ws + OFF_WFF2), (const char*)(ws + OFF_FFH) + (size_t)64 * 256 * 4096 * 2, (size_t)256 * 4096 * 2, (size_t)256 * 4096 * 2, (size_t)256 * 4096 * 2, 64, 8, 256, last ? 0 : 256, G, wg};
          EpiRes E{H, H + (size_t)ML * 1024, H, modl, 5, (float*)(ws + OFF_PART)};
          gemm_phase(lds, 4096, 4096, S, E);
        } break;
#endif
      }
    }
    }
    if (ph + 1 < p_arg.ph_hi) { xcd_barrier(xb);
#if (DBL_MASK >> 12) & 1
      xcd_barrier(xb);
#endif
    }
  }
}

extern "C" void kernel_launch(void* const* d_in, const int* in_sizes, int n_in, void* d_out, int out_size, void* d_ws, size_t ws_size, hipStream_t stream) {
  constexpr size_t kDynLds = 131072 + 16;
  static int grid_blocks = 0;
  if (!grid_blocks) {
    (void)hipFuncSetAttribute((const void*)mk_forward, hipFuncAttributeMaxDynamicSharedMemorySize, (int)kDynLds);
    int dev = 0, cus = 0, per_cu = 0;
    (void)hipGetDevice(&dev);
    (void)hipDeviceGetAttribute(&cus, hipDeviceAttributeMultiprocessorCount, dev);
    (void)hipOccupancyMaxActiveBlocksPerMultiprocessor(&per_cu, mk_forward, 512, kDynLds);
    if (per_cu < 1) per_cu = 1;
    grid_blocks = cus;
  }
  P p{};
  const float** pp = (const float**)&p;
  for (int i = 0; i < 29; ++i) pp[i] = (const float*)d_in[i];
  p.out = (float*)d_out; p.ws = (unsigned char*)d_ws;
  (void)hipMemsetAsync((unsigned char*)d_ws + OFF_BAR, 0, 16384, stream);
#if MULTI_LAUNCH
  for (int ph = 0; ph < N_PHASES; ++ph) {
    p.ph_lo = ph; p.ph_hi = ph + 1;
    hipLaunchKernelGGL(mk_forward, dim3(grid_blocks), dim3(512), kDynLds, stream, p);
  }
#else
  p.ph_lo = 0; p.ph_hi = N_PHASES;
  void* args[] = {&p};
  (void)hipLaunchCooperativeKernel((void*)mk_forward, dim3(grid_blocks), dim3(512), args, kDynLds, stream);
#endif
}
```
